# Optimizing an MI355X kernel written in HIP

```python
import math
import jax
import jax.numpy as jnp
from jax import lax
import numpy as np

D_MODEL = 1024
BATCH = 4
SEQ = 8192
DEPTH = 1

GRID_W = 64
CTX_LEN = 256
RG_WIDTH = 1024
RG_HEADS = 16
RG_HEAD_DIM = RG_WIDTH // RG_HEADS
RG_CONV_W = 4
RG_CONV_LEFT = 2
RG_C = 8.0
HY_WIDTH = 1024
HY_CONV_W = 3
HY_CONV_LEFT = 1
HY_SEQ_BANDS = 16
HY_COL_BANDS = 8
HY_EMB_DIM = 1 + 2 * HY_SEQ_BANDS + 1 + 2 * HY_COL_BANDS
HY_FILTER_HIDDEN = 64
HY_DECAY_TARGET = 1e-2
HY_FAST_DECAY = 0.3
HY_SLOW_DECAY = 1.5
N_GROUPS = 4
EXPERTS_PER_GROUP = 8
N_EXPERTS = N_GROUPS * EXPERTS_PER_GROUP
TOP_K = 2
D_EXPERT = 512
MOE_BLOCK = 256
N_MOD = 6
EPS = 1e-6
IN_COLS = 2 * RG_WIDTH + 3 * HY_WIDTH + 2 * D_MODEL
IN_SPLITS = (RG_WIDTH, 2 * RG_WIDTH, 2 * RG_WIDTH + 3 * HY_WIDTH,
             2 * RG_WIDTH + 3 * HY_WIDTH + D_MODEL)

kernel_name = 'hybrid_rglru_hyena_hmoe_dit_block'


def rmsnorm(x, g):
    xf = x.astype(jnp.float32)
    y = xf * lax.rsqrt(jnp.mean(xf * xf, axis=-1, keepdims=True) + EPS)
    return (y * g.astype(jnp.float32)).astype(x.dtype)


def modulate(h, shift, scale):
    return h * (1.0 + scale[..., None, :]) + shift[..., None, :]


def dwconv_centred(x, w, b, left):
    k, L = w.shape[0], x.shape[1]
    xp = jnp.pad(x, ((0, 0), (left, k - 1 - left), (0, 0)))
    y = b + xp[:, 0:L] * w[0]
    for j in range(1, k):
        y = y + xp[:, j:j + L] * w[j]
    return y


def rglru_coeffs(xc, wa, ba, wx, bx, lam):
    B, L, W = xc.shape
    xh = xc.reshape(B, L, RG_HEADS, RG_HEAD_DIM)
    r = jax.nn.sigmoid(jnp.einsum('blhd,hde->blhe', xh, wa).reshape(B, L, W) + ba)
    i = jax.nn.sigmoid(jnp.einsum('blhd,hde->blhe', xh, wx).reshape(B, L, W) + bx)
    log_a = -RG_C * r.astype(jnp.float32) * jax.nn.softplus(-lam.astype(jnp.float32))
    a = jnp.exp(log_a)
    b = jnp.sqrt(-jnp.expm1(2.0 * log_a)) * (i * xc).astype(jnp.float32)
    return a, b


def _scan_op(left, right):
    a_l, b_l = left
    a_r, b_r = right
    return a_r * a_l, a_r * b_l + b_r


def linear_scan(a, b, h0, reverse):
    idx = -1 if reverse else 0
    b = b.at[:, idx].add(a[:, idx] * h0)
    _, h = lax.associative_scan(_scan_op, (a, b), reverse=reverse, axis=1)
    return h


def bidir_rglru(xc, h0_f, h0_b, rg_f, rg_b):
    a_f, b_f = rglru_coeffs(xc, *rg_f)
    a_b, b_b = rglru_coeffs(xc, *rg_b)
    h_f = linear_scan(a_f, b_f, h0_f, False)
    h_b = linear_scan(a_b, b_b, h0_b, True)
    return h_f, h_b


def hyena_filter(L, rows, w1, b1, w2, b2, freq, w3):
    f32 = jnp.float32
    s = jnp.arange(L, dtype=jnp.int32)
    sf = s.astype(f32)
    t_norm = sf / max(L - 1, 1)
    seq_bands = jnp.linspace(1e-4, HY_SEQ_BANDS - 1, HY_SEQ_BANDS, dtype=f32)
    ang = (2.0 * math.pi / L) * sf[:, None] * seq_bands[None, :]
    if rows is None:
        grid = jnp.zeros((L, 1 + 2 * HY_COL_BANDS), f32)
    else:
        row_lag = (s // GRID_W).astype(f32) / rows
        col_bands = jnp.arange(1, HY_COL_BANDS + 1, dtype=f32)
        col_ang = (2.0 * math.pi / GRID_W) * (s % GRID_W).astype(f32)[:, None] * col_bands[None, :]
        grid = jnp.concatenate([row_lag[:, None], jnp.cos(col_ang), jnp.sin(col_ang)], axis=-1)
    feats = jnp.concatenate([t_norm[:, None], jnp.cos(ang), jnp.sin(ang), grid], axis=-1)
    fr = freq.astype(f32)
    z = jnp.sin(fr * (feats @ w1.astype(f32) + b1.astype(f32)))
    z = jnp.sin(fr * (z @ w2.astype(f32) + b2.astype(f32)))
    k = z @ w3.astype(f32)
    max_decay = math.log(HY_DECAY_TARGET) / HY_FAST_DECAY
    min_decay = math.log(HY_DECAY_TARGET) / HY_SLOW_DECAY
    deltas = jnp.abs(jnp.linspace(min_decay, max_decay, HY_WIDTH, dtype=f32))
    decay = jnp.exp(-t_norm[:, None] * deltas[None, :])
    k_fwd = k[:, :HY_WIDTH] * decay
    k_bwd = k[:, HY_WIDTH:] * decay
    return jnp.concatenate([k_fwd, jnp.zeros((1, HY_WIDTH), f32), k_bwd[:0:-1]], axis=0)


def bidir_fftconv(u, k2, skip):
    L = u.shape[1]
    uf = u.astype(jnp.float32)
    U = jnp.fft.rfft(uf, n=2 * L, axis=1)
    K = jnp.fft.rfft(k2, n=2 * L, axis=0)
    y = jnp.fft.irfft(U * K[None], n=2 * L, axis=1)[:, :L]
    return (y + uf * skip.astype(jnp.float32)).astype(u.dtype)


def hyena_mix(p_hy, conv_w, conv_b, k2, skip):
    z = dwconv_centred(p_hy, conv_w, conv_b, HY_CONV_LEFT)
    x0, x1, v = jnp.split(z, 3, axis=-1)
    return bidir_fftconv(v * x1, k2, skip) * x0


def token_mixer(h, rows, h0_f, h0_b, w_in, rg_conv_w, rg_conv_b, rg_f, rg_b, rg_proj,
                hy_conv_w, hy_conv_b, hy_filt, hy_skip, hy_proj, w_out):
    L = h.shape[1]
    p = h @ w_in
    p_rx, p_rg, p_hy, p_ga, p_gb = jnp.split(p, IN_SPLITS, axis=-1)
    xc = dwconv_centred(p_rx, rg_conv_w, rg_conv_b, RG_CONV_LEFT)
    h_f, h_b = bidir_rglru(xc, h0_f, h0_b, rg_f, rg_b)
    y_rg = (h_f + h_b).astype(h.dtype) * jax.nn.gelu(p_rg)
    k2 = hyena_filter(L, rows, *hy_filt)
    y_hy = hyena_mix(p_hy, hy_conv_w, hy_conv_b, k2, hy_skip)
    merged = jax.nn.sigmoid(p_ga) * (y_rg @ rg_proj) + jax.nn.sigmoid(p_gb) * (y_hy @ hy_proj)
    return merged @ w_out, h_f, h_b


def context_scan_states(hc, w_in_rx, rg_conv_w, rg_conv_b, rg_f, rg_b):
    xc = dwconv_centred(hc @ w_in_rx, rg_conv_w, rg_conv_b, RG_CONV_LEFT)
    zero = jnp.zeros((hc.shape[0], RG_WIDTH), jnp.float32)
    h_f, h_b = bidir_rglru(xc, zero, zero, rg_f, rg_b)
    return h_f[:, -1], h_b[:, 0]


def hier_moe(h, wg, bg, we, be, w1, w3, w2):
    B, L, D = h.shape
    N = B * L
    xs = h.reshape(N, D)
    p_group = jax.nn.softmax((xs @ wg + bg).astype(jnp.float32), axis=-1)
    grp = jnp.argmax(p_group, axis=-1).astype(jnp.int32)
    p_g = jnp.max(p_group, axis=-1)
    e_logits = (xs @ we + be).astype(jnp.float32).reshape(N, N_GROUPS, EXPERTS_PER_GROUP)
    e_in = e_logits[jnp.arange(N), grp]
    top_val, top_idx = lax.top_k(e_in, TOP_K)
    p_k = jax.nn.softmax(top_val, axis=-1)
    eid = (grp[:, None] * EXPERTS_PER_GROUP + top_idx).reshape(-1)
    wt = (p_g[:, None] * p_k).reshape(-1)
    tok = jnp.repeat(jnp.arange(N, dtype=jnp.int32), TOP_K)
    A = N * TOP_K
    order = jnp.argsort(eid)
    e_s, t_s, w_s = eid[order], tok[order], wt[order]
    counts = jax.ops.segment_sum(jnp.ones((A,), jnp.int32), eid, num_segments=N_EXPERTS)
    padded = ((counts + MOE_BLOCK - 1) // MOE_BLOCK) * MOE_BLOCK
    start = jnp.cumsum(counts) - counts
    pend = jnp.cumsum(padded)
    pstart = pend - padded
    dest = pstart[e_s] + (jnp.arange(A, dtype=jnp.int32) - start[e_s])
    NB = (A + N_EXPERTS * (MOE_BLOCK - 1)) // MOE_BLOCK
    P = NB * MOE_BLOCK
    row_tok = jnp.full((P,), N, jnp.int32).at[dest].set(t_s)
    row_wt = jnp.zeros((P,), jnp.float32).at[dest].set(w_s)
    blk_exp = jnp.minimum(jnp.searchsorted(pend, jnp.arange(NB, dtype=jnp.int32) * MOE_BLOCK,
                                           side='right'), N_EXPERTS - 1)
    xs_pad = jnp.concatenate([xs, jnp.zeros((1, D), xs.dtype)], axis=0)
    xb = xs_pad[row_tok].reshape(NB, MOE_BLOCK, D)

    def expert_block(args):
        xblk, e = args
        hid = jax.nn.silu(xblk @ w1[e]) * (xblk @ w3[e])
        return hid @ w2[e]

    yb = lax.map(expert_block, (xb, blk_exp)).reshape(P, D)
    out = jnp.zeros((N + 1, D), h.dtype).at[row_tok].add(yb * row_wt[:, None].astype(h.dtype))
    return out[:N].reshape(B, L, D)


def setup_inputs(seed: int = 0) -> dict:
    key = jax.random.key(seed)
    ks = iter(jax.random.split(key, 48))

    def nrm(shape, s):
        return jax.random.normal(next(ks), shape, jnp.float32) * s

    def lam_init():
        u = jax.random.uniform(next(ks), (DEPTH, RG_WIDTH), jnp.float32, minval=0.9, maxval=0.999)
        sg = u ** (1.0 / RG_C)
        return jnp.log(sg) - jnp.log1p(-sg)

    D = D_MODEL
    return {
        'x': nrm((BATCH, SEQ, D), 1.0),
        'c': nrm((BATCH, D), 1.0),
        'ctx': nrm((BATCH, CTX_LEN, D), 1.0),
        'c_ctx': nrm((D,), 1.0),
        'ada_w': nrm((DEPTH, D, N_MOD * D), D ** -0.5),
        'ada_b': nrm((DEPTH, N_MOD * D), 0.02),
        'norm1_g': 1.0 + nrm((DEPTH, D), 0.05),
        'norm2_g': 1.0 + nrm((DEPTH, D), 0.05),
        'final_g': 1.0 + nrm((D,), 0.05),
        'w_in': nrm((DEPTH, D, IN_COLS), D ** -0.5),
        'rg_conv_w': nrm((DEPTH, RG_CONV_W, RG_WIDTH), 0.5),
        'rg_conv_b': nrm((DEPTH, RG_WIDTH), 0.02),
        'rg_wa_f': nrm((DEPTH, RG_HEADS, RG_HEAD_DIM, RG_HEAD_DIM), RG_HEAD_DIM ** -0.5),
        'rg_ba_f': nrm((DEPTH, RG_WIDTH), 0.1),
        'rg_wx_f': nrm((DEPTH, RG_HEADS, RG_HEAD_DIM, RG_HEAD_DIM), RG_HEAD_DIM ** -0.5),
        'rg_bx_f': nrm((DEPTH, RG_WIDTH), 0.1),
        'rg_lam_f': lam_init(),
        'rg_wa_b': nrm((DEPTH, RG_HEADS, RG_HEAD_DIM, RG_HEAD_DIM), RG_HEAD_DIM ** -0.5),
        'rg_ba_b': nrm((DEPTH, RG_WIDTH), 0.1),
        'rg_wx_b': nrm((DEPTH, RG_HEADS, RG_HEAD_DIM, RG_HEAD_DIM), RG_HEAD_DIM ** -0.5),
        'rg_bx_b': nrm((DEPTH, RG_WIDTH), 0.1),
        'rg_lam_b': lam_init(),
        'rg_proj': nrm((DEPTH, RG_WIDTH, D), RG_WIDTH ** -0.5),
        'hy_conv_w': nrm((DEPTH, HY_CONV_W, 3 * HY_WIDTH), HY_CONV_W ** -0.5),
        'hy_conv_b': nrm((DEPTH, 3 * HY_WIDTH), 0.02),
        'hy_pos_w1': nrm((DEPTH, HY_EMB_DIM, HY_FILTER_HIDDEN), HY_EMB_DIM ** -0.5),
        'hy_pos_b1': nrm((DEPTH, HY_FILTER_HIDDEN), 0.1),
        'hy_pos_w2': nrm((DEPTH, HY_FILTER_HIDDEN, HY_FILTER_HIDDEN), HY_FILTER_HIDDEN ** -0.5),
        'hy_pos_b2': nrm((DEPTH, HY_FILTER_HIDDEN), 0.1),
        'hy_freq': 1.0 + nrm((DEPTH, HY_FILTER_HIDDEN), 0.1),
        'hy_pos_w3': nrm((DEPTH, HY_FILTER_HIDDEN, 2 * HY_WIDTH), 0.003),
        'hy_skip': nrm((DEPTH, HY_WIDTH), 1.0),
        'hy_proj': nrm((DEPTH, HY_WIDTH, D), HY_WIDTH ** -0.5),
        'w_out': nrm((DEPTH, D, D), D ** -0.5),
        'moe_wg': nrm((DEPTH, D, N_GROUPS), D ** -0.5),
        'moe_bg': nrm((DEPTH, N_GROUPS), 0.01),
        'moe_we': nrm((DEPTH, D, N_EXPERTS), D ** -0.5),
        'moe_be': nrm((DEPTH, N_EXPERTS), 0.01),
        'moe_w1': nrm((DEPTH, N_EXPERTS, D, D_EXPERT), D ** -0.5),
        'moe_w3': nrm((DEPTH, N_EXPERTS, D, D_EXPERT), D ** -0.5),
        'moe_w2': nrm((DEPTH, N_EXPERTS, D_EXPERT, D), D_EXPERT ** -0.5),
    }


def reference(x, c, ctx, c_ctx, ada_w, ada_b, norm1_g, norm2_g, final_g, w_in,
              rg_conv_w, rg_conv_b, rg_wa_f, rg_ba_f, rg_wx_f, rg_bx_f, rg_lam_f,
              rg_wa_b, rg_ba_b, rg_wx_b, rg_bx_b, rg_lam_b, rg_proj,
              hy_conv_w, hy_conv_b, hy_pos_w1, hy_pos_b1, hy_pos_w2, hy_pos_b2, hy_freq,
              hy_pos_w3, hy_skip, hy_proj, w_out,
              moe_wg, moe_bg, moe_we, moe_be, moe_w1, moe_w3, moe_w2):
    B, L, D = x.shape
    rows = L // GRID_W
    for l in range(DEPTH):
        rg_f = (rg_wa_f[l], rg_ba_f[l], rg_wx_f[l], rg_bx_f[l], rg_lam_f[l])
        rg_b = (rg_wa_b[l], rg_ba_b[l], rg_wx_b[l], rg_bx_b[l], rg_lam_b[l])
        hy_filt = (hy_pos_w1[l], hy_pos_b1[l], hy_pos_w2[l], hy_pos_b2[l], hy_freq[l], hy_pos_w3[l])
        sh1, sc1, g1, sh2, sc2, g2 = jnp.split(jax.nn.silu(c) @ ada_w[l] + ada_b[l], N_MOD, axis=-1)
        if l == DEPTH - 1:
            csh1, csc1 = jnp.split(jax.nn.silu(c_ctx) @ ada_w[l][:, :2 * D] + ada_b[l][:2 * D], 2, axis=-1)
            hc = modulate(rmsnorm(ctx, norm1_g[l]), csh1, csc1)
            hcf, hcb = context_scan_states(hc, w_in[l][:, :RG_WIDTH], rg_conv_w[l], rg_conv_b[l], rg_f, rg_b)
        else:
            csh1, csc1, cg1, csh2, csc2, cg2 = jnp.split(
                jax.nn.silu(c_ctx) @ ada_w[l] + ada_b[l], N_MOD, axis=-1)
            hc = modulate(rmsnorm(ctx, norm1_g[l]), csh1, csc1)
            zero = jnp.zeros((B, RG_WIDTH), jnp.float32)
            out_c, hcf_seq, hcb_seq = token_mixer(
                hc, None, zero, zero, w_in[l], rg_conv_w[l], rg_conv_b[l], rg_f, rg_b, rg_proj[l],
                hy_conv_w[l], hy_conv_b[l], hy_filt, hy_skip[l], hy_proj[l], w_out[l])
            hcf, hcb = hcf_seq[:, -1], hcb_seq[:, 0]
            ctx = ctx + cg1[None, None, :] * out_c
            hc2 = modulate(rmsnorm(ctx, norm2_g[l]), csh2, csc2)
            ctx = ctx + cg2[None, None, :] * hier_moe(hc2, moe_wg[l], moe_bg[l], moe_we[l], moe_be[l],
                                                      moe_w1[l], moe_w3[l], moe_w2[l])
        hx = modulate(rmsnorm(x, norm1_g[l]), sh1, sc1)
        out_x, _, _ = token_mixer(
            hx, rows, hcf, hcb, w_in[l], rg_conv_w[l], rg_conv_b[l], rg_f, rg_b, rg_proj[l],
            hy_conv_w[l], hy_conv_b[l], hy_filt, hy_skip[l], hy_proj[l], w_out[l])
        x = x + g1[:, None, :] * out_x
        hx2 = modulate(rmsnorm(x, norm2_g[l]), sh2, sc2)
        x = x + g2[:, None, :] * hier_moe(hx2, moe_wg[l], moe_bg[l], moe_we[l], moe_be[l],
                                          moe_w1[l], moe_w3[l], moe_w2[l])
    return rmsnorm(x, final_g)
```

```cpp
#include <hip/hip_runtime.h>
#include <hip/hip_cooperative_groups.h>
#include <cstdio>
#include <cstdint>
namespace cg = cooperative_groups;

#ifndef ONE_LAUNCH
#define ONE_LAUNCH 0
#endif

#define LAS __attribute__((address_space(3)))
typedef unsigned short bf16;
typedef float f32x4 __attribute__((ext_vector_type(4)));
typedef float f32x2 __attribute__((ext_vector_type(2)));
typedef short bf16x8 __attribute__((ext_vector_type(8)));
typedef unsigned u32x4 __attribute__((ext_vector_type(4)));
typedef unsigned u32x2 __attribute__((ext_vector_type(2)));

constexpr int DM = 1024, NBATCH = 4, SEQ = 8192, NTOK = NBATCH * SEQ, CTXL = 256, NCTX = NBATCH * CTXL, MROWS = NTOK + NCTX;
constexpr int INC = 7168, NEXP = 32, DEXP = 512, PMAXBLK = 288;
constexpr int NCHUNK = 132;
constexpr int NTHREADS = 512, NWAVES = 8;
constexpr int LDS_BYTES = 147456;
constexpr int MISC_OFF = 131072;

constexpr size_t MiB = 1u << 20;
constexpr size_t WS_CTL = 0, WS_MOD = 1 * MiB, WS_Z2 = 2 * MiB, WS_SSQ = 4 * MiB, WS_ROUTE = 6 * MiB, WS_GATEW = 7 * MiB;
constexpr size_t WS_WSMALL = 8 * MiB, WS_WIN = 14 * MiB;
constexpr size_t WS_HX = 32 * MiB;
constexpr size_t WS_PRX = 98 * MiB;
constexpr size_t WS_GRG = 164 * MiB;
constexpr size_t WS_PHY = 228 * MiB;
constexpr size_t WS_W13 = 228 * MiB, WS_W2 = 292 * MiB;
constexpr size_t WS_XG = 324 * MiB;
constexpr size_t WS_KF = 420 * MiB;
constexpr size_t WS_CARR = 484 * MiB, WS_CIN = 494 * MiB, WS_END = 512 * MiB;

__device__ __forceinline__ unsigned f2bf(float f) { unsigned u = __builtin_bit_cast(unsigned, f); return (u + 0x7fffu + ((u >> 16) & 1u)) >> 16; }
__device__ __forceinline__ unsigned pk2(float lo, float hi) { return f2bf(lo) | (f2bf(hi) << 16); }
__device__ __forceinline__ float bf2f(unsigned b) { return __builtin_bit_cast(float, b << 16); }
__device__ __forceinline__ float bflo(unsigned w) { return __builtin_bit_cast(float, w << 16); }
__device__ __forceinline__ float bfhi(unsigned w) { return __builtin_bit_cast(float, w & 0xffff0000u); }
__device__ __forceinline__ float wave_sum(float v) {
#pragma unroll
    for (int o = 1; o < 64; o <<= 1) v += __shfl_xor(v, o);
    return v;
}
__device__ __forceinline__ float sigmoidf_(float v) { return 1.f / (1.f + __expf(-v)); }
__device__ __forceinline__ float gelu_tanh(float v) { const float z = 0.7978845608028654f * (v + 0.044715f * v * v * v); const float t = 1.f - 2.f / (1.f + __expf(2.f * z)); return 0.5f * v * (1.f + t); }
#define LDS_WAIT() asm volatile("s_waitcnt lgkmcnt(0)" ::: "memory")

namespace pg8 {
#define PG8_LAS __attribute__((address_space(3)))
constexpr int BM = 256, BK = 64, HALF = 128, HTB = HALF * BK * 2, STAGE_BYTES = 8 * HTB, NXCD = 8, WGM = 8;
__host__ __device__ __forceinline__ int lds_byte(int r, int c) { const int st = (r >> 4) * 2 + (c >> 5), rr = r & 15, cc = c & 31, ob = rr * 64 + cc * 2; return st * 1024 + (ob ^ (((ob >> 9) & 1) << 5)); }
__host__ __device__ __forceinline__ void stage_rc(int b, int& R, int& C) { const int st = b / 1024, sb = b % 1024, swz = sb ^ (((sb >> 9) & 1) << 5); R = (st >> 1) * 16 + swz / 64; C = (st & 1) * 32 + (swz % 64) / 2; }

struct Unit { int pm, pn, last; const char* A; const char* B; };

__device__ __forceinline__ void rect_map(int wg, int nM, int nN, int& pm, int& pn) {
    const int nwg = nM * nN; int wgid = wg; { const int q = nwg / NXCD, r = nwg % NXCD, xcd = wgid % NXCD, off = wgid / NXCD; wgid = (xcd < r ? xcd * (q + 1) : r * (q + 1) + (xcd - r) * q) + off; }
    const int nig = WGM * nN, gid = wgid / nig, fm = gid * WGM, gsz = (nM - fm) < WGM ? (nM - fm) : WGM;
    pm = fm + ((wgid % nig) % gsz); pn = (wgid % nig) / gsz;
}

template <class Epi, class Sched>
__device__ __forceinline__ void gemm_phase(PG8_LAS unsigned char* lds, const int K, const Sched& S, const Epi& E) {
    const int tid = threadIdx.x, wid = __builtin_amdgcn_readfirstlane(tid >> 6), lane = tid & 63, wr = wid >> 2, wc = wid & 3, fr = lane & 15, fq = lane >> 4;
    const int nt = K / BK;
    unsigned voffA[2];
#pragma unroll
    for (int i = 0; i < 2; ++i) { int R, C; stage_rc(tid * 16 + i * 8192, R, C); voffA[i] = (unsigned)(R * K + C) * 2u; }
    const size_t kstep = (size_t)(BK * 2);
    const size_t hstep = (size_t)HALF * K * 2;
    const unsigned ldsw = (unsigned)wid * 1024u;
    const int aoff = lds_byte(wr * 64 + fr, fq * 8), boff = lds_byte(wc * 32 + fr, fq * 8);
#define PG8_SA(b, h) (((b) * 2 + (h)) * HTB)
#define PG8_SB(b, h) ((4 + (b) * 2 + (h)) * HTB)
#define PG8_STAGE(bufoff, gbase, voff) do { _Pragma("unroll") for (int _i = 0; _i < 2; ++_i) \
        __builtin_amdgcn_global_load_lds((const unsigned*)((const char*)(gbase) + (voff)[_i]), (PG8_LAS unsigned*)(lds + (bufoff) + ldsw + _i * 8192), 16, 0, 0); } while (0)
#define PG8_LDA(dst, b, h) do { _Pragma("unroll") for (int m = 0; m < 4; ++m) _Pragma("unroll") for (int k = 0; k < 2; ++k) dst[m][k] = *(const PG8_LAS bf16x8*)(lds + PG8_SA(b, h) + aoff + m * 2048 + k * 1024); } while (0)
#define PG8_LDB(dst, b, h) do { _Pragma("unroll") for (int n = 0; n < 2; ++n) _Pragma("unroll") for (int k = 0; k < 2; ++k) dst[n][k] = *(const PG8_LAS bf16x8*)(lds + PG8_SB(b, h) + boff + n * 2048 + k * 1024); } while (0)
#define PG8_MMA(ai, bj, At, Bt) do { __builtin_amdgcn_s_setprio(1); _Pragma("unroll") for (int m = 0; m < 4; ++m) _Pragma("unroll") for (int n = 0; n < 2; ++n) _Pragma("unroll") for (int k = 0; k < 2; ++k) \
        acc[ai][bj][m][n] = __builtin_amdgcn_mfma_f32_16x16x32_bf16(Bt[n][k], At[m][k], acc[ai][bj][m][n], 0, 0, 0); __builtin_amdgcn_s_setprio(0); } while (0)
#define PG8_WAIT_V(n) asm volatile("s_waitcnt vmcnt(" #n ")" ::: "memory")
#define PG8_WAIT_L(n) asm volatile("s_waitcnt lgkmcnt(" #n ")" ::: "memory")
#define PG8_BAR __builtin_amdgcn_s_barrier()
#define PG8_SCHED __builtin_amdgcn_sched_barrier(0)
    Unit cur, nxt; int ui = 0;
    if (!S.next(0, cur)) return;
    f32x4 acc[2][2][4][2];
#pragma unroll
    for (int a = 0; a < 2; ++a)
#pragma unroll
        for (int b = 0; b < 2; ++b)
#pragma unroll
            for (int m = 0; m < 4; ++m)
#pragma unroll
                for (int n = 0; n < 2; ++n) acc[a][b][m][n] = (f32x4){0.f, 0.f, 0.f, 0.f};
    bf16x8 At[4][2], B0[2][2], B1[2][2];
    const char* cA = cur.A; const char* cB = cur.B;
    PG8_STAGE(PG8_SB(0, 0), cB, voffA); PG8_STAGE(PG8_SB(0, 1), cB + hstep, voffA); PG8_STAGE(PG8_SA(0, 0), cA, voffA); PG8_STAGE(PG8_SA(0, 1), cA + hstep, voffA);
    if (wr == 1) PG8_BAR;
    PG8_WAIT_V(2); PG8_BAR;
    PG8_STAGE(PG8_SB(1, 0), cB + kstep, voffA); PG8_STAGE(PG8_SA(1, 0), cA + kstep, voffA); PG8_STAGE(PG8_SB(1, 1), cB + hstep + kstep, voffA);
    PG8_WAIT_V(6); PG8_BAR;
    for (;;) {
        const bool has_next = S.next(ui + 1, nxt);
        const char* nA = has_next ? nxt.A : cA; const char* nB = has_next ? nxt.B : cB;
        for (int t = 0; t < nt; t += 2) {
            const bool last = (t == nt - 2);
            const char* a1 = cA + (size_t)(t + 1) * kstep;
            const char* a2 = last ? nA : cA + (size_t)(t + 2) * kstep; const char* b2 = last ? nB : cB + (size_t)(t + 2) * kstep;
            const char* a3 = a2 + kstep; const char* b3 = b2 + kstep;
            PG8_LDB(B0, 0, 0); PG8_LDB(B1, 0, 1); PG8_SCHED; PG8_LDA(At, 0, 0); PG8_STAGE(PG8_SA(1, 1), a1 + hstep, voffA);
            PG8_WAIT_V(8); PG8_WAIT_L(0); PG8_BAR; PG8_MMA(0, 0, At, B0); PG8_MMA(0, 1, At, B1); PG8_BAR; PG8_SCHED;
            PG8_LDA(At, 0, 1); PG8_STAGE(PG8_SB(0, 0), b2, voffA); PG8_STAGE(PG8_SB(0, 1), b2 + hstep, voffA); PG8_STAGE(PG8_SA(0, 0), a2, voffA);
            PG8_WAIT_V(8); PG8_WAIT_L(0); PG8_BAR; PG8_MMA(1, 0, At, B0); PG8_MMA(1, 1, At, B1); PG8_BAR; PG8_SCHED;
            PG8_LDB(B0, 1, 0); PG8_LDB(B1, 1, 1); PG8_SCHED; PG8_LDA(At, 1, 0); PG8_STAGE(PG8_SA(0, 1), a2 + hstep, voffA);
            PG8_WAIT_V(8); PG8_WAIT_L(0); PG8_BAR; PG8_MMA(0, 0, At, B0); PG8_MMA(0, 1, At, B1); PG8_BAR; PG8_SCHED;
            PG8_LDA(At, 1, 1); PG8_STAGE(PG8_SB(1, 0), b3, voffA); PG8_STAGE(PG8_SB(1, 1), b3 + hstep, voffA); PG8_STAGE(PG8_SA(1, 0), a3, voffA);
            PG8_WAIT_V(8); PG8_WAIT_L(0); PG8_BAR; PG8_MMA(1, 0, At, B0); PG8_MMA(1, 1, At, B1); PG8_BAR; PG8_SCHED;
        }
        if (wr == 0) PG8_BAR;
        if (cur.last) E.fin(acc, cur, wr, wc, fr, fq); else E.mid(acc, cur, wr, wc, fr, fq);
        if (!has_next) break;
        if (cur.last) {
#pragma unroll
            for (int a = 0; a < 2; ++a)
#pragma unroll
                for (int b = 0; b < 2; ++b)
#pragma unroll
                    for (int m = 0; m < 4; ++m)
#pragma unroll
                        for (int n = 0; n < 2; ++n) acc[a][b][m][n] = (f32x4){0.f, 0.f, 0.f, 0.f};
        }
        cur = nxt; cA = nA; cB = nB; ++ui;
        if (wr == 1) PG8_BAR;
    }
    PG8_WAIT_V(0);
    PG8_BAR;
#undef PG8_SA
#undef PG8_SB
#undef PG8_STAGE
#undef PG8_LDA
#undef PG8_LDB
#undef PG8_MMA
#undef PG8_WAIT_V
#undef PG8_WAIT_L
#undef PG8_BAR
#undef PG8_SCHED
}
}
using pg8::Unit;
typedef f32x4 AccT[2][2][4][2];

__device__ __forceinline__ u32x2 pack4(f32x4 v) { u32x2 w; w.x = pk2(v[0], v[1]); w.y = pk2(v[2], v[3]); return w; }

#define EPI_LOOP_ROWS _Pragma("unroll") for (int ai = 0; ai < 2; ++ai) _Pragma("unroll") for (int m = 0; m < 4; ++m)
#define EPI_LOOP_COLS _Pragma("unroll") for (int bj = 0; bj < 2; ++bj) _Pragma("unroll") for (int n = 0; n < 2; ++n)

struct EpiInA {
    bf16* prx; bf16* grg; bf16* gates;
    __device__ __forceinline__ void mid(AccT& acc, const Unit& u, int wr, int wc, int fr, int fq) const {}
    __device__ __forceinline__ void fin(AccT& acc, const Unit& u, int wr, int wc, int fr, int fq) const {
        const int row0 = u.pm * 256 + wr * 64 + fr, col0 = u.pn * 256 + wc * 32 + 4 * fq;
        EPI_LOOP_ROWS { const size_t r = (size_t)(row0 + ai * 128 + m * 16);
            EPI_LOOP_COLS { const int c = col0 + bj * 128 + n * 16; f32x4 v = acc[ai][bj][m][n];
                if (u.pn < 4) { *(u32x2*)(prx + r * 1024 + c) = pack4(v); }
                else if (u.pn < 8) { f32x4 g; for (int i = 0; i < 4; ++i) g[i] = gelu_tanh(v[i]); *(u32x2*)(grg + r * 1024 + (c - 1024)) = pack4(g); }
                else { f32x4 g; for (int i = 0; i < 4; ++i) g[i] = sigmoidf_(v[i]); *(u32x2*)(gates + r * 2048 + (c - 2048)) = pack4(g); } } }
    }
};
struct EpiInB {
    bf16* phyT;
    __device__ __forceinline__ void mid(AccT& acc, const Unit& u, int wr, int wc, int fr, int fq) const {}
    __device__ __forceinline__ void fin(AccT& acc, const Unit& u, int wr, int wc, int fr, int fq) const {
        const int row0 = u.pm * 256 + wr * 64 + fr, col0 = u.pn * 256 + wc * 32 + 4 * fq;
        const int b = u.pn >> 5;
        EPI_LOOP_ROWS { const size_t j = (size_t)(row0 + ai * 128 + m * 16);
            EPI_LOOP_COLS { const int t = col0 + bj * 128 + n * 16 - b * SEQ;
                *(u32x2*)(phyT + ((size_t)b * 3072 + j) * SEQ + t) = pack4(acc[ai][bj][m][n]); } }
    }
};
struct EpiMerge {
    const bf16* gates; bf16* merged;
    __device__ __forceinline__ void mid(AccT& acc, const Unit& u, int wr, int wc, int fr, int fq) const {
        const int row0 = u.pm * 256 + wr * 64 + fr, col0 = u.pn * 256 + wc * 32 + 4 * fq;
        EPI_LOOP_ROWS { const size_t r = (size_t)(row0 + ai * 128 + m * 16);
            EPI_LOOP_COLS { const int c = col0 + bj * 128 + n * 16;
                const u32x2 a = *(const u32x2*)(gates + r * 2048 + c), b = *(const u32x2*)(gates + r * 2048 + 1024 + c);
                f32x4 sa = {bflo(a.x), bfhi(a.x), bflo(a.y), bfhi(a.y)}, sb = {bflo(b.x), bfhi(b.x), bflo(b.y), bfhi(b.y)};
                for (int i = 0; i < 4; ++i) acc[ai][bj][m][n][i] *= sa[i] / fmaxf(sb[i], 1e-30f); } }
    }
    __device__ __forceinline__ void fin(AccT& acc, const Unit& u, int wr, int wc, int fr, int fq) const {
        const int row0 = u.pm * 256 + wr * 64 + fr, col0 = u.pn * 256 + wc * 32 + 4 * fq;
        EPI_LOOP_ROWS { const size_t r = (size_t)(row0 + ai * 128 + m * 16);
            EPI_LOOP_COLS { const int c = col0 + bj * 128 + n * 16;
                const u32x2 b = *(const u32x2*)(gates + r * 2048 + 1024 + c);
                f32x4 sb = {bflo(b.x), bfhi(b.x), bflo(b.y), bfhi(b.y)};
                f32x4 v = acc[ai][bj][m][n]; for (int i = 0; i < 4; ++i) v[i] *= fmaxf(sb[i], 1e-30f);
                *(u32x2*)(merged + r * 1024 + c) = pack4(v); } }
    }
};
struct EpiOut {
    const float* x; const float* mod; float* x1; float* ssq;
    __device__ __forceinline__ void mid(AccT& acc, const Unit& u, int wr, int wc, int fr, int fq) const {}
    __device__ __forceinline__ void fin(AccT& acc, const Unit& u, int wr, int wc, int fr, int fq) const {
        const int row0 = u.pm * 256 + wr * 64 + fr, col0 = u.pn * 256 + wc * 32 + 4 * fq;
        const float* g1 = mod + (u.pm >> 5) * 6144 + 2048;
        EPI_LOOP_ROWS { const size_t r = (size_t)(row0 + ai * 128 + m * 16); float s = 0.f;
            EPI_LOOP_COLS { const int c = col0 + bj * 128 + n * 16;
                const f32x4 xv = *(const f32x4*)(x + r * 1024 + c), gv = *(const f32x4*)(g1 + c);
                const f32x4 o = xv + gv * acc[ai][bj][m][n];
                *(f32x4*)(x1 + r * 1024 + c) = o; s += (o[0] * o[0] + o[1] * o[1]) + (o[2] * o[2] + o[3] * o[3]); }
            s += __shfl_xor(s, 16); s += __shfl_xor(s, 32);
            if (fq == 0) ssq[r * 16 + u.pn * 4 + wc] = s; }
    }
};
struct EpiMoeUp {
    bf16* H;
    __device__ __forceinline__ void mid(AccT& acc, const Unit& u, int wr, int wc, int fr, int fq) const {}
    __device__ __forceinline__ void fin(AccT& acc, const Unit& u, int wr, int wc, int fr, int fq) const {
        const int row0 = u.pm * 256 + wr * 64 + fr, col0 = u.pn * 128 + wc * 32 + 4 * fq;
        EPI_LOOP_ROWS { const size_t r = (size_t)(row0 + ai * 128 + m * 16);
#pragma unroll
            for (int n = 0; n < 2; ++n) { const f32x4 a = acc[ai][0][m][n], b = acc[ai][1][m][n]; f32x4 h;
                for (int i = 0; i < 4; ++i) h[i] = a[i] * sigmoidf_(a[i]) * b[i];
                *(u32x2*)(H + r * 512 + col0 + n * 16) = pack4(h); } }
    }
};
struct EpiMoeDown {
    bf16* Y;
    __device__ __forceinline__ void mid(AccT& acc, const Unit& u, int wr, int wc, int fr, int fq) const {}
    __device__ __forceinline__ void fin(AccT& acc, const Unit& u, int wr, int wc, int fr, int fq) const {
        const int row0 = u.pm * 256 + wr * 64 + fr, col0 = u.pn * 256 + wc * 32 + 4 * fq;
        EPI_LOOP_ROWS { const size_t r = (size_t)(row0 + ai * 128 + m * 16);
            EPI_LOOP_COLS { const int c = col0 + bj * 128 + n * 16; *(u32x2*)(Y + r * 1024 + c) = pack4(acc[ai][bj][m][n]); } }
    }
};

constexpr size_t TSTEP1K = (size_t)256 * 1024 * 2;
struct SchedInA { const char* hx; const char* wt; int G, c;
    __device__ __forceinline__ bool next(int i, Unit& u) const {
        int Lx = i * G + c, pm, pn;
        if (Lx < 2048) pg8::rect_map(Lx, 128, 16, pm, pn);
        else { Lx -= 2048; if (Lx >= 16) return false; pm = 128 + (Lx >> 2); pn = Lx & 3; }
        const int wrow = pn < 8 ? pn * 256 : 5120 + (pn - 8) * 256;
        u.pm = pm; u.pn = pn; u.last = 1; u.A = hx + (size_t)pm * TSTEP1K; u.B = wt + (size_t)wrow * 2048; return true; } };
struct SchedInB { const char* hx; const char* wt; int G, c;
    __device__ __forceinline__ bool next(int i, Unit& u) const {
        const int Lx = i * G + c; if (Lx >= 12 * 128) return false; int pm, pn; pg8::rect_map(Lx, 12, 128, pm, pn);
        u.pm = pm; u.pn = pn; u.last = 1; u.A = wt + (size_t)(2048 + pm * 256) * 2048; u.B = hx + (size_t)pn * TSTEP1K; return true; } };
struct SchedMerge { const char* yrg; const char* yhy; const char* wrg; const char* why; int G, c;
    __device__ __forceinline__ bool next(int i, Unit& u) const {
        const int T = (i >> 1) * G + c, part = i & 1; if (T >= 512) return false; int pm, pn; pg8::rect_map(T, 128, 4, pm, pn);
        u.pm = pm; u.pn = pn; u.last = part; u.A = (part ? yhy : yrg) + (size_t)pm * TSTEP1K; u.B = (part ? why : wrg) + (size_t)pn * TSTEP1K; return true; } };
struct SchedOut { const char* a; const char* w; int G, c;
    __device__ __forceinline__ bool next(int i, Unit& u) const {
        const int T = i * G + c; if (T >= 512) return false; int pm, pn; pg8::rect_map(T, 128, 4, pm, pn);
        u.pm = pm; u.pn = pn; u.last = 1; u.A = a + (size_t)pm * TSTEP1K; u.B = w + (size_t)pn * TSTEP1K; return true; } };
struct SchedMoeUp { const char* xg; const char* w13; const LAS int* blk_exp; int nblk, G, c;
    __device__ __forceinline__ bool next(int i, Unit& u) const {
        const int T = i * G + c; if (T >= nblk * 4) return false; const int pm = T >> 2, pn = T & 3, e = blk_exp[pm];
        u.pm = pm; u.pn = pn; u.last = 1; u.A = xg + (size_t)pm * TSTEP1K; u.B = w13 + (size_t)e * (1024 * 1024 * 2) + (size_t)pn * TSTEP1K; return true; } };
struct SchedMoeDown { const char* h; const char* w2; const LAS int* blk_exp; int nblk, G, c;
    __device__ __forceinline__ bool next(int i, Unit& u) const {
        const int T = i * G + c; if (T >= nblk * 4) return false; const int pm = T >> 2, pn = T & 3, e = blk_exp[pm];
        u.pm = pm; u.pn = pn; u.last = 1; u.A = h + (size_t)pm * (256 * 512 * 2); u.B = w2 + (size_t)e * (1024 * 512 * 2) + (size_t)pn * (256 * 512 * 2); return true; } };

__device__ __forceinline__ void transpose_item(const float* W, int K, int N, bf16* WT, int mode, LAS float* scr, int item, int lane) {
    const int nblk = N / 32, kb = item / nblk, nb = item % nblk, k0 = 64 * kb, n0 = 32 * nb;
#pragma unroll 8
    for (int i = 0; i < 32; ++i) { const int kk = 2 * i + (lane >> 5); scr[kk * 33 + (lane & 31)] = W[(size_t)(k0 + kk) * N + n0 + (lane & 31)]; }
    LDS_WAIT(); asm volatile("" ::: "memory");
    const int c = lane & 7;
#pragma unroll
    for (int j = 0; j < 4; ++j) { const int n = (lane >> 3) + 8 * j; const LAS float* s = scr + (8 * c) * 33 + n;
        u32x4 o; o.x = pk2(s[0 * 33], s[1 * 33]); o.y = pk2(s[2 * 33], s[3 * 33]); o.z = pk2(s[4 * 33], s[5 * 33]); o.w = pk2(s[6 * 33], s[7 * 33]);
        const int nn = n0 + n; int row;
        if (mode == 0) row = nn;
        else if (mode == 1) row = (nn >> 7) * 256 + (nn & 127);
        else row = (nn >> 7) * 256 + 128 + (nn & 127);
        *(u32x4*)(WT + (size_t)row * K + k0 + 8 * c) = o; }
    LDS_WAIT(); asm volatile("" ::: "memory");
}

struct Args { const float* in[41]; float* out; unsigned char* ws; int ph_lo, ph_hi; };

enum { I_X = 0, I_C, I_CTX, I_CCTX, I_ADAW, I_ADAB, I_N1G, I_N2G, I_FG, I_WIN, I_RGCW, I_RGCB, I_WAF, I_BAF, I_WXF, I_BXF, I_LAMF, I_WAB, I_BAB, I_WXB, I_BXB, I_LAMB,
       I_RGPROJ, I_HYCW, I_HYCB, I_PW1, I_PB1, I_PW2, I_PB2, I_FREQ, I_PW3, I_SKIP, I_HYPROJ, I_WOUT, I_WG, I_BG, I_WE, I_BE, I_MW1, I_MW3, I_MW2 };

constexpr int NPHASE = 13;

__global__ void __launch_bounds__(NTHREADS, 2) fwd_kernel(Args args) {
    extern __shared__ __attribute__((aligned(16))) unsigned char lds_raw[];
    LAS unsigned char* lds = (LAS unsigned char*)lds_raw;
    const int tid = threadIdx.x, lane = tid & 63, wave = __builtin_amdgcn_readfirstlane(tid >> 6);
    const int G = gridDim.x, bid = blockIdx.x;
    const int gw = bid * NWAVES + wave, NGW = G * NWAVES;
    unsigned char* ws = args.ws;
    const int lo = args.ph_lo, hi = args.ph_hi;
#define IN(k) (lo <= (k) && (k) < hi)
#if ONE_LAUNCH
    cg::grid_group grid = cg::this_grid();
#define GRID_SYNC(k) do { if (IN(k) && IN((k) + 1)) grid.sync(); } while (0)
#else
#define GRID_SYNC(k) do { } while (0)
#endif
    int* cnt = (int*)(ws + WS_CTL);
    float* mod = (float*)(ws + WS_MOD);
    float* z2 = (float*)(ws + WS_Z2);
    float* ssq = (float*)(ws + WS_SSQ);
    int* tok_e = (int*)(ws + WS_ROUTE); int* tok_rank = tok_e + 2 * NTOK; float* tok_w = (float*)(tok_rank + 2 * NTOK); int* tok_slot = (int*)(tok_w + 2 * NTOK);
    bf16* rgproj_t = (bf16*)(ws + WS_WSMALL); bf16* hyproj_t = rgproj_t + 1024 * 1024; bf16* wout_t = hyproj_t + 1024 * 1024;
    bf16* win_t = (bf16*)(ws + WS_WIN);
    bf16* hx = (bf16*)(ws + WS_HX); bf16* yhy = (bf16*)(ws + WS_HX); bf16* Hbuf = (bf16*)(ws + WS_HX);
    bf16* prx = (bf16*)(ws + WS_PRX); bf16* merged = (bf16*)(ws + WS_PRX);
    bf16* grg = (bf16*)(ws + WS_GRG); bf16* hx2 = (bf16*)(ws + WS_GRG);
    bf16* phyT = (bf16*)(ws + WS_PHY);
    bf16* w13t = (bf16*)(ws + WS_W13); bf16* w2t = (bf16*)(ws + WS_W2);
    bf16* Xg = (bf16*)(ws + WS_XG); bf16* Ybuf = (bf16*)(ws + WS_XG);
    float* kf = (float*)(ws + WS_KF); bf16* yrg = (bf16*)(ws + WS_KF);
    f32x2* carr = (f32x2*)(ws + WS_CARR); float* cin = (float*)(ws + WS_CIN);
    bf16* gates = (bf16*)args.out;
    float* x1 = args.out;

    if (IN(0)) {
        if (bid == 0 && tid < 64) cnt[tid] = 0;
        {
            LAS float* red = (LAS float*)lds;
            const float* c = args.in[I_C]; const float* cctx = args.in[I_CCTX]; const float* ada_w = args.in[I_ADAW]; const float* ada_b = args.in[I_ADAB];
            for (int g = bid; g < 96; g += G) {
                const int n = g * 64 + lane; float acc[5] = {0.f, 0.f, 0.f, 0.f, 0.f};
                for (int kk = 0; kk < 128; ++kk) { const int k = wave * 128 + kk; const float a = ada_w[(size_t)k * 6144 + n];
#pragma unroll
                    for (int r = 0; r < 5; ++r) { const float cv = (r < 4) ? c[r * 1024 + k] : cctx[k]; acc[r] += cv * sigmoidf_(cv) * a; } }
#pragma unroll
                for (int r = 0; r < 5; ++r) red[(wave * 5 + r) * 64 + lane] = acc[r];
                __syncthreads();
                if (wave == 0) {
#pragma unroll
                    for (int r = 0; r < 5; ++r) { float s = ada_b[n]; for (int w = 0; w < 8; ++w) s += red[(w * 5 + r) * 64 + lane]; mod[r * 6144 + n] = s; } }
                __syncthreads();
            }
        }
        {
            LAS float* fe = (LAS float*)lds + wave * 128; LAS float* z1 = fe + 64;
            const float* w1 = args.in[I_PW1]; const float* b1 = args.in[I_PB1]; const float* w2 = args.in[I_PW2]; const float* b2 = args.in[I_PB2]; const float* fr = args.in[I_FREQ];
            const float TWO_PI = 6.283185307179586f;
            for (int s = gw; s < SEQ; s += NGW) {
                float f = 0.f; const float sf = (float)s;
                if (lane == 0) f = sf / 8191.f;
                else if (lane <= 32) { const int j = (lane - 1) & 15; const float band = 1e-4f + (float)j * ((15.f - 1e-4f) / 15.f); float rev = sf * band * (1.f / 8192.f); rev -= floorf(rev + 0.5f);
                    f = (lane <= 16) ? cosf(TWO_PI * rev) : sinf(TWO_PI * rev); }
                else if (lane == 33) f = (float)(s >> 6) / 128.f;
                else if (lane <= 49) { const int mm = (lane <= 41) ? (lane - 33) : (lane - 41); float rev = (float)((s & 63) * mm) * (1.f / 64.f); rev -= floorf(rev + 0.5f);
                    f = (lane <= 41) ? cosf(TWO_PI * rev) : sinf(TWO_PI * rev); }
                fe[lane] = f; LDS_WAIT(); asm volatile("" ::: "memory");
                float a = b1[lane];
                for (int i = 0; i < 50; ++i) a += fe[i] * w1[i * 64 + lane];
                z1[lane] = sinf(fr[lane] * a); LDS_WAIT(); asm volatile("" ::: "memory");
                float a2 = b2[lane];
                for (int i = 0; i < 64; ++i) a2 += z1[i] * w2[i * 64 + lane];
                z2[(size_t)s * 64 + lane] = sinf(fr[lane] * a2);
                LDS_WAIT(); asm volatile("" ::: "memory");
            }
        }
        __syncthreads();
        {
            LAS float* scr = (LAS float*)lds + wave * 2176;
            constexpr int I_IN = 16 * 224, I_SQ = 16 * 32;
            constexpr int NITEMS = I_IN + 3 * I_SQ;
            for (int it = gw; it < NITEMS; it += NGW) {
                int r = it;
                if (r < I_IN) { transpose_item(args.in[I_WIN], 1024, INC, win_t, 0, scr, r, lane); continue; } r -= I_IN;
                if (r < I_SQ) { transpose_item(args.in[I_RGPROJ], 1024, 1024, rgproj_t, 0, scr, r, lane); continue; } r -= I_SQ;
                if (r < I_SQ) { transpose_item(args.in[I_HYPROJ], 1024, 1024, hyproj_t, 0, scr, r, lane); continue; } r -= I_SQ;
                transpose_item(args.in[I_WOUT], 1024, 1024, wout_t, 0, scr, r, lane);
            }
        }
    }
    GRID_SYNC(0);

    if (IN(1)) {
        const float* x = args.in[I_X]; const float* ctx = args.in[I_CTX]; const float* n1g = args.in[I_N1G];
        for (int m = gw; m < MROWS; m += NGW) {
            const float* xr = (m < NTOK) ? x + (size_t)m * 1024 : ctx + (size_t)(m - NTOK) * 1024; const int r = (m < NTOK) ? (m >> 13) : 4;
            const float* sh = mod + r * 6144; const float* sc = sh + 1024;
            f32x4 v[4]; float ss = 0.f;
#pragma unroll
            for (int j = 0; j < 4; ++j) { v[j] = ((const f32x4*)xr)[64 * j + lane]; ss += (v[j][0] * v[j][0] + v[j][1] * v[j][1]) + (v[j][2] * v[j][2] + v[j][3] * v[j][3]); }
            const float rstd = rsqrtf(wave_sum(ss) * (1.f / 1024.f) + 1e-6f);
#pragma unroll
            for (int j = 0; j < 4; ++j) { const int k = 4 * (64 * j + lane); const f32x4 g = *(const f32x4*)(n1g + k), s = *(const f32x4*)(sc + k), h = *(const f32x4*)(sh + k);
                const f32x4 o = v[j] * rstd * g * (1.f + s) + h; *(u32x2*)(hx + (size_t)m * 1024 + k) = pack4(o); }
        }
        {
            LAS float* z2s = (LAS float*)lds; LAS float* w3s = z2s + 64 * 65;
            const float* w3 = args.in[I_PW3];
            for (int it = bid; it < 128 * 32; it += G) {
                const int s0 = (it & 127) * 64, c0 = (it >> 7) * 64;
                for (int e = tid; e < 64 * 64; e += NTHREADS) { const int r = e >> 6, cc = e & 63; z2s[r * 65 + cc] = z2[(size_t)(s0 + r) * 64 + cc]; w3s[r * 65 + cc] = w3[(size_t)r * 2048 + c0 + cc]; }
                __syncthreads();
                float acc[8] = {0.f, 0.f, 0.f, 0.f, 0.f, 0.f, 0.f, 0.f};
                for (int j = 0; j < 64; ++j) { const float z = z2s[lane * 65 + j];
#pragma unroll
                    for (int q = 0; q < 8; ++q) acc[q] += z * w3s[j * 65 + wave * 8 + q]; }
                const float tn = (float)(s0 + lane) / 8191.f;
#pragma unroll
                for (int q = 0; q < 8; ++q) { const int cp = c0 + wave * 8 + q, ch = cp & 1023;
                    const float mind = -3.0701134573253944f, maxd = -15.350567286626972f;
                    const float delta = fabsf(mind + (float)ch * ((maxd - mind) / 1023.f));
                    kf[(size_t)cp * SEQ + s0 + lane] = acc[q] * __expf(-tn * delta); }
                __syncthreads();
            }
        }
    }
    GRID_SYNC(1);

    if (IN(2)) {
        { SchedInA S{(const char*)hx, (const char*)win_t, G, bid}; EpiInA E{prx, grg, gates}; pg8::gemm_phase(lds, 1024, S, E); }
        { SchedInB S{(const char*)hx, (const char*)win_t, G, bid}; EpiInB E{phyT}; pg8::gemm_phase(lds, 1024, S, E); }
    }
    GRID_SYNC(2);

    const float* rgcw = args.in[I_RGCW]; const float* rgcb = args.in[I_RGCB];
#define SCAN_LOAD_XC(rowbase, seglen, t0, h) do {   \
        const int tok = tid >> 3, e0 = (tid & 7) * 8; const int cg0 = (h) * 64 + e0; \
        float xv[8]; _Pragma("unroll") for (int q = 0; q < 8; ++q) xv[q] = rgcb[cg0 + q]; \
        _Pragma("unroll") for (int j = 0; j < 4; ++j) { const int tt = (t0) + tok + j - 2; \
            if (tt >= 0 && tt < (seglen)) { const u32x4 p = *(const u32x4*)(prx + (size_t)((rowbase) + tt) * 1024 + cg0); const f32x4 w0 = *(const f32x4*)(rgcw + j * 1024 + cg0), w1 = *(const f32x4*)(rgcw + j * 1024 + cg0 + 4); \
                xv[0] += w0[0] * bflo(p.x); xv[1] += w0[1] * bfhi(p.x); xv[2] += w0[2] * bflo(p.y); xv[3] += w0[3] * bfhi(p.y); \
                xv[4] += w1[0] * bflo(p.z); xv[5] += w1[1] * bfhi(p.z); xv[6] += w1[2] * bflo(p.w); xv[7] += w1[3] * bfhi(p.w); } } \
        _Pragma("unroll") for (int q = 0; q < 8; ++q) XC[tok * 65 + e0 + q] = xv[q]; } while (0)
#define SCAN_GATES(wa, wx, ba, bx, lam, h) do { \
        for (int e = tid; e < 2 * 4096; e += NTHREADS) { const int g = e >> 12, r = e & 4095; WG[e] = (g ? (wx) : (wa))[(size_t)(h) * 4096 + r]; } \
        __syncthreads(); \
        const int tok = tid >> 3, e0 = (tid & 7) * 8; float ar[8], ai_[8]; \
        _Pragma("unroll") for (int q = 0; q < 8; ++q) { ar[q] = 0.f; ai_[q] = 0.f; } \
        for (int d = 0; d < 64; ++d) { const float xd = XC[tok * 65 + d]; const f32x4 r0 = *(const LAS f32x4*)(WG + d * 64 + e0), r1 = *(const LAS f32x4*)(WG + d * 64 + e0 + 4), i0 = *(const LAS f32x4*)(WG + 4096 + d * 64 + e0), i1 = *(const LAS f32x4*)(WG + 4096 + d * 64 + e0 + 4); \
            _Pragma("unroll") for (int q = 0; q < 4; ++q) { ar[q] += xd * r0[q]; ar[4 + q] += xd * r1[q]; ai_[q] += xd * i0[q]; ai_[4 + q] += xd * i1[q]; } } \
        _Pragma("unroll") for (int q = 0; q < 8; ++q) { const int cgl = (h) * 64 + e0 + q; \
            const float rr = sigmoidf_(ar[q] + (ba)[cgl]), ii = sigmoidf_(ai_[q] + (bx)[cgl]); \
            const float sp = log1pf(__expf(-(lam)[cgl])); const float la = -8.f * rr * sp; \
            const float a = __expf(la); const float om = -expm1f(2.f * la); \
            SA[tok * 64 + e0 + q] = a; SB[tok * 64 + e0 + q] = sqrtf(om) * ii * XC[tok * 65 + e0 + q]; } \
        __syncthreads(); } while (0)

    if (IN(3)) {
        LAS float* XC = (LAS float*)lds; LAS float* WG = XC + 64 * 65 + 32; LAS float* SA = WG + 2 * 4096; LAS float* SB = SA + 4096;
        for (int it = bid; it < NBATCH * NCHUNK * 16; it += G) {
            const int h = it & 15, rest = it >> 4, j = rest % NCHUNK, b = rest / NCHUNK;
            const int isctx = j < 4; const int seglen = isctx ? CTXL : SEQ; const int t0 = isctx ? j * 64 : (j - 4) * 64; const int rowbase = isctx ? NTOK + b * CTXL : b * SEQ;
            SCAN_LOAD_XC(rowbase, seglen, t0, h);
            __syncthreads();
            for (int dir = 0; dir < 2; ++dir) {
                if (dir == 0) SCAN_GATES(args.in[I_WAF], args.in[I_WXF], args.in[I_BAF], args.in[I_BXF], args.in[I_LAMF], h);
                else SCAN_GATES(args.in[I_WAB], args.in[I_WXB], args.in[I_BAB], args.in[I_BXB], args.in[I_LAMB], h);
                if (tid < 64) { float P = 1.f, hh = 0.f;
                    if (dir == 0) { for (int t = 0; t < 64; ++t) { const float a = SA[t * 64 + tid]; hh = a * hh + SB[t * 64 + tid]; P *= a; } }
                    else { for (int t = 63; t >= 0; --t) { const float a = SA[t * 64 + tid]; hh = a * hh + SB[t * 64 + tid]; P *= a; } }
                    carr[((size_t)(b * NCHUNK + j) * 2 + dir) * 1024 + h * 64 + tid] = (f32x2){P, hh}; }
                __syncthreads();
            }
        }
        {
            LAS float* U = (LAS float*)lds; LAS float* K2 = U + SEQ;
            const float* hcw = args.in[I_HYCW]; const float* hcb = args.in[I_HYCB]; const float* skip = args.in[I_SKIP];
            for (int it = bid; it < NBATCH * 1024; it += G) {
                const int c = it & 1023, b = it >> 10;
                const bf16* r0 = phyT + ((size_t)b * 3072 + c) * SEQ; const bf16* r1 = r0 + (size_t)1024 * SEQ; const bf16* r2 = r0 + (size_t)2048 * SEQ;
                const float w00 = hcw[c], w01 = hcw[3072 + c], w02 = hcw[6144 + c], b0 = hcb[c];
                const float w10 = hcw[1024 + c], w11 = hcw[3072 + 1024 + c], w12 = hcw[6144 + 1024 + c], b1 = hcb[1024 + c];
                const float w20 = hcw[2048 + c], w21 = hcw[3072 + 2048 + c], w22 = hcw[6144 + 2048 + c], b2 = hcb[2048 + c];
                float x0v[16];
#pragma unroll
                for (int i = 0; i < 16; ++i) { const int t = tid + 512 * i;
                    const float pm0 = t > 0 ? bf2f(r0[t - 1]) : 0.f, pc0 = bf2f(r0[t]), pp0 = t < SEQ - 1 ? bf2f(r0[t + 1]) : 0.f;
                    const float pm1 = t > 0 ? bf2f(r1[t - 1]) : 0.f, pc1 = bf2f(r1[t]), pp1 = t < SEQ - 1 ? bf2f(r1[t + 1]) : 0.f;
                    const float pm2 = t > 0 ? bf2f(r2[t - 1]) : 0.f, pc2 = bf2f(r2[t]), pp2 = t < SEQ - 1 ? bf2f(r2[t + 1]) : 0.f;
                    x0v[i] = b0 + w00 * pm0 + w01 * pc0 + w02 * pp0;
                    const float xx1 = b1 + w10 * pm1 + w11 * pc1 + w12 * pp1, vv = b2 + w20 * pm2 + w21 * pc2 + w22 * pp2;
                    U[t] = vv * xx1;
                    K2[t] = kf[(size_t)c * SEQ + t];
                    K2[SEQ + t] = (t == 0) ? 0.f : kf[(size_t)(1024 + c) * SEQ + (SEQ - t)]; }
                __syncthreads();
                float acc[16];
#pragma unroll
                for (int i = 0; i < 16; ++i) acc[i] = 0.f;
                for (int s = 0; s < SEQ; ++s) { const float uu = U[s];
#pragma unroll
                    for (int i = 0; i < 16; ++i) acc[i] += uu * K2[(tid + 512 * i - s) & 16383]; }
                const float sk = skip[c];
                __syncthreads();
#pragma unroll
                for (int i = 0; i < 16; ++i) { const int t = tid + 512 * i; const float y = (acc[i] + sk * U[t]) * x0v[i]; ((bf16*)r0)[t] = (bf16)f2bf(y); }
                __syncthreads();
            }
        }
    }
    GRID_SYNC(3);

    if (IN(4)) {
        const int gt = bid * NTHREADS + tid;
        if (gt < NBATCH * 2 * 1024) {
            const int c = gt & 1023, dir = (gt >> 10) & 1, b = gt >> 11; float s = 0.f;
            for (int q = 0; q < NCHUNK; ++q) { const int j = dir == 0 ? q : (q < 4 ? 3 - q : NCHUNK + 3 - q);
                const size_t idx = ((size_t)(b * NCHUNK + j) * 2 + dir) * 1024 + c; const f32x2 ab = carr[idx]; cin[idx] = s; s = ab.x * s + ab.y; }
        }
    }
    GRID_SYNC(4);

    if (IN(5)) {
        LAS float* XC = (LAS float*)lds; LAS float* WG = XC + 64 * 65 + 32; LAS float* SA = WG + 2 * 4096; LAS float* SB = SA + 4096; LAS float* HF = SB + 4096;
        for (int it = bid; it < NBATCH * 128 * 16; it += G) {
            const int h = it & 15, rest = it >> 4, j = (rest & 127) + 4, b = rest >> 7;
            const int t0 = (j - 4) * 64; const int rowbase = b * SEQ;
            SCAN_LOAD_XC(rowbase, SEQ, t0, h);
            __syncthreads();
            SCAN_GATES(args.in[I_WAF], args.in[I_WXF], args.in[I_BAF], args.in[I_BXF], args.in[I_LAMF], h);
            if (tid < 64) { float hh = cin[((size_t)(b * NCHUNK + j) * 2 + 0) * 1024 + h * 64 + tid];
                for (int t = 0; t < 64; ++t) { hh = SA[t * 64 + tid] * hh + SB[t * 64 + tid]; HF[t * 64 + tid] = hh; } }
            __syncthreads();
            SCAN_GATES(args.in[I_WAB], args.in[I_WXB], args.in[I_BAB], args.in[I_BXB], args.in[I_LAMB], h);
            if (tid < 64) { float hh = cin[((size_t)(b * NCHUNK + j) * 2 + 1) * 1024 + h * 64 + tid];
                for (int t = 63; t >= 0; --t) { hh = SA[t * 64 + tid] * hh + SB[t * 64 + tid];
                    const size_t o = (size_t)(rowbase + t0 + t) * 1024 + h * 64 + tid;
                    yrg[o] = (bf16)f2bf((HF[t * 64 + tid] + hh) * bf2f(grg[o])); } }
            __syncthreads();
        }
        {
            LAS bf16* T = (LAS bf16*)lds;
            for (int it = bid; it < NBATCH * 16 * 128; it += G) {
                const int tb = it & 127, cb = (it >> 7) & 15, b = it >> 11;
                { const int cl = tid >> 3, ch = tid & 7; *(LAS u32x4*)(T + cl * 72 + ch * 8) = *(const u32x4*)(phyT + ((size_t)b * 3072 + cb * 64 + cl) * SEQ + tb * 64 + ch * 8); }
                __syncthreads();
                { const int tl = tid >> 3, ch = tid & 7; unsigned v[8];
#pragma unroll
                    for (int q = 0; q < 8; ++q) v[q] = T[(ch * 8 + q) * 72 + tl];
                    u32x4 o; o.x = v[0] | (v[1] << 16); o.y = v[2] | (v[3] << 16); o.z = v[4] | (v[5] << 16); o.w = v[6] | (v[7] << 16);
                    *(u32x4*)(yhy + (size_t)(b * SEQ + tb * 64 + tl) * 1024 + cb * 64 + ch * 8) = o; }
                __syncthreads();
            }
        }
    }
    GRID_SYNC(5);

    if (IN(6)) {
        SchedMerge S{(const char*)yrg, (const char*)yhy, (const char*)rgproj_t, (const char*)hyproj_t, G, bid}; EpiMerge E{gates, merged};
        pg8::gemm_phase(lds, 1024, S, E);
    }
    GRID_SYNC(6);

    if (IN(7)) {
        SchedOut S{(const char*)merged, (const char*)wout_t, G, bid}; EpiOut E{args.in[I_X], mod, x1, ssq};
        pg8::gemm_phase(lds, 1024, S, E);
    }
    GRID_SYNC(7);

    if (IN(8)) {
        {
            LAS float* rowbuf = (LAS float*)lds + wave * 1088;
            const float* n2g = args.in[I_N2G]; const float* wg = args.in[I_WG]; const float* bg = args.in[I_BG]; const float* we = args.in[I_WE]; const float* be = args.in[I_BE];
            for (int m = gw; m < NTOK; m += NGW) {
                const int b = m >> 13; const float* sh = mod + b * 6144 + 3072; const float* sc = sh + 1024;
                float ss = 0.f; { const float* sp = ssq + (size_t)m * 16; for (int q = 0; q < 16; ++q) ss += sp[q]; }
                const float rstd = rsqrtf(ss * (1.f / 1024.f) + 1e-6f);
#pragma unroll
                for (int j = 0; j < 4; ++j) { const int k = 4 * (64 * j + lane); const f32x4 v = *(const f32x4*)(x1 + (size_t)m * 1024 + k);
                    const f32x4 g = *(const f32x4*)(n2g + k), s = *(const f32x4*)(sc + k), hh = *(const f32x4*)(sh + k);
                    const f32x4 o = v * rstd * g * (1.f + s) + hh; *(u32x2*)(hx2 + (size_t)m * 1024 + k) = pack4(o); *(LAS f32x4*)(rowbuf + k) = o; }
                LDS_WAIT(); asm volatile("" ::: "memory");
                float lg = 0.f;
                if (lane < 36) { const float* wp = lane < 4 ? wg + lane : we + (lane - 4); const int st = lane < 4 ? 4 : 32;
                    for (int k = 0; k < 1024; ++k) lg += rowbuf[k] * wp[(size_t)k * st];
                    lg += lane < 4 ? bg[lane] : be[lane - 4]; }
                rowbuf[1024 + lane] = lg; LDS_WAIT(); asm volatile("" ::: "memory");
                if (lane == 0) {
                    const LAS float* lgp = rowbuf + 1024;
                    int grp = 0; float gm = lgp[0]; for (int q = 1; q < 4; ++q) if (lgp[q] > gm) { gm = lgp[q]; grp = q; }
                    float den = 0.f; for (int q = 0; q < 4; ++q) den += __expf(lgp[q] - gm);
                    const float pg = 1.f / den;
                    const LAS float* ep = lgp + 4 + grp * 8;
                    int i1 = 0; float v1 = ep[0]; for (int q = 1; q < 8; ++q) if (ep[q] > v1) { v1 = ep[q]; i1 = q; }
                    int i2 = -1; float v2 = -3.0e38f; for (int q = 0; q < 8; ++q) if (q != i1 && ep[q] > v2) { v2 = ep[q]; i2 = q; }
                    const float e2 = __expf(v2 - v1); const float p1 = 1.f / (1.f + e2), p2 = e2 / (1.f + e2);
                    const int ea = grp * 8 + i1, eb = grp * 8 + i2;
                    const int ra = atomicAdd(cnt + ea, 1), rb = atomicAdd(cnt + eb, 1);
                    tok_e[2 * m] = ea; tok_e[2 * m + 1] = eb; tok_rank[2 * m] = ra; tok_rank[2 * m + 1] = rb; tok_w[2 * m] = pg * p1; tok_w[2 * m + 1] = pg * p2;
                }
                LDS_WAIT(); asm volatile("" ::: "memory");
            }
        }
        __syncthreads();
        {
            LAS float* scr = (LAS float*)lds + wave * 2176;
            constexpr int I_E13 = 16 * 16, I_E2 = 8 * 32;
            constexpr int NITEMS = NEXP * (2 * I_E13 + I_E2);
            for (int it = gw; it < NITEMS; it += NGW) {
                const int e = it / (2 * I_E13 + I_E2); int r = it % (2 * I_E13 + I_E2);
                if (r < I_E13) { transpose_item(args.in[I_MW1] + (size_t)e * 1024 * 512, 1024, 512, w13t + (size_t)e * 1024 * 1024, 1, scr, r, lane); continue; } r -= I_E13;
                if (r < I_E13) { transpose_item(args.in[I_MW3] + (size_t)e * 1024 * 512, 1024, 512, w13t + (size_t)e * 1024 * 1024, 2, scr, r, lane); continue; } r -= I_E13;
                transpose_item(args.in[I_MW2] + (size_t)e * 512 * 1024, 512, 1024, w2t + (size_t)e * 1024 * 512, 0, scr, r, lane);
            }
        }
    }
    GRID_SYNC(8);

    LAS int* blk_exp = (LAS int*)(lds + MISC_OFF); LAS int* pstart = blk_exp + 320;
    int nblk = 0;
    if (hi > 9 && lo <= 11) {
        __syncthreads();
        if (tid == 0) { int p = 0; for (int e = 0; e < NEXP; ++e) { const int c_ = __hip_atomic_load(cnt + e, __ATOMIC_RELAXED, __HIP_MEMORY_SCOPE_AGENT); const int nb = (c_ + 255) >> 8; pstart[e] = p * 256; for (int q = 0; q < nb; ++q) blk_exp[p + q] = e; p += nb; } pstart[32] = p; }
        __syncthreads();
        nblk = pstart[32];
    }

    if (IN(9)) {
        for (int a = gw; a < 2 * NTOK; a += NGW) {
            const int e = tok_e[a], rk = tok_rank[a]; const int slot = pstart[e] + rk; const int m = a >> 1;
            if (lane == 0) tok_slot[a] = slot;
            const u32x4* src = (const u32x4*)(hx2 + (size_t)m * 1024); u32x4* dst = (u32x4*)(Xg + (size_t)slot * 1024);
            dst[lane] = src[lane]; dst[64 + lane] = src[64 + lane];
        }
    }
    GRID_SYNC(9);

    if (IN(10)) {
        SchedMoeUp S{(const char*)Xg, (const char*)w13t, blk_exp, nblk, G, bid}; EpiMoeUp E{Hbuf};
        pg8::gemm_phase(lds, 1024, S, E);
    }
    GRID_SYNC(10);

    if (IN(11)) {
        SchedMoeDown S{(const char*)Hbuf, (const char*)w2t, blk_exp, nblk, G, bid}; EpiMoeDown E{Ybuf};
        pg8::gemm_phase(lds, 512, S, E);
    }
    GRID_SYNC(11);

    if (IN(12)) {
        const float* fg = args.in[I_FG];
        for (int m = gw; m < NTOK; m += NGW) {
            const int b = m >> 13; const float* g2 = mod + b * 6144 + 5120;
            const int sa = tok_slot[2 * m], sb = tok_slot[2 * m + 1]; const float wa = tok_w[2 * m], wb = tok_w[2 * m + 1];
            f32x4 v[4]; float ss = 0.f;
#pragma unroll
            for (int j = 0; j < 4; ++j) { const int k = 4 * (64 * j + lane);
                const u32x2 ya = *(const u32x2*)(Ybuf + (size_t)sa * 1024 + k), yb = *(const u32x2*)(Ybuf + (size_t)sb * 1024 + k);
                const f32x4 fa = {bflo(ya.x), bfhi(ya.x), bflo(ya.y), bfhi(ya.y)}, fb = {bflo(yb.x), bfhi(yb.x), bflo(yb.y), bfhi(yb.y)};
                const f32x4 xv = *(const f32x4*)(x1 + (size_t)m * 1024 + k), gv = *(const f32x4*)(g2 + k);
                v[j] = xv + gv * (fa * wa + fb * wb); ss += (v[j][0] * v[j][0] + v[j][1] * v[j][1]) + (v[j][2] * v[j][2] + v[j][3] * v[j][3]); }
            const float rstd = rsqrtf(wave_sum(ss) * (1.f / 1024.f) + 1e-6f);
#pragma unroll
            for (int j = 0; j < 4; ++j) { const int k = 4 * (64 * j + lane); const f32x4 g = *(const f32x4*)(fg + k); *(f32x4*)(args.out + (size_t)m * 1024 + k) = v[j] * rstd * g; }
        }
    }
}

extern "C" void kernel_launch(void* const* d_in, const int* in_sizes, int n_in, void* d_out, int out_size, void* d_ws, size_t ws_size, hipStream_t stream) {
    static int grid = 0;
    if (grid == 0) {
        if (n_in != 41 || out_size != NTOK * DM || ws_size < WS_END) { fprintf(stderr, "kernel_launch: unexpected shapes (n_in %d, out %d, ws %zu)\n", n_in, out_size, ws_size); grid = -1; return; }
        int dev = 0, cus = 0, per_cu = 0;
        hipGetDevice(&dev); hipDeviceGetAttribute(&cus, hipDeviceAttributeMultiprocessorCount, dev);
        if (hipFuncSetAttribute((const void*)fwd_kernel, hipFuncAttributeMaxDynamicSharedMemorySize, LDS_BYTES) != hipSuccess) { fprintf(stderr, "kernel_launch: hipFuncSetAttribute failed\n"); grid = -1; return; }
        hipOccupancyMaxActiveBlocksPerMultiprocessor(&per_cu, (const void*)fwd_kernel, NTHREADS, LDS_BYTES);
        (void)hipGetLastError();
        if (per_cu < 1) { fprintf(stderr, "kernel_launch: occupancy query says %d blocks per CU\n", per_cu); per_cu = 1; }
        grid = cus;
        fprintf(stderr, "kernel_launch: grid %d (cus %d, per_cu %d)\n", grid, cus, per_cu);
    }
    if (grid < 0) return;
    Args a{};
    for (int i = 0; i < 41; ++i) a.in[i] = (const float*)d_in[i];
    a.out = (float*)d_out; a.ws = (unsigned char*)d_ws;
#if ONE_LAUNCH
    a.ph_lo = 0; a.ph_hi = NPHASE;
    void* kargs[] = {&a};
    hipError_t e = hipLaunchCooperativeKernel((const void*)fwd_kernel, dim3(grid), dim3(NTHREADS), kargs, LDS_BYTES, stream);
    if (e != hipSuccess) fprintf(stderr, "cooperative launch failed: %s (grid %d)\n", hipGetErrorString(e), grid);
#else
    for (int p = 0; p < NPHASE; ++p) { a.ph_lo = p; a.ph_hi = p + 1; hipLaunchKernelGGL(fwd_kernel, dim3(grid), dim3(NTHREADS), LDS_BYTES, stream, a); }
#endif
}
```

```cpp
#include <hip/hip_runtime.h>
#include <hip/hip_cooperative_groups.h>
#include <cstdio>
#include <cstdint>
namespace cg = cooperative_groups;

#ifndef ONE_LAUNCH
#define ONE_LAUNCH 1
#endif

#define LAS __attribute__((address_space(3)))
typedef unsigned short bf16;
typedef float f32x4 __attribute__((ext_vector_type(4)));
typedef float f32x2 __attribute__((ext_vector_type(2)));
typedef short bf16x8 __attribute__((ext_vector_type(8)));
typedef unsigned u32x4 __attribute__((ext_vector_type(4)));
typedef unsigned u32x2 __attribute__((ext_vector_type(2)));

constexpr int DM = 1024, NBATCH = 4, SEQ = 8192, NTOK = NBATCH * SEQ, CTXL = 256, NCTX = NBATCH * CTXL, MROWS = NTOK + NCTX;
constexpr int INC = 7168, NEXP = 32, DEXP = 512, PMAXBLK = 288;
constexpr int NCHUNK = 132;
constexpr int NTHREADS = 512, NWAVES = 8;
constexpr int LDS_BYTES = 147456;
constexpr int MISC_OFF = 131072;

constexpr size_t MiB = 1u << 20;
constexpr size_t WS_CTL = 0, WS_MOD = 1 * MiB, WS_Z2 = 2 * MiB, WS_SSQ = 4 * MiB, WS_ROUTE = 6 * MiB, WS_GATEW = 7 * MiB;
constexpr size_t WS_WSMALL = 8 * MiB, WS_WIN = 14 * MiB;
constexpr size_t WS_HX = 32 * MiB;
constexpr size_t WS_PRX = 98 * MiB;
constexpr size_t WS_GRG = 164 * MiB;
constexpr size_t WS_PHY = 228 * MiB;
constexpr size_t WS_W13 = 228 * MiB, WS_W2 = 292 * MiB;
constexpr size_t WS_XG = 324 * MiB;
constexpr size_t WS_KF = 420 * MiB;
constexpr size_t WS_CARR = 484 * MiB, WS_CIN = 494 * MiB, WS_END = 512 * MiB;

__device__ __forceinline__ unsigned f2bf(float f) { unsigned u = __builtin_bit_cast(unsigned, f); return (u + 0x7fffu + ((u >> 16) & 1u)) >> 16; }
__device__ __forceinline__ unsigned pk2(float lo, float hi) { return f2bf(lo) | (f2bf(hi) << 16); }
__device__ __forceinline__ float bf2f(unsigned b) { return __builtin_bit_cast(float, b << 16); }
__device__ __forceinline__ float bflo(unsigned w) { return __builtin_bit_cast(float, w << 16); }
__device__ __forceinline__ float bfhi(unsigned w) { return __builtin_bit_cast(float, w & 0xffff0000u); }
__device__ __forceinline__ float wave_sum(float v) {
#pragma unroll
    for (int o = 1; o < 64; o <<= 1) v += __shfl_xor(v, o);
    return v;
}
__device__ __forceinline__ float sigmoidf_(float v) { return 1.f / (1.f + __expf(-v)); }
__device__ __forceinline__ float gelu_tanh(float v) { const float z = 0.7978845608028654f * (v + 0.044715f * v * v * v); const float t = 1.f - 2.f / (1.f + __expf(2.f * z)); return 0.5f * v * (1.f + t); }
#define LDS_WAIT() asm volatile("s_waitcnt lgkmcnt(0)" ::: "memory")

namespace pg8 {
#define PG8_LAS __attribute__((address_space(3)))
constexpr int BM = 256, BK = 64, HALF = 128, HTB = HALF * BK * 2, STAGE_BYTES = 8 * HTB, NXCD = 8, WGM = 8;
__host__ __device__ __forceinline__ int lds_byte(int r, int c) { const int st = (r >> 4) * 2 + (c >> 5), rr = r & 15, cc = c & 31, ob = rr * 64 + cc * 2; return st * 1024 + (ob ^ (((ob >> 9) & 1) << 5)); }
__host__ __device__ __forceinline__ void stage_rc(int b, int& R, int& C) { const int st = b / 1024, sb = b % 1024, swz = sb ^ (((sb >> 9) & 1) << 5); R = (st >> 1) * 16 + swz / 64; C = (st & 1) * 32 + (swz % 64) / 2; }

struct Unit { int pm, pn, last; const char* A; const char* B; };

__device__ __forceinline__ void rect_map(int wg, int nM, int nN, int& pm, int& pn) {
    const int nwg = nM * nN; int wgid = wg; { const int q = nwg / NXCD, r = nwg % NXCD, xcd = wgid % NXCD, off = wgid / NXCD; wgid = (xcd < r ? xcd * (q + 1) : r * (q + 1) + (xcd - r) * q) + off; }
    const int nig = WGM * nN, gid = wgid / nig, fm = gid * WGM, gsz = (nM - fm) < WGM ? (nM - fm) : WGM;
    pm = fm + ((wgid % nig) % gsz); pn = (wgid % nig) / gsz;
}

template <class Epi, class Sched>
__device__ __forceinline__ void gemm_phase(PG8_LAS unsigned char* lds, const int K, const Sched& S, const Epi& E) {
    const int tid = threadIdx.x, wid = __builtin_amdgcn_readfirstlane(tid >> 6), lane = tid & 63, wr = wid >> 2, wc = wid & 3, fr = lane & 15, fq = lane >> 4;
    const int nt = K / BK;
    unsigned voffA[2];
#pragma unroll
    for (int i = 0; i < 2; ++i) { int R, C; stage_rc(tid * 16 + i * 8192, R, C); voffA[i] = (unsigned)(R * K + C) * 2u; }
    const size_t kstep = (size_t)(BK * 2);
    const size_t hstep = (size_t)HALF * K * 2;
    const unsigned ldsw = (unsigned)wid * 1024u;
    const int aoff = lds_byte(wr * 64 + fr, fq * 8), boff = lds_byte(wc * 32 + fr, fq * 8);
#define PG8_SA(b, h) (((b) * 2 + (h)) * HTB)
#define PG8_SB(b, h) ((4 + (b) * 2 + (h)) * HTB)
#define PG8_STAGE(bufoff, gbase, voff) do { _Pragma("unroll") for (int _i = 0; _i < 2; ++_i) \
        __builtin_amdgcn_global_load_lds((const unsigned*)((const char*)(gbase) + (voff)[_i]), (PG8_LAS unsigned*)(lds + (bufoff) + ldsw + _i * 8192), 16, 0, 0); } while (0)
#define PG8_LDA(dst, b, h) do { _Pragma("unroll") for (int m = 0; m < 4; ++m) _Pragma("unroll") for (int k = 0; k < 2; ++k) dst[m][k] = *(const PG8_LAS bf16x8*)(lds + PG8_SA(b, h) + aoff + m * 2048 + k * 1024); } while (0)
#define PG8_LDB(dst, b, h) do { _Pragma("unroll") for (int n = 0; n < 2; ++n) _Pragma("unroll") for (int k = 0; k < 2; ++k) dst[n][k] = *(const PG8_LAS bf16x8*)(lds + PG8_SB(b, h) + boff + n * 2048 + k * 1024); } while (0)
#define PG8_MMA(ai, bj, At, Bt) do { __builtin_amdgcn_s_setprio(1); _Pragma("unroll") for (int m = 0; m < 4; ++m) _Pragma("unroll") for (int n = 0; n < 2; ++n) _Pragma("unroll") for (int k = 0; k < 2; ++k) \
        acc[ai][bj][m][n] = __builtin_amdgcn_mfma_f32_16x16x32_bf16(Bt[n][k], At[m][k], acc[ai][bj][m][n], 0, 0, 0); __builtin_amdgcn_s_setprio(0); } while (0)
#define PG8_WAIT_V(n) asm volatile("s_waitcnt vmcnt(" #n ")" ::: "memory")
#define PG8_WAIT_L(n) asm volatile("s_waitcnt lgkmcnt(" #n ")" ::: "memory")
#define PG8_BAR __builtin_amdgcn_s_barrier()
#define PG8_SCHED __builtin_amdgcn_sched_barrier(0)
    Unit cur, nxt; int ui = 0;
    if (!S.next(0, cur)) return;
    f32x4 acc[2][2][4][2];
#pragma unroll
    for (int a = 0; a < 2; ++a)
#pragma unroll
        for (int b = 0; b < 2; ++b)
#pragma unroll
            for (int m = 0; m < 4; ++m)
#pragma unroll
                for (int n = 0; n < 2; ++n) acc[a][b][m][n] = (f32x4){0.f, 0.f, 0.f, 0.f};
    bf16x8 At[4][2], B0[2][2], B1[2][2];
    const char* cA = cur.A; const char* cB = cur.B;
    PG8_STAGE(PG8_SB(0, 0), cB, voffA); PG8_STAGE(PG8_SB(0, 1), cB + hstep, voffA); PG8_STAGE(PG8_SA(0, 0), cA, voffA); PG8_STAGE(PG8_SA(0, 1), cA + hstep, voffA);
    if (wr == 1) PG8_BAR;
    PG8_WAIT_V(2); PG8_BAR;
    PG8_STAGE(PG8_SB(1, 0), cB + kstep, voffA); PG8_STAGE(PG8_SA(1, 0), cA + kstep, voffA); PG8_STAGE(PG8_SB(1, 1), cB + hstep + kstep, voffA);
    PG8_WAIT_V(6); PG8_BAR;
    for (;;) {
        const bool has_next = S.next(ui + 1, nxt);
        const char* nA = has_next ? nxt.A : cA; const char* nB = has_next ? nxt.B : cB;
        for (int t = 0; t < nt; t += 2) {
            const bool last = (t == nt - 2);
            const char* a1 = cA + (size_t)(t + 1) * kstep;
            const char* a2 = last ? nA : cA + (size_t)(t + 2) * kstep; const char* b2 = last ? nB : cB + (size_t)(t + 2) * kstep;
            const char* a3 = a2 + kstep; const char* b3 = b2 + kstep;
            PG8_LDB(B0, 0, 0); PG8_LDB(B1, 0, 1); PG8_SCHED; PG8_LDA(At, 0, 0); PG8_STAGE(PG8_SA(1, 1), a1 + hstep, voffA);
            PG8_WAIT_V(8); PG8_WAIT_L(0); PG8_BAR; PG8_MMA(0, 0, At, B0); PG8_MMA(0, 1, At, B1); PG8_BAR; PG8_SCHED;
            PG8_LDA(At, 0, 1); PG8_STAGE(PG8_SB(0, 0), b2, voffA); PG8_STAGE(PG8_SB(0, 1), b2 + hstep, voffA); PG8_STAGE(PG8_SA(0, 0), a2, voffA);
            PG8_WAIT_V(8); PG8_WAIT_L(0); PG8_BAR; PG8_MMA(1, 0, At, B0); PG8_MMA(1, 1, At, B1); PG8_BAR; PG8_SCHED;
            PG8_LDB(B0, 1, 0); PG8_LDB(B1, 1, 1); PG8_SCHED; PG8_LDA(At, 1, 0); PG8_STAGE(PG8_SA(0, 1), a2 + hstep, voffA);
            PG8_WAIT_V(8); PG8_WAIT_L(0); PG8_BAR; PG8_MMA(0, 0, At, B0); PG8_MMA(0, 1, At, B1); PG8_BAR; PG8_SCHED;
            PG8_LDA(At, 1, 1); PG8_STAGE(PG8_SB(1, 0), b3, voffA); PG8_STAGE(PG8_SB(1, 1), b3 + hstep, voffA); PG8_STAGE(PG8_SA(1, 0), a3, voffA);
            PG8_WAIT_V(8); PG8_WAIT_L(0); PG8_BAR; PG8_MMA(1, 0, At, B0); PG8_MMA(1, 1, At, B1); PG8_BAR; PG8_SCHED;
        }
        if (wr == 0) PG8_BAR;
        if (cur.last) E.fin(acc, cur, wr, wc, fr, fq); else E.mid(acc, cur, wr, wc, fr, fq);
        if (!has_next) break;
        if (cur.last) {
#pragma unroll
            for (int a = 0; a < 2; ++a)
#pragma unroll
                for (int b = 0; b < 2; ++b)
#pragma unroll
                    for (int m = 0; m < 4; ++m)
#pragma unroll
                        for (int n = 0; n < 2; ++n) acc[a][b][m][n] = (f32x4){0.f, 0.f, 0.f, 0.f};
        }
        cur = nxt; cA = nA; cB = nB; ++ui;
        if (wr == 1) PG8_BAR;
    }
    PG8_WAIT_V(0);
    PG8_BAR;
#undef PG8_SA
#undef PG8_SB
#undef PG8_STAGE
#undef PG8_LDA
#undef PG8_LDB
#undef PG8_MMA
#undef PG8_WAIT_V
#undef PG8_WAIT_L
#undef PG8_BAR
#undef PG8_SCHED
}
}
using pg8::Unit;
typedef f32x4 AccT[2][2][4][2];

__device__ __forceinline__ u32x2 pack4(f32x4 v) { u32x2 w; w.x = pk2(v[0], v[1]); w.y = pk2(v[2], v[3]); return w; }

#define EPI_LOOP_ROWS _Pragma("unroll") for (int ai = 0; ai < 2; ++ai) _Pragma("unroll") for (int m = 0; m < 4; ++m)
#define EPI_LOOP_COLS _Pragma("unroll") for (int bj = 0; bj < 2; ++bj) _Pragma("unroll") for (int n = 0; n < 2; ++n)

struct EpiInA {
    bf16* prx; bf16* grg; bf16* gates;
    __device__ __forceinline__ void mid(AccT& acc, const Unit& u, int wr, int wc, int fr, int fq) const {}
    __device__ __forceinline__ void fin(AccT& acc, const Unit& u, int wr, int wc, int fr, int fq) const {
        const int row0 = u.pm * 256 + wr * 64 + fr, col0 = u.pn * 256 + wc * 32 + 4 * fq;
        EPI_LOOP_ROWS { const size_t r = (size_t)(row0 + ai * 128 + m * 16);
            EPI_LOOP_COLS { const int c = col0 + bj * 128 + n * 16; f32x4 v = acc[ai][bj][m][n];
                if (u.pn < 4) { *(u32x2*)(prx + r * 1024 + c) = pack4(v); }
                else if (u.pn < 8) { f32x4 g; for (int i = 0; i < 4; ++i) g[i] = gelu_tanh(v[i]); *(u32x2*)(grg + r * 1024 + (c - 1024)) = pack4(g); }
                else { f32x4 g; for (int i = 0; i < 4; ++i) g[i] = sigmoidf_(v[i]); *(u32x2*)(gates + r * 2048 + (c - 2048)) = pack4(g); } } }
    }
};
struct EpiInB {
    bf16* phyT;
    __device__ __forceinline__ void mid(AccT& acc, const Unit& u, int wr, int wc, int fr, int fq) const {}
    __device__ __forceinline__ void fin(AccT& acc, const Unit& u, int wr, int wc, int fr, int fq) const {
        const int row0 = u.pm * 256 + wr * 64 + fr, col0 = u.pn * 256 + wc * 32 + 4 * fq;
        const int b = u.pn >> 5;
        EPI_LOOP_ROWS { const size_t j = (size_t)(row0 + ai * 128 + m * 16);
            EPI_LOOP_COLS { const int t = col0 + bj * 128 + n * 16 - b * SEQ;
                *(u32x2*)(phyT + ((size_t)b * 3072 + j) * SEQ + t) = pack4(acc[ai][bj][m][n]); } }
    }
};
struct EpiMerge {
    const bf16* gates; bf16* merged;
    __device__ __forceinline__ void mid(AccT& acc, const Unit& u, int wr, int wc, int fr, int fq) const {
        const int row0 = u.pm * 256 + wr * 64 + fr, col0 = u.pn * 256 + wc * 32 + 4 * fq;
        EPI_LOOP_ROWS { const size_t r = (size_t)(row0 + ai * 128 + m * 16);
            EPI_LOOP_COLS { const int c = col0 + bj * 128 + n * 16;
                const u32x2 a = *(const u32x2*)(gates + r * 2048 + c), b = *(const u32x2*)(gates + r * 2048 + 1024 + c);
                f32x4 sa = {bflo(a.x), bfhi(a.x), bflo(a.y), bfhi(a.y)}, sb = {bflo(b.x), bfhi(b.x), bflo(b.y), bfhi(b.y)};
                for (int i = 0; i < 4; ++i) acc[ai][bj][m][n][i] *= sa[i] / fmaxf(sb[i], 1e-30f); } }
    }
    __device__ __forceinline__ void fin(AccT& acc, const Unit& u, int wr, int wc, int fr, int fq) const {
        const int row0 = u.pm * 256 + wr * 64 + fr, col0 = u.pn * 256 + wc * 32 + 4 * fq;
        EPI_LOOP_ROWS { const size_t r = (size_t)(row0 + ai * 128 + m * 16);
            EPI_LOOP_COLS { const int c = col0 + bj * 128 + n * 16;
                const u32x2 b = *(const u32x2*)(gates + r * 2048 + 1024 + c);
                f32x4 sb = {bflo(b.x), bfhi(b.x), bflo(b.y), bfhi(b.y)};
                f32x4 v = acc[ai][bj][m][n]; for (int i = 0; i < 4; ++i) v[i] *= fmaxf(sb[i], 1e-30f);
                *(u32x2*)(merged + r * 1024 + c) = pack4(v); } }
    }
};
struct EpiOut {
    const float* x; const float* mod; float* x1; float* ssq;
    __device__ __forceinline__ void mid(AccT& acc, const Unit& u, int wr, int wc, int fr, int fq) const {}
    __device__ __forceinline__ void fin(AccT& acc, const Unit& u, int wr, int wc, int fr, int fq) const {
        const int row0 = u.pm * 256 + wr * 64 + fr, col0 = u.pn * 256 + wc * 32 + 4 * fq;
        const float* g1 = mod + (u.pm >> 5) * 6144 + 2048;
        EPI_LOOP_ROWS { const size_t r = (size_t)(row0 + ai * 128 + m * 16); float s = 0.f;
            EPI_LOOP_COLS { const int c = col0 + bj * 128 + n * 16;
                const f32x4 xv = *(const f32x4*)(x + r * 1024 + c), gv = *(const f32x4*)(g1 + c);
                const f32x4 o = xv + gv * acc[ai][bj][m][n];
                *(f32x4*)(x1 + r * 1024 + c) = o; s += (o[0] * o[0] + o[1] * o[1]) + (o[2] * o[2] + o[3] * o[3]); }
            s += __shfl_xor(s, 16); s += __shfl_xor(s, 32);
            if (fq == 0) ssq[r * 16 + u.pn * 4 + wc] = s; }
    }
};
struct EpiMoeUp {
    bf16* H;
    __device__ __forceinline__ void mid(AccT& acc, const Unit& u, int wr, int wc, int fr, int fq) const {}
    __device__ __forceinline__ void fin(AccT& acc, const Unit& u, int wr, int wc, int fr, int fq) const {
        const int row0 = u.pm * 256 + wr * 64 + fr, col0 = u.pn * 128 + wc * 32 + 4 * fq;
        EPI_LOOP_ROWS { const size_t r = (size_t)(row0 + ai * 128 + m * 16);
#pragma unroll
            for (int n = 0; n < 2; ++n) { const f32x4 a = acc[ai][0][m][n], b = acc[ai][1][m][n]; f32x4 h;
                for (int i = 0; i < 4; ++i) h[i] = a[i] * sigmoidf_(a[i]) * b[i];
                *(u32x2*)(H + r * 512 + col0 + n * 16) = pack4(h); } }
    }
};
struct EpiMoeDown {
    bf16* Y;
    __device__ __forceinline__ void mid(AccT& acc, const Unit& u, int wr, int wc, int fr, int fq) const {}
    __device__ __forceinline__ void fin(AccT& acc, const Unit& u, int wr, int wc, int fr, int fq) const {
        const int row0 = u.pm * 256 + wr * 64 + fr, col0 = u.pn * 256 + wc * 32 + 4 * fq;
        EPI_LOOP_ROWS { const size_t r = (size_t)(row0 + ai * 128 + m * 16);
            EPI_LOOP_COLS { const int c = col0 + bj * 128 + n * 16; *(u32x2*)(Y + r * 1024 + c) = pack4(acc[ai][bj][m][n]); } }
    }
};

constexpr size_t TSTEP1K = (size_t)256 * 1024 * 2;
struct SchedInA { const char* hx; const char* wt; int G, c;
    __device__ __forceinline__ bool next(int i, Unit& u) const {
        int Lx = i * G + c, pm, pn;
        if (Lx < 2048) pg8::rect_map(Lx, 128, 16, pm, pn);
        else { Lx -= 2048; if (Lx >= 16) return false; pm = 128 + (Lx >> 2); pn = Lx & 3; }
        const int wrow = pn < 8 ? pn * 256 : 5120 + (pn - 8) * 256;
        u.pm = pm; u.pn = pn; u.last = 1; u.A = hx + (size_t)pm * TSTEP1K; u.B = wt + (size_t)wrow * 2048; return true; } };
struct SchedInB { const char* hx; const char* wt; int G, c;
    __device__ __forceinline__ bool next(int i, Unit& u) const {
        const int Lx = i * G + c; if (Lx >= 12 * 128) return false; int pm, pn; pg8::rect_map(Lx, 12, 128, pm, pn);
        u.pm = pm; u.pn = pn; u.last = 1; u.A = wt + (size_t)(2048 + pm * 256) * 2048; u.B = hx + (size_t)pn * TSTEP1K; return true; } };
struct SchedMerge { const char* yrg; const char* yhy; const char* wrg; const char* why; int G, c;
    __device__ __forceinline__ bool next(int i, Unit& u) const {
        const int T = (i >> 1) * G + c, part = i & 1; if (T >= 512) return false; int pm, pn; pg8::rect_map(T, 128, 4, pm, pn);
        u.pm = pm; u.pn = pn; u.last = part; u.A = (part ? yhy : yrg) + (size_t)pm * TSTEP1K; u.B = (part ? why : wrg) + (size_t)pn * TSTEP1K; return true; } };
struct SchedOut { const char* a; const char* w; int G, c;
    __device__ __forceinline__ bool next(int i, Unit& u) const {
        const int T = i * G + c; if (T >= 512) return false; int pm, pn; pg8::rect_map(T, 128, 4, pm, pn);
        u.pm = pm; u.pn = pn; u.last = 1; u.A = a + (size_t)pm * TSTEP1K; u.B = w + (size_t)pn * TSTEP1K; return true; } };
struct SchedMoeUp { const char* xg; const char* w13; const LAS int* blk_exp; int nblk, G, c;
    __device__ __forceinline__ bool next(int i, Unit& u) const {
        const int T = i * G + c; if (T >= nblk * 4) return false; const int pm = T >> 2, pn = T & 3, e = blk_exp[pm];
        u.pm = pm; u.pn = pn; u.last = 1; u.A = xg + (size_t)pm * TSTEP1K; u.B = w13 + (size_t)e * (1024 * 1024 * 2) + (size_t)pn * TSTEP1K; return true; } };
struct SchedMoeDown { const char* h; const char* w2; const LAS int* blk_exp; int nblk, G, c;
    __device__ __forceinline__ bool next(int i, Unit& u) const {
        const int T = i * G + c; if (T >= nblk * 4) return false; const int pm = T >> 2, pn = T & 3, e = blk_exp[pm];
        u.pm = pm; u.pn = pn; u.last = 1; u.A = h + (size_t)pm * (256 * 512 * 2); u.B = w2 + (size_t)e * (1024 * 512 * 2) + (size_t)pn * (256 * 512 * 2); return true; } };


typedef f32x2 cpx;
__device__ __forceinline__ int pidx(int i) { return i + (i >> 4); }
__device__ __forceinline__ cpx cmul(cpx a, cpx b) { return (cpx){a.x * b.x - a.y * b.y, a.x * b.y + a.y * b.x}; }
template <bool INV> __device__ __forceinline__ cpx mul_w4(cpx a) { return INV ? (cpx){-a.y, a.x} : (cpx){a.y, -a.x}; }
template <bool INV> __device__ __forceinline__ void dft4(cpx& a, cpx& b, cpx& c, cpx& d) {
    const cpx t0 = a + c, t1 = a - c, t2 = b + d, t3 = b - d; const cpx t3r = mul_w4<INV>(t3);
    a = t0 + t2; b = t1 + t3r; c = t0 - t2; d = t1 - t3r; }
template <bool INV> __device__ __forceinline__ cpx twc(cpx x, float cr, float ci) { return cmul(x, (cpx){cr, INV ? -ci : ci}); }
#define SLOT16(q) (4 * ((q) & 3) + ((q) >> 2))
template <bool INV> __device__ __forceinline__ void dft16(cpx (&x)[16]) {
    const float C1 = 0.9238795325112867f, S1 = 0.3826834323650898f, R = 0.7071067811865476f;
#pragma unroll
    for (int m2 = 0; m2 < 4; ++m2) dft4<INV>(x[m2], x[4 + m2], x[8 + m2], x[12 + m2]);
    x[5] = twc<INV>(x[5], C1, -S1); x[9] = twc<INV>(x[9], R, -R); x[6] = twc<INV>(x[6], R, -R);
    x[13] = twc<INV>(x[13], S1, -C1); x[7] = twc<INV>(x[7], S1, -C1); x[10] = mul_w4<INV>(x[10]);
    x[14] = twc<INV>(x[14], -R, -R); x[11] = twc<INV>(x[11], -R, -R); x[15] = twc<INV>(x[15], -C1, S1);
#pragma unroll
    for (int q1 = 0; q1 < 4; ++q1) dft4<INV>(x[4 * q1], x[4 * q1 + 1], x[4 * q1 + 2], x[4 * q1 + 3]);
}
template <int S_, int NIN> __device__ __forceinline__ void fft_fwd16(LAS cpx* X, int tid) {
    constexpr int PS = S_ + S_ / 16;
#pragma unroll 1
    for (int it = 0; it < 2; ++it) {
        int bf = tid + 512 * it; asm volatile("" : "+v"(bf)); const int blk = bf / S_, j = bf % S_; const int base = pidx(blk * (16 * S_) + j);
        cpx x[16];
#pragma unroll
        for (int m = 0; m < 16; ++m) x[m] = (m < NIN) ? X[base + PS * m] : (cpx){0.f, 0.f};
        dft16<false>(x);
        float sn, cs; sincospif(-(float)j / (float)(8 * S_), &sn, &cs); const cpx w1 = {cs, sn}; cpx w = w1;
        X[base] = x[0];
#pragma unroll
        for (int q = 1; q < 16; ++q) { X[base + PS * q] = cmul(x[SLOT16(q)], w); w = cmul(w, w1); }
    }
}
template <int S_, int NOUT> __device__ __forceinline__ void fft_inv16(LAS cpx* X, int tid) {
    constexpr int PS = S_ + S_ / 16;
#pragma unroll 1
    for (int it = 0; it < 2; ++it) {
        int bf = tid + 512 * it; asm volatile("" : "+v"(bf)); const int blk = bf / S_, j = bf % S_; const int base = pidx(blk * (16 * S_) + j);
        float sn, cs; sincospif((float)j / (float)(8 * S_), &sn, &cs); const cpx w1 = {cs, sn}; cpx w = w1;
        cpx x[16]; x[0] = X[base];
#pragma unroll
        for (int q = 1; q < 16; ++q) { x[q] = cmul(X[base + PS * q], w); w = cmul(w, w1); }
        dft16<true>(x);
#pragma unroll
        for (int m = 0; m < NOUT; ++m) X[base + PS * m] = x[SLOT16(m)];
    }
}
template <bool INV> __device__ __forceinline__ void fft_r4(LAS cpx* X, int tid) {
#pragma unroll 2
    for (int it = 0; it < 8; ++it) {
        int bf = tid + 512 * it; asm volatile("" : "+v"(bf)); const int blk = bf >> 4, j = bf & 15; const int base = 68 * blk + j;
        float sn, cs; sincospif((INV ? 1.f : -1.f) * (float)j * (1.f / 32.f), &sn, &cs); const cpx w1 = {cs, sn}; const cpx w2 = cmul(w1, w1), w3 = cmul(w2, w1);
        cpx a = X[base], b = X[base + 17], c = X[base + 34], d = X[base + 51];
        if (INV) { b = cmul(b, w1); c = cmul(c, w2); d = cmul(d, w3); }
        dft4<INV>(a, b, c, d);
        if (!INV) { b = cmul(b, w1); c = cmul(c, w2); d = cmul(d, w3); }
        X[base] = a; X[base + 17] = b; X[base + 34] = c; X[base + 51] = d;
    }
}
__device__ __forceinline__ void fft_fwdD_toK(const LAS cpx* X, cpx* Kb, int tid) {
#pragma unroll 1
    for (int it = 0; it < 2; ++it) {
        int bf = tid + 512 * it; asm volatile("" : "+v"(bf)); const int base = 17 * bf;
        cpx x[16];
#pragma unroll
        for (int m = 0; m < 16; ++m) x[m] = X[base + m];
        dft16<false>(x);
#pragma unroll
        for (int q = 0; q < 16; ++q) Kb[q * 1024 + bf] = x[SLOT16(q)] * (1.f / 16384.f);
    }
}
__device__ __forceinline__ void fft_fusedD(LAS cpx* X, const cpx* Kb, int tid) {
#pragma unroll 1
    for (int it = 0; it < 2; ++it) {
        int bf = tid + 512 * it; asm volatile("" : "+v"(bf)); const int base = 17 * bf;
        cpx x[16], z[16];
#pragma unroll
        for (int m = 0; m < 16; ++m) x[m] = X[base + m];
        dft16<false>(x);
#pragma unroll
        for (int q = 0; q < 16; ++q) { const unsigned long long kb = __hip_atomic_load((const unsigned long long*)(Kb + q * 1024 + bf), __ATOMIC_RELAXED, __HIP_MEMORY_SCOPE_AGENT);
            const cpx kq = {__builtin_bit_cast(float, (unsigned)kb), __builtin_bit_cast(float, (unsigned)(kb >> 32))}; z[q] = cmul(x[SLOT16(q)], kq); }
        dft16<true>(z);
#pragma unroll
        for (int m = 0; m < 16; ++m) X[base + m] = z[SLOT16(m)];
    }
}
__device__ __forceinline__ void load10(const bf16* row, int t0, float (&pv)[10]) {
    const u32x4 q = *(const u32x4*)(row + t0);
    pv[0] = t0 > 0 ? bf2f(row[t0 - 1]) : 0.f; pv[9] = (t0 + 8 < SEQ) ? bf2f(row[t0 + 8]) : 0.f;
    pv[1] = bflo(q.x); pv[2] = bfhi(q.x); pv[3] = bflo(q.y); pv[4] = bfhi(q.y); pv[5] = bflo(q.z); pv[6] = bfhi(q.z); pv[7] = bflo(q.w); pv[8] = bfhi(q.w);
}

__device__ __forceinline__ void transpose_item(const float* W, int K, int N, bf16* WT, int mode, LAS float* scr, int item, int lane) {
    const int nblk = N / 32, kb = item / nblk, nb = item % nblk, k0 = 64 * kb, n0 = 32 * nb;
#pragma unroll 8
    for (int i = 0; i < 32; ++i) { const int kk = 2 * i + (lane >> 5); scr[kk * 33 + (lane & 31)] = W[(size_t)(k0 + kk) * N + n0 + (lane & 31)]; }
    LDS_WAIT(); asm volatile("" ::: "memory");
    const int c = lane & 7;
#pragma unroll
    for (int j = 0; j < 4; ++j) { const int n = (lane >> 3) + 8 * j; const LAS float* s = scr + (8 * c) * 33 + n;
        u32x4 o; o.x = pk2(s[0 * 33], s[1 * 33]); o.y = pk2(s[2 * 33], s[3 * 33]); o.z = pk2(s[4 * 33], s[5 * 33]); o.w = pk2(s[6 * 33], s[7 * 33]);
        const int nn = n0 + n; int row;
        if (mode == 0) row = nn;
        else if (mode == 1) row = (nn >> 7) * 256 + (nn & 127);
        else row = (nn >> 7) * 256 + 128 + (nn & 127);
        *(u32x4*)(WT + (size_t)row * K + k0 + 8 * c) = o; }
    LDS_WAIT(); asm volatile("" ::: "memory");
}

struct Args { const float* in[41]; float* out; unsigned char* ws; int ph_lo, ph_hi; };

enum { I_X = 0, I_C, I_CTX, I_CCTX, I_ADAW, I_ADAB, I_N1G, I_N2G, I_FG, I_WIN, I_RGCW, I_RGCB, I_WAF, I_BAF, I_WXF, I_BXF, I_LAMF, I_WAB, I_BAB, I_WXB, I_BXB, I_LAMB,
       I_RGPROJ, I_HYCW, I_HYCB, I_PW1, I_PB1, I_PW2, I_PB2, I_FREQ, I_PW3, I_SKIP, I_HYPROJ, I_WOUT, I_WG, I_BG, I_WE, I_BE, I_MW1, I_MW3, I_MW2 };

constexpr int NPHASE = 13;

__global__ void __launch_bounds__(NTHREADS, 2) fwd_kernel(Args args) {
    extern __shared__ __attribute__((aligned(16))) unsigned char lds_raw[];
    LAS unsigned char* lds = (LAS unsigned char*)lds_raw;
    const int tid = threadIdx.x, lane = tid & 63, wave = __builtin_amdgcn_readfirstlane(tid >> 6);
    const int G = gridDim.x, bid = blockIdx.x;
    const int gw = bid * NWAVES + wave, NGW = G * NWAVES;
    unsigned char* ws = args.ws;
    const int lo = args.ph_lo, hi = args.ph_hi;
#define IN(k) (lo <= (k) && (k) < hi)
#if ONE_LAUNCH
    cg::grid_group grid = cg::this_grid();
#define GRID_SYNC(k) do { if (IN(k) && IN((k) + 1)) grid.sync(); } while (0)
#else
#define GRID_SYNC(k) do { } while (0)
#endif
    int* cnt = (int*)(ws + WS_CTL);
    float* mod = (float*)(ws + WS_MOD);
    float* z2 = (float*)(ws + WS_Z2);
    float* ssq = (float*)(ws + WS_SSQ);
    int* tok_e = (int*)(ws + WS_ROUTE); int* tok_rank = tok_e + 2 * NTOK; float* tok_w = (float*)(tok_rank + 2 * NTOK); int* tok_slot = (int*)(tok_w + 2 * NTOK);
    bf16* rgproj_t = (bf16*)(ws + WS_WSMALL); bf16* hyproj_t = rgproj_t + 1024 * 1024; bf16* wout_t = hyproj_t + 1024 * 1024;
    bf16* win_t = (bf16*)(ws + WS_WIN);
    bf16* hx = (bf16*)(ws + WS_HX); bf16* yhy = (bf16*)(ws + WS_HX); bf16* Hbuf = (bf16*)(ws + WS_HX);
    bf16* prx = (bf16*)(ws + WS_PRX); bf16* merged = (bf16*)(ws + WS_PRX);
    bf16* grg = (bf16*)(ws + WS_GRG); bf16* hx2 = (bf16*)(ws + WS_GRG);
    bf16* phyT = (bf16*)(ws + WS_PHY);
    bf16* w13t = (bf16*)(ws + WS_W13); bf16* w2t = (bf16*)(ws + WS_W2);
    bf16* Xg = (bf16*)(ws + WS_XG); bf16* Ybuf = (bf16*)(ws + WS_XG);
    float* kf = (float*)(ws + WS_KF); bf16* yrg = (bf16*)(ws + WS_KF);
    f32x2* carr = (f32x2*)(ws + WS_CARR); float* cin = (float*)(ws + WS_CIN);
    bf16* gates = (bf16*)args.out;
    float* x1 = args.out;

    if (IN(0)) {
        if (bid == 0 && tid < 64) cnt[tid] = 0;
        {
            LAS float* red = (LAS float*)lds;
            const float* c = args.in[I_C]; const float* cctx = args.in[I_CCTX]; const float* ada_w = args.in[I_ADAW]; const float* ada_b = args.in[I_ADAB];
            for (int g = bid; g < 96; g += G) {
                const int n = g * 64 + lane; float acc[5] = {0.f, 0.f, 0.f, 0.f, 0.f};
                for (int kk = 0; kk < 128; ++kk) { const int k = wave * 128 + kk; const float a = ada_w[(size_t)k * 6144 + n];
#pragma unroll
                    for (int r = 0; r < 5; ++r) { const float cv = (r < 4) ? c[r * 1024 + k] : cctx[k]; acc[r] += cv * sigmoidf_(cv) * a; } }
#pragma unroll
                for (int r = 0; r < 5; ++r) red[(wave * 5 + r) * 64 + lane] = acc[r];
                __syncthreads();
                if (wave == 0) {
#pragma unroll
                    for (int r = 0; r < 5; ++r) { float s = ada_b[n]; for (int w = 0; w < 8; ++w) s += red[(w * 5 + r) * 64 + lane]; mod[r * 6144 + n] = s; } }
                __syncthreads();
            }
        }
        {
            LAS float* fe = (LAS float*)lds + wave * 128; LAS float* z1 = fe + 64;
            const float* w1 = args.in[I_PW1]; const float* b1 = args.in[I_PB1]; const float* w2 = args.in[I_PW2]; const float* b2 = args.in[I_PB2]; const float* fr = args.in[I_FREQ];
            const float TWO_PI = 6.283185307179586f;
            for (int s = gw; s < SEQ; s += NGW) {
                float f = 0.f; const float sf = (float)s;
                if (lane == 0) f = sf / 8191.f;
                else if (lane <= 32) { const int j = (lane - 1) & 15; const float band = 1e-4f + (float)j * ((15.f - 1e-4f) / 15.f); float rev = sf * band * (1.f / 8192.f); rev -= floorf(rev + 0.5f);
                    f = (lane <= 16) ? cosf(TWO_PI * rev) : sinf(TWO_PI * rev); }
                else if (lane == 33) f = (float)(s >> 6) / 128.f;
                else if (lane <= 49) { const int mm = (lane <= 41) ? (lane - 33) : (lane - 41); float rev = (float)((s & 63) * mm) * (1.f / 64.f); rev -= floorf(rev + 0.5f);
                    f = (lane <= 41) ? cosf(TWO_PI * rev) : sinf(TWO_PI * rev); }
                fe[lane] = f; LDS_WAIT(); asm volatile("" ::: "memory");
                float a = b1[lane];
                for (int i = 0; i < 50; ++i) a += fe[i] * w1[i * 64 + lane];
                z1[lane] = sinf(fr[lane] * a); LDS_WAIT(); asm volatile("" ::: "memory");
                float a2 = b2[lane];
                for (int i = 0; i < 64; ++i) a2 += z1[i] * w2[i * 64 + lane];
                z2[(size_t)s * 64 + lane] = sinf(fr[lane] * a2);
                LDS_WAIT(); asm volatile("" ::: "memory");
            }
        }
        __syncthreads();
        {
            LAS float* scr = (LAS float*)lds + wave * 2176;
            constexpr int I_IN = 16 * 224, I_SQ = 16 * 32;
            constexpr int NITEMS = I_IN + 3 * I_SQ;
            for (int it = gw; it < NITEMS; it += NGW) {
                int r = it;
                if (r < I_IN) { transpose_item(args.in[I_WIN], 1024, INC, win_t, 0, scr, r, lane); continue; } r -= I_IN;
                if (r < I_SQ) { transpose_item(args.in[I_RGPROJ], 1024, 1024, rgproj_t, 0, scr, r, lane); continue; } r -= I_SQ;
                if (r < I_SQ) { transpose_item(args.in[I_HYPROJ], 1024, 1024, hyproj_t, 0, scr, r, lane); continue; } r -= I_SQ;
                transpose_item(args.in[I_WOUT], 1024, 1024, wout_t, 0, scr, r, lane);
            }
        }
    }
    GRID_SYNC(0);

    if (IN(1)) {
        const float* x = args.in[I_X]; const float* ctx = args.in[I_CTX]; const float* n1g = args.in[I_N1G];
        for (int m = gw; m < MROWS; m += NGW) {
            const float* xr = (m < NTOK) ? x + (size_t)m * 1024 : ctx + (size_t)(m - NTOK) * 1024; const int r = (m < NTOK) ? (m >> 13) : 4;
            const float* sh = mod + r * 6144; const float* sc = sh + 1024;
            f32x4 v[4]; float ss = 0.f;
#pragma unroll
            for (int j = 0; j < 4; ++j) { v[j] = ((const f32x4*)xr)[64 * j + lane]; ss += (v[j][0] * v[j][0] + v[j][1] * v[j][1]) + (v[j][2] * v[j][2] + v[j][3] * v[j][3]); }
            const float rstd = rsqrtf(wave_sum(ss) * (1.f / 1024.f) + 1e-6f);
#pragma unroll
            for (int j = 0; j < 4; ++j) { const int k = 4 * (64 * j + lane); const f32x4 g = *(const f32x4*)(n1g + k), s = *(const f32x4*)(sc + k), h = *(const f32x4*)(sh + k);
                const f32x4 o = v[j] * rstd * g * (1.f + s) + h; *(u32x2*)(hx + (size_t)m * 1024 + k) = pack4(o); }
        }
        {
            LAS float* z2s = (LAS float*)lds; LAS float* w3s = z2s + 64 * 65;
            const float* w3 = args.in[I_PW3];
            for (int it = bid; it < 128 * 32; it += G) {
                const int s0 = (it & 127) * 64, c0 = (it >> 7) * 64;
                for (int e = tid; e < 64 * 64; e += NTHREADS) { const int r = e >> 6, cc = e & 63; z2s[r * 65 + cc] = z2[(size_t)(s0 + r) * 64 + cc]; w3s[r * 65 + cc] = w3[(size_t)r * 2048 + c0 + cc]; }
                __syncthreads();
                float acc[8] = {0.f, 0.f, 0.f, 0.f, 0.f, 0.f, 0.f, 0.f};
                for (int j = 0; j < 64; ++j) { const float z = z2s[lane * 65 + j];
#pragma unroll
                    for (int q = 0; q < 8; ++q) acc[q] += z * w3s[j * 65 + wave * 8 + q]; }
                const float tn = (float)(s0 + lane) / 8191.f;
#pragma unroll
                for (int q = 0; q < 8; ++q) { const int cp = c0 + wave * 8 + q, ch = cp & 1023;
                    const float mind = -3.0701134573253944f, maxd = -15.350567286626972f;
                    const float delta = fabsf(mind + (float)ch * ((maxd - mind) / 1023.f));
                    kf[(size_t)cp * SEQ + s0 + lane] = acc[q] * __expf(-tn * delta); }
                __syncthreads();
            }
        }
    }
    GRID_SYNC(1);

    if (IN(2)) {
        { SchedInA S{(const char*)hx, (const char*)win_t, G, bid}; EpiInA E{prx, grg, gates}; pg8::gemm_phase(lds, 1024, S, E); }
        { SchedInB S{(const char*)hx, (const char*)win_t, G, bid}; EpiInB E{phyT}; pg8::gemm_phase(lds, 1024, S, E); }
    }
    GRID_SYNC(2);

    const float* rgcw = args.in[I_RGCW]; const float* rgcb = args.in[I_RGCB];
#define SCAN_LOAD_XC(rowbase, seglen, t0, h) do {   \
        const int tok = tid >> 3, e0 = (tid & 7) * 8; const int cg0 = (h) * 64 + e0; \
        float xv[8]; _Pragma("unroll") for (int q = 0; q < 8; ++q) xv[q] = rgcb[cg0 + q]; \
        _Pragma("unroll") for (int j = 0; j < 4; ++j) { const int tt = (t0) + tok + j - 2; \
            if (tt >= 0 && tt < (seglen)) { const u32x4 p = *(const u32x4*)(prx + (size_t)((rowbase) + tt) * 1024 + cg0); const f32x4 w0 = *(const f32x4*)(rgcw + j * 1024 + cg0), w1 = *(const f32x4*)(rgcw + j * 1024 + cg0 + 4); \
                xv[0] += w0[0] * bflo(p.x); xv[1] += w0[1] * bfhi(p.x); xv[2] += w0[2] * bflo(p.y); xv[3] += w0[3] * bfhi(p.y); \
                xv[4] += w1[0] * bflo(p.z); xv[5] += w1[1] * bfhi(p.z); xv[6] += w1[2] * bflo(p.w); xv[7] += w1[3] * bfhi(p.w); } } \
        _Pragma("unroll") for (int q = 0; q < 8; ++q) XC[tok * 65 + e0 + q] = xv[q]; } while (0)
#define SCAN_GATES(wa, wx, ba, bx, lam, h) do { \
        for (int e = tid; e < 2 * 4096; e += NTHREADS) { const int g = e >> 12, r = e & 4095; WG[e] = (g ? (wx) : (wa))[(size_t)(h) * 4096 + r]; } \
        __syncthreads(); \
        const int tok = tid >> 3, e0 = (tid & 7) * 8; float ar[8], ai_[8]; \
        _Pragma("unroll") for (int q = 0; q < 8; ++q) { ar[q] = 0.f; ai_[q] = 0.f; } \
        for (int d = 0; d < 64; ++d) { const float xd = XC[tok * 65 + d]; const f32x4 r0 = *(const LAS f32x4*)(WG + d * 64 + e0), r1 = *(const LAS f32x4*)(WG + d * 64 + e0 + 4), i0 = *(const LAS f32x4*)(WG + 4096 + d * 64 + e0), i1 = *(const LAS f32x4*)(WG + 4096 + d * 64 + e0 + 4); \
            _Pragma("unroll") for (int q = 0; q < 4; ++q) { ar[q] += xd * r0[q]; ar[4 + q] += xd * r1[q]; ai_[q] += xd * i0[q]; ai_[4 + q] += xd * i1[q]; } } \
        _Pragma("unroll") for (int q = 0; q < 8; ++q) { const int cgl = (h) * 64 + e0 + q; \
            const float rr = sigmoidf_(ar[q] + (ba)[cgl]), ii = sigmoidf_(ai_[q] + (bx)[cgl]); \
            const float sp = log1pf(__expf(-(lam)[cgl])); const float la = -8.f * rr * sp; \
            const float a = __expf(la); const float om = -expm1f(2.f * la); \
            SA[tok * 64 + e0 + q] = a; SB[tok * 64 + e0 + q] = sqrtf(om) * ii * XC[tok * 65 + e0 + q]; } \
        __syncthreads(); } while (0)

    if (IN(3)) {
        LAS float* XC = (LAS float*)lds; LAS float* WG = XC + 64 * 65 + 32; LAS float* SA = WG + 2 * 4096; LAS float* SB = SA + 4096;
        for (int it = bid; it < NBATCH * NCHUNK * 16; it += G) {
            const int h = it & 15, rest = it >> 4, j = rest % NCHUNK, b = rest / NCHUNK;
            const int isctx = j < 4; const int seglen = isctx ? CTXL : SEQ; const int t0 = isctx ? j * 64 : (j - 4) * 64; const int rowbase = isctx ? NTOK + b * CTXL : b * SEQ;
            SCAN_LOAD_XC(rowbase, seglen, t0, h);
            __syncthreads();
            for (int dir = 0; dir < 2; ++dir) {
                if (dir == 0) SCAN_GATES(args.in[I_WAF], args.in[I_WXF], args.in[I_BAF], args.in[I_BXF], args.in[I_LAMF], h);
                else SCAN_GATES(args.in[I_WAB], args.in[I_WXB], args.in[I_BAB], args.in[I_BXB], args.in[I_LAMB], h);
                if (tid < 64) { float P = 1.f, hh = 0.f;
                    if (dir == 0) { for (int t = 0; t < 64; ++t) { const float a = SA[t * 64 + tid]; hh = a * hh + SB[t * 64 + tid]; P *= a; } }
                    else { for (int t = 63; t >= 0; --t) { const float a = SA[t * 64 + tid]; hh = a * hh + SB[t * 64 + tid]; P *= a; } }
                    carr[((size_t)(b * NCHUNK + j) * 2 + dir) * 1024 + h * 64 + tid] = (f32x2){P, hh}; }
                __syncthreads();
            }
        }
        {
            LAS cpx* X = (LAS cpx*)lds;
            cpx* Kb = (cpx*)(ws + WS_HX) + (size_t)bid * 16384;
            const float* hcw = args.in[I_HYCW]; const float* hcb = args.in[I_HYCB]; const float* skip = args.in[I_SKIP];
            for (int c = bid; c < 1024; c += G) {
                __syncthreads();
                for (int q = 0; q < 32; ++q) { const int i = tid + 512 * q;
                    const float v = (i < SEQ) ? kf[(size_t)c * SEQ + i] : ((i == SEQ) ? 0.f : kf[(size_t)(1024 + c) * SEQ + (16384 - i)]);
                    X[pidx(i)] = (cpx){v, 0.f}; }
                __syncthreads();
                fft_fwd16<1024, 16>(X, tid); __syncthreads();
                fft_fwd16<64, 16>(X, tid); __syncthreads();
                fft_r4<false>(X, tid); __syncthreads();
                fft_fwdD_toK(X, Kb, tid);
                const float w00 = hcw[c], w01 = hcw[3072 + c], w02 = hcw[6144 + c], b0 = hcb[c];
                const float w10 = hcw[1024 + c], w11 = hcw[3072 + 1024 + c], w12 = hcw[6144 + 1024 + c], b1 = hcb[1024 + c];
                const float w20 = hcw[2048 + c], w21 = hcw[3072 + 2048 + c], w22 = hcw[6144 + 2048 + c], b2 = hcb[2048 + c];
                const float sk = skip[c];
                for (int pair = 0; pair < 2; ++pair) {
                    const bf16* rA = phyT + ((size_t)(2 * pair) * 3072 + c) * SEQ; const bf16* rB = rA + (size_t)3072 * SEQ;
                    __syncthreads();
#pragma unroll 1
                    for (int it = 0; it < 2; ++it) { int t0 = 8 * (tid + 512 * it); asm volatile("" : "+v"(t0)); float p1[10], p2[10], ua[8], ub[8];
                        load10(rA + (size_t)1024 * SEQ, t0, p1); load10(rA + (size_t)2048 * SEQ, t0, p2);
#pragma unroll
                        for (int k = 0; k < 8; ++k) ua[k] = (b2 + w20 * p2[k] + w21 * p2[k + 1] + w22 * p2[k + 2]) * (b1 + w10 * p1[k] + w11 * p1[k + 1] + w12 * p1[k + 2]);
                        load10(rB + (size_t)1024 * SEQ, t0, p1); load10(rB + (size_t)2048 * SEQ, t0, p2);
#pragma unroll
                        for (int k = 0; k < 8; ++k) ub[k] = (b2 + w20 * p2[k] + w21 * p2[k + 1] + w22 * p2[k + 2]) * (b1 + w10 * p1[k] + w11 * p1[k + 1] + w12 * p1[k + 2]);
                        const int pb = pidx(t0);
#pragma unroll
                        for (int k = 0; k < 8; ++k) X[pb + k] = (cpx){ua[k], ub[k]}; }
                    __syncthreads();
                    fft_fwd16<1024, 8>(X, tid); __syncthreads();
                    fft_fwd16<64, 16>(X, tid); __syncthreads();
                    fft_r4<false>(X, tid); __syncthreads();
                    fft_fusedD(X, Kb, tid); __syncthreads();
                    fft_r4<true>(X, tid); __syncthreads();
                    fft_inv16<64, 16>(X, tid); __syncthreads();
                    fft_inv16<1024, 8>(X, tid); __syncthreads();
#pragma unroll 1
                    for (int it = 0; it < 2; ++it) { int t0 = 8 * (tid + 512 * it); asm volatile("" : "+v"(t0)); float p0[10], p1[10], p2[10]; const int pb = pidx(t0);
                        load10(rA, t0, p0); load10(rA + (size_t)1024 * SEQ, t0, p1); load10(rA + (size_t)2048 * SEQ, t0, p2);
#pragma unroll
                        for (int k = 0; k < 8; ++k) { const float uu = (b2 + w20 * p2[k] + w21 * p2[k + 1] + w22 * p2[k + 2]) * (b1 + w10 * p1[k] + w11 * p1[k + 1] + w12 * p1[k + 2]);
                            const float x0 = b0 + w00 * p0[k] + w01 * p0[k + 1] + w02 * p0[k + 2]; X[pb + k].x = (X[pb + k].x + sk * uu) * x0; }
                        load10(rB, t0, p0); load10(rB + (size_t)1024 * SEQ, t0, p1); load10(rB + (size_t)2048 * SEQ, t0, p2);
#pragma unroll
                        for (int k = 0; k < 8; ++k) { const float uu = (b2 + w20 * p2[k] + w21 * p2[k + 1] + w22 * p2[k + 2]) * (b1 + w10 * p1[k] + w11 * p1[k + 1] + w12 * p1[k + 2]);
                            const float x0 = b0 + w00 * p0[k] + w01 * p0[k + 1] + w02 * p0[k + 2]; X[pb + k].y = (X[pb + k].y + sk * uu) * x0; } }
                    __syncthreads();
#pragma unroll 1
                    for (int it = 0; it < 2; ++it) { int t0 = 8 * (tid + 512 * it); asm volatile("" : "+v"(t0)); const int pb = pidx(t0); cpx y[8];
#pragma unroll
                        for (int k = 0; k < 8; ++k) y[k] = X[pb + k];
                        *(u32x4*)((bf16*)rA + t0) = (u32x4){pk2(y[0].x, y[1].x), pk2(y[2].x, y[3].x), pk2(y[4].x, y[5].x), pk2(y[6].x, y[7].x)};
                        *(u32x4*)((bf16*)rB + t0) = (u32x4){pk2(y[0].y, y[1].y), pk2(y[2].y, y[3].y), pk2(y[4].y, y[5].y), pk2(y[6].y, y[7].y)}; }
                }
            }
        }
    }
    GRID_SYNC(3);

    if (IN(4)) {
        const int gt = bid * NTHREADS + tid;
        if (gt < NBATCH * 2 * 1024) {
            const int c = gt & 1023, dir = (gt >> 10) & 1, b = gt >> 11; float s = 0.f;
            for (int q = 0; q < NCHUNK; ++q) { const int j = dir == 0 ? q : (q < 4 ? 3 - q : NCHUNK + 3 - q);
                const size_t idx = ((size_t)(b * NCHUNK + j) * 2 + dir) * 1024 + c; const f32x2 ab = carr[idx]; cin[idx] = s; s = ab.x * s + ab.y; }
        }
    }
    GRID_SYNC(4);

    if (IN(5)) {
        LAS float* XC = (LAS float*)lds; LAS float* WG = XC + 64 * 65 + 32; LAS float* SA = WG + 2 * 4096; LAS float* SB = SA + 4096; LAS float* HF = SB + 4096;
        for (int it = bid; it < NBATCH * 128 * 16; it += G) {
            const int h = it & 15, rest = it >> 4, j = (rest & 127) + 4, b = rest >> 7;
            const int t0 = (j - 4) * 64; const int rowbase = b * SEQ;
            SCAN_LOAD_XC(rowbase, SEQ, t0, h);
            __syncthreads();
            SCAN_GATES(args.in[I_WAF], args.in[I_WXF], args.in[I_BAF], args.in[I_BXF], args.in[I_LAMF], h);
            if (tid < 64) { float hh = cin[((size_t)(b * NCHUNK + j) * 2 + 0) * 1024 + h * 64 + tid];
                for (int t = 0; t < 64; ++t) { hh = SA[t * 64 + tid] * hh + SB[t * 64 + tid]; HF[t * 64 + tid] = hh; } }
            __syncthreads();
            SCAN_GATES(args.in[I_WAB], args.in[I_WXB], args.in[I_BAB], args.in[I_BXB], args.in[I_LAMB], h);
            if (tid < 64) { float hh = cin[((size_t)(b * NCHUNK + j) * 2 + 1) * 1024 + h * 64 + tid];
                for (int t = 63; t >= 0; --t) { hh = SA[t * 64 + tid] * hh + SB[t * 64 + tid];
                    const size_t o = (size_t)(rowbase + t0 + t) * 1024 + h * 64 + tid;
                    yrg[o] = (bf16)f2bf((HF[t * 64 + tid] + hh) * bf2f(grg[o])); } }
            __syncthreads();
        }
        {
            LAS bf16* T = (LAS bf16*)lds;
            for (int it = bid; it < NBATCH * 16 * 128; it += G) {
                const int tb = it & 127, cb = (it >> 7) & 15, b = it >> 11;
                { const int cl = tid >> 3, ch = tid & 7; *(LAS u32x4*)(T + cl * 72 + ch * 8) = *(const u32x4*)(phyT + ((size_t)b * 3072 + cb * 64 + cl) * SEQ + tb * 64 + ch * 8); }
                __syncthreads();
                { const int tl = tid >> 3, ch = tid & 7; unsigned v[8];
#pragma unroll
                    for (int q = 0; q < 8; ++q) v[q] = T[(ch * 8 + q) * 72 + tl];
                    u32x4 o; o.x = v[0] | (v[1] << 16); o.y = v[2] | (v[3] << 16); o.z = v[4] | (v[5] << 16); o.w = v[6] | (v[7] << 16);
                    *(u32x4*)(yhy + (size_t)(b * SEQ + tb * 64 + tl) * 1024 + cb * 64 + ch * 8) = o; }
                __syncthreads();
            }
        }
    }
    GRID_SYNC(5);

    if (IN(6)) {
        SchedMerge S{(const char*)yrg, (const char*)yhy, (const char*)rgproj_t, (const char*)hyproj_t, G, bid}; EpiMerge E{gates, merged};
        pg8::gemm_phase(lds, 1024, S, E);
    }
    GRID_SYNC(6);

    if (IN(7)) {
        SchedOut S{(const char*)merged, (const char*)wout_t, G, bid}; EpiOut E{args.in[I_X], mod, x1, ssq};
        pg8::gemm_phase(lds, 1024, S, E);
    }
    GRID_SYNC(7);

    if (IN(8)) {
        {
            LAS float* rowbuf = (LAS float*)lds + wave * 1088;
            const float* n2g = args.in[I_N2G]; const float* wg = args.in[I_WG]; const float* bg = args.in[I_BG]; const float* we = args.in[I_WE]; const float* be = args.in[I_BE];
            for (int m = gw; m < NTOK; m += NGW) {
                const int b = m >> 13; const float* sh = mod + b * 6144 + 3072; const float* sc = sh + 1024;
                float ss = 0.f; { const float* sp = ssq + (size_t)m * 16; for (int q = 0; q < 16; ++q) ss += sp[q]; }
                const float rstd = rsqrtf(ss * (1.f / 1024.f) + 1e-6f);
#pragma unroll
                for (int j = 0; j < 4; ++j) { const int k = 4 * (64 * j + lane); const f32x4 v = *(const f32x4*)(x1 + (size_t)m * 1024 + k);
                    const f32x4 g = *(const f32x4*)(n2g + k), s = *(const f32x4*)(sc + k), hh = *(const f32x4*)(sh + k);
                    const f32x4 o = v * rstd * g * (1.f + s) + hh; *(u32x2*)(hx2 + (size_t)m * 1024 + k) = pack4(o); *(LAS f32x4*)(rowbuf + k) = o; }
                LDS_WAIT(); asm volatile("" ::: "memory");
                float lg = 0.f;
                if (lane < 36) { const float* wp = lane < 4 ? wg + lane : we + (lane - 4); const int st = lane < 4 ? 4 : 32;
                    for (int k = 0; k < 1024; ++k) lg += rowbuf[k] * wp[(size_t)k * st];
                    lg += lane < 4 ? bg[lane] : be[lane - 4]; }
                rowbuf[1024 + lane] = lg; LDS_WAIT(); asm volatile("" ::: "memory");
                if (lane == 0) {
                    const LAS float* lgp = rowbuf + 1024;
                    int grp = 0; float gm = lgp[0]; for (int q = 1; q < 4; ++q) if (lgp[q] > gm) { gm = lgp[q]; grp = q; }
                    float den = 0.f; for (int q = 0; q < 4; ++q) den += __expf(lgp[q] - gm);
                    const float pg = 1.f / den;
                    const LAS float* ep = lgp + 4 + grp * 8;
                    int i1 = 0; float v1 = ep[0]; for (int q = 1; q < 8; ++q) if (ep[q] > v1) { v1 = ep[q]; i1 = q; }
                    int i2 = -1; float v2 = -3.0e38f; for (int q = 0; q < 8; ++q) if (q != i1 && ep[q] > v2) { v2 = ep[q]; i2 = q; }
                    const float e2 = __expf(v2 - v1); const float p1 = 1.f / (1.f + e2), p2 = e2 / (1.f + e2);
                    const int ea = grp * 8 + i1, eb = grp * 8 + i2;
                    const int ra = atomicAdd(cnt + ea, 1), rb = atomicAdd(cnt + eb, 1);
                    tok_e[2 * m] = ea; tok_e[2 * m + 1] = eb; tok_rank[2 * m] = ra; tok_rank[2 * m + 1] = rb; tok_w[2 * m] = pg * p1; tok_w[2 * m + 1] = pg * p2;
                }
                LDS_WAIT(); asm volatile("" ::: "memory");
            }
        }
        __syncthreads();
        {
            LAS float* scr = (LAS float*)lds + wave * 2176;
            constexpr int I_E13 = 16 * 16, I_E2 = 8 * 32;
            constexpr int NITEMS = NEXP * (2 * I_E13 + I_E2);
            for (int it = gw; it < NITEMS; it += NGW) {
                const int e = it / (2 * I_E13 + I_E2); int r = it % (2 * I_E13 + I_E2);
                if (r < I_E13) { transpose_item(args.in[I_MW1] + (size_t)e * 1024 * 512, 1024, 512, w13t + (size_t)e * 1024 * 1024, 1, scr, r, lane); continue; } r -= I_E13;
                if (r < I_E13) { transpose_item(args.in[I_MW3] + (size_t)e * 1024 * 512, 1024, 512, w13t + (size_t)e * 1024 * 1024, 2, scr, r, lane); continue; } r -= I_E13;
                transpose_item(args.in[I_MW2] + (size_t)e * 512 * 1024, 512, 1024, w2t + (size_t)e * 1024 * 512, 0, scr, r, lane);
            }
        }
    }
    GRID_SYNC(8);

    LAS int* blk_exp = (LAS int*)(lds + MISC_OFF); LAS int* pstart = blk_exp + 320;
    int nblk = 0;
    if (hi > 9 && lo <= 11) {
        __syncthreads();
        if (tid == 0) { int p = 0; for (int e = 0; e < NEXP; ++e) { const int c_ = __hip_atomic_load(cnt + e, __ATOMIC_RELAXED, __HIP_MEMORY_SCOPE_AGENT); const int nb = (c_ + 255) >> 8; pstart[e] = p * 256; for (int q = 0; q < nb; ++q) blk_exp[p + q] = e; p += nb; } pstart[32] = p; }
        __syncthreads();
        nblk = pstart[32];
    }

    if (IN(9)) {
        for (int a = gw; a < 2 * NTOK; a += NGW) {
            const int e = tok_e[a], rk = tok_rank[a]; const int slot = pstart[e] + rk; const int m = a >> 1;
            if (lane == 0) tok_slot[a] = slot;
            const u32x4* src = (const u32x4*)(hx2 + (size_t)m * 1024); u32x4* dst = (u32x4*)(Xg + (size_t)slot * 1024);
            dst[lane] = src[lane]; dst[64 + lane] = src[64 + lane];
        }
    }
    GRID_SYNC(9);

    if (IN(10)) {
        SchedMoeUp S{(const char*)Xg, (const char*)w13t, blk_exp, nblk, G, bid}; EpiMoeUp E{Hbuf};
        pg8::gemm_phase(lds, 1024, S, E);
    }
    GRID_SYNC(10);

    if (IN(11)) {
        SchedMoeDown S{(const char*)Hbuf, (const char*)w2t, blk_exp, nblk, G, bid}; EpiMoeDown E{Ybuf};
        pg8::gemm_phase(lds, 512, S, E);
    }
    GRID_SYNC(11);

    if (IN(12)) {
        const float* fg = args.in[I_FG];
        for (int m = gw; m < NTOK; m += NGW) {
            const int b = m >> 13; const float* g2 = mod + b * 6144 + 5120;
            const int sa = tok_slot[2 * m], sb = tok_slot[2 * m + 1]; const float wa = tok_w[2 * m], wb = tok_w[2 * m + 1];
            f32x4 v[4]; float ss = 0.f;
#pragma unroll
            for (int j = 0; j < 4; ++j) { const int k = 4 * (64 * j + lane);
                const u32x2 ya = *(const u32x2*)(Ybuf + (size_t)sa * 1024 + k), yb = *(const u32x2*)(Ybuf + (size_t)sb * 1024 + k);
                const f32x4 fa = {bflo(ya.x), bfhi(ya.x), bflo(ya.y), bfhi(ya.y)}, fb = {bflo(yb.x), bfhi(yb.x), bflo(yb.y), bfhi(yb.y)};
                const f32x4 xv = *(const f32x4*)(x1 + (size_t)m * 1024 + k), gv = *(const f32x4*)(g2 + k);
                v[j] = xv + gv * (fa * wa + fb * wb); ss += (v[j][0] * v[j][0] + v[j][1] * v[j][1]) + (v[j][2] * v[j][2] + v[j][3] * v[j][3]); }
            const float rstd = rsqrtf(wave_sum(ss) * (1.f / 1024.f) + 1e-6f);
#pragma unroll
            for (int j = 0; j < 4; ++j) { const int k = 4 * (64 * j + lane); const f32x4 g = *(const f32x4*)(fg + k); *(f32x4*)(args.out + (size_t)m * 1024 + k) = v[j] * rstd * g; }
        }
    }
}

extern "C" void kernel_launch(void* const* d_in, const int* in_sizes, int n_in, void* d_out, int out_size, void* d_ws, size_t ws_size, hipStream_t stream) {
    static int grid = 0;
    if (grid == 0) {
        if (n_in != 41 || out_size != NTOK * DM || ws_size < WS_END) { fprintf(stderr, "kernel_launch: unexpected shapes (n_in %d, out %d, ws %zu)\n", n_in, out_size, ws_size); grid = -1; return; }
        int dev = 0, cus = 0, per_cu = 0;
        hipGetDevice(&dev); hipDeviceGetAttribute(&cus, hipDeviceAttributeMultiprocessorCount, dev);
        if (hipFuncSetAttribute((const void*)fwd_kernel, hipFuncAttributeMaxDynamicSharedMemorySize, LDS_BYTES) != hipSuccess) { fprintf(stderr, "kernel_launch: hipFuncSetAttribute failed\n"); grid = -1; return; }
        hipOccupancyMaxActiveBlocksPerMultiprocessor(&per_cu, (const void*)fwd_kernel, NTHREADS, LDS_BYTES);
        (void)hipGetLastError();
        if (per_cu < 1) { fprintf(stderr, "kernel_launch: occupancy query says %d blocks per CU\n", per_cu); per_cu = 1; }
        grid = cus;
        fprintf(stderr, "kernel_launch: grid %d (cus %d, per_cu %d)\n", grid, cus, per_cu);
    }
    if (grid < 0) return;
    Args a{};
    for (int i = 0; i < 41; ++i) a.in[i] = (const float*)d_in[i];
    a.out = (float*)d_out; a.ws = (unsigned char*)d_ws;
#if ONE_LAUNCH
    a.ph_lo = 0; a.ph_hi = NPHASE;
    void* kargs[] = {&a};
    hipError_t e = hipLaunchCooperativeKernel((const void*)fwd_kernel, dim3(grid), dim3(NTHREADS), kargs, LDS_BYTES, stream);
    if (e != hipSuccess) fprintf(stderr, "cooperative launch failed: %s (grid %d)\n", hipGetErrorString(e), grid);
#else
    for (int p = 0; p < NPHASE; ++p) { a.ph_lo = p; a.ph_hi = p + 1; hipLaunchKernelGGL(fwd_kernel, dim3(grid), dim3(NTHREADS), LDS_BYTES, stream, a); }
#endif
}
```

```cpp
#include <hip/hip_runtime.h>
#include <hip/hip_cooperative_groups.h>
#include <cstdio>
#include <cstdint>
namespace cg = cooperative_groups;

#ifndef ONE_LAUNCH
#define ONE_LAUNCH 1
#endif

#ifndef PROBE_REP
#define PROBE_REP -1
#endif
#define REPN(k) ((PROBE_REP == (k)) ? 2 : 1)
#define LAS __attribute__((address_space(3)))
typedef unsigned short bf16;
typedef float f32x4 __attribute__((ext_vector_type(4)));
typedef float f32x2 __attribute__((ext_vector_type(2)));
typedef short bf16x8 __attribute__((ext_vector_type(8)));
typedef unsigned u32x4 __attribute__((ext_vector_type(4)));
typedef unsigned u32x2 __attribute__((ext_vector_type(2)));

constexpr int DM = 1024, NBATCH = 4, SEQ = 8192, NTOK = NBATCH * SEQ, CTXL = 256, NCTX = NBATCH * CTXL, MROWS = NTOK + NCTX;
constexpr int INC = 7168, NEXP = 32, DEXP = 512, PMAXBLK = 288;
constexpr int NCHUNK = 132;
constexpr int NTHREADS = 512, NWAVES = 8;
constexpr int LDS_BYTES = 147456;
constexpr int MISC_OFF = 131072;

constexpr size_t MiB = 1u << 20;
constexpr size_t WS_CTL = 0, WS_MOD = 1 * MiB, WS_Z2 = 2 * MiB, WS_SSQ = 4 * MiB, WS_ROUTE = 6 * MiB, WS_GATEW = 7 * MiB;
constexpr size_t WS_WSMALL = 8 * MiB, WS_WIN = 14 * MiB;
constexpr size_t WS_HX = 32 * MiB;
constexpr size_t WS_PRX = 98 * MiB;
constexpr size_t WS_GRG = 164 * MiB;
constexpr size_t WS_PHY = 228 * MiB;
constexpr size_t WS_W13 = 228 * MiB, WS_W2 = 292 * MiB;
constexpr size_t WS_XG = 324 * MiB;
constexpr size_t WS_KF = 420 * MiB;
constexpr size_t WS_CARR = 484 * MiB, WS_CIN = 494 * MiB, WS_END = 512 * MiB;

__device__ __forceinline__ unsigned f2bf(float f) { unsigned u = __builtin_bit_cast(unsigned, f); return (u + 0x7fffu + ((u >> 16) & 1u)) >> 16; }
__device__ __forceinline__ unsigned pk2(float lo, float hi) { return f2bf(lo) | (f2bf(hi) << 16); }
__device__ __forceinline__ float bf2f(unsigned b) { return __builtin_bit_cast(float, b << 16); }
__device__ __forceinline__ float bflo(unsigned w) { return __builtin_bit_cast(float, w << 16); }
__device__ __forceinline__ float bfhi(unsigned w) { return __builtin_bit_cast(float, w & 0xffff0000u); }
__device__ __forceinline__ float wave_sum(float v) {
#pragma unroll
    for (int o = 1; o < 64; o <<= 1) v += __shfl_xor(v, o);
    return v;
}
__device__ __forceinline__ float sigmoidf_(float v) { return 1.f / (1.f + __expf(-v)); }
__device__ __forceinline__ float gelu_tanh(float v) { const float z = 0.7978845608028654f * (v + 0.044715f * v * v * v); const float t = 1.f - 2.f / (1.f + __expf(2.f * z)); return 0.5f * v * (1.f + t); }
#define LDS_WAIT() asm volatile("s_waitcnt lgkmcnt(0)" ::: "memory")

namespace pg8 {
#define PG8_LAS __attribute__((address_space(3)))
constexpr int BM = 256, BK = 64, HALF = 128, HTB = HALF * BK * 2, STAGE_BYTES = 8 * HTB, NXCD = 8, WGM = 8;
__host__ __device__ __forceinline__ int lds_byte(int r, int c) { const int st = (r >> 4) * 2 + (c >> 5), rr = r & 15, cc = c & 31, ob = rr * 64 + cc * 2; return st * 1024 + (ob ^ (((ob >> 9) & 1) << 5)); }
__host__ __device__ __forceinline__ void stage_rc(int b, int& R, int& C) { const int st = b / 1024, sb = b % 1024, swz = sb ^ (((sb >> 9) & 1) << 5); R = (st >> 1) * 16 + swz / 64; C = (st & 1) * 32 + (swz % 64) / 2; }

struct Unit { int pm, pn, last; const char* A; const char* B; };

__device__ __forceinline__ void rect_map(int wg, int nM, int nN, int& pm, int& pn) {
    const int nwg = nM * nN; int wgid = wg; { const int q = nwg / NXCD, r = nwg % NXCD, xcd = wgid % NXCD, off = wgid / NXCD; wgid = (xcd < r ? xcd * (q + 1) : r * (q + 1) + (xcd - r) * q) + off; }
    const int nig = WGM * nN, gid = wgid / nig, fm = gid * WGM, gsz = (nM - fm) < WGM ? (nM - fm) : WGM;
    pm = fm + ((wgid % nig) % gsz); pn = (wgid % nig) / gsz;
}

template <class Epi, class Sched>
__device__ __forceinline__ void gemm_phase(PG8_LAS unsigned char* lds, const int K, const Sched& S, const Epi& E) {
    const int tid = threadIdx.x, wid = __builtin_amdgcn_readfirstlane(tid >> 6), lane = tid & 63, wr = wid >> 2, wc = wid & 3, fr = lane & 15, fq = lane >> 4;
    const int nt = K / BK;
    unsigned voffA[2];
#pragma unroll
    for (int i = 0; i < 2; ++i) { int R, C; stage_rc(tid * 16 + i * 8192, R, C); voffA[i] = (unsigned)(R * K + C) * 2u; }
    const size_t kstep = (size_t)(BK * 2);
    const size_t hstep = (size_t)HALF * K * 2;
    const unsigned ldsw = (unsigned)wid * 1024u;
    const int aoff = lds_byte(wr * 64 + fr, fq * 8), boff = lds_byte(wc * 32 + fr, fq * 8);
#define PG8_SA(b, h) (((b) * 2 + (h)) * HTB)
#define PG8_SB(b, h) ((4 + (b) * 2 + (h)) * HTB)
#define PG8_STAGE(bufoff, gbase, voff) do { _Pragma("unroll") for (int _i = 0; _i < 2; ++_i) \
        __builtin_amdgcn_global_load_lds((const unsigned*)((const char*)(gbase) + (voff)[_i]), (PG8_LAS unsigned*)(lds + (bufoff) + ldsw + _i * 8192), 16, 0, 0); } while (0)
#define PG8_LDA(dst, b, h) do { _Pragma("unroll") for (int m = 0; m < 4; ++m) _Pragma("unroll") for (int k = 0; k < 2; ++k) dst[m][k] = *(const PG8_LAS bf16x8*)(lds + PG8_SA(b, h) + aoff + m * 2048 + k * 1024); } while (0)
#define PG8_LDB(dst, b, h) do { _Pragma("unroll") for (int n = 0; n < 2; ++n) _Pragma("unroll") for (int k = 0; k < 2; ++k) dst[n][k] = *(const PG8_LAS bf16x8*)(lds + PG8_SB(b, h) + boff + n * 2048 + k * 1024); } while (0)
#define PG8_MMA(ai, bj, At, Bt) do { __builtin_amdgcn_s_setprio(1); _Pragma("unroll") for (int m = 0; m < 4; ++m) _Pragma("unroll") for (int n = 0; n < 2; ++n) _Pragma("unroll") for (int k = 0; k < 2; ++k) \
        acc[ai][bj][m][n] = __builtin_amdgcn_mfma_f32_16x16x32_bf16(Bt[n][k], At[m][k], acc[ai][bj][m][n], 0, 0, 0); __builtin_amdgcn_s_setprio(0); } while (0)
#define PG8_WAIT_V(n) asm volatile("s_waitcnt vmcnt(" #n ")" ::: "memory")
#define PG8_WAIT_L(n) asm volatile("s_waitcnt lgkmcnt(" #n ")" ::: "memory")
#define PG8_BAR __builtin_amdgcn_s_barrier()
#define PG8_SCHED __builtin_amdgcn_sched_barrier(0)
    Unit cur, nxt; int ui = 0;
    if (!S.next(0, cur)) return;
    f32x4 acc[2][2][4][2];
#pragma unroll
    for (int a = 0; a < 2; ++a)
#pragma unroll
        for (int b = 0; b < 2; ++b)
#pragma unroll
            for (int m = 0; m < 4; ++m)
#pragma unroll
                for (int n = 0; n < 2; ++n) acc[a][b][m][n] = (f32x4){0.f, 0.f, 0.f, 0.f};
    bf16x8 At[4][2], B0[2][2], B1[2][2];
    const char* cA = cur.A; const char* cB = cur.B;
    PG8_STAGE(PG8_SB(0, 0), cB, voffA); PG8_STAGE(PG8_SB(0, 1), cB + hstep, voffA); PG8_STAGE(PG8_SA(0, 0), cA, voffA); PG8_STAGE(PG8_SA(0, 1), cA + hstep, voffA);
    if (wr == 1) PG8_BAR;
    PG8_WAIT_V(2); PG8_BAR;
    PG8_STAGE(PG8_SB(1, 0), cB + kstep, voffA); PG8_STAGE(PG8_SA(1, 0), cA + kstep, voffA); PG8_STAGE(PG8_SB(1, 1), cB + hstep + kstep, voffA);
    PG8_WAIT_V(6); PG8_BAR;
    for (;;) {
        const bool has_next = S.next(ui + 1, nxt);
        const char* nA = has_next ? nxt.A : cA; const char* nB = has_next ? nxt.B : cB;
        for (int t = 0; t < nt; t += 2) {
            const bool last = (t == nt - 2);
            const char* a1 = cA + (size_t)(t + 1) * kstep;
            const char* a2 = last ? nA : cA + (size_t)(t + 2) * kstep; const char* b2 = last ? nB : cB + (size_t)(t + 2) * kstep;
            const char* a3 = a2 + kstep; const char* b3 = b2 + kstep;
            PG8_LDB(B0, 0, 0); PG8_LDB(B1, 0, 1); PG8_SCHED; PG8_LDA(At, 0, 0); PG8_STAGE(PG8_SA(1, 1), a1 + hstep, voffA);
            PG8_WAIT_V(8); PG8_WAIT_L(0); PG8_BAR; PG8_MMA(0, 0, At, B0); PG8_MMA(0, 1, At, B1); PG8_BAR; PG8_SCHED;
            PG8_LDA(At, 0, 1); PG8_STAGE(PG8_SB(0, 0), b2, voffA); PG8_STAGE(PG8_SB(0, 1), b2 + hstep, voffA); PG8_STAGE(PG8_SA(0, 0), a2, voffA);
            PG8_WAIT_V(8); PG8_WAIT_L(0); PG8_BAR; PG8_MMA(1, 0, At, B0); PG8_MMA(1, 1, At, B1); PG8_BAR; PG8_SCHED;
            PG8_LDB(B0, 1, 0); PG8_LDB(B1, 1, 1); PG8_SCHED; PG8_LDA(At, 1, 0); PG8_STAGE(PG8_SA(0, 1), a2 + hstep, voffA);
            PG8_WAIT_V(8); PG8_WAIT_L(0); PG8_BAR; PG8_MMA(0, 0, At, B0); PG8_MMA(0, 1, At, B1); PG8_BAR; PG8_SCHED;
            PG8_LDA(At, 1, 1); PG8_STAGE(PG8_SB(1, 0), b3, voffA); PG8_STAGE(PG8_SB(1, 1), b3 + hstep, voffA); PG8_STAGE(PG8_SA(1, 0), a3, voffA);
            PG8_WAIT_V(8); PG8_WAIT_L(0); PG8_BAR; PG8_MMA(1, 0, At, B0); PG8_MMA(1, 1, At, B1); PG8_BAR; PG8_SCHED;
        }
        if (wr == 0) PG8_BAR;
        if (cur.last) E.fin(acc, cur, wr, wc, fr, fq); else E.mid(acc, cur, wr, wc, fr, fq);
        if (!has_next) break;
        if (cur.last) {
#pragma unroll
            for (int a = 0; a < 2; ++a)
#pragma unroll
                for (int b = 0; b < 2; ++b)
#pragma unroll
                    for (int m = 0; m < 4; ++m)
#pragma unroll
                        for (int n = 0; n < 2; ++n) acc[a][b][m][n] = (f32x4){0.f, 0.f, 0.f, 0.f};
        }
        cur = nxt; cA = nA; cB = nB; ++ui;
        if (wr == 1) PG8_BAR;
    }
    PG8_WAIT_V(0);
    PG8_BAR;
#undef PG8_SA
#undef PG8_SB
#undef PG8_STAGE
#undef PG8_LDA
#undef PG8_LDB
#undef PG8_MMA
#undef PG8_WAIT_V
#undef PG8_WAIT_L
#undef PG8_BAR
#undef PG8_SCHED
}
}
using pg8::Unit;
typedef f32x4 AccT[2][2][4][2];

__device__ __forceinline__ u32x2 pack4(f32x4 v) { u32x2 w; w.x = pk2(v[0], v[1]); w.y = pk2(v[2], v[3]); return w; }

#define EPI_LOOP_ROWS _Pragma("unroll") for (int ai = 0; ai < 2; ++ai) _Pragma("unroll") for (int m = 0; m < 4; ++m)
#define EPI_LOOP_COLS _Pragma("unroll") for (int bj = 0; bj < 2; ++bj) _Pragma("unroll") for (int n = 0; n < 2; ++n)

struct EpiInA {
    bf16* prx; bf16* grg; bf16* gates;
    __device__ __forceinline__ void mid(AccT& acc, const Unit& u, int wr, int wc, int fr, int fq) const {}
    __device__ __forceinline__ void fin(AccT& acc, const Unit& u, int wr, int wc, int fr, int fq) const {
        const int row0 = u.pm * 256 + wr * 64 + fr, col0 = u.pn * 256 + wc * 32 + 4 * fq;
        EPI_LOOP_ROWS { const size_t r = (size_t)(row0 + ai * 128 + m * 16);
            EPI_LOOP_COLS { const int c = col0 + bj * 128 + n * 16; f32x4 v = acc[ai][bj][m][n];
                if (u.pn < 4) { *(u32x2*)(prx + r * 1024 + c) = pack4(v); }
                else if (u.pn < 8) { f32x4 g; for (int i = 0; i < 4; ++i) g[i] = gelu_tanh(v[i]); *(u32x2*)(grg + r * 1024 + (c - 1024)) = pack4(g); }
                else { f32x4 g; for (int i = 0; i < 4; ++i) g[i] = sigmoidf_(v[i]); *(u32x2*)(gates + r * 2048 + (c - 2048)) = pack4(g); } } }
    }
};
struct EpiInB {
    bf16* phyT;
    __device__ __forceinline__ void mid(AccT& acc, const Unit& u, int wr, int wc, int fr, int fq) const {}
    __device__ __forceinline__ void fin(AccT& acc, const Unit& u, int wr, int wc, int fr, int fq) const {
        const int row0 = u.pm * 256 + wr * 64 + fr, col0 = u.pn * 256 + wc * 32 + 4 * fq;
        const int b = u.pn >> 5;
        EPI_LOOP_ROWS { const size_t j = (size_t)(row0 + ai * 128 + m * 16);
            EPI_LOOP_COLS { const int t = col0 + bj * 128 + n * 16 - b * SEQ;
                *(u32x2*)(phyT + ((size_t)b * 3072 + j) * SEQ + t) = pack4(acc[ai][bj][m][n]); } }
    }
};
struct EpiMerge {
    const bf16* gates; bf16* merged;
    __device__ __forceinline__ void mid(AccT& acc, const Unit& u, int wr, int wc, int fr, int fq) const {
        const int row0 = u.pm * 256 + wr * 64 + fr, col0 = u.pn * 256 + wc * 32 + 4 * fq;
        EPI_LOOP_ROWS { const size_t r = (size_t)(row0 + ai * 128 + m * 16);
            EPI_LOOP_COLS { const int c = col0 + bj * 128 + n * 16;
                const u32x2 a = *(const u32x2*)(gates + r * 2048 + c), b = *(const u32x2*)(gates + r * 2048 + 1024 + c);
                f32x4 sa = {bflo(a.x), bfhi(a.x), bflo(a.y), bfhi(a.y)}, sb = {bflo(b.x), bfhi(b.x), bflo(b.y), bfhi(b.y)};
                for (int i = 0; i < 4; ++i) acc[ai][bj][m][n][i] *= sa[i] / fmaxf(sb[i], 1e-30f); } }
    }
    __device__ __forceinline__ void fin(AccT& acc, const Unit& u, int wr, int wc, int fr, int fq) const {
        const int row0 = u.pm * 256 + wr * 64 + fr, col0 = u.pn * 256 + wc * 32 + 4 * fq;
        EPI_LOOP_ROWS { const size_t r = (size_t)(row0 + ai * 128 + m * 16);
            EPI_LOOP_COLS { const int c = col0 + bj * 128 + n * 16;
                const u32x2 b = *(const u32x2*)(gates + r * 2048 + 1024 + c);
                f32x4 sb = {bflo(b.x), bfhi(b.x), bflo(b.y), bfhi(b.y)};
                f32x4 v = acc[ai][bj][m][n]; for (int i = 0; i < 4; ++i) v[i] *= fmaxf(sb[i], 1e-30f);
                *(u32x2*)(merged + r * 1024 + c) = pack4(v); } }
    }
};
struct EpiOut {
    const float* x; const float* mod; float* x1; float* ssq;
    __device__ __forceinline__ void mid(AccT& acc, const Unit& u, int wr, int wc, int fr, int fq) const {}
    __device__ __forceinline__ void fin(AccT& acc, const Unit& u, int wr, int wc, int fr, int fq) const {
        const int row0 = u.pm * 256 + wr * 64 + fr, col0 = u.pn * 256 + wc * 32 + 4 * fq;
        const float* g1 = mod + (u.pm >> 5) * 6144 + 2048;
        EPI_LOOP_ROWS { const size_t r = (size_t)(row0 + ai * 128 + m * 16); float s = 0.f;
            EPI_LOOP_COLS { const int c = col0 + bj * 128 + n * 16;
                const f32x4 xv = *(const f32x4*)(x + r * 1024 + c), gv = *(const f32x4*)(g1 + c);
                const f32x4 o = xv + gv * acc[ai][bj][m][n];
                *(f32x4*)(x1 + r * 1024 + c) = o; s += (o[0] * o[0] + o[1] * o[1]) + (o[2] * o[2] + o[3] * o[3]); }
            s += __shfl_xor(s, 16); s += __shfl_xor(s, 32);
            if (fq == 0) ssq[r * 16 + u.pn * 4 + wc] = s; }
    }
};
struct EpiMoeUp {
    bf16* H;
    __device__ __forceinline__ void mid(AccT& acc, const Unit& u, int wr, int wc, int fr, int fq) const {}
    __device__ __forceinline__ void fin(AccT& acc, const Unit& u, int wr, int wc, int fr, int fq) const {
        const int row0 = u.pm * 256 + wr * 64 + fr, col0 = u.pn * 128 + wc * 32 + 4 * fq;
        EPI_LOOP_ROWS { const size_t r = (size_t)(row0 + ai * 128 + m * 16);
#pragma unroll
            for (int n = 0; n < 2; ++n) { const f32x4 a = acc[ai][0][m][n], b = acc[ai][1][m][n]; f32x4 h;
                for (int i = 0; i < 4; ++i) h[i] = a[i] * sigmoidf_(a[i]) * b[i];
                *(u32x2*)(H + r * 512 + col0 + n * 16) = pack4(h); } }
    }
};
struct EpiMoeDown {
    bf16* Y;
    __device__ __forceinline__ void mid(AccT& acc, const Unit& u, int wr, int wc, int fr, int fq) const {}
    __device__ __forceinline__ void fin(AccT& acc, const Unit& u, int wr, int wc, int fr, int fq) const {
        const int row0 = u.pm * 256 + wr * 64 + fr, col0 = u.pn * 256 + wc * 32 + 4 * fq;
        EPI_LOOP_ROWS { const size_t r = (size_t)(row0 + ai * 128 + m * 16);
            EPI_LOOP_COLS { const int c = col0 + bj * 128 + n * 16; *(u32x2*)(Y + r * 1024 + c) = pack4(acc[ai][bj][m][n]); } }
    }
};

constexpr size_t TSTEP1K = (size_t)256 * 1024 * 2;
struct SchedInA { const char* hx; const char* wt; int G, c;
    __device__ __forceinline__ bool next(int i, Unit& u) const {
        int Lx = (i >> (REPN(2) - 1)) * G + c, pm, pn;
        if (Lx < 2048) pg8::rect_map(Lx, 128, 16, pm, pn);
        else { Lx -= 2048; if (Lx >= 16) return false; pm = 128 + (Lx >> 2); pn = Lx & 3; }
        const int wrow = pn < 8 ? pn * 256 : 5120 + (pn - 8) * 256;
        u.pm = pm; u.pn = pn; u.last = 1; u.A = hx + (size_t)pm * TSTEP1K; u.B = wt + (size_t)wrow * 2048; return true; } };
struct SchedInB { const char* hx; const char* wt; int G, c;
    __device__ __forceinline__ bool next(int i, Unit& u) const {
        const int Lx = (i >> (REPN(21) - 1)) * G + c; if (Lx >= 12 * 128) return false; int pm, pn; pg8::rect_map(Lx, 12, 128, pm, pn);
        u.pm = pm; u.pn = pn; u.last = 1; u.A = wt + (size_t)(2048 + pm * 256) * 2048; u.B = hx + (size_t)pn * TSTEP1K; return true; } };
struct SchedMerge { const char* yrg; const char* yhy; const char* wrg; const char* why; int G, c;
    __device__ __forceinline__ bool next(int i, Unit& u) const {
        const int T = (i >> 1) * G + c, part = i & 1; if (T >= 512) return false; int pm, pn; pg8::rect_map(T, 128, 4, pm, pn);
        u.pm = pm; u.pn = pn; u.last = part; u.A = (part ? yhy : yrg) + (size_t)pm * TSTEP1K; u.B = (part ? why : wrg) + (size_t)pn * TSTEP1K; return true; } };
struct SchedOut { const char* a; const char* w; int G, c;
    __device__ __forceinline__ bool next(int i, Unit& u) const {
        const int T = (i >> (REPN(7) - 1)) * G + c; if (T >= 512) return false; int pm, pn; pg8::rect_map(T, 128, 4, pm, pn);
        u.pm = pm; u.pn = pn; u.last = 1; u.A = a + (size_t)pm * TSTEP1K; u.B = w + (size_t)pn * TSTEP1K; return true; } };
struct SchedMoeUp { const char* xg; const char* w13; const LAS int* blk_exp; int nblk, G, c;
    __device__ __forceinline__ bool next(int i, Unit& u) const {
        const int T = i * G + c; if (T >= nblk * 4) return false; const int pm = T >> 2, pn = T & 3, e = blk_exp[pm];
        u.pm = pm; u.pn = pn; u.last = 1; u.A = xg + (size_t)pm * TSTEP1K; u.B = w13 + (size_t)e * (1024 * 1024 * 2) + (size_t)pn * TSTEP1K; return true; } };
struct SchedMoeDown { const char* h; const char* w2; const LAS int* blk_exp; int nblk, G, c;
    __device__ __forceinline__ bool next(int i, Unit& u) const {
        const int T = i * G + c; if (T >= nblk * 4) return false; const int pm = T >> 2, pn = T & 3, e = blk_exp[pm];
        u.pm = pm; u.pn = pn; u.last = 1; u.A = h + (size_t)pm * (256 * 512 * 2); u.B = w2 + (size_t)e * (1024 * 512 * 2) + (size_t)pn * (256 * 512 * 2); return true; } };


typedef f32x2 cpx;
__device__ __forceinline__ int pidx(int i) { return i + (i >> 4); }
__device__ __forceinline__ cpx cmul(cpx a, cpx b) { return (cpx){a.x * b.x - a.y * b.y, a.x * b.y + a.y * b.x}; }
template <bool INV> __device__ __forceinline__ cpx mul_w4(cpx a) { return INV ? (cpx){-a.y, a.x} : (cpx){a.y, -a.x}; }
template <bool INV> __device__ __forceinline__ void dft4(cpx& a, cpx& b, cpx& c, cpx& d) {
    const cpx t0 = a + c, t1 = a - c, t2 = b + d, t3 = b - d; const cpx t3r = mul_w4<INV>(t3);
    a = t0 + t2; b = t1 + t3r; c = t0 - t2; d = t1 - t3r; }
template <bool INV> __device__ __forceinline__ cpx twc(cpx x, float cr, float ci) { return cmul(x, (cpx){cr, INV ? -ci : ci}); }
#define SLOT16(q) (4 * ((q) & 3) + ((q) >> 2))
template <bool INV> __device__ __forceinline__ void dft16(cpx (&x)[16]) {
    const float C1 = 0.9238795325112867f, S1 = 0.3826834323650898f, R = 0.7071067811865476f;
#pragma unroll
    for (int m2 = 0; m2 < 4; ++m2) dft4<INV>(x[m2], x[4 + m2], x[8 + m2], x[12 + m2]);
    x[5] = twc<INV>(x[5], C1, -S1); x[9] = twc<INV>(x[9], R, -R); x[6] = twc<INV>(x[6], R, -R);
    x[13] = twc<INV>(x[13], S1, -C1); x[7] = twc<INV>(x[7], S1, -C1); x[10] = mul_w4<INV>(x[10]);
    x[14] = twc<INV>(x[14], -R, -R); x[11] = twc<INV>(x[11], -R, -R); x[15] = twc<INV>(x[15], -C1, S1);
#pragma unroll
    for (int q1 = 0; q1 < 4; ++q1) dft4<INV>(x[4 * q1], x[4 * q1 + 1], x[4 * q1 + 2], x[4 * q1 + 3]);
}
template <int S_, int NIN> __device__ __forceinline__ void fft_fwd16(LAS cpx* X, int tid) {
    constexpr int PS = S_ + S_ / 16;
#pragma unroll 1
    for (int it = 0; it < 2; ++it) {
        int bf = tid + 512 * it; asm volatile("" : "+v"(bf)); const int blk = bf / S_, j = bf % S_; const int base = pidx(blk * (16 * S_) + j);
        cpx x[16];
#pragma unroll
        for (int m = 0; m < 16; ++m) x[m] = (m < NIN) ? X[base + PS * m] : (cpx){0.f, 0.f};
        dft16<false>(x);
        float sn, cs; sincospif(-(float)j / (float)(8 * S_), &sn, &cs); const cpx w1 = {cs, sn}; cpx w = w1;
        X[base] = x[0];
#pragma unroll
        for (int q = 1; q < 16; ++q) { X[base + PS * q] = cmul(x[SLOT16(q)], w); w = cmul(w, w1); }
    }
}
template <int S_, int NOUT> __device__ __forceinline__ void fft_inv16(LAS cpx* X, int tid) {
    constexpr int PS = S_ + S_ / 16;
#pragma unroll 1
    for (int it = 0; it < 2; ++it) {
        int bf = tid + 512 * it; asm volatile("" : "+v"(bf)); const int blk = bf / S_, j = bf % S_; const int base = pidx(blk * (16 * S_) + j);
        float sn, cs; sincospif((float)j / (float)(8 * S_), &sn, &cs); const cpx w1 = {cs, sn}; cpx w = w1;
        cpx x[16]; x[0] = X[base];
#pragma unroll
        for (int q = 1; q < 16; ++q) { x[q] = cmul(X[base + PS * q], w); w = cmul(w, w1); }
        dft16<true>(x);
#pragma unroll
        for (int m = 0; m < NOUT; ++m) X[base + PS * m] = x[SLOT16(m)];
    }
}
template <bool INV> __device__ __forceinline__ void fft_r4(LAS cpx* X, int tid) {
#pragma unroll 2
    for (int it = 0; it < 8; ++it) {
        int bf = tid + 512 * it; asm volatile("" : "+v"(bf)); const int blk = bf >> 4, j = bf & 15; const int base = 68 * blk + j;
        float sn, cs; sincospif((INV ? 1.f : -1.f) * (float)j * (1.f / 32.f), &sn, &cs); const cpx w1 = {cs, sn}; const cpx w2 = cmul(w1, w1), w3 = cmul(w2, w1);
        cpx a = X[base], b = X[base + 17], c = X[base + 34], d = X[base + 51];
        if (INV) { b = cmul(b, w1); c = cmul(c, w2); d = cmul(d, w3); }
        dft4<INV>(a, b, c, d);
        if (!INV) { b = cmul(b, w1); c = cmul(c, w2); d = cmul(d, w3); }
        X[base] = a; X[base + 17] = b; X[base + 34] = c; X[base + 51] = d;
    }
}
__device__ __forceinline__ void fft_fwdD_toK(const LAS cpx* X, cpx* Kb, int tid) {
#pragma unroll 1
    for (int it = 0; it < 2; ++it) {
        int bf = tid + 512 * it; asm volatile("" : "+v"(bf)); const int base = 17 * bf;
        cpx x[16];
#pragma unroll
        for (int m = 0; m < 16; ++m) x[m] = X[base + m];
        dft16<false>(x);
#pragma unroll
        for (int q = 0; q < 16; ++q) Kb[q * 1024 + bf] = x[SLOT16(q)] * (1.f / 16384.f);
    }
}
__device__ __forceinline__ void fft_fusedD(LAS cpx* X, const cpx* Kb, int tid) {
#pragma unroll 1
    for (int it = 0; it < 2; ++it) {
        int bf = tid + 512 * it; asm volatile("" : "+v"(bf)); const int base = 17 * bf;
        cpx x[16], z[16];
#pragma unroll
        for (int m = 0; m < 16; ++m) x[m] = X[base + m];
        dft16<false>(x);
#pragma unroll
        for (int q = 0; q < 16; ++q) { const unsigned long long kb = __hip_atomic_load((const unsigned long long*)(Kb + q * 1024 + bf), __ATOMIC_RELAXED, __HIP_MEMORY_SCOPE_AGENT);
            const cpx kq = {__builtin_bit_cast(float, (unsigned)kb), __builtin_bit_cast(float, (unsigned)(kb >> 32))}; z[q] = cmul(x[SLOT16(q)], kq); }
        dft16<true>(z);
#pragma unroll
        for (int m = 0; m < 16; ++m) X[base + m] = z[SLOT16(m)];
    }
}
__device__ __forceinline__ void load10(const bf16* row, int t0, float (&pv)[10]) {
    const u32x4 q = *(const u32x4*)(row + t0);
    pv[0] = t0 > 0 ? bf2f(row[t0 - 1]) : 0.f; pv[9] = (t0 + 8 < SEQ) ? bf2f(row[t0 + 8]) : 0.f;
    pv[1] = bflo(q.x); pv[2] = bfhi(q.x); pv[3] = bflo(q.y); pv[4] = bfhi(q.y); pv[5] = bflo(q.z); pv[6] = bfhi(q.z); pv[7] = bflo(q.w); pv[8] = bfhi(q.w);
}


struct ScanW { const bf16* prx; const bf16* grg; bf16* yrg; const float* rgcw; const float* rgcb; const bf16* wgt;
               const float* ba_f; const float* bx_f; const float* lam_f; const float* ba_b; const float* bx_b; const float* lam_b; f32x2* carr; const float* cin; };
__device__ __forceinline__ float neg_expm1_neg(float x) {
    return (x > -0.1f) ? -x * (1.f + x * 0.5f * (1.f + x * (1.f / 3.f) * (1.f + x * 0.25f * (1.f + x * 0.2f)))) : 1.f - __expf(x);
}
template <int PASS>
__device__ __forceinline__ void scan_item(LAS unsigned char* lds, const ScanW& W, int b, int j, int h, int tid, int lane, int wave) {
    LAS float* XCF = (LAS float*)lds;
    LAS bf16* XCB = (LAS bf16*)(lds + 16896);
    LAS float* HX = (LAS float*)(lds + 16896 + 9216);
    const int isctx = j < 4; const int seglen = isctx ? CTXL : SEQ; const int t0 = isctx ? j * 64 : (j - 4) * 64; const int rowbase = isctx ? NTOK + b * CTXL : b * SEQ;
    {
        const int tok = tid >> 3, e0 = (tid & 7) * 8; const int cg0 = h * 64 + e0;
        float xv[8];
        { const f32x4 c0 = *(const f32x4*)(W.rgcb + cg0), c1 = *(const f32x4*)(W.rgcb + cg0 + 4); xv[0] = c0[0]; xv[1] = c0[1]; xv[2] = c0[2]; xv[3] = c0[3]; xv[4] = c1[0]; xv[5] = c1[1]; xv[6] = c1[2]; xv[7] = c1[3]; }
#pragma unroll
        for (int jj = 0; jj < 4; ++jj) { const int tt = t0 + tok + jj - 2;
            if (tt >= 0 && tt < seglen) { const u32x4 p = *(const u32x4*)(W.prx + (size_t)(rowbase + tt) * 1024 + cg0); const f32x4 w0 = *(const f32x4*)(W.rgcw + jj * 1024 + cg0), w1 = *(const f32x4*)(W.rgcw + jj * 1024 + cg0 + 4);
                xv[0] += w0[0] * bflo(p.x); xv[1] += w0[1] * bfhi(p.x); xv[2] += w0[2] * bflo(p.y); xv[3] += w0[3] * bfhi(p.y);
                xv[4] += w1[0] * bflo(p.z); xv[5] += w1[1] * bfhi(p.z); xv[6] += w1[2] * bflo(p.w); xv[7] += w1[3] * bfhi(p.w); } }
#pragma unroll
        for (int q = 0; q < 8; ++q) XCF[tok * 65 + e0 + q] = xv[q];
        *(LAS u32x4*)(XCB + tok * 72 + e0) = (u32x4){pk2(xv[0], xv[1]), pk2(xv[2], xv[3]), pk2(xv[4], xv[5]), pk2(xv[6], xv[7])};
    }
    u32x4 gl = {0u, 0u, 0u, 0u};
    if (PASS == 2) gl = *(const u32x4*)(W.grg + (size_t)(rowbase + t0 + (tid >> 3)) * 1024 + h * 64 + (tid & 7) * 8);
    __syncthreads();
    const int dir = wave >> 2, eb = wave & 3, g = lane >> 4, li = lane & 15; const int ch = h * 64 + eb * 16 + li;
    bf16x8 bR[2], bI[2];
    { const bf16* wp = W.wgt + ((size_t)((dir * 2) * 16 + h) * 64 + eb * 16 + li) * 64 + g * 8;
        bR[0] = *(const bf16x8*)(wp); bR[1] = *(const bf16x8*)(wp + 32); bI[0] = *(const bf16x8*)(wp + 16 * 4096); bI[1] = *(const bf16x8*)(wp + 16 * 4096 + 32); }
    f32x4 aR[4], aI[4];
#pragma unroll
    for (int mb = 0; mb < 4; ++mb) { aR[mb] = (f32x4){0.f, 0.f, 0.f, 0.f}; aI[mb] = (f32x4){0.f, 0.f, 0.f, 0.f};
        const int trow = 16 * (li >> 2) + 4 * mb + (li & 3);
#pragma unroll
        for (int ks = 0; ks < 2; ++ks) { const bf16x8 af = *(const LAS bf16x8*)(XCB + trow * 72 + ks * 32 + g * 8);
            aR[mb] = __builtin_amdgcn_mfma_f32_16x16x32_bf16(af, bR[ks], aR[mb], 0, 0, 0); aI[mb] = __builtin_amdgcn_mfma_f32_16x16x32_bf16(af, bI[ks], aI[mb], 0, 0, 0); } }
    const float ba = (dir ? W.ba_b : W.ba_f)[ch], bx = (dir ? W.bx_b : W.bx_f)[ch], lam = (dir ? W.lam_b : W.lam_f)[ch];
    const float sp8 = -8.f * log1pf(__expf(-lam));
    float av[16], bv[16];
#pragma unroll
    for (int mb = 0; mb < 4; ++mb)
#pragma unroll
        for (int r = 0; r < 4; ++r) { const int tok = 16 * g + 4 * mb + r; const float xcv = XCF[tok * 65 + eb * 16 + li];
            const float rr = sigmoidf_(aR[mb][r] + ba), ii = sigmoidf_(aI[mb][r] + bx); const float la = sp8 * rr;
            av[4 * mb + r] = __expf(la); bv[4 * mb + r] = sqrtf(neg_expm1_neg(2.f * la)) * ii * xcv; }
    float A16 = 1.f, B16 = 0.f;
    if (dir == 0) {
#pragma unroll
        for (int q = 0; q < 16; ++q) { B16 = av[q] * B16 + bv[q]; A16 *= av[q]; }
    } else {
#pragma unroll
        for (int q = 15; q >= 0; --q) { B16 = av[q] * B16 + bv[q]; A16 *= av[q]; }
    }
    const size_t cidx = ((size_t)(b * NCHUNK + j) * 2 + dir) * 1024 + ch;
    float Pc = 1.f, Hc = 0.f, hin = 0.f;
    if (PASS == 2) Hc = W.cin[cidx];
    const int src = (lane + (dir == 0 ? 48 : 16)) & 63;
#pragma unroll
    for (int k = 0; k < 4; ++k) { const int gk = (dir == 0) ? k : 3 - k; if (g == gk) hin = Hc;
        const float Po = A16 * Pc, Ho = A16 * Hc + B16;
        if (k < 3) { Pc = __shfl(Po, src); Hc = __shfl(Ho, src); } else { Pc = Po; Hc = Ho; } }
    if (PASS == 1) {
        if (g == ((dir == 0) ? 3 : 0)) W.carr[cidx] = (f32x2){Pc, Hc};
        __syncthreads();
    } else {
        LAS float* hx = HX + dir * (64 * 68) + (16 * g) * 68 + eb * 16 + li; float H = hin;
        if (dir == 0) {
#pragma unroll
            for (int q = 0; q < 16; ++q) { H = av[q] * H + bv[q]; hx[q * 68] = H; }
        } else {
#pragma unroll
            for (int q = 15; q >= 0; --q) { H = av[q] * H + bv[q]; hx[q * 68] = H; }
        }
        __syncthreads();
        const int tok = tid >> 3, c8 = (tid & 7) * 8;
        const f32x4 f0 = *(const LAS f32x4*)(HX + tok * 68 + c8), f1 = *(const LAS f32x4*)(HX + tok * 68 + c8 + 4);
        const f32x4 g0 = *(const LAS f32x4*)(HX + 64 * 68 + tok * 68 + c8), g1 = *(const LAS f32x4*)(HX + 64 * 68 + tok * 68 + c8 + 4);
        u32x4 o; o.x = pk2((f0[0] + g0[0]) * bflo(gl.x), (f0[1] + g0[1]) * bfhi(gl.x)); o.y = pk2((f0[2] + g0[2]) * bflo(gl.y), (f0[3] + g0[3]) * bfhi(gl.y));
        o.z = pk2((f1[0] + g1[0]) * bflo(gl.z), (f1[1] + g1[1]) * bfhi(gl.z)); o.w = pk2((f1[2] + g1[2]) * bflo(gl.w), (f1[3] + g1[3]) * bfhi(gl.w));
        *(u32x4*)(W.yrg + (size_t)(rowbase + t0 + tok) * 1024 + h * 64 + c8) = o;
    }
}


#define XB_TMO      128
#define XB_XCNT(j)  (256  + 64 * (j))
#define XB_XSUB(j)  (1280 + 64 * (j))
#define XB_XGEN(j)  (2304 + 64 * (j))
#define XB_TOP      3328
#define XB_TOPGEN   3392
#define XCD_BAR_WORDS 3456
#define XB_SPIN_CAP (1u << 18)
__device__ __forceinline__ unsigned xb_ld(unsigned* p)              { return __hip_atomic_load(p, __ATOMIC_RELAXED, __HIP_MEMORY_SCOPE_AGENT); }
__device__ __forceinline__ unsigned xb_add(unsigned* p, unsigned v) { return __hip_atomic_fetch_add(p, v, __ATOMIC_RELAXED, __HIP_MEMORY_SCOPE_AGENT); }
__device__ __forceinline__ unsigned xb_xcc_id() { return (unsigned)__builtin_amdgcn_s_getreg((3 << 11) | 20) & 0xFu; }
#define XB_SPIN(cond, bar) do { unsigned _sp = 0; while (cond) { __builtin_amdgcn_s_sleep(1); \
    if ((++_sp & 255u) == 0u) { if (xb_ld(&(bar)[XB_TMO])) break; if (_sp > XB_SPIN_CAP) { atomicAdd(&(bar)[XB_TMO], 1u); break; } } } } while (0)
struct XcdBarrier { unsigned* bar; unsigned x; volatile LAS unsigned* st; };
__device__ __forceinline__ void xcd_barrier_complete(unsigned* bar, unsigned x, unsigned& nloc, unsigned& nx) {
    const unsigned Gn = gridDim.x * gridDim.y * gridDim.z;
    unsigned sum, cntx, mine, sp = 0u;
    for (;;) {
        sum = 0u; cntx = 0u; mine = 0u;
#pragma unroll
        for (unsigned j = 0; j < 16; ++j) { const unsigned c = xb_ld(&bar[XB_XCNT(j)]); sum += c; cntx += (c > 0u) ? 1u : 0u; mine = (j == x) ? c : mine; }
        if (sum == Gn) break;
        __builtin_amdgcn_s_sleep(1);
        if ((++sp & 255u) == 0u) { if (xb_ld(&bar[XB_TMO])) break; if (sp > XB_SPIN_CAP) { atomicAdd(&bar[XB_TMO], 1u); break; } }
    }
    nloc = mine > 0u ? mine : 1u; nx = cntx > 0u ? cntx : 1u;
}
__device__ __forceinline__ void xcd_barrier(const XcdBarrier& b) {
    asm volatile("s_waitcnt vmcnt(0)" ::: "memory");
    __syncthreads();
    if (threadIdx.x == 0) {
        unsigned* bar = b.bar;
        __builtin_amdgcn_s_waitcnt(0);
        unsigned nloc = b.st[0], nx = b.st[1];
        if (nloc == 0u) { xcd_barrier_complete(bar, b.x, nloc, nx); b.st[0] = nloc; b.st[1] = nx; }
        const unsigned old = xb_add(&bar[XB_XSUB(b.x)], 1u);
        const unsigned gen = old / nloc;
        if (old + 1u == (gen + 1u) * nloc) {
            __builtin_amdgcn_fence(__ATOMIC_RELEASE, "agent");
            asm volatile("s_waitcnt vmcnt(0)" ::: "memory");
            const unsigned og = xb_add(&bar[XB_TOP], 1u);
            const unsigned tg = og / nx;
            if (og + 1u == (tg + 1u) * nx) xb_add(&bar[XB_TOPGEN], 1u);
            else XB_SPIN(xb_ld(&bar[XB_TOPGEN]) == tg, bar);
            __builtin_amdgcn_fence(__ATOMIC_ACQUIRE, "agent");
            xb_add(&bar[XB_XGEN(b.x)], 1u);
            asm volatile("s_waitcnt vmcnt(0)" ::: "memory");
        } else {
            XB_SPIN(xb_ld(&bar[XB_XGEN(b.x)]) == gen, bar);
            __builtin_amdgcn_fence(__ATOMIC_ACQUIRE, "agent");
            asm volatile("s_waitcnt vmcnt(0)" ::: "memory");
        }
    }
    __syncthreads();
}

__device__ __forceinline__ void transpose_item(const float* W, int K, int N, bf16* WT, int mode, LAS float* scr, int item, int lane) {
    const int nblk = N / 32, kb = item / nblk, nb = item % nblk, k0 = 64 * kb, n0 = 32 * nb;
#pragma unroll 8
    for (int i = 0; i < 32; ++i) { const int kk = 2 * i + (lane >> 5); scr[kk * 33 + (lane & 31)] = W[(size_t)(k0 + kk) * N + n0 + (lane & 31)]; }
    LDS_WAIT(); asm volatile("" ::: "memory");
    const int c = lane & 7;
#pragma unroll
    for (int j = 0; j < 4; ++j) { const int n = (lane >> 3) + 8 * j; const LAS float* s = scr + (8 * c) * 33 + n;
        u32x4 o; o.x = pk2(s[0 * 33], s[1 * 33]); o.y = pk2(s[2 * 33], s[3 * 33]); o.z = pk2(s[4 * 33], s[5 * 33]); o.w = pk2(s[6 * 33], s[7 * 33]);
        const int nn = n0 + n; int row;
        if (mode == 0) row = nn;
        else if (mode == 1) row = (nn >> 7) * 256 + (nn & 127);
        else row = (nn >> 7) * 256 + 128 + (nn & 127);
        *(u32x4*)(WT + (size_t)row * K + k0 + 8 * c) = o; }
    LDS_WAIT(); asm volatile("" ::: "memory");
}

struct Args { const float* in[41]; float* out; unsigned char* ws; int ph_lo, ph_hi; };

enum { I_X = 0, I_C, I_CTX, I_CCTX, I_ADAW, I_ADAB, I_N1G, I_N2G, I_FG, I_WIN, I_RGCW, I_RGCB, I_WAF, I_BAF, I_WXF, I_BXF, I_LAMF, I_WAB, I_BAB, I_WXB, I_BXB, I_LAMB,
       I_RGPROJ, I_HYCW, I_HYCB, I_PW1, I_PB1, I_PW2, I_PB2, I_FREQ, I_PW3, I_SKIP, I_HYPROJ, I_WOUT, I_WG, I_BG, I_WE, I_BE, I_MW1, I_MW3, I_MW2 };

constexpr int NPHASE = 13;

__global__ void __launch_bounds__(NTHREADS, 2) fwd_kernel(Args args) {
    extern __shared__ __attribute__((aligned(16))) unsigned char lds_raw[];
    LAS unsigned char* lds = (LAS unsigned char*)lds_raw;
    const int tid = threadIdx.x, lane = tid & 63, wave = __builtin_amdgcn_readfirstlane(tid >> 6);
    const int G = gridDim.x, bid = blockIdx.x;
    const int gw = bid * NWAVES + wave, NGW = G * NWAVES;
    unsigned char* ws = args.ws;
    const int lo = args.ph_lo, hi = args.ph_hi;
#define IN(k) (lo <= (k) && (k) < hi)
#if ONE_LAUNCH
    cg::grid_group grid = cg::this_grid();
#define GRID_SYNC(k) do { if (IN(k) && IN((k) + 1)) { if ((k) == 0) { grid.sync(); if (tid == 0) (void)xb_add(&xbar.bar[XB_XCNT(xbar.x)], 1u); } \
        else { xcd_barrier(xbar); if (REPN(99) == 2) xcd_barrier(xbar); } } } while (0)
#else
#define GRID_SYNC(k) do { } while (0)
#endif
    int* cnt = (int*)(ws + WS_CTL);
    XcdBarrier xbar; xbar.bar = (unsigned*)(ws + WS_CTL) + 4096; xbar.x = xb_xcc_id(); xbar.st = (volatile LAS unsigned*)(lds + LDS_BYTES - 64);
    if (tid < 2) xbar.st[tid] = 0u;
    __syncthreads();
    float* mod = (float*)(ws + WS_MOD);
    float* z2 = (float*)(ws + WS_Z2);
    float* ssq = (float*)(ws + WS_SSQ);
    int* tok_e = (int*)(ws + WS_ROUTE); int* tok_rank = tok_e + 2 * NTOK; float* tok_w = (float*)(tok_rank + 2 * NTOK); int* tok_slot = (int*)(tok_w + 2 * NTOK);
    bf16* rgproj_t = (bf16*)(ws + WS_WSMALL); bf16* hyproj_t = rgproj_t + 1024 * 1024; bf16* wout_t = hyproj_t + 1024 * 1024;
    bf16* win_t = (bf16*)(ws + WS_WIN);
    bf16* hx = (bf16*)(ws + WS_HX); bf16* yhy = (bf16*)(ws + WS_HX); bf16* Hbuf = (bf16*)(ws + WS_HX);
    bf16* prx = (bf16*)(ws + WS_PRX); bf16* merged = (bf16*)(ws + WS_PRX);
    bf16* grg = (bf16*)(ws + WS_GRG); bf16* hx2 = (bf16*)(ws + WS_GRG);
    bf16* phyT = (bf16*)(ws + WS_PHY);
    bf16* w13t = (bf16*)(ws + WS_W13); bf16* w2t = (bf16*)(ws + WS_W2);
    bf16* Xg = (bf16*)(ws + WS_XG); bf16* Ybuf = (bf16*)(ws + WS_XG);
    float* kf = (float*)(ws + WS_KF); bf16* yrg = (bf16*)(ws + WS_KF);
    f32x2* carr = (f32x2*)(ws + WS_CARR); float* cin = (float*)(ws + WS_CIN);
    bf16* gates = (bf16*)args.out;
    float* x1 = args.out;

    if (IN(0)) for (int rp = 0; rp < REPN(0); ++rp) {
        if (bid == 0 && tid < 64) cnt[tid] = 0;
        if (bid == 0) for (int i = tid; i < XCD_BAR_WORDS; i += NTHREADS) xbar.bar[i] = 0u;
        {
            LAS float* red = (LAS float*)lds;
            const float* c = args.in[I_C]; const float* cctx = args.in[I_CCTX]; const float* ada_w = args.in[I_ADAW]; const float* ada_b = args.in[I_ADAB];
            for (int g = bid; g < 96; g += G) {
                const int n = g * 64 + lane; float acc[5] = {0.f, 0.f, 0.f, 0.f, 0.f};
                for (int kk = 0; kk < 128; ++kk) { const int k = wave * 128 + kk; const float a = ada_w[(size_t)k * 6144 + n];
#pragma unroll
                    for (int r = 0; r < 5; ++r) { const float cv = (r < 4) ? c[r * 1024 + k] : cctx[k]; acc[r] += cv * sigmoidf_(cv) * a; } }
#pragma unroll
                for (int r = 0; r < 5; ++r) red[(wave * 5 + r) * 64 + lane] = acc[r];
                __syncthreads();
                if (wave == 0) {
#pragma unroll
                    for (int r = 0; r < 5; ++r) { float s = ada_b[n]; for (int w = 0; w < 8; ++w) s += red[(w * 5 + r) * 64 + lane]; mod[r * 6144 + n] = s; } }
                __syncthreads();
            }
        }
        {
            LAS float* fe = (LAS float*)lds + wave * 128; LAS float* z1 = fe + 64;
            const float* w1 = args.in[I_PW1]; const float* b1 = args.in[I_PB1]; const float* w2 = args.in[I_PW2]; const float* b2 = args.in[I_PB2]; const float* fr = args.in[I_FREQ];
            const float TWO_PI = 6.283185307179586f;
            for (int s = gw; s < SEQ; s += NGW) {
                float f = 0.f; const float sf = (float)s;
                if (lane == 0) f = sf / 8191.f;
                else if (lane <= 32) { const int j = (lane - 1) & 15; const float band = 1e-4f + (float)j * ((15.f - 1e-4f) / 15.f); float rev = sf * band * (1.f / 8192.f); rev -= floorf(rev + 0.5f);
                    f = (lane <= 16) ? cosf(TWO_PI * rev) : sinf(TWO_PI * rev); }
                else if (lane == 33) f = (float)(s >> 6) / 128.f;
                else if (lane <= 49) { const int mm = (lane <= 41) ? (lane - 33) : (lane - 41); float rev = (float)((s & 63) * mm) * (1.f / 64.f); rev -= floorf(rev + 0.5f);
                    f = (lane <= 41) ? cosf(TWO_PI * rev) : sinf(TWO_PI * rev); }
                fe[lane] = f; LDS_WAIT(); asm volatile("" ::: "memory");
                float a = b1[lane];
                for (int i = 0; i < 50; ++i) a += fe[i] * w1[i * 64 + lane];
                z1[lane] = sinf(fr[lane] * a); LDS_WAIT(); asm volatile("" ::: "memory");
                float a2 = b2[lane];
                for (int i = 0; i < 64; ++i) a2 += z1[i] * w2[i * 64 + lane];
                z2[(size_t)s * 64 + lane] = sinf(fr[lane] * a2);
                LDS_WAIT(); asm volatile("" ::: "memory");
            }
        }
        __syncthreads();
        {
            LAS float* scr = (LAS float*)lds + wave * 2176;
            constexpr int I_IN = 16 * 224, I_SQ = 16 * 32;
            constexpr int NITEMS = I_IN + 3 * I_SQ;
            for (int it = gw; it < NITEMS; it += NGW) {
                int r = it;
                if (r < I_IN) { transpose_item(args.in[I_WIN], 1024, INC, win_t, 0, scr, r, lane); continue; } r -= I_IN;
                if (r < I_SQ) { transpose_item(args.in[I_RGPROJ], 1024, 1024, rgproj_t, 0, scr, r, lane); continue; } r -= I_SQ;
                if (r < I_SQ) { transpose_item(args.in[I_HYPROJ], 1024, 1024, hyproj_t, 0, scr, r, lane); continue; } r -= I_SQ;
                transpose_item(args.in[I_WOUT], 1024, 1024, wout_t, 0, scr, r, lane);
            }
        }
        {
            bf16* wgt = (bf16*)(ws + WS_GATEW);
            for (int i = bid * NTHREADS + tid; i < 4 * 65536; i += G * NTHREADS) { const int gi = i >> 16, r = i & 65535, hh = r >> 12, e = (r >> 6) & 63, d = r & 63;
                const float* src = gi == 0 ? args.in[I_WAF] : gi == 1 ? args.in[I_WXF] : gi == 2 ? args.in[I_WAB] : args.in[I_WXB];
                wgt[i] = (bf16)f2bf(src[hh * 4096 + d * 64 + e]); }
        }
    }
    GRID_SYNC(0);

    if (IN(1)) for (int rp = 0; rp < REPN(1); ++rp) {
        const float* x = args.in[I_X]; const float* ctx = args.in[I_CTX]; const float* n1g = args.in[I_N1G];
        for (int m = gw; m < MROWS; m += NGW) {
            const float* xr = (m < NTOK) ? x + (size_t)m * 1024 : ctx + (size_t)(m - NTOK) * 1024; const int r = (m < NTOK) ? (m >> 13) : 4;
            const float* sh = mod + r * 6144; const float* sc = sh + 1024;
            f32x4 v[4]; float ss = 0.f;
#pragma unroll
            for (int j = 0; j < 4; ++j) { v[j] = ((const f32x4*)xr)[64 * j + lane]; ss += (v[j][0] * v[j][0] + v[j][1] * v[j][1]) + (v[j][2] * v[j][2] + v[j][3] * v[j][3]); }
            const float rstd = rsqrtf(wave_sum(ss) * (1.f / 1024.f) + 1e-6f);
#pragma unroll
            for (int j = 0; j < 4; ++j) { const int k = 4 * (64 * j + lane); const f32x4 g = *(const f32x4*)(n1g + k), s = *(const f32x4*)(sc + k), h = *(const f32x4*)(sh + k);
                const f32x4 o = v[j] * rstd * g * (1.f + s) + h; *(u32x2*)(hx + (size_t)m * 1024 + k) = pack4(o); }
        }
        {
            LAS float* z2s = (LAS float*)lds; LAS float* w3s = z2s + 64 * 65;
            const float* w3 = args.in[I_PW3];
            for (int it = bid; it < 128 * 32; it += G) {
                const int s0 = (it & 127) * 64, c0 = (it >> 7) * 64;
                for (int e = tid; e < 64 * 64; e += NTHREADS) { const int r = e >> 6, cc = e & 63; z2s[r * 65 + cc] = z2[(size_t)(s0 + r) * 64 + cc]; w3s[r * 65 + cc] = w3[(size_t)r * 2048 + c0 + cc]; }
                __syncthreads();
                float acc[8] = {0.f, 0.f, 0.f, 0.f, 0.f, 0.f, 0.f, 0.f};
                for (int j = 0; j < 64; ++j) { const float z = z2s[lane * 65 + j];
#pragma unroll
                    for (int q = 0; q < 8; ++q) acc[q] += z * w3s[j * 65 + wave * 8 + q]; }
                const float tn = (float)(s0 + lane) / 8191.f;
#pragma unroll
                for (int q = 0; q < 8; ++q) { const int cp = c0 + wave * 8 + q, ch = cp & 1023;
                    const float mind = -3.0701134573253944f, maxd = -15.350567286626972f;
                    const float delta = fabsf(mind + (float)ch * ((maxd - mind) / 1023.f));
                    kf[(size_t)cp * SEQ + s0 + lane] = acc[q] * __expf(-tn * delta); }
                __syncthreads();
            }
        }
    }
    GRID_SYNC(1);

    if (IN(2)) {
        { SchedInA S{(const char*)hx, (const char*)win_t, G, bid}; EpiInA E{prx, grg, gates}; pg8::gemm_phase(lds, 1024, S, E); }
        { SchedInB S{(const char*)hx, (const char*)win_t, G, bid}; EpiInB E{phyT}; pg8::gemm_phase(lds, 1024, S, E); }
    }
    GRID_SYNC(2);

    const ScanW SW{prx, grg, yrg, args.in[I_RGCW], args.in[I_RGCB], (const bf16*)(ws + WS_GATEW), args.in[I_BAF], args.in[I_BXF], args.in[I_LAMF], args.in[I_BAB], args.in[I_BXB], args.in[I_LAMB], carr, cin};
    if (IN(3)) {
        for (int rp = 0; rp < REPN(3); ++rp)
        for (int it = bid; it < NBATCH * NCHUNK * 16; it += G) {
            const int h = it & 15, rest = it >> 4, j = rest % NCHUNK, b = rest / NCHUNK;
            scan_item<1>(lds, SW, b, j, h, tid, lane, wave);
        }
        {
            LAS cpx* X = (LAS cpx*)lds;
            cpx* Kb = (cpx*)(ws + WS_HX) + (size_t)bid * 16384;
            const float* hcw = args.in[I_HYCW]; const float* hcb = args.in[I_HYCB]; const float* skip = args.in[I_SKIP];
            for (int rp = 0; rp < REPN(30); ++rp)
            for (int c = bid; c < 1024; c += G) {
                __syncthreads();
                for (int q = 0; q < 32; ++q) { const int i = tid + 512 * q;
                    const float v = (i < SEQ) ? kf[(size_t)c * SEQ + i] : ((i == SEQ) ? 0.f : kf[(size_t)(1024 + c) * SEQ + (16384 - i)]);
                    X[pidx(i)] = (cpx){v, 0.f}; }
                __syncthreads();
                fft_fwd16<1024, 16>(X, tid); __syncthreads();
                fft_fwd16<64, 16>(X, tid); __syncthreads();
                fft_r4<false>(X, tid); __syncthreads();
                fft_fwdD_toK(X, Kb, tid);
                const float w00 = hcw[c], w01 = hcw[3072 + c], w02 = hcw[6144 + c], b0 = hcb[c];
                const float w10 = hcw[1024 + c], w11 = hcw[3072 + 1024 + c], w12 = hcw[6144 + 1024 + c], b1 = hcb[1024 + c];
                const float w20 = hcw[2048 + c], w21 = hcw[3072 + 2048 + c], w22 = hcw[6144 + 2048 + c], b2 = hcb[2048 + c];
                const float sk = skip[c];
                for (int pair = 0; pair < 2; ++pair) {
                    const bf16* rA = phyT + ((size_t)(2 * pair) * 3072 + c) * SEQ; const bf16* rB = rA + (size_t)3072 * SEQ;
                    __syncthreads();
#pragma unroll 1
                    for (int it = 0; it < 2; ++it) { int t0 = 8 * (tid + 512 * it); asm volatile("" : "+v"(t0)); float p1[10], p2[10], ua[8], ub[8];
                        load10(rA + (size_t)1024 * SEQ, t0, p1); load10(rA + (size_t)2048 * SEQ, t0, p2);
#pragma unroll
                        for (int k = 0; k < 8; ++k) ua[k] = (b2 + w20 * p2[k] + w21 * p2[k + 1] + w22 * p2[k + 2]) * (b1 + w10 * p1[k] + w11 * p1[k + 1] + w12 * p1[k + 2]);
                        load10(rB + (size_t)1024 * SEQ, t0, p1); load10(rB + (size_t)2048 * SEQ, t0, p2);
#pragma unroll
                        for (int k = 0; k < 8; ++k) ub[k] = (b2 + w20 * p2[k] + w21 * p2[k + 1] + w22 * p2[k + 2]) * (b1 + w10 * p1[k] + w11 * p1[k + 1] + w12 * p1[k + 2]);
                        const int pb = pidx(t0);
#pragma unroll
                        for (int k = 0; k < 8; ++k) X[pb + k] = (cpx){ua[k], ub[k]}; }
                    __syncthreads();
                    fft_fwd16<1024, 8>(X, tid); __syncthreads();
                    fft_fwd16<64, 16>(X, tid); __syncthreads();
                    fft_r4<false>(X, tid); __syncthreads();
                    fft_fusedD(X, Kb, tid); __syncthreads();
                    fft_r4<true>(X, tid); __syncthreads();
                    fft_inv16<64, 16>(X, tid); __syncthreads();
                    fft_inv16<1024, 8>(X, tid); __syncthreads();
#pragma unroll 1
                    for (int it = 0; it < 2; ++it) { int t0 = 8 * (tid + 512 * it); asm volatile("" : "+v"(t0)); float p0[10], p1[10], p2[10]; const int pb = pidx(t0);
                        load10(rA, t0, p0); load10(rA + (size_t)1024 * SEQ, t0, p1); load10(rA + (size_t)2048 * SEQ, t0, p2);
#pragma unroll
                        for (int k = 0; k < 8; ++k) { const float uu = (b2 + w20 * p2[k] + w21 * p2[k + 1] + w22 * p2[k + 2]) * (b1 + w10 * p1[k] + w11 * p1[k + 1] + w12 * p1[k + 2]);
                            const float x0 = b0 + w00 * p0[k] + w01 * p0[k + 1] + w02 * p0[k + 2]; X[pb + k].x = (X[pb + k].x + sk * uu) * x0; }
                        load10(rB, t0, p0); load10(rB + (size_t)1024 * SEQ, t0, p1); load10(rB + (size_t)2048 * SEQ, t0, p2);
#pragma unroll
                        for (int k = 0; k < 8; ++k) { const float uu = (b2 + w20 * p2[k] + w21 * p2[k + 1] + w22 * p2[k + 2]) * (b1 + w10 * p1[k] + w11 * p1[k + 1] + w12 * p1[k + 2]);
                            const float x0 = b0 + w00 * p0[k] + w01 * p0[k + 1] + w02 * p0[k + 2]; X[pb + k].y = (X[pb + k].y + sk * uu) * x0; } }
                    __syncthreads();
#pragma unroll 1
                    for (int it = 0; it < 2; ++it) { int t0 = 8 * (tid + 512 * it); asm volatile("" : "+v"(t0)); const int pb = pidx(t0); cpx y[8];
#pragma unroll
                        for (int k = 0; k < 8; ++k) y[k] = X[pb + k];
                        if (rp == REPN(30) - 1) *(u32x4*)((bf16*)rA + t0) = (u32x4){pk2(y[0].x, y[1].x), pk2(y[2].x, y[3].x), pk2(y[4].x, y[5].x), pk2(y[6].x, y[7].x)};
                        if (rp == REPN(30) - 1) *(u32x4*)((bf16*)rB + t0) = (u32x4){pk2(y[0].y, y[1].y), pk2(y[2].y, y[3].y), pk2(y[4].y, y[5].y), pk2(y[6].y, y[7].y)}; }
                }
            }
        }
    }
    GRID_SYNC(3);

    if (IN(4)) for (int rp = 0; rp < REPN(4); ++rp) {
        const int gt = bid * NTHREADS + tid;
        if (gt < NBATCH * 2 * 1024) {
            const int c = gt & 1023, dir = (gt >> 10) & 1, b = gt >> 11; float s = 0.f;
            for (int q = 0; q < NCHUNK; ++q) { const int j = dir == 0 ? q : (q < 4 ? 3 - q : NCHUNK + 3 - q);
                const size_t idx = ((size_t)(b * NCHUNK + j) * 2 + dir) * 1024 + c; const f32x2 ab = carr[idx]; cin[idx] = s; s = ab.x * s + ab.y; }
        }
    }
    GRID_SYNC(4);

    if (IN(5)) {
        for (int rp = 0; rp < REPN(5); ++rp)
        for (int it = bid; it < NBATCH * 128 * 16; it += G) {
            const int h = it & 15, rest = it >> 4, j = (rest & 127) + 4, b = rest >> 7;
            scan_item<2>(lds, SW, b, j, h, tid, lane, wave);
        }
        __syncthreads();
        {
            LAS bf16* T = (LAS bf16*)lds;
            for (int rp = 0; rp < REPN(50); ++rp)
            for (int it = bid; it < NBATCH * 16 * 128; it += G) {
                const int tb = it & 127, cb = (it >> 7) & 15, b = it >> 11;
                { const int cl = tid >> 3, ch = tid & 7; *(LAS u32x4*)(T + cl * 72 + ch * 8) = *(const u32x4*)(phyT + ((size_t)b * 3072 + cb * 64 + cl) * SEQ + tb * 64 + ch * 8); }
                __syncthreads();
                { const int tl = tid >> 3, ch = tid & 7; unsigned v[8];
#pragma unroll
                    for (int q = 0; q < 8; ++q) v[q] = T[(ch * 8 + q) * 72 + tl];
                    u32x4 o; o.x = v[0] | (v[1] << 16); o.y = v[2] | (v[3] << 16); o.z = v[4] | (v[5] << 16); o.w = v[6] | (v[7] << 16);
                    *(u32x4*)(yhy + (size_t)(b * SEQ + tb * 64 + tl) * 1024 + cb * 64 + ch * 8) = o; }
                __syncthreads();
            }
        }
    }
    GRID_SYNC(5);

    if (IN(6)) for (int rp = 0; rp < REPN(6); ++rp) {
        SchedMerge S{(const char*)yrg, (const char*)yhy, (const char*)rgproj_t, (const char*)hyproj_t, G, bid}; EpiMerge E{gates, merged};
        pg8::gemm_phase(lds, 1024, S, E);
    }
    GRID_SYNC(6);

    if (IN(7)) {
        SchedOut S{(const char*)merged, (const char*)wout_t, G, bid}; EpiOut E{args.in[I_X], mod, x1, ssq};
        pg8::gemm_phase(lds, 1024, S, E);
    }
    GRID_SYNC(7);

    if (IN(8)) {
        {
            LAS float* XT = (LAS float*)lds;
            LAS float* WL = XT + 64 * 129;
            LAS float* RS = WL + 64 * 36;
            LAS float* PART = RS + 128;
            const float* n2g = args.in[I_N2G]; const float* wg = args.in[I_WG]; const float* bg = args.in[I_BG]; const float* we = args.in[I_WE]; const float* be = args.in[I_BE];
            int nrep8 = REPN(8); asm volatile("" : "+s"(nrep8));
_Pragma("unroll 1")
            for (int rp = 0; rp < nrep8; ++rp)
            for (int tile = bid; tile < NTOK / 128; tile += G) {
                const int R0 = tile * 128; const int b = R0 >> 13; const float* sh = mod + b * 6144 + 3072; const float* sc = sh + 1024;
                __syncthreads();
                if (tid < 128) { const float* sp = ssq + (size_t)(R0 + tid) * 16; float ss = 0.f; for (int q = 0; q < 16; ++q) ss += sp[q]; RS[tid] = rsqrtf(ss * (1.f / 1024.f) + 1e-6f); }
                __syncthreads();
                float acc[36];
#pragma unroll
                for (int c = 0; c < 36; ++c) acc[c] = 0.f;
                const int lrow = tid >> 2, lq = tid & 3; const float rstd = RS[lrow];
                const int rh = wave & 1, kq = wave >> 1;
#pragma unroll 1
                for (int kc = 0; kc < 16; ++kc) {
                    const int k0 = kc * 64 + lq * 16;
                    f32x4 o[4];
#pragma unroll
                    for (int i = 0; i < 4; ++i) { const int k = k0 + 4 * i; const f32x4 v = *(const f32x4*)(x1 + (size_t)(R0 + lrow) * 1024 + k);
                        const f32x4 g = *(const f32x4*)(n2g + k), s_ = *(const f32x4*)(sc + k), hh = *(const f32x4*)(sh + k); o[i] = v * rstd * g * (1.f + s_) + hh; }
                    *(u32x4*)(hx2 + (size_t)(R0 + lrow) * 1024 + k0) = (u32x4){pk2(o[0][0], o[0][1]), pk2(o[0][2], o[0][3]), pk2(o[1][0], o[1][1]), pk2(o[1][2], o[1][3])};
                    *(u32x4*)(hx2 + (size_t)(R0 + lrow) * 1024 + k0 + 8) = (u32x4){pk2(o[2][0], o[2][1]), pk2(o[2][2], o[2][3]), pk2(o[3][0], o[3][1]), pk2(o[3][2], o[3][3])};
                    float wv[5]; int widx[5];
#pragma unroll
                    for (int i = 0; i < 5; ++i) { const int e = tid + 512 * i; widx[i] = e; const int kk = e / 36, cc = e % 36;
                        wv[i] = (e < 64 * 36) ? ((cc < 4) ? wg[(size_t)(kc * 64 + kk) * 4 + cc] : we[(size_t)(kc * 64 + kk) * 32 + (cc - 4)]) : 0.f; }
                    __syncthreads();
#pragma unroll
                    for (int i = 0; i < 4; ++i)
#pragma unroll
                        for (int q = 0; q < 4; ++q) XT[(lq * 16 + 4 * i + q) * 129 + lrow] = o[i][q];
#pragma unroll
                    for (int i = 0; i < 5; ++i) if (widx[i] < 64 * 36) WL[widx[i]] = wv[i];
                    __syncthreads();
#pragma unroll 4
                    for (int kk = 0; kk < 16; ++kk) { const int k = kq * 16 + kk; const float xv = XT[k * 129 + rh * 64 + lane];
#pragma unroll
                        for (int c4 = 0; c4 < 9; ++c4) { const f32x4 w4 = *(const LAS f32x4*)(WL + k * 36 + 4 * c4);
                            acc[4 * c4] += xv * w4[0]; acc[4 * c4 + 1] += xv * w4[1]; acc[4 * c4 + 2] += xv * w4[2]; acc[4 * c4 + 3] += xv * w4[3]; } }
                }
#pragma unroll
                for (int c = 0; c < 36; ++c) PART[(kq * 128 + rh * 64 + lane) * 37 + c] = acc[c];
                __syncthreads();
                if (tid < 128) {
                    float lg[36];
#pragma unroll
                    for (int c = 0; c < 36; ++c) lg[c] = ((PART[(0 * 128 + tid) * 37 + c] + PART[(1 * 128 + tid) * 37 + c]) + (PART[(2 * 128 + tid) * 37 + c] + PART[(3 * 128 + tid) * 37 + c])) + (c < 4 ? bg[c] : be[c - 4]);
                    int grp = 0; float gm = lg[0];
#pragma unroll
                    for (int q = 1; q < 4; ++q) if (lg[q] > gm) { gm = lg[q]; grp = q; }
                    float den = 0.f;
#pragma unroll
                    for (int q = 0; q < 4; ++q) den += __expf(lg[q] - gm);
                    const float pg = 1.f / den;
                    float ep[8];
#pragma unroll
                    for (int q = 0; q < 8; ++q) ep[q] = grp == 0 ? lg[4 + q] : grp == 1 ? lg[12 + q] : grp == 2 ? lg[20 + q] : lg[28 + q];
                    int i1 = 0; float v1 = ep[0];
#pragma unroll
                    for (int q = 1; q < 8; ++q) if (ep[q] > v1) { v1 = ep[q]; i1 = q; }
                    int i2 = -1; float v2 = -3.0e38f;
#pragma unroll
                    for (int q = 0; q < 8; ++q) if (q != i1 && ep[q] > v2) { v2 = ep[q]; i2 = q; }
                    const float e2 = __expf(v2 - v1); const float p1 = 1.f / (1.f + e2), p2 = e2 / (1.f + e2);
                    const int ea = grp * 8 + i1, eb = grp * 8 + i2; const int m = R0 + tid;
                    if (rp == nrep8 - 1) {
                    const int ra = atomicAdd(cnt + ea, 1), rb = atomicAdd(cnt + eb, 1);
                    tok_e[2 * m] = ea; tok_e[2 * m + 1] = eb; tok_rank[2 * m] = ra; tok_rank[2 * m + 1] = rb; tok_w[2 * m] = pg * p1; tok_w[2 * m + 1] = pg * p2; }
                }
            }
        }
        __syncthreads();
        {
            LAS float* scr = (LAS float*)lds + wave * 2176;
            constexpr int I_E13 = 16 * 16, I_E2 = 8 * 32;
            constexpr int NITEMS = NEXP * (2 * I_E13 + I_E2);
            for (int rp = 0; rp < REPN(80); ++rp)
            for (int it = gw; it < NITEMS; it += NGW) {
                const int e = it / (2 * I_E13 + I_E2); int r = it % (2 * I_E13 + I_E2);
                if (r < I_E13) { transpose_item(args.in[I_MW1] + (size_t)e * 1024 * 512, 1024, 512, w13t + (size_t)e * 1024 * 1024, 1, scr, r, lane); continue; } r -= I_E13;
                if (r < I_E13) { transpose_item(args.in[I_MW3] + (size_t)e * 1024 * 512, 1024, 512, w13t + (size_t)e * 1024 * 1024, 2, scr, r, lane); continue; } r -= I_E13;
                transpose_item(args.in[I_MW2] + (size_t)e * 512 * 1024, 512, 1024, w2t + (size_t)e * 1024 * 512, 0, scr, r, lane);
            }
        }
    }
    GRID_SYNC(8);

    LAS int* blk_exp = (LAS int*)(lds + MISC_OFF); LAS int* pstart = blk_exp + 320;
    int nblk = 0;
    if (hi > 9 && lo <= 11) {
        __syncthreads();
        if (tid == 0) { int p = 0; for (int e = 0; e < NEXP; ++e) { const int c_ = __hip_atomic_load(cnt + e, __ATOMIC_RELAXED, __HIP_MEMORY_SCOPE_AGENT); const int nb = (c_ + 255) >> 8; pstart[e] = p * 256; for (int q = 0; q < nb; ++q) blk_exp[p + q] = e; p += nb; } pstart[32] = p; }
        __syncthreads();
        nblk = pstart[32];
    }

    if (IN(9)) for (int rp = 0; rp < REPN(9); ++rp) {
        for (int a = gw; a < 2 * NTOK; a += NGW) {
            const int e = tok_e[a], rk = tok_rank[a]; const int slot = pstart[e] + rk; const int m = a >> 1;
            if (lane == 0) tok_slot[a] = slot;
            const u32x4* src = (const u32x4*)(hx2 + (size_t)m * 1024); u32x4* dst = (u32x4*)(Xg + (size_t)slot * 1024);
            dst[lane] = src[lane]; dst[64 + lane] = src[64 + lane];
        }
    }
    GRID_SYNC(9);

    if (IN(10)) for (int rp = 0; rp < REPN(10); ++rp) {
        SchedMoeUp S{(const char*)Xg, (const char*)w13t, blk_exp, nblk, G, bid}; EpiMoeUp E{Hbuf};
        pg8::gemm_phase(lds, 1024, S, E);
    }
    GRID_SYNC(10);

    if (IN(11)) for (int rp = 0; rp < REPN(11); ++rp) {
        SchedMoeDown S{(const char*)Hbuf, (const char*)w2t, blk_exp, nblk, G, bid}; EpiMoeDown E{Ybuf};
        pg8::gemm_phase(lds, 512, S, E);
    }
    GRID_SYNC(11);

    if (IN(12)) {
        const float* fg = args.in[I_FG];
        int nrep12 = REPN(12); asm volatile("" : "+s"(nrep12));
_Pragma("unroll 1")
        for (int rp = 0; rp < nrep12; ++rp)
        for (int m = gw; m < NTOK; m += NGW) {
            const int b = m >> 13; const float* g2 = mod + b * 6144 + 5120;
            const int sa = tok_slot[2 * m], sb = tok_slot[2 * m + 1]; const float wa = tok_w[2 * m], wb = tok_w[2 * m + 1];
            f32x4 v[4]; float ss = 0.f;
#pragma unroll
            for (int j = 0; j < 4; ++j) { const int k = 4 * (64 * j + lane);
                const u32x2 ya = *(const u32x2*)(Ybuf + (size_t)sa * 1024 + k), yb = *(const u32x2*)(Ybuf + (size_t)sb * 1024 + k);
                const f32x4 fa = {bflo(ya.x), bfhi(ya.x), bflo(ya.y), bfhi(ya.y)}, fb = {bflo(yb.x), bfhi(yb.x), bflo(yb.y), bfhi(yb.y)};
                const f32x4 xv = *(const f32x4*)(x1 + (size_t)m * 1024 + k), gv = *(const f32x4*)(g2 + k);
                v[j] = xv + gv * (fa * wa + fb * wb); ss += (v[j][0] * v[j][0] + v[j][1] * v[j][1]) + (v[j][2] * v[j][2] + v[j][3] * v[j][3]); }
            const float rstd = rsqrtf(wave_sum(ss) * (1.f / 1024.f) + 1e-6f);
#pragma unroll
            for (int j = 0; j < 4; ++j) { const int k = 4 * (64 * j + lane); const f32x4 g = *(const f32x4*)(fg + k); if (rp == nrep12 - 1) *(f32x4*)(args.out + (size_t)m * 1024 + k) = v[j] * rstd * g; }
        }
    }
}

extern "C" void kernel_launch(void* const* d_in, const int* in_sizes, int n_in, void* d_out, int out_size, void* d_ws, size_t ws_size, hipStream_t stream) {
    static int grid = 0;
    if (grid == 0) {
        if (n_in != 41 || out_size != NTOK * DM || ws_size < WS_END) { fprintf(stderr, "kernel_launch: unexpected shapes (n_in %d, out %d, ws %zu)\n", n_in, out_size, ws_size); grid = -1; return; }
        int dev = 0, cus = 0, per_cu = 0;
        hipGetDevice(&dev); hipDeviceGetAttribute(&cus, hipDeviceAttributeMultiprocessorCount, dev);
        if (hipFuncSetAttribute((const void*)fwd_kernel, hipFuncAttributeMaxDynamicSharedMemorySize, LDS_BYTES) != hipSuccess) { fprintf(stderr, "kernel_launch: hipFuncSetAttribute failed\n"); grid = -1; return; }
        hipOccupancyMaxActiveBlocksPerMultiprocessor(&per_cu, (const void*)fwd_kernel, NTHREADS, LDS_BYTES);
        (void)hipGetLastError();
        if (per_cu < 1) { fprintf(stderr, "kernel_launch: occupancy query says %d blocks per CU\n", per_cu); per_cu = 1; }
        grid = cus;
        fprintf(stderr, "kernel_launch: grid %d (cus %d, per_cu %d)\n", grid, cus, per_cu);
    }
    if (grid < 0) return;
    Args a{};
    for (int i = 0; i < 41; ++i) a.in[i] = (const float*)d_in[i];
    a.out = (float*)d_out; a.ws = (unsigned char*)d_ws;
#if ONE_LAUNCH
    a.ph_lo = 0; a.ph_hi = NPHASE;
    void* kargs[] = {&a};
    hipError_t e = hipLaunchCooperativeKernel((const void*)fwd_kernel, dim3(grid), dim3(NTHREADS), kargs, LDS_BYTES, stream);
    if (e != hipSuccess) fprintf(stderr, "cooperative launch failed: %s (grid %d)\n", hipGetErrorString(e), grid);
#else
    for (int p = 0; p < NPHASE; ++p) { a.ph_lo = p; a.ph_hi = p + 1; hipLaunchKernelGGL(fwd_kernel, dim3(grid), dim3(NTHREADS), LDS_BYTES, stream, a); }
#endif
}
```

```cpp
#include <hip/hip_runtime.h>
#include <hip/hip_cooperative_groups.h>
#include <cstdio>
#include <cstdint>
namespace cg = cooperative_groups;

#ifndef ONE_LAUNCH
#define ONE_LAUNCH 1
#endif

#ifndef PROBE_REP
#define PROBE_REP -1
#endif
#define REPN(k) ((PROBE_REP == (k)) ? 2 : 1)
#define LAS __attribute__((address_space(3)))
typedef unsigned short bf16;
typedef float f32x4 __attribute__((ext_vector_type(4)));
typedef float f32x2 __attribute__((ext_vector_type(2)));
typedef short bf16x8 __attribute__((ext_vector_type(8)));
typedef unsigned u32x4 __attribute__((ext_vector_type(4)));
typedef unsigned u32x2 __attribute__((ext_vector_type(2)));

constexpr int DM = 1024, NBATCH = 4, SEQ = 8192, NTOK = NBATCH * SEQ, CTXL = 256, NCTX = NBATCH * CTXL, MROWS = NTOK + NCTX;
constexpr int INC = 7168, NEXP = 32, DEXP = 512, PMAXBLK = 288;
constexpr int NCHUNK = 132;
constexpr int NTHREADS = 512, NWAVES = 8;
constexpr int LDS_BYTES = 148480;
constexpr int MISC_OFF = 131072;

constexpr size_t MiB = 1u << 20;
constexpr size_t WS_CTL = 0, WS_MOD = 1 * MiB, WS_Z2 = 2 * MiB, WS_SSQ = 4 * MiB, WS_ROUTE = 6 * MiB, WS_GATEW = 7 * MiB;
constexpr size_t WS_WSMALL = 8 * MiB, WS_WIN = 14 * MiB;
constexpr size_t WS_HX = 32 * MiB;
constexpr size_t WS_PRX = 98 * MiB;
constexpr size_t WS_GRG = 164 * MiB;
constexpr size_t WS_PHY = 228 * MiB;
constexpr size_t WS_W13 = 228 * MiB, WS_W2 = 292 * MiB;
constexpr size_t WS_XG = 324 * MiB;
constexpr size_t WS_KF = 420 * MiB;
constexpr size_t WS_CARR = 484 * MiB, WS_CIN = 494 * MiB, WS_END = 512 * MiB;

__device__ __forceinline__ unsigned f2bf(float f) { unsigned u = __builtin_bit_cast(unsigned, f); return (u + 0x7fffu + ((u >> 16) & 1u)) >> 16; }
__device__ __forceinline__ unsigned pk2(float lo, float hi) { return f2bf(lo) | (f2bf(hi) << 16); }
__device__ __forceinline__ float bf2f(unsigned b) { return __builtin_bit_cast(float, b << 16); }
__device__ __forceinline__ float bflo(unsigned w) { return __builtin_bit_cast(float, w << 16); }
__device__ __forceinline__ float bfhi(unsigned w) { return __builtin_bit_cast(float, w & 0xffff0000u); }
__device__ __forceinline__ float wave_sum(float v) {
#pragma unroll
    for (int o = 1; o < 64; o <<= 1) v += __shfl_xor(v, o);
    return v;
}
__device__ __forceinline__ float sigmoidf_(float v) { return __builtin_amdgcn_rcpf(1.f + __expf(-v)); }
__device__ __forceinline__ float gelu_tanh(float v) { const float z = 0.7978845608028654f * (v + 0.044715f * v * v * v); const float t = 1.f - 2.f * __builtin_amdgcn_rcpf(1.f + __expf(2.f * z)); return 0.5f * v * (1.f + t); }
#define LDS_WAIT() asm volatile("s_waitcnt lgkmcnt(0)" ::: "memory")

namespace pg8 {
#define PG8_LAS __attribute__((address_space(3)))
constexpr int BM = 256, BK = 64, HALF = 128, HTB = HALF * BK * 2, STAGE_BYTES = 8 * HTB, NXCD = 8, WGM = 8;
__host__ __device__ __forceinline__ int lds_byte(int r, int c) { const int st = (r >> 4) * 2 + (c >> 5), rr = r & 15, cc = c & 31, ob = rr * 64 + cc * 2; return st * 1024 + (ob ^ (((ob >> 9) & 1) << 5)); }
__host__ __device__ __forceinline__ void stage_rc(int b, int& R, int& C) { const int st = b / 1024, sb = b % 1024, swz = sb ^ (((sb >> 9) & 1) << 5); R = (st >> 1) * 16 + swz / 64; C = (st & 1) * 32 + (swz % 64) / 2; }

struct Unit { int pm, pn, last; const char* A; const char* B; };

__device__ __forceinline__ void rect_map(int wg, int nM, int nN, int& pm, int& pn) {
    const int nwg = nM * nN; int wgid = wg; { const int q = nwg / NXCD, r = nwg % NXCD, xcd = wgid % NXCD, off = wgid / NXCD; wgid = (xcd < r ? xcd * (q + 1) : r * (q + 1) + (xcd - r) * q) + off; }
    const int nig = WGM * nN, gid = wgid / nig, fm = gid * WGM, gsz = (nM - fm) < WGM ? (nM - fm) : WGM;
    pm = fm + ((wgid % nig) % gsz); pn = (wgid % nig) / gsz;
}

template <class Epi, class Sched>
__device__ __forceinline__ void gemm_phase(PG8_LAS unsigned char* lds, const int K, const Sched& S, const Epi& E) {
    const int tid = threadIdx.x, wid = __builtin_amdgcn_readfirstlane(tid >> 6), lane = tid & 63, wr = wid >> 2, wc = wid & 3, fr = lane & 15, fq = lane >> 4;
    const int nt = K / BK;
    unsigned voffA[2];
#pragma unroll
    for (int i = 0; i < 2; ++i) { int R, C; stage_rc(tid * 16 + i * 8192, R, C); voffA[i] = (unsigned)(R * K + C) * 2u; }
    const size_t kstep = (size_t)(BK * 2);
    const size_t hstep = (size_t)HALF * K * 2;
    const unsigned ldsw = (unsigned)wid * 1024u;
    const int aoff = lds_byte(wr * 64 + fr, fq * 8), boff = lds_byte(wc * 32 + fr, fq * 8);
#define PG8_SA(b, h) (((b) * 2 + (h)) * HTB)
#define PG8_SB(b, h) ((4 + (b) * 2 + (h)) * HTB)
#define PG8_STAGE(bufoff, gbase, voff) do { _Pragma("unroll") for (int _i = 0; _i < 2; ++_i) \
        __builtin_amdgcn_global_load_lds((const unsigned*)((const char*)(gbase) + (voff)[_i]), (PG8_LAS unsigned*)(lds + (bufoff) + ldsw + _i * 8192), 16, 0, 0); } while (0)
#define PG8_LDA(dst, b, h) do { _Pragma("unroll") for (int m = 0; m < 4; ++m) _Pragma("unroll") for (int k = 0; k < 2; ++k) dst[m][k] = *(const PG8_LAS bf16x8*)(lds + PG8_SA(b, h) + aoff + m * 2048 + k * 1024); } while (0)
#define PG8_LDB(dst, b, h) do { _Pragma("unroll") for (int n = 0; n < 2; ++n) _Pragma("unroll") for (int k = 0; k < 2; ++k) dst[n][k] = *(const PG8_LAS bf16x8*)(lds + PG8_SB(b, h) + boff + n * 2048 + k * 1024); } while (0)
#define PG8_MMA(ai, bj, At, Bt) do { __builtin_amdgcn_s_setprio(1); _Pragma("unroll") for (int m = 0; m < 4; ++m) _Pragma("unroll") for (int n = 0; n < 2; ++n) _Pragma("unroll") for (int k = 0; k < 2; ++k) \
        acc[ai][bj][m][n] = __builtin_amdgcn_mfma_f32_16x16x32_bf16(Bt[n][k], At[m][k], acc[ai][bj][m][n], 0, 0, 0); __builtin_amdgcn_s_setprio(0); } while (0)
#define PG8_WAIT_V(n) asm volatile("s_waitcnt vmcnt(" #n ")" ::: "memory")
#define PG8_WAIT_L(n) asm volatile("s_waitcnt lgkmcnt(" #n ")" ::: "memory")
#define PG8_BAR __builtin_amdgcn_s_barrier()
#define PG8_SCHED __builtin_amdgcn_sched_barrier(0)
    Unit cur, nxt; int ui = 0;
    if (!S.next(0, cur)) return;
    f32x4 acc[2][2][4][2];
#pragma unroll
    for (int a = 0; a < 2; ++a)
#pragma unroll
        for (int b = 0; b < 2; ++b)
#pragma unroll
            for (int m = 0; m < 4; ++m)
#pragma unroll
                for (int n = 0; n < 2; ++n) acc[a][b][m][n] = (f32x4){0.f, 0.f, 0.f, 0.f};
    bf16x8 At[4][2], B0[2][2], B1[2][2];
    const char* cA = cur.A; const char* cB = cur.B;
    PG8_STAGE(PG8_SB(0, 0), cB, voffA); PG8_STAGE(PG8_SB(0, 1), cB + hstep, voffA); PG8_STAGE(PG8_SA(0, 0), cA, voffA); PG8_STAGE(PG8_SA(0, 1), cA + hstep, voffA);
    if (wr == 1) PG8_BAR;
    PG8_WAIT_V(2); PG8_BAR;
    PG8_STAGE(PG8_SB(1, 0), cB + kstep, voffA); PG8_STAGE(PG8_SA(1, 0), cA + kstep, voffA); PG8_STAGE(PG8_SB(1, 1), cB + hstep + kstep, voffA);
    PG8_WAIT_V(6); PG8_BAR;
    for (;;) {
        const bool has_next = S.next(ui + 1, nxt);
        const char* nA = has_next ? nxt.A : cA; const char* nB = has_next ? nxt.B : cB;
        for (int t = 0; t < nt; t += 2) {
            const bool last = (t == nt - 2);
            const char* a1 = cA + (size_t)(t + 1) * kstep;
            const char* a2 = last ? nA : cA + (size_t)(t + 2) * kstep; const char* b2 = last ? nB : cB + (size_t)(t + 2) * kstep;
            const char* a3 = a2 + kstep; const char* b3 = b2 + kstep;
            PG8_LDB(B0, 0, 0); PG8_LDB(B1, 0, 1); PG8_SCHED; PG8_LDA(At, 0, 0); PG8_STAGE(PG8_SA(1, 1), a1 + hstep, voffA);
            PG8_WAIT_V(8); PG8_WAIT_L(0); PG8_BAR; PG8_MMA(0, 0, At, B0); PG8_MMA(0, 1, At, B1); PG8_BAR; PG8_SCHED;
            PG8_LDA(At, 0, 1); PG8_STAGE(PG8_SB(0, 0), b2, voffA); PG8_STAGE(PG8_SB(0, 1), b2 + hstep, voffA); PG8_STAGE(PG8_SA(0, 0), a2, voffA);
            PG8_WAIT_V(8); PG8_WAIT_L(0); PG8_BAR; PG8_MMA(1, 0, At, B0); PG8_MMA(1, 1, At, B1); PG8_BAR; PG8_SCHED;
            PG8_LDB(B0, 1, 0); PG8_LDB(B1, 1, 1); PG8_SCHED; PG8_LDA(At, 1, 0); PG8_STAGE(PG8_SA(0, 1), a2 + hstep, voffA);
            PG8_WAIT_V(8); PG8_WAIT_L(0); PG8_BAR; PG8_MMA(0, 0, At, B0); PG8_MMA(0, 1, At, B1); PG8_BAR; PG8_SCHED;
            PG8_LDA(At, 1, 1); PG8_STAGE(PG8_SB(1, 0), b3, voffA); PG8_STAGE(PG8_SB(1, 1), b3 + hstep, voffA); PG8_STAGE(PG8_SA(1, 0), a3, voffA);
            PG8_WAIT_V(8); PG8_WAIT_L(0); PG8_BAR; PG8_MMA(1, 0, At, B0); PG8_MMA(1, 1, At, B1); PG8_BAR; PG8_SCHED;
        }
        if (wr == 0) PG8_BAR;
        if (cur.last) E.fin(acc, cur, wr, wc, fr, fq); else E.mid(acc, cur, wr, wc, fr, fq);
        if (!has_next) break;
        if (cur.last) {
#pragma unroll
            for (int a = 0; a < 2; ++a)
#pragma unroll
                for (int b = 0; b < 2; ++b)
#pragma unroll
                    for (int m = 0; m < 4; ++m)
#pragma unroll
                        for (int n = 0; n < 2; ++n) acc[a][b][m][n] = (f32x4){0.f, 0.f, 0.f, 0.f};
        }
        cur = nxt; cA = nA; cB = nB; ++ui;
        if (wr == 1) PG8_BAR;
    }
    PG8_WAIT_V(0);
    PG8_BAR;
#undef PG8_SA
#undef PG8_SB
#undef PG8_STAGE
#undef PG8_LDA
#undef PG8_LDB
#undef PG8_MMA
#undef PG8_WAIT_V
#undef PG8_WAIT_L
#undef PG8_BAR
#undef PG8_SCHED
}
}
using pg8::Unit;
typedef f32x4 AccT[2][2][4][2];

__device__ __forceinline__ u32x2 pack4(f32x4 v) { u32x2 w; w.x = pk2(v[0], v[1]); w.y = pk2(v[2], v[3]); return w; }

#define EPI_LOOP_ROWS _Pragma("unroll") for (int ai = 0; ai < 2; ++ai) _Pragma("unroll") for (int m = 0; m < 4; ++m)
#define EPI_LOOP_COLS _Pragma("unroll") for (int bj = 0; bj < 2; ++bj) _Pragma("unroll") for (int n = 0; n < 2; ++n)

struct EpiInA {
    bf16* prx; bf16* grg; bf16* gates;
    __device__ __forceinline__ void mid(AccT& acc, const Unit& u, int wr, int wc, int fr, int fq) const {}
    __device__ __forceinline__ void fin(AccT& acc, const Unit& u, int wr, int wc, int fr, int fq) const {
        const int row0 = u.pm * 256 + wr * 64 + fr, col0 = u.pn * 256 + wc * 32 + 4 * fq;
        EPI_LOOP_ROWS { const size_t r = (size_t)(row0 + ai * 128 + m * 16);
            EPI_LOOP_COLS { const int c = col0 + bj * 128 + n * 16; f32x4 v = acc[ai][bj][m][n];
                if (u.pn < 4) { *(u32x2*)(prx + r * 1024 + c) = pack4(v); }
                else if (u.pn < 8) { f32x4 g; for (int i = 0; i < 4; ++i) g[i] = gelu_tanh(v[i]); *(u32x2*)(grg + r * 1024 + (c - 1024)) = pack4(g); }
                else { f32x4 g; for (int i = 0; i < 4; ++i) g[i] = sigmoidf_(v[i]); *(u32x2*)(gates + r * 2048 + (c - 2048)) = pack4(g); } } }
    }
};
struct EpiInB {
    bf16* phyT;
    __device__ __forceinline__ void mid(AccT& acc, const Unit& u, int wr, int wc, int fr, int fq) const {}
    __device__ __forceinline__ void fin(AccT& acc, const Unit& u, int wr, int wc, int fr, int fq) const {
        const int row0 = u.pm * 256 + wr * 64 + fr, col0 = u.pn * 256 + wc * 32 + 4 * fq;
        const int b = u.pn >> 5;
        EPI_LOOP_ROWS { const size_t j = (size_t)(row0 + ai * 128 + m * 16);
            EPI_LOOP_COLS { const int t = col0 + bj * 128 + n * 16 - b * SEQ;
                *(u32x2*)(phyT + ((size_t)b * 3072 + j) * SEQ + t) = pack4(acc[ai][bj][m][n]); } }
    }
};
struct EpiMerge {
    const bf16* gates; bf16* merged;
    __device__ __forceinline__ void mid(AccT& acc, const Unit& u, int wr, int wc, int fr, int fq) const {
        const int row0 = u.pm * 256 + wr * 64 + fr, col0 = u.pn * 256 + wc * 32 + 4 * fq;
        EPI_LOOP_ROWS { const size_t r = (size_t)(row0 + ai * 128 + m * 16);
            EPI_LOOP_COLS { const int c = col0 + bj * 128 + n * 16;
                const u32x2 a = *(const u32x2*)(gates + r * 2048 + c), b = *(const u32x2*)(gates + r * 2048 + 1024 + c);
                f32x4 sa = {bflo(a.x), bfhi(a.x), bflo(a.y), bfhi(a.y)}, sb = {bflo(b.x), bfhi(b.x), bflo(b.y), bfhi(b.y)};
                for (int i = 0; i < 4; ++i) acc[ai][bj][m][n][i] *= sa[i] / fmaxf(sb[i], 1e-30f); } }
    }
    __device__ __forceinline__ void fin(AccT& acc, const Unit& u, int wr, int wc, int fr, int fq) const {
        const int row0 = u.pm * 256 + wr * 64 + fr, col0 = u.pn * 256 + wc * 32 + 4 * fq;
        EPI_LOOP_ROWS { const size_t r = (size_t)(row0 + ai * 128 + m * 16);
            EPI_LOOP_COLS { const int c = col0 + bj * 128 + n * 16;
                const u32x2 b = *(const u32x2*)(gates + r * 2048 + 1024 + c);
                f32x4 sb = {bflo(b.x), bfhi(b.x), bflo(b.y), bfhi(b.y)};
                f32x4 v = acc[ai][bj][m][n]; for (int i = 0; i < 4; ++i) v[i] *= fmaxf(sb[i], 1e-30f);
                *(u32x2*)(merged + r * 1024 + c) = pack4(v); } }
    }
};
struct EpiOut {
    const float* x; const float* mod; float* x1; float* ssq;
    __device__ __forceinline__ void mid(AccT& acc, const Unit& u, int wr, int wc, int fr, int fq) const {}
    __device__ __forceinline__ void fin(AccT& acc, const Unit& u, int wr, int wc, int fr, int fq) const {
        const int row0 = u.pm * 256 + wr * 64 + fr, col0 = u.pn * 256 + wc * 32 + 4 * fq;
        const float* g1 = mod + (u.pm >> 5) * 6144 + 2048;
        EPI_LOOP_ROWS { const size_t r = (size_t)(row0 + ai * 128 + m * 16); float s = 0.f;
            EPI_LOOP_COLS { const int c = col0 + bj * 128 + n * 16;
                const f32x4 xv = *(const f32x4*)(x + r * 1024 + c), gv = *(const f32x4*)(g1 + c);
                const f32x4 o = xv + gv * acc[ai][bj][m][n];
                *(f32x4*)(x1 + r * 1024 + c) = o; s += (o[0] * o[0] + o[1] * o[1]) + (o[2] * o[2] + o[3] * o[3]); }
            s += __shfl_xor(s, 16); s += __shfl_xor(s, 32);
            if (fq == 0) ssq[r * 16 + u.pn * 4 + wc] = s; }
    }
};
struct EpiMoeUp {
    bf16* H;
    __device__ __forceinline__ void mid(AccT& acc, const Unit& u, int wr, int wc, int fr, int fq) const {}
    __device__ __forceinline__ void fin(AccT& acc, const Unit& u, int wr, int wc, int fr, int fq) const {
        const int row0 = u.pm * 256 + wr * 64 + fr, col0 = u.pn * 128 + wc * 32 + 4 * fq;
        EPI_LOOP_ROWS { const size_t r = (size_t)(row0 + ai * 128 + m * 16);
#pragma unroll
            for (int n = 0; n < 2; ++n) { const f32x4 a = acc[ai][0][m][n], b = acc[ai][1][m][n]; f32x4 h;
                for (int i = 0; i < 4; ++i) h[i] = a[i] * sigmoidf_(a[i]) * b[i];
                *(u32x2*)(H + r * 512 + col0 + n * 16) = pack4(h); } }
    }
};
struct EpiMoeDown {
    bf16* Y;
    __device__ __forceinline__ void mid(AccT& acc, const Unit& u, int wr, int wc, int fr, int fq) const {}
    __device__ __forceinline__ void fin(AccT& acc, const Unit& u, int wr, int wc, int fr, int fq) const {
        const int row0 = u.pm * 256 + wr * 64 + fr, col0 = u.pn * 256 + wc * 32 + 4 * fq;
        EPI_LOOP_ROWS { const size_t r = (size_t)(row0 + ai * 128 + m * 16);
            EPI_LOOP_COLS { const int c = col0 + bj * 128 + n * 16; *(u32x2*)(Y + r * 1024 + c) = pack4(acc[ai][bj][m][n]); } }
    }
};

constexpr size_t TSTEP1K = (size_t)256 * 1024 * 2;
struct SchedInA { const char* hx; const char* wt; int G, c;
    __device__ __forceinline__ bool next(int i, Unit& u) const {
        int Lx = (i >> (REPN(2) - 1)) * G + c, pm, pn;
        if (Lx < 2048) pg8::rect_map(Lx, 128, 16, pm, pn);
        else { Lx -= 2048; if (Lx >= 16) return false; pm = 128 + (Lx >> 2); pn = Lx & 3; }
        const int wrow = pn < 8 ? pn * 256 : 5120 + (pn - 8) * 256;
        u.pm = pm; u.pn = pn; u.last = 1; u.A = hx + (size_t)pm * TSTEP1K; u.B = wt + (size_t)wrow * 2048; return true; } };
struct SchedInB { const char* hx; const char* wt; int G, c;
    __device__ __forceinline__ bool next(int i, Unit& u) const {
        const int Lx = (i >> (REPN(21) - 1)) * G + c; if (Lx >= 12 * 128) return false; int pm, pn; pg8::rect_map(Lx, 12, 128, pm, pn);
        u.pm = pm; u.pn = pn; u.last = 1; u.A = wt + (size_t)(2048 + pm * 256) * 2048; u.B = hx + (size_t)pn * TSTEP1K; return true; } };
struct SchedMerge { const char* yrg; const char* yhy; const char* wrg; const char* why; int G, c;
    __device__ __forceinline__ bool next(int i, Unit& u) const {
        const int T = (i >> 1) * G + c, part = i & 1; if (T >= 512) return false; int pm, pn; pg8::rect_map(T, 128, 4, pm, pn);
        u.pm = pm; u.pn = pn; u.last = part; u.A = (part ? yhy : yrg) + (size_t)pm * TSTEP1K; u.B = (part ? why : wrg) + (size_t)pn * TSTEP1K; return true; } };
struct SchedOut { const char* a; const char* w; int G, c;
    __device__ __forceinline__ bool next(int i, Unit& u) const {
        const int T = (i >> (REPN(7) - 1)) * G + c; if (T >= 512) return false; int pm, pn; pg8::rect_map(T, 128, 4, pm, pn);
        u.pm = pm; u.pn = pn; u.last = 1; u.A = a + (size_t)pm * TSTEP1K; u.B = w + (size_t)pn * TSTEP1K; return true; } };
struct SchedMoeUp { const char* xg; const char* w13; const LAS int* blk_exp; int nblk, G, c;
    __device__ __forceinline__ bool next(int i, Unit& u) const {
        const int T = i * G + c; if (T >= nblk * 4) return false; const int pm = T >> 2, pn = T & 3, e = blk_exp[pm];
        u.pm = pm; u.pn = pn; u.last = 1; u.A = xg + (size_t)pm * TSTEP1K; u.B = w13 + (size_t)e * (1024 * 1024 * 2) + (size_t)pn * TSTEP1K; return true; } };
struct SchedMoeDown { const char* h; const char* w2; const LAS int* blk_exp; int nblk, G, c;
    __device__ __forceinline__ bool next(int i, Unit& u) const {
        const int T = i * G + c; if (T >= nblk * 4) return false; const int pm = T >> 2, pn = T & 3, e = blk_exp[pm];
        u.pm = pm; u.pn = pn; u.last = 1; u.A = h + (size_t)pm * (256 * 512 * 2); u.B = w2 + (size_t)e * (1024 * 512 * 2) + (size_t)pn * (256 * 512 * 2); return true; } };


typedef f32x2 cpx;
__device__ __forceinline__ int pidx(int i) { return i + (i >> 4); }
__device__ __forceinline__ cpx cmul(cpx a, cpx b) { return (cpx){a.x * b.x - a.y * b.y, a.x * b.y + a.y * b.x}; }
template <bool INV> __device__ __forceinline__ cpx mul_w4(cpx a) { return INV ? (cpx){-a.y, a.x} : (cpx){a.y, -a.x}; }
template <bool INV> __device__ __forceinline__ void dft4(cpx& a, cpx& b, cpx& c, cpx& d) {
    const cpx t0 = a + c, t1 = a - c, t2 = b + d, t3 = b - d; const cpx t3r = mul_w4<INV>(t3);
    a = t0 + t2; b = t1 + t3r; c = t0 - t2; d = t1 - t3r; }
template <bool INV> __device__ __forceinline__ cpx twc(cpx x, float cr, float ci) { return cmul(x, (cpx){cr, INV ? -ci : ci}); }
#define SLOT16(q) (4 * ((q) & 3) + ((q) >> 2))
template <bool INV> __device__ __forceinline__ void dft16(cpx (&x)[16]) {
    const float C1 = 0.9238795325112867f, S1 = 0.3826834323650898f, R = 0.7071067811865476f;
#pragma unroll
    for (int m2 = 0; m2 < 4; ++m2) dft4<INV>(x[m2], x[4 + m2], x[8 + m2], x[12 + m2]);
    x[5] = twc<INV>(x[5], C1, -S1); x[9] = twc<INV>(x[9], R, -R); x[6] = twc<INV>(x[6], R, -R);
    x[13] = twc<INV>(x[13], S1, -C1); x[7] = twc<INV>(x[7], S1, -C1); x[10] = mul_w4<INV>(x[10]);
    x[14] = twc<INV>(x[14], -R, -R); x[11] = twc<INV>(x[11], -R, -R); x[15] = twc<INV>(x[15], -C1, S1);
#pragma unroll
    for (int q1 = 0; q1 < 4; ++q1) dft4<INV>(x[4 * q1], x[4 * q1 + 1], x[4 * q1 + 2], x[4 * q1 + 3]);
}
template <int S_, int NIN> __device__ __forceinline__ void fft_fwd16(LAS cpx* X, const LAS cpx* TW, int tid) {
    constexpr int PS = S_ + S_ / 16;
#pragma unroll 1
    for (int it = 0; it < 2; ++it) {
        int bf = tid + 512 * it; asm volatile("" : "+v"(bf)); const int blk = bf / S_, j = bf % S_; const int base = pidx(blk * (16 * S_) + j);
        cpx x[16];
#pragma unroll
        for (int m = 0; m < 16; ++m) x[m] = (m < NIN) ? X[base + PS * m] : (cpx){0.f, 0.f};
        dft16<false>(x);
        const cpx w1 = TW[j]; cpx w = w1;
        X[base] = x[0];
#pragma unroll
        for (int q = 1; q < 16; ++q) { X[base + PS * q] = cmul(x[SLOT16(q)], w); w = cmul(w, w1); }
    }
}
template <int S_, int NOUT> __device__ __forceinline__ void fft_inv16(LAS cpx* X, const LAS cpx* TW, int tid) {
    constexpr int PS = S_ + S_ / 16;
#pragma unroll 1
    for (int it = 0; it < 2; ++it) {
        int bf = tid + 512 * it; asm volatile("" : "+v"(bf)); const int blk = bf / S_, j = bf % S_; const int base = pidx(blk * (16 * S_) + j);
        cpx w1 = TW[j]; w1.y = -w1.y; cpx w = w1;
        cpx x[16]; x[0] = X[base];
#pragma unroll
        for (int q = 1; q < 16; ++q) { x[q] = cmul(X[base + PS * q], w); w = cmul(w, w1); }
        dft16<true>(x);
#pragma unroll
        for (int m = 0; m < NOUT; ++m) X[base + PS * m] = x[SLOT16(m)];
    }
}
template <bool INV> __device__ __forceinline__ void fft_r4(LAS cpx* X, const LAS cpx* TW, int tid) {
#pragma unroll 2
    for (int it = 0; it < 8; ++it) {
        int bf = tid + 512 * it; asm volatile("" : "+v"(bf)); const int blk = bf >> 4, j = bf & 15; const int base = 68 * blk + j;
        cpx w1 = TW[j]; if (INV) w1.y = -w1.y; const cpx w2 = cmul(w1, w1), w3 = cmul(w2, w1);
        cpx a = X[base], b = X[base + 17], c = X[base + 34], d = X[base + 51];
        if (INV) { b = cmul(b, w1); c = cmul(c, w2); d = cmul(d, w3); }
        dft4<INV>(a, b, c, d);
        if (!INV) { b = cmul(b, w1); c = cmul(c, w2); d = cmul(d, w3); }
        X[base] = a; X[base + 17] = b; X[base + 34] = c; X[base + 51] = d;
    }
}
__device__ __forceinline__ void fft_fwdD_toK(const LAS cpx* X, cpx* Kb, int tid) {
#pragma unroll 1
    for (int it = 0; it < 2; ++it) {
        int bf = tid + 512 * it; asm volatile("" : "+v"(bf)); const int base = 17 * bf;
        cpx x[16];
#pragma unroll
        for (int m = 0; m < 16; ++m) x[m] = X[base + m];
        dft16<false>(x);
#pragma unroll
        for (int q = 0; q < 16; ++q) Kb[q * 1024 + bf] = x[SLOT16(q)] * (1.f / 16384.f);
    }
}
__device__ __forceinline__ void fft_fusedD(LAS cpx* X, const cpx* Kb, int tid) {
#pragma unroll 1
    for (int it = 0; it < 2; ++it) {
        int bf = tid + 512 * it; asm volatile("" : "+v"(bf)); const int base = 17 * bf;
        cpx x[16], z[16];
#pragma unroll
        for (int m = 0; m < 16; ++m) x[m] = X[base + m];
        dft16<false>(x);
#pragma unroll
        for (int q = 0; q < 16; ++q) { const unsigned long long kb = __hip_atomic_load((const unsigned long long*)(Kb + q * 1024 + bf), __ATOMIC_RELAXED, __HIP_MEMORY_SCOPE_AGENT);
            const cpx kq = {__builtin_bit_cast(float, (unsigned)kb), __builtin_bit_cast(float, (unsigned)(kb >> 32))}; z[q] = cmul(x[SLOT16(q)], kq); }
        dft16<true>(z);
#pragma unroll
        for (int m = 0; m < 16; ++m) X[base + m] = z[SLOT16(m)];
    }
}
__device__ __forceinline__ void load10(const bf16* row, int t0, float (&pv)[10]) {
    const u32x4 q = *(const u32x4*)(row + t0); const int lane = threadIdx.x & 63;
    pv[1] = bflo(q.x); pv[2] = bfhi(q.x); pv[3] = bflo(q.y); pv[4] = bfhi(q.y); pv[5] = bflo(q.z); pv[6] = bfhi(q.z); pv[7] = bflo(q.w); pv[8] = bfhi(q.w);
    float l = __shfl_up(pv[8], 1), r = __shfl_down(pv[1], 1);
    if (lane == 0) l = t0 > 0 ? bf2f(row[t0 - 1]) : 0.f;
    if (lane == 63) r = (t0 + 8 < SEQ) ? bf2f(row[t0 + 8]) : 0.f;
    pv[0] = l; pv[9] = r;
}

struct ScanW { const bf16* prx; const bf16* grg; bf16* yrg; const float* rgcw; const float* rgcb; const bf16* wgt;
               const float* ba_f; const float* bx_f; const float* lam_f; const float* ba_b; const float* bx_b; const float* lam_b; f32x2* carr; const float* cin; };
__device__ __forceinline__ float neg_expm1_neg(float x) {
    return (x > -0.1f) ? -x * (1.f + x * 0.5f * (1.f + x * (1.f / 3.f) * (1.f + x * 0.25f * (1.f + x * 0.2f)))) : 1.f - __expf(x);
}
struct ScanPre { u32x4 p[4]; u32x4 gl; };
template <int PASS>
__device__ __forceinline__ void scan_decode(int it, int& b, int& j, int& h) {
    h = it & 15; const int rest = it >> 4;
    if (PASS == 1) { j = rest % NCHUNK; b = rest / NCHUNK; } else { j = (rest & 127) + 4; b = rest >> 7; }
}
template <int PASS>
__device__ __forceinline__ void scan_prefetch(ScanPre& R, const ScanW& W, int it, int tid) {
    int b, j, h; scan_decode<PASS>(it, b, j, h);
    const int isctx = j < 4; const int seglen = isctx ? CTXL : SEQ; const int t0 = isctx ? j * 64 : (j - 4) * 64; const int rowbase = isctx ? NTOK + b * CTXL : b * SEQ;
    const int tok = tid >> 3, cg0 = h * 64 + (tid & 7) * 8;
#pragma unroll
    for (int jj = 0; jj < 4; ++jj) { const int tt = t0 + tok + jj - 2; R.p[jj] = (u32x4){0u, 0u, 0u, 0u};
        if (tt >= 0 && tt < seglen) R.p[jj] = *(const u32x4*)(W.prx + (size_t)(rowbase + tt) * 1024 + cg0); }
    if (PASS == 2) R.gl = *(const u32x4*)(W.grg + (size_t)(rowbase + t0 + tok) * 1024 + cg0);
}
template <int PASS>
__device__ __forceinline__ void scan_phase(LAS unsigned char* lds, const ScanW& W, int first, int stride, int nitems, int tid, int lane, int wave) {
    LAS float* XCF = (LAS float*)lds;
    LAS bf16* XCB = (LAS bf16*)(lds + 16896);
    LAS float* HX = (LAS float*)(lds + 16896 + 9216);
    if (first >= nitems) return;
    const int dir = wave >> 2, eb = wave & 3, g = lane >> 4, li = lane & 15;
    const int tok = tid >> 3, e0 = (tid & 7) * 8;
    int hcur = -1;
    float cw[4][8], cb[8]; bf16x8 bR[2], bI[2]; float ba = 0.f, bx = 0.f, sp8 = 0.f;
    ScanPre R; scan_prefetch<PASS>(R, W, first, tid);
#pragma unroll 1
    for (int it = first; it < nitems; it += stride) {
        int b, j, h; scan_decode<PASS>(it, b, j, h);
        const int isctx = j < 4; const int t0 = isctx ? j * 64 : (j - 4) * 64; const int rowbase = isctx ? NTOK + b * CTXL : b * SEQ;
        const int ch = h * 64 + eb * 16 + li;
        const size_t cidx = ((size_t)(b * NCHUNK + j) * 2 + dir) * 1024 + ch;
        float cinv = 0.f; if (PASS == 2) cinv = W.cin[cidx];
        if (h != hcur) {
            hcur = h; const int cg0 = h * 64 + e0;
#pragma unroll
            for (int jj = 0; jj < 4; ++jj) { const f32x4 w0 = *(const f32x4*)(W.rgcw + jj * 1024 + cg0), w1 = *(const f32x4*)(W.rgcw + jj * 1024 + cg0 + 4);
                cw[jj][0] = w0[0]; cw[jj][1] = w0[1]; cw[jj][2] = w0[2]; cw[jj][3] = w0[3]; cw[jj][4] = w1[0]; cw[jj][5] = w1[1]; cw[jj][6] = w1[2]; cw[jj][7] = w1[3]; }
            { const f32x4 c0 = *(const f32x4*)(W.rgcb + cg0), c1 = *(const f32x4*)(W.rgcb + cg0 + 4); cb[0] = c0[0]; cb[1] = c0[1]; cb[2] = c0[2]; cb[3] = c0[3]; cb[4] = c1[0]; cb[5] = c1[1]; cb[6] = c1[2]; cb[7] = c1[3]; }
            const bf16* wp = W.wgt + ((size_t)((dir * 2) * 16 + h) * 64 + eb * 16 + li) * 64 + g * 8;
            bR[0] = *(const bf16x8*)(wp); bR[1] = *(const bf16x8*)(wp + 32); bI[0] = *(const bf16x8*)(wp + 16 * 4096); bI[1] = *(const bf16x8*)(wp + 16 * 4096 + 32);
            ba = (dir ? W.ba_b : W.ba_f)[ch]; bx = (dir ? W.bx_b : W.bx_f)[ch]; const float lam = (dir ? W.lam_b : W.lam_f)[ch];
            sp8 = -8.f * log1pf(__expf(-lam));
        }
        {
            float xv[8];
#pragma unroll
            for (int q = 0; q < 8; ++q) xv[q] = cb[q];
#pragma unroll
            for (int jj = 0; jj < 4; ++jj) { const u32x4 p = R.p[jj];
                xv[0] += cw[jj][0] * bflo(p.x); xv[1] += cw[jj][1] * bfhi(p.x); xv[2] += cw[jj][2] * bflo(p.y); xv[3] += cw[jj][3] * bfhi(p.y);
                xv[4] += cw[jj][4] * bflo(p.z); xv[5] += cw[jj][5] * bfhi(p.z); xv[6] += cw[jj][6] * bflo(p.w); xv[7] += cw[jj][7] * bfhi(p.w); }
#pragma unroll
            for (int q = 0; q < 8; ++q) XCF[tok * 65 + e0 + q] = xv[q];
            *(LAS u32x4*)(XCB + tok * 72 + e0) = (u32x4){pk2(xv[0], xv[1]), pk2(xv[2], xv[3]), pk2(xv[4], xv[5]), pk2(xv[6], xv[7])};
        }
        const u32x4 gl = R.gl;
        if (it + stride < nitems) scan_prefetch<PASS>(R, W, it + stride, tid);
        __syncthreads();
        f32x4 aR[4], aI[4];
#pragma unroll
        for (int mb = 0; mb < 4; ++mb) { aR[mb] = (f32x4){0.f, 0.f, 0.f, 0.f}; aI[mb] = (f32x4){0.f, 0.f, 0.f, 0.f};
            const int trow = 16 * (li >> 2) + 4 * mb + (li & 3);
#pragma unroll
            for (int ks = 0; ks < 2; ++ks) { const bf16x8 af = *(const LAS bf16x8*)(XCB + trow * 72 + ks * 32 + g * 8);
                aR[mb] = __builtin_amdgcn_mfma_f32_16x16x32_bf16(af, bR[ks], aR[mb], 0, 0, 0); aI[mb] = __builtin_amdgcn_mfma_f32_16x16x32_bf16(af, bI[ks], aI[mb], 0, 0, 0); } }
        float av[16], bv[16];
#pragma unroll
        for (int mb = 0; mb < 4; ++mb)
#pragma unroll
            for (int r = 0; r < 4; ++r) { const int tk = 16 * g + 4 * mb + r; const float xcv = XCF[tk * 65 + eb * 16 + li];
                const float rr = sigmoidf_(aR[mb][r] + ba), ii = sigmoidf_(aI[mb][r] + bx); const float la = sp8 * rr; const float a = __expf(la); const float x2 = 2.f * la;
                const float pol = -x2 * (1.f + x2 * 0.5f * (1.f + x2 * (1.f / 3.f) * (1.f + x2 * 0.25f * (1.f + x2 * 0.2f)))), far_ = 1.f - a * a;
                const float sel = (x2 > -0.1f) ? 1.f : 0.f; const float om = sel * pol + (1.f - sel) * far_;
                av[4 * mb + r] = a; bv[4 * mb + r] = __builtin_amdgcn_sqrtf(om) * ii * xcv; }
        float A16 = 1.f, B16 = 0.f;
        if (dir == 0) {
#pragma unroll
            for (int q = 0; q < 16; ++q) { B16 = av[q] * B16 + bv[q]; A16 *= av[q]; }
        } else {
#pragma unroll
            for (int q = 15; q >= 0; --q) { B16 = av[q] * B16 + bv[q]; A16 *= av[q]; }
        }
        float Pc = 1.f, Hc = cinv, hin = 0.f;
        const int src = (lane + (dir == 0 ? 48 : 16)) & 63;
#pragma unroll
        for (int k = 0; k < 4; ++k) { const int gk = (dir == 0) ? k : 3 - k; if (g == gk) hin = Hc;
            const float Po = A16 * Pc, Ho = A16 * Hc + B16;
            if (k < 3) { Pc = __shfl(Po, src); Hc = __shfl(Ho, src); } else { Pc = Po; Hc = Ho; } }
        if (PASS == 1) {
            if (g == ((dir == 0) ? 3 : 0)) W.carr[cidx] = (f32x2){Pc, Hc};
            __syncthreads();
        } else {
            LAS float* hx = HX + dir * (64 * 68) + (16 * g) * 68 + eb * 16 + li; float H = hin;
            if (dir == 0) {
#pragma unroll
                for (int q = 0; q < 16; ++q) { H = av[q] * H + bv[q]; hx[q * 68] = H; }
            } else {
#pragma unroll
                for (int q = 15; q >= 0; --q) { H = av[q] * H + bv[q]; hx[q * 68] = H; }
            }
            __syncthreads();
            const f32x4 f0 = *(const LAS f32x4*)(HX + tok * 68 + e0), f1 = *(const LAS f32x4*)(HX + tok * 68 + e0 + 4);
            const f32x4 g0 = *(const LAS f32x4*)(HX + 64 * 68 + tok * 68 + e0), g1 = *(const LAS f32x4*)(HX + 64 * 68 + tok * 68 + e0 + 4);
            u32x4 o; o.x = pk2((f0[0] + g0[0]) * bflo(gl.x), (f0[1] + g0[1]) * bfhi(gl.x)); o.y = pk2((f0[2] + g0[2]) * bflo(gl.y), (f0[3] + g0[3]) * bfhi(gl.y));
            o.z = pk2((f1[0] + g1[0]) * bflo(gl.z), (f1[1] + g1[1]) * bfhi(gl.z)); o.w = pk2((f1[2] + g1[2]) * bflo(gl.w), (f1[3] + g1[3]) * bfhi(gl.w));
            *(u32x4*)(W.yrg + (size_t)(rowbase + t0 + tok) * 1024 + h * 64 + e0) = o;
        }
    }
}

#define XB_TMO      128
#define XB_XCNT(j)  (256  + 64 * (j))
#define XB_XSUB(j)  (1280 + 64 * (j))
#define XB_XGEN(j)  (2304 + 64 * (j))
#define XB_TOP      3328
#define XB_TOPGEN   3392
#define XCD_BAR_WORDS 3456
#define XB_SPIN_CAP (1u << 18)
__device__ __forceinline__ unsigned xb_ld(unsigned* p)              { return __hip_atomic_load(p, __ATOMIC_RELAXED, __HIP_MEMORY_SCOPE_AGENT); }
__device__ __forceinline__ unsigned xb_add(unsigned* p, unsigned v) { return __hip_atomic_fetch_add(p, v, __ATOMIC_RELAXED, __HIP_MEMORY_SCOPE_AGENT); }
__device__ __forceinline__ unsigned xb_xcc_id() { return (unsigned)__builtin_amdgcn_s_getreg((3 << 11) | 20) & 0xFu; }
#define XB_SPIN(cond, bar) do { unsigned _sp = 0; while (cond) { __builtin_amdgcn_s_sleep(1); \
    if ((++_sp & 255u) == 0u) { if (xb_ld(&(bar)[XB_TMO])) break; if (_sp > XB_SPIN_CAP) { atomicAdd(&(bar)[XB_TMO], 1u); break; } } } } while (0)
struct XcdBarrier { unsigned* bar; unsigned x; volatile LAS unsigned* st; };
__device__ __forceinline__ void xcd_barrier_complete(unsigned* bar, unsigned x, unsigned& nloc, unsigned& nx) {
    const unsigned Gn = gridDim.x * gridDim.y * gridDim.z;
    unsigned sum, cntx, mine, sp = 0u;
    for (;;) {
        sum = 0u; cntx = 0u; mine = 0u;
#pragma unroll
        for (unsigned j = 0; j < 16; ++j) { const unsigned c = xb_ld(&bar[XB_XCNT(j)]); sum += c; cntx += (c > 0u) ? 1u : 0u; mine = (j == x) ? c : mine; }
        if (sum == Gn) break;
        __builtin_amdgcn_s_sleep(1);
        if ((++sp & 255u) == 0u) { if (xb_ld(&bar[XB_TMO])) break; if (sp > XB_SPIN_CAP) { atomicAdd(&bar[XB_TMO], 1u); break; } }
    }
    nloc = mine > 0u ? mine : 1u; nx = cntx > 0u ? cntx : 1u;
}
__device__ __forceinline__ void xcd_barrier(const XcdBarrier& b) {
    asm volatile("s_waitcnt vmcnt(0)" ::: "memory");
    __syncthreads();
    if (threadIdx.x == 0) {
        unsigned* bar = b.bar;
        __builtin_amdgcn_s_waitcnt(0);
        unsigned nloc = b.st[0], nx = b.st[1];
        if (nloc == 0u) { xcd_barrier_complete(bar, b.x, nloc, nx); b.st[0] = nloc; b.st[1] = nx; }
        const unsigned old = xb_add(&bar[XB_XSUB(b.x)], 1u);
        const unsigned gen = old / nloc;
        if (old + 1u == (gen + 1u) * nloc) {
            __builtin_amdgcn_fence(__ATOMIC_RELEASE, "agent");
            asm volatile("s_waitcnt vmcnt(0)" ::: "memory");
            const unsigned og = xb_add(&bar[XB_TOP], 1u);
            const unsigned tg = og / nx;
            if (og + 1u == (tg + 1u) * nx) xb_add(&bar[XB_TOPGEN], 1u);
            else XB_SPIN(xb_ld(&bar[XB_TOPGEN]) == tg, bar);
            __builtin_amdgcn_fence(__ATOMIC_ACQUIRE, "agent");
            xb_add(&bar[XB_XGEN(b.x)], 1u);
            asm volatile("s_waitcnt vmcnt(0)" ::: "memory");
        } else {
            XB_SPIN(xb_ld(&bar[XB_XGEN(b.x)]) == gen, bar);
            __builtin_amdgcn_fence(__ATOMIC_ACQUIRE, "agent");
            asm volatile("s_waitcnt vmcnt(0)" ::: "memory");
        }
    }
    __syncthreads();
}

__device__ __forceinline__ void transpose_item(const float* W, int K, int N, bf16* WT, int mode, LAS float* scr, int item, int lane) {
    const int nblk = N / 32, kb = item / nblk, nb = item % nblk, k0 = 64 * kb, n0 = 32 * nb;
#pragma unroll 8
    for (int i = 0; i < 32; ++i) { const int kk = 2 * i + (lane >> 5); scr[kk * 33 + (lane & 31)] = W[(size_t)(k0 + kk) * N + n0 + (lane & 31)]; }
    LDS_WAIT(); asm volatile("" ::: "memory");
    const int c = lane & 7;
#pragma unroll
    for (int j = 0; j < 4; ++j) { const int n = (lane >> 3) + 8 * j; const LAS float* s = scr + (8 * c) * 33 + n;
        u32x4 o; o.x = pk2(s[0 * 33], s[1 * 33]); o.y = pk2(s[2 * 33], s[3 * 33]); o.z = pk2(s[4 * 33], s[5 * 33]); o.w = pk2(s[6 * 33], s[7 * 33]);
        const int nn = n0 + n; int row;
        if (mode == 0) row = nn;
        else if (mode == 1) row = (nn >> 7) * 256 + (nn & 127);
        else row = (nn >> 7) * 256 + 128 + (nn & 127);
        *(u32x4*)(WT + (size_t)row * K + k0 + 8 * c) = o; }
    LDS_WAIT(); asm volatile("" ::: "memory");
}

struct Args { const float* in[41]; float* out; unsigned char* ws; int ph_lo, ph_hi; };

enum { I_X = 0, I_C, I_CTX, I_CCTX, I_ADAW, I_ADAB, I_N1G, I_N2G, I_FG, I_WIN, I_RGCW, I_RGCB, I_WAF, I_BAF, I_WXF, I_BXF, I_LAMF, I_WAB, I_BAB, I_WXB, I_BXB, I_LAMB,
       I_RGPROJ, I_HYCW, I_HYCB, I_PW1, I_PB1, I_PW2, I_PB2, I_FREQ, I_PW3, I_SKIP, I_HYPROJ, I_WOUT, I_WG, I_BG, I_WE, I_BE, I_MW1, I_MW3, I_MW2 };

constexpr int NPHASE = 13;

__global__ void __launch_bounds__(NTHREADS, 2) fwd_kernel(Args args) {
    extern __shared__ __attribute__((aligned(16))) unsigned char lds_raw[];
    LAS unsigned char* lds = (LAS unsigned char*)lds_raw;
    const int tid = threadIdx.x, lane = tid & 63, wave = __builtin_amdgcn_readfirstlane(tid >> 6);
    const int G = gridDim.x, bid = blockIdx.x;
    const int gw = bid * NWAVES + wave, NGW = G * NWAVES;
    unsigned char* ws = args.ws;
    const int lo = args.ph_lo, hi = args.ph_hi;
#define IN(k) (lo <= (k) && (k) < hi)
#if ONE_LAUNCH
    cg::grid_group grid = cg::this_grid();
#define GRID_SYNC(k) do { if (IN(k) && IN((k) + 1)) { if ((k) == 0) { grid.sync(); if (tid == 0) (void)xb_add(&xbar.bar[XB_XCNT(xbar.x)], 1u); } \
        else { xcd_barrier(xbar); if (REPN(99) == 2) xcd_barrier(xbar); } } } while (0)
#else
#define GRID_SYNC(k) do { } while (0)
#endif
    int* cnt = (int*)(ws + WS_CTL);
    XcdBarrier xbar; xbar.bar = (unsigned*)(ws + WS_CTL) + 4096; xbar.x = xb_xcc_id(); xbar.st = (volatile LAS unsigned*)(lds + LDS_BYTES - 64);
    if (tid < 2) xbar.st[tid] = 0u;
    __syncthreads();
    float* mod = (float*)(ws + WS_MOD);
    float* z2 = (float*)(ws + WS_Z2);
    float* ssq = (float*)(ws + WS_SSQ);
    int* tok_e = (int*)(ws + WS_ROUTE); int* tok_rank = tok_e + 2 * NTOK; float* tok_w = (float*)(tok_rank + 2 * NTOK); int* tok_slot = (int*)(tok_w + 2 * NTOK);
    bf16* rgproj_t = (bf16*)(ws + WS_WSMALL); bf16* hyproj_t = rgproj_t + 1024 * 1024; bf16* wout_t = hyproj_t + 1024 * 1024;
    bf16* win_t = (bf16*)(ws + WS_WIN);
    bf16* hx = (bf16*)(ws + WS_HX); bf16* yhy = (bf16*)(ws + WS_HX); bf16* Hbuf = (bf16*)(ws + WS_HX);
    bf16* prx = (bf16*)(ws + WS_PRX); bf16* merged = (bf16*)(ws + WS_PRX);
    bf16* grg = (bf16*)(ws + WS_GRG); bf16* hx2 = (bf16*)(ws + WS_GRG);
    bf16* phyT = (bf16*)(ws + WS_PHY);
    bf16* w13t = (bf16*)(ws + WS_W13); bf16* w2t = (bf16*)(ws + WS_W2);
    bf16* Xg = (bf16*)(ws + WS_XG); bf16* Ybuf = (bf16*)(ws + WS_XG);
    float* kf = (float*)(ws + WS_KF); bf16* yrg = (bf16*)(ws + WS_KF);
    f32x2* carr = (f32x2*)(ws + WS_CARR); float* cin = (float*)(ws + WS_CIN);
    bf16* gates = (bf16*)args.out;
    float* x1 = args.out;

    if (IN(0)) for (int rp = 0; rp < REPN(0); ++rp) {
        if (bid == 0 && tid < 64) cnt[tid] = 0;
        if (bid == 0) for (int i = tid; i < XCD_BAR_WORDS; i += NTHREADS) xbar.bar[i] = 0u;
        {
            LAS float* red = (LAS float*)lds;
            const float* c = args.in[I_C]; const float* cctx = args.in[I_CCTX]; const float* ada_w = args.in[I_ADAW]; const float* ada_b = args.in[I_ADAB];
            for (int g = bid; g < 96; g += G) {
                const int n = g * 64 + lane; float acc[5] = {0.f, 0.f, 0.f, 0.f, 0.f};
                for (int kk = 0; kk < 128; ++kk) { const int k = wave * 128 + kk; const float a = ada_w[(size_t)k * 6144 + n];
#pragma unroll
                    for (int r = 0; r < 5; ++r) { const float cv = (r < 4) ? c[r * 1024 + k] : cctx[k]; acc[r] += cv * sigmoidf_(cv) * a; } }
#pragma unroll
                for (int r = 0; r < 5; ++r) red[(wave * 5 + r) * 64 + lane] = acc[r];
                __syncthreads();
                if (wave == 0) {
#pragma unroll
                    for (int r = 0; r < 5; ++r) { float s = ada_b[n]; for (int w = 0; w < 8; ++w) s += red[(w * 5 + r) * 64 + lane]; mod[r * 6144 + n] = s; } }
                __syncthreads();
            }
        }
        {
            LAS float* fe = (LAS float*)lds + wave * 128; LAS float* z1 = fe + 64;
            const float* w1 = args.in[I_PW1]; const float* b1 = args.in[I_PB1]; const float* w2 = args.in[I_PW2]; const float* b2 = args.in[I_PB2]; const float* fr = args.in[I_FREQ];
            const float TWO_PI = 6.283185307179586f;
            for (int s = gw; s < SEQ; s += NGW) {
                float f = 0.f; const float sf = (float)s;
                if (lane == 0) f = sf / 8191.f;
                else if (lane <= 32) { const int j = (lane - 1) & 15; const float band = 1e-4f + (float)j * ((15.f - 1e-4f) / 15.f); float rev = sf * band * (1.f / 8192.f); rev -= floorf(rev + 0.5f);
                    f = (lane <= 16) ? cosf(TWO_PI * rev) : sinf(TWO_PI * rev); }
                else if (lane == 33) f = (float)(s >> 6) / 128.f;
                else if (lane <= 49) { const int mm = (lane <= 41) ? (lane - 33) : (lane - 41); float rev = (float)((s & 63) * mm) * (1.f / 64.f); rev -= floorf(rev + 0.5f);
                    f = (lane <= 41) ? cosf(TWO_PI * rev) : sinf(TWO_PI * rev); }
                fe[lane] = f; LDS_WAIT(); asm volatile("" ::: "memory");
                float a = b1[lane];
                for (int i = 0; i < 50; ++i) a += fe[i] * w1[i * 64 + lane];
                z1[lane] = sinf(fr[lane] * a); LDS_WAIT(); asm volatile("" ::: "memory");
                float a2 = b2[lane];
                for (int i = 0; i < 64; ++i) a2 += z1[i] * w2[i * 64 + lane];
                z2[(size_t)s * 64 + lane] = sinf(fr[lane] * a2);
                LDS_WAIT(); asm volatile("" ::: "memory");
            }
        }
        __syncthreads();
        {
            LAS float* scr = (LAS float*)lds + wave * 2176;
            constexpr int I_IN = 16 * 224, I_SQ = 16 * 32;
            constexpr int NITEMS = I_IN + 3 * I_SQ;
            for (int it = gw; it < NITEMS; it += NGW) {
                int r = it;
                if (r < I_IN) { transpose_item(args.in[I_WIN], 1024, INC, win_t, 0, scr, r, lane); continue; } r -= I_IN;
                if (r < I_SQ) { transpose_item(args.in[I_RGPROJ], 1024, 1024, rgproj_t, 0, scr, r, lane); continue; } r -= I_SQ;
                if (r < I_SQ) { transpose_item(args.in[I_HYPROJ], 1024, 1024, hyproj_t, 0, scr, r, lane); continue; } r -= I_SQ;
                transpose_item(args.in[I_WOUT], 1024, 1024, wout_t, 0, scr, r, lane);
            }
        }
        {
            bf16* wgt = (bf16*)(ws + WS_GATEW);
            for (int i = bid * NTHREADS + tid; i < 4 * 65536; i += G * NTHREADS) { const int gi = i >> 16, r = i & 65535, hh = r >> 12, e = (r >> 6) & 63, d = r & 63;
                const float* src = gi == 0 ? args.in[I_WAF] : gi == 1 ? args.in[I_WXF] : gi == 2 ? args.in[I_WAB] : args.in[I_WXB];
                wgt[i] = (bf16)f2bf(src[hh * 4096 + d * 64 + e]); }
        }
    }
    GRID_SYNC(0);

    if (IN(1)) for (int rp = 0; rp < REPN(1); ++rp) {
        const float* x = args.in[I_X]; const float* ctx = args.in[I_CTX]; const float* n1g = args.in[I_N1G];
        for (int m0 = 2 * gw; m0 < MROWS; m0 += 2 * NGW) {
            f32x4 v[2][4]; float ss[2] = {0.f, 0.f};
#pragma unroll
            for (int u = 0; u < 2; ++u) { const int m = m0 + u; const float* xr = (m < NTOK) ? x + (size_t)m * 1024 : ctx + (size_t)(m - NTOK) * 1024;
#pragma unroll
                for (int j = 0; j < 4; ++j) v[u][j] = ((const f32x4*)xr)[64 * j + lane]; }
#pragma unroll
            for (int u = 0; u < 2; ++u)
#pragma unroll
                for (int j = 0; j < 4; ++j) ss[u] += (v[u][j][0] * v[u][j][0] + v[u][j][1] * v[u][j][1]) + (v[u][j][2] * v[u][j][2] + v[u][j][3] * v[u][j][3]);
#pragma unroll
            for (int u = 0; u < 2; ++u) { const int m = m0 + u; const int r = (m < NTOK) ? (m >> 13) : 4; const float* sh = mod + r * 6144; const float* sc = sh + 1024;
                const float rstd = rsqrtf(wave_sum(ss[u]) * (1.f / 1024.f) + 1e-6f);
#pragma unroll
                for (int j = 0; j < 4; ++j) { const int k = 4 * (64 * j + lane); const f32x4 g = *(const f32x4*)(n1g + k), s_ = *(const f32x4*)(sc + k), h = *(const f32x4*)(sh + k);
                    const f32x4 o = v[u][j] * rstd * g * (1.f + s_) + h; *(u32x2*)(hx + (size_t)m * 1024 + k) = pack4(o); } }
        }
        {
            LAS float* w3s = (LAS float*)lds;
            LAS float* z2t = w3s + 64 * 256;
            const float* w3 = args.in[I_PW3];
            const int sg = tid & 7, cgp = tid >> 3;
            for (int it = bid; it < 8 * 128; it += G) {
                const int s0 = (it & 127) * 64, c0 = (it >> 7) * 256;
                __syncthreads();
                for (int e = tid; e < 64 * 64; e += NTHREADS) { const int r = e >> 6, jj = e & 63; z2t[jj * 68 + r] = z2[(size_t)(s0 + r) * 64 + jj]; }
                for (int e = tid; e < 64 * 64; e += NTHREADS) { const int jj = e >> 6, c4 = e & 63; *(LAS f32x4*)(w3s + jj * 256 + 4 * c4) = *(const f32x4*)(w3 + (size_t)jj * 2048 + c0 + 4 * c4); }
                __syncthreads();
                float acc[4][8];
#pragma unroll
                for (int a = 0; a < 4; ++a)
#pragma unroll
                    for (int q = 0; q < 8; ++q) acc[a][q] = 0.f;
#pragma unroll 4
                for (int jj = 0; jj < 64; ++jj) { const f32x4 w = *(const LAS f32x4*)(w3s + jj * 256 + 4 * cgp); const f32x4 za = *(const LAS f32x4*)(z2t + jj * 68 + 8 * sg), zb = *(const LAS f32x4*)(z2t + jj * 68 + 8 * sg + 4);
#pragma unroll
                    for (int a = 0; a < 4; ++a) { acc[a][0] += w[a] * za[0]; acc[a][1] += w[a] * za[1]; acc[a][2] += w[a] * za[2]; acc[a][3] += w[a] * za[3];
                        acc[a][4] += w[a] * zb[0]; acc[a][5] += w[a] * zb[1]; acc[a][6] += w[a] * zb[2]; acc[a][7] += w[a] * zb[3]; } }
                const float mind = -3.0701134573253944f, maxd = -15.350567286626972f;
#pragma unroll
                for (int a = 0; a < 4; ++a) { const int cp = c0 + 4 * cgp + a, ch = cp & 1023; const float delta = fabsf(mind + (float)ch * ((maxd - mind) / 1023.f));
                    f32x4 o0, o1;
#pragma unroll
                    for (int q = 0; q < 4; ++q) { o0[q] = acc[a][q] * __expf(-((float)(s0 + 8 * sg + q) / 8191.f) * delta); o1[q] = acc[a][4 + q] * __expf(-((float)(s0 + 8 * sg + 4 + q) / 8191.f) * delta); }
                    *(f32x4*)(kf + (size_t)cp * SEQ + s0 + 8 * sg) = o0; *(f32x4*)(kf + (size_t)cp * SEQ + s0 + 8 * sg + 4) = o1; }
            }
        }
    }
    GRID_SYNC(1);

    if (IN(2)) {
        { SchedInA S{(const char*)hx, (const char*)win_t, G, bid}; EpiInA E{prx, grg, gates}; pg8::gemm_phase(lds, 1024, S, E); }
        { SchedInB S{(const char*)hx, (const char*)win_t, G, bid}; EpiInB E{phyT}; pg8::gemm_phase(lds, 1024, S, E); }
    }
    GRID_SYNC(2);

    const ScanW SW{prx, grg, yrg, args.in[I_RGCW], args.in[I_RGCB], (const bf16*)(ws + WS_GATEW), args.in[I_BAF], args.in[I_BXF], args.in[I_LAMF], args.in[I_BAB], args.in[I_BXB], args.in[I_LAMB], carr, cin};
    if (IN(3)) {
        for (int rp = 0; rp < REPN(3); ++rp) scan_phase<1>(lds, SW, bid, G, NBATCH * NCHUNK * 16, tid, lane, wave);
        __syncthreads();
        {
            LAS cpx* X = (LAS cpx*)lds;
            LAS cpx* TWA = (LAS cpx*)(lds + 139264); LAS cpx* TWB = TWA + 1024; LAS cpx* TWC = TWB + 64;
            for (int i = tid; i < 1024 + 64 + 16; i += NTHREADS) { const float fr_ = (i < 1024) ? (float)i * (1.f / 8192.f) : (i < 1088) ? (float)(i - 1024) * (1.f / 512.f) : (float)(i - 1088) * (1.f / 32.f);
                float sn, cs; sincospif(-fr_, &sn, &cs); TWA[i] = (cpx){cs, sn}; }
            __syncthreads();
            cpx* Kb = (cpx*)(ws + WS_HX) + (size_t)bid * 16384;
            const float* hcw = args.in[I_HYCW]; const float* hcb = args.in[I_HYCB]; const float* skip = args.in[I_SKIP];
            for (int rp = 0; rp < REPN(30); ++rp)
            for (int c = bid; c < 1024; c += G) {
                __syncthreads();
                for (int q = 0; q < 32; ++q) { const int i = tid + 512 * q;
                    const float v = (i < SEQ) ? kf[(size_t)c * SEQ + i] : ((i == SEQ) ? 0.f : kf[(size_t)(1024 + c) * SEQ + (16384 - i)]);
                    X[pidx(i)] = (cpx){v, 0.f}; }
                __syncthreads();
                fft_fwd16<1024, 16>(X, TWA, tid); __syncthreads();
                fft_fwd16<64, 16>(X, TWB, tid); __syncthreads();
                fft_r4<false>(X, TWC, tid); __syncthreads();
                fft_fwdD_toK(X, Kb, tid);
                const float w00 = hcw[c], w01 = hcw[3072 + c], w02 = hcw[6144 + c], b0 = hcb[c];
                const float w10 = hcw[1024 + c], w11 = hcw[3072 + 1024 + c], w12 = hcw[6144 + 1024 + c], b1 = hcb[1024 + c];
                const float w20 = hcw[2048 + c], w21 = hcw[3072 + 2048 + c], w22 = hcw[6144 + 2048 + c], b2 = hcb[2048 + c];
                const float sk = skip[c];
                for (int pair = 0; pair < 2; ++pair) {
                    const bf16* rA = phyT + ((size_t)(2 * pair) * 3072 + c) * SEQ; const bf16* rB = rA + (size_t)3072 * SEQ;
                    __syncthreads();
#pragma unroll 1
                    for (int it = 0; it < 2; ++it) { int t0 = 8 * (tid + 512 * it); asm volatile("" : "+v"(t0)); float p1[10], p2[10], ua[8], ub[8];
                        load10(rA + (size_t)1024 * SEQ, t0, p1); load10(rA + (size_t)2048 * SEQ, t0, p2);
#pragma unroll
                        for (int k = 0; k < 8; ++k) ua[k] = (b2 + w20 * p2[k] + w21 * p2[k + 1] + w22 * p2[k + 2]) * (b1 + w10 * p1[k] + w11 * p1[k + 1] + w12 * p1[k + 2]);
                        load10(rB + (size_t)1024 * SEQ, t0, p1); load10(rB + (size_t)2048 * SEQ, t0, p2);
#pragma unroll
                        for (int k = 0; k < 8; ++k) ub[k] = (b2 + w20 * p2[k] + w21 * p2[k + 1] + w22 * p2[k + 2]) * (b1 + w10 * p1[k] + w11 * p1[k + 1] + w12 * p1[k + 2]);
                        const int pb = pidx(t0);
#pragma unroll
                        for (int k = 0; k < 8; ++k) X[pb + k] = (cpx){ua[k], ub[k]}; }
                    __syncthreads();
                    fft_fwd16<1024, 8>(X, TWA, tid); __syncthreads();
                    fft_fwd16<64, 16>(X, TWB, tid); __syncthreads();
                    fft_r4<false>(X, TWC, tid); __syncthreads();
                    fft_fusedD(X, Kb, tid); __syncthreads();
                    fft_r4<true>(X, TWC, tid); __syncthreads();
                    fft_inv16<64, 16>(X, TWB, tid); __syncthreads();
                    fft_inv16<1024, 8>(X, TWA, tid); __syncthreads();
#pragma unroll 1
                    for (int it = 0; it < 2; ++it) { int t0 = 8 * (tid + 512 * it); asm volatile("" : "+v"(t0)); float p0[10], p1[10], p2[10]; const int pb = pidx(t0);
                        load10(rA, t0, p0); load10(rA + (size_t)1024 * SEQ, t0, p1); load10(rA + (size_t)2048 * SEQ, t0, p2);
#pragma unroll
                        for (int k = 0; k < 8; ++k) { const float uu = (b2 + w20 * p2[k] + w21 * p2[k + 1] + w22 * p2[k + 2]) * (b1 + w10 * p1[k] + w11 * p1[k + 1] + w12 * p1[k + 2]);
                            const float x0 = b0 + w00 * p0[k] + w01 * p0[k + 1] + w02 * p0[k + 2]; X[pb + k].x = (X[pb + k].x + sk * uu) * x0; }
                        load10(rB, t0, p0); load10(rB + (size_t)1024 * SEQ, t0, p1); load10(rB + (size_t)2048 * SEQ, t0, p2);
#pragma unroll
                        for (int k = 0; k < 8; ++k) { const float uu = (b2 + w20 * p2[k] + w21 * p2[k + 1] + w22 * p2[k + 2]) * (b1 + w10 * p1[k] + w11 * p1[k + 1] + w12 * p1[k + 2]);
                            const float x0 = b0 + w00 * p0[k] + w01 * p0[k + 1] + w02 * p0[k + 2]; X[pb + k].y = (X[pb + k].y + sk * uu) * x0; } }
                    __syncthreads();
#pragma unroll 1
                    for (int it = 0; it < 2; ++it) { int t0 = 8 * (tid + 512 * it); asm volatile("" : "+v"(t0)); const int pb = pidx(t0); cpx y[8];
#pragma unroll
                        for (int k = 0; k < 8; ++k) y[k] = X[pb + k];
                        if (rp == REPN(30) - 1) *(u32x4*)((bf16*)rA + t0) = (u32x4){pk2(y[0].x, y[1].x), pk2(y[2].x, y[3].x), pk2(y[4].x, y[5].x), pk2(y[6].x, y[7].x)};
                        if (rp == REPN(30) - 1) *(u32x4*)((bf16*)rB + t0) = (u32x4){pk2(y[0].y, y[1].y), pk2(y[2].y, y[3].y), pk2(y[4].y, y[5].y), pk2(y[6].y, y[7].y)}; }
                }
            }
        }
    }
    GRID_SYNC(3);

    if (IN(4)) for (int rp = 0; rp < REPN(4); ++rp) {
        const int gt = bid * NTHREADS + tid;
        if (gt < NBATCH * 2 * 1024) {
            const int c = gt & 1023, dir = (gt >> 10) & 1, b = gt >> 11; float s = 0.f;
            for (int q = 0; q < NCHUNK; ++q) { const int j = dir == 0 ? q : (q < 4 ? 3 - q : NCHUNK + 3 - q);
                const size_t idx = ((size_t)(b * NCHUNK + j) * 2 + dir) * 1024 + c; const f32x2 ab = carr[idx]; cin[idx] = s; s = ab.x * s + ab.y; }
        }
    }
    GRID_SYNC(4);

    if (IN(5)) {
        for (int rp = 0; rp < REPN(5); ++rp) scan_phase<2>(lds, SW, bid, G, NBATCH * 128 * 16, tid, lane, wave);
        __syncthreads();
        {
            LAS bf16* T = (LAS bf16*)lds;
            for (int rp = 0; rp < REPN(50); ++rp)
            for (int it = bid; it < NBATCH * 16 * 128; it += G) {
                const int tb = it & 127, cb = (it >> 7) & 15, b = it >> 11;
                { const int cl = tid >> 3, ch = tid & 7; *(LAS u32x4*)(T + cl * 72 + ch * 8) = *(const u32x4*)(phyT + ((size_t)b * 3072 + cb * 64 + cl) * SEQ + tb * 64 + ch * 8); }
                __syncthreads();
                { const int tl = tid >> 3, ch = tid & 7; unsigned v[8];
#pragma unroll
                    for (int q = 0; q < 8; ++q) v[q] = T[(ch * 8 + q) * 72 + tl];
                    u32x4 o; o.x = v[0] | (v[1] << 16); o.y = v[2] | (v[3] << 16); o.z = v[4] | (v[5] << 16); o.w = v[6] | (v[7] << 16);
                    *(u32x4*)(yhy + (size_t)(b * SEQ + tb * 64 + tl) * 1024 + cb * 64 + ch * 8) = o; }
                __syncthreads();
            }
        }
    }
    GRID_SYNC(5);

    if (IN(6)) for (int rp = 0; rp < REPN(6); ++rp) {
        SchedMerge S{(const char*)yrg, (const char*)yhy, (const char*)rgproj_t, (const char*)hyproj_t, G, bid}; EpiMerge E{gates, merged};
        pg8::gemm_phase(lds, 1024, S, E);
    }
    GRID_SYNC(6);

    if (IN(7)) {
        SchedOut S{(const char*)merged, (const char*)wout_t, G, bid}; EpiOut E{args.in[I_X], mod, x1, ssq};
        pg8::gemm_phase(lds, 1024, S, E);
    }
    GRID_SYNC(7);

    if (IN(8)) {
        {
            LAS float* XT = (LAS float*)lds;
            LAS float* WL = XT + 64 * 129;
            LAS float* RS = WL + 64 * 36;
            LAS float* PART = RS + 128;
            const float* n2g = args.in[I_N2G]; const float* wg = args.in[I_WG]; const float* bg = args.in[I_BG]; const float* we = args.in[I_WE]; const float* be = args.in[I_BE];
            int nrep8 = REPN(8); asm volatile("" : "+s"(nrep8));
_Pragma("unroll 1")
            for (int rp = 0; rp < nrep8; ++rp)
            for (int tile = bid; tile < NTOK / 128; tile += G) {
                const int R0 = tile * 128; const int b = R0 >> 13; const float* sh = mod + b * 6144 + 3072; const float* sc = sh + 1024;
                __syncthreads();
                if (tid < 128) { const float* sp = ssq + (size_t)(R0 + tid) * 16; float ss = 0.f; for (int q = 0; q < 16; ++q) ss += sp[q]; RS[tid] = rsqrtf(ss * (1.f / 1024.f) + 1e-6f); }
                __syncthreads();
                float acc[36];
#pragma unroll
                for (int c = 0; c < 36; ++c) acc[c] = 0.f;
                const int lrow = tid >> 2, lq = tid & 3; const float rstd = RS[lrow];
                const int rh = wave & 1, kq = wave >> 1;
                f32x4 xr[4]; float wv[5];
#define ROUTER_LOAD(kc_) do { const int k0_ = (kc_) * 64 + lq * 16; \
                    _Pragma("unroll") for (int i = 0; i < 4; ++i) xr[i] = *(const f32x4*)(x1 + (size_t)(R0 + lrow) * 1024 + k0_ + 4 * i); \
                    _Pragma("unroll") for (int i = 0; i < 5; ++i) { const int e = tid + 512 * i; const int kk = e / 36, cc = e % 36; \
                        wv[i] = (e < 64 * 36) ? ((cc < 4) ? wg[(size_t)((kc_) * 64 + kk) * 4 + cc] : we[(size_t)((kc_) * 64 + kk) * 32 + (cc - 4)]) : 0.f; } } while (0)
                ROUTER_LOAD(0);
#pragma unroll 1
                for (int kc = 0; kc < 16; ++kc) {
                    const int k0 = kc * 64 + lq * 16;
                    f32x4 o[4];
#pragma unroll
                    for (int i = 0; i < 4; ++i) { const int k = k0 + 4 * i;
                        const f32x4 g = *(const f32x4*)(n2g + k), s_ = *(const f32x4*)(sc + k), hh = *(const f32x4*)(sh + k); o[i] = xr[i] * rstd * g * (1.f + s_) + hh; }
                    *(u32x4*)(hx2 + (size_t)(R0 + lrow) * 1024 + k0) = (u32x4){pk2(o[0][0], o[0][1]), pk2(o[0][2], o[0][3]), pk2(o[1][0], o[1][1]), pk2(o[1][2], o[1][3])};
                    *(u32x4*)(hx2 + (size_t)(R0 + lrow) * 1024 + k0 + 8) = (u32x4){pk2(o[2][0], o[2][1]), pk2(o[2][2], o[2][3]), pk2(o[3][0], o[3][1]), pk2(o[3][2], o[3][3])};
                    __syncthreads();
#pragma unroll
                    for (int i = 0; i < 4; ++i)
#pragma unroll
                        for (int q = 0; q < 4; ++q) XT[(lq * 16 + 4 * i + q) * 129 + lrow] = o[i][q];
#pragma unroll
                    for (int i = 0; i < 5; ++i) { const int e = tid + 512 * i; if (e < 64 * 36) WL[e] = wv[i]; }
                    __syncthreads();
                    if (kc < 15) ROUTER_LOAD(kc + 1);
#pragma unroll 4
                    for (int kk = 0; kk < 16; ++kk) { const int k = kq * 16 + kk; const float xv = XT[k * 129 + rh * 64 + lane];
#pragma unroll
                        for (int c4 = 0; c4 < 9; ++c4) { const f32x4 w4 = *(const LAS f32x4*)(WL + k * 36 + 4 * c4);
                            acc[4 * c4] += xv * w4[0]; acc[4 * c4 + 1] += xv * w4[1]; acc[4 * c4 + 2] += xv * w4[2]; acc[4 * c4 + 3] += xv * w4[3]; } }
                }
#undef ROUTER_LOAD
#pragma unroll
                for (int c = 0; c < 36; ++c) PART[(kq * 128 + rh * 64 + lane) * 37 + c] = acc[c];
                __syncthreads();
                if (tid < 128) {
                    float lg[36];
#pragma unroll
                    for (int c = 0; c < 36; ++c) lg[c] = ((PART[(0 * 128 + tid) * 37 + c] + PART[(1 * 128 + tid) * 37 + c]) + (PART[(2 * 128 + tid) * 37 + c] + PART[(3 * 128 + tid) * 37 + c])) + (c < 4 ? bg[c] : be[c - 4]);
                    int grp = 0; float gm = lg[0];
#pragma unroll
                    for (int q = 1; q < 4; ++q) if (lg[q] > gm) { gm = lg[q]; grp = q; }
                    float den = 0.f;
#pragma unroll
                    for (int q = 0; q < 4; ++q) den += __expf(lg[q] - gm);
                    const float pg = 1.f / den;
                    float ep[8];
#pragma unroll
                    for (int q = 0; q < 8; ++q) ep[q] = grp == 0 ? lg[4 + q] : grp == 1 ? lg[12 + q] : grp == 2 ? lg[20 + q] : lg[28 + q];
                    int i1 = 0; float v1 = ep[0];
#pragma unroll
                    for (int q = 1; q < 8; ++q) if (ep[q] > v1) { v1 = ep[q]; i1 = q; }
                    int i2 = -1; float v2 = -3.0e38f;
#pragma unroll
                    for (int q = 0; q < 8; ++q) if (q != i1 && ep[q] > v2) { v2 = ep[q]; i2 = q; }
                    const float e2 = __expf(v2 - v1); const float p1 = 1.f / (1.f + e2), p2 = e2 / (1.f + e2);
                    const int ea = grp * 8 + i1, eb = grp * 8 + i2; const int m = R0 + tid;
                    if (rp == nrep8 - 1) {
                    const int ra = atomicAdd(cnt + ea, 1), rb = atomicAdd(cnt + eb, 1);
                    tok_e[2 * m] = ea; tok_e[2 * m + 1] = eb; tok_rank[2 * m] = ra; tok_rank[2 * m + 1] = rb; tok_w[2 * m] = pg * p1; tok_w[2 * m + 1] = pg * p2; }
                }
            }
        }
        __syncthreads();
        {
            LAS float* scr = (LAS float*)lds + wave * 2176;
            constexpr int I_E13 = 16 * 16, I_E2 = 8 * 32;
            constexpr int NITEMS = NEXP * (2 * I_E13 + I_E2);
            for (int rp = 0; rp < REPN(80); ++rp)
            for (int it = gw; it < NITEMS; it += NGW) {
                const int e = it / (2 * I_E13 + I_E2); int r = it % (2 * I_E13 + I_E2);
                if (r < I_E13) { transpose_item(args.in[I_MW1] + (size_t)e * 1024 * 512, 1024, 512, w13t + (size_t)e * 1024 * 1024, 1, scr, r, lane); continue; } r -= I_E13;
                if (r < I_E13) { transpose_item(args.in[I_MW3] + (size_t)e * 1024 * 512, 1024, 512, w13t + (size_t)e * 1024 * 1024, 2, scr, r, lane); continue; } r -= I_E13;
                transpose_item(args.in[I_MW2] + (size_t)e * 512 * 1024, 512, 1024, w2t + (size_t)e * 1024 * 512, 0, scr, r, lane);
            }
        }
    }
    GRID_SYNC(8);

    LAS int* blk_exp = (LAS int*)(lds + MISC_OFF); LAS int* pstart = blk_exp + 320;
    int nblk = 0;
    if (hi > 9 && lo <= 11) {
        __syncthreads();
        if (tid == 0) { int p = 0; for (int e = 0; e < NEXP; ++e) { const int c_ = __hip_atomic_load(cnt + e, __ATOMIC_RELAXED, __HIP_MEMORY_SCOPE_AGENT); const int nb = (c_ + 255) >> 8; pstart[e] = p * 256; for (int q = 0; q < nb; ++q) blk_exp[p + q] = e; p += nb; } pstart[32] = p; }
        __syncthreads();
        nblk = pstart[32];
    }

    if (IN(9)) for (int rp = 0; rp < REPN(9); ++rp) {
        for (int a = gw; a < 2 * NTOK; a += NGW) {
            const int e = tok_e[a], rk = tok_rank[a]; const int slot = pstart[e] + rk; const int m = a >> 1;
            if (lane == 0) tok_slot[a] = slot;
            const u32x4* src = (const u32x4*)(hx2 + (size_t)m * 1024); u32x4* dst = (u32x4*)(Xg + (size_t)slot * 1024);
            dst[lane] = src[lane]; dst[64 + lane] = src[64 + lane];
        }
    }
    GRID_SYNC(9);

    if (IN(10)) for (int rp = 0; rp < REPN(10); ++rp) {
        SchedMoeUp S{(const char*)Xg, (const char*)w13t, blk_exp, nblk, G, bid}; EpiMoeUp E{Hbuf};
        pg8::gemm_phase(lds, 1024, S, E);
    }
    GRID_SYNC(10);

    if (IN(11)) for (int rp = 0; rp < REPN(11); ++rp) {
        SchedMoeDown S{(const char*)Hbuf, (const char*)w2t, blk_exp, nblk, G, bid}; EpiMoeDown E{Ybuf};
        pg8::gemm_phase(lds, 512, S, E);
    }
    GRID_SYNC(11);

    if (IN(12)) {
        const float* fg = args.in[I_FG];
        int nrep12 = REPN(12); asm volatile("" : "+s"(nrep12));
_Pragma("unroll 1")
        for (int rp = 0; rp < nrep12; ++rp)
        for (int m0 = 2 * gw; m0 < NTOK; m0 += 2 * NGW) {
            f32x4 v[2][4]; float ss[2] = {0.f, 0.f};
#pragma unroll
            for (int u = 0; u < 2; ++u) { const int m = m0 + u; const int b = m >> 13; const float* g2 = mod + b * 6144 + 5120;
                const int sa = tok_slot[2 * m], sb = tok_slot[2 * m + 1]; const float wa = tok_w[2 * m], wb = tok_w[2 * m + 1];
#pragma unroll
                for (int j = 0; j < 4; ++j) { const int k = 4 * (64 * j + lane);
                    const u32x2 ya = *(const u32x2*)(Ybuf + (size_t)sa * 1024 + k), yb = *(const u32x2*)(Ybuf + (size_t)sb * 1024 + k);
                    const f32x4 fa = {bflo(ya.x), bfhi(ya.x), bflo(ya.y), bfhi(ya.y)}, fb = {bflo(yb.x), bfhi(yb.x), bflo(yb.y), bfhi(yb.y)};
                    const f32x4 xv = *(const f32x4*)(x1 + (size_t)m * 1024 + k), gv = *(const f32x4*)(g2 + k);
                    v[u][j] = xv + gv * (fa * wa + fb * wb); ss[u] += (v[u][j][0] * v[u][j][0] + v[u][j][1] * v[u][j][1]) + (v[u][j][2] * v[u][j][2] + v[u][j][3] * v[u][j][3]); } }
#pragma unroll
            for (int u = 0; u < 2; ++u) { const int m = m0 + u; const float rstd = rsqrtf(wave_sum(ss[u]) * (1.f / 1024.f) + 1e-6f);
#pragma unroll
                for (int j = 0; j < 4; ++j) { const int k = 4 * (64 * j + lane); const f32x4 g = *(const f32x4*)(fg + k); if (rp == nrep12 - 1) *(f32x4*)(args.out + (size_t)m * 1024 + k) = v[u][j] * rstd * g; } }
        }
    }
}

extern "C" void kernel_launch(void* const* d_in, const int* in_sizes, int n_in, void* d_out, int out_size, void* d_ws, size_t ws_size, hipStream_t stream) {
    static int grid = 0;
    if (grid == 0) {
        if (n_in != 41 || out_size != NTOK * DM || ws_size < WS_END) { fprintf(stderr, "kernel_launch: unexpected shapes (n_in %d, out %d, ws %zu)\n", n_in, out_size, ws_size); grid = -1; return; }
        int dev = 0, cus = 0, per_cu = 0;
        hipGetDevice(&dev); hipDeviceGetAttribute(&cus, hipDeviceAttributeMultiprocessorCount, dev);
        if (hipFuncSetAttribute((const void*)fwd_kernel, hipFuncAttributeMaxDynamicSharedMemorySize, LDS_BYTES) != hipSuccess) { fprintf(stderr, "kernel_launch: hipFuncSetAttribute failed\n"); grid = -1; return; }
        hipOccupancyMaxActiveBlocksPerMultiprocessor(&per_cu, (const void*)fwd_kernel, NTHREADS, LDS_BYTES);
        (void)hipGetLastError();
        if (per_cu < 1) { fprintf(stderr, "kernel_launch: occupancy query says %d blocks per CU\n", per_cu); per_cu = 1; }
        grid = cus;
        fprintf(stderr, "kernel_launch: grid %d (cus %d, per_cu %d)\n", grid, cus, per_cu);
    }
    if (grid < 0) return;
    Args a{};
    for (int i = 0; i < 41; ++i) a.in[i] = (const float*)d_in[i];
    a.out = (float*)d_out; a.ws = (unsigned char*)d_ws;
#if ONE_LAUNCH
    a.ph_lo = 0; a.ph_hi = NPHASE;
    void* kargs[] = {&a};
    hipError_t e = hipLaunchCooperativeKernel((const void*)fwd_kernel, dim3(grid), dim3(NTHREADS), kargs, LDS_BYTES, stream);
    if (e != hipSuccess) fprintf(stderr, "cooperative launch failed: %s (grid %d)\n", hipGetErrorString(e), grid);
#else
    for (int p = 0; p < NPHASE; ++p) { a.ph_lo = p; a.ph_hi = p + 1; hipLaunchKernelGGL(fwd_kernel, dim3(grid), dim3(NTHREADS), LDS_BYTES, stream, a); }
#endif
}
```

```cpp
#include <hip/hip_runtime.h>
#include <hip/hip_cooperative_groups.h>
#include <cstdio>
#include <cstdint>
namespace cg = cooperative_groups;

#ifndef ONE_LAUNCH
#define ONE_LAUNCH 1
#endif

#ifndef PROBE_REP
#define PROBE_REP -1
#endif
#ifndef PROBE_TS
#define PROBE_TS -1
#endif
#define REPN(k) ((PROBE_REP == (k)) ? 2 : 1)
#define LAS __attribute__((address_space(3)))
typedef unsigned short bf16;
typedef float f32x4 __attribute__((ext_vector_type(4)));
typedef float f32x2 __attribute__((ext_vector_type(2)));
typedef short bf16x8 __attribute__((ext_vector_type(8)));
typedef unsigned u32x4 __attribute__((ext_vector_type(4)));
typedef unsigned u32x2 __attribute__((ext_vector_type(2)));

constexpr int DM = 1024, NBATCH = 4, SEQ = 8192, NTOK = NBATCH * SEQ, CTXL = 256, NCTX = NBATCH * CTXL, MROWS = NTOK + NCTX;
constexpr int INC = 7168, NEXP = 32, DEXP = 512, PMAXBLK = 288;
constexpr int NCHUNK = 132;
constexpr int NTHREADS = 512, NWAVES = 8;
constexpr int LDS_BYTES = 148480;
constexpr int MISC_OFF = 131072;

constexpr size_t MiB = 1u << 20;
constexpr size_t WS_CTL = 0, WS_MOD = 1 * MiB, WS_Z2 = 2 * MiB, WS_SSQ = 4 * MiB, WS_ROUTE = 6 * MiB, WS_GATEW = 7 * MiB;
constexpr size_t WS_WSMALL = 8 * MiB, WS_WIN = 14 * MiB;
constexpr size_t WS_HX = 32 * MiB;
constexpr size_t WS_PRX = 98 * MiB;
constexpr size_t WS_GRG = 164 * MiB;
constexpr size_t WS_PHY = 228 * MiB;
constexpr size_t WS_W13 = 228 * MiB, WS_W2 = 292 * MiB;
constexpr size_t WS_XG = 324 * MiB;
constexpr size_t WS_KF = 420 * MiB;
constexpr size_t WS_CARR = 484 * MiB, WS_CIN = 494 * MiB, WS_END = 512 * MiB;

__device__ __forceinline__ unsigned f2bf(float f) { unsigned u = __builtin_bit_cast(unsigned, f); return (u + 0x7fffu + ((u >> 16) & 1u)) >> 16; }
__device__ __forceinline__ unsigned pk2(float lo, float hi) { unsigned r; asm("v_cvt_pk_bf16_f32 %0, %1, %2" : "=v"(r) : "v"(lo), "v"(hi)); return r; }
__device__ __forceinline__ float bf2f(unsigned b) { return __builtin_bit_cast(float, b << 16); }
__device__ __forceinline__ float bflo(unsigned w) { return __builtin_bit_cast(float, w << 16); }
__device__ __forceinline__ float bfhi(unsigned w) { return __builtin_bit_cast(float, w & 0xffff0000u); }
__device__ __forceinline__ float wave_sum(float v) {
#pragma unroll
    for (int o = 1; o < 64; o <<= 1) v += __shfl_xor(v, o);
    return v;
}
__device__ __forceinline__ float sigmoidf_(float v) { return __builtin_amdgcn_rcpf(1.f + __expf(-v)); }
__device__ __forceinline__ float gelu_tanh(float v) { const float z = 0.7978845608028654f * (v + 0.044715f * v * v * v); const float t = 1.f - 2.f * __builtin_amdgcn_rcpf(1.f + __expf(2.f * z)); return 0.5f * v * (1.f + t); }
#define LDS_WAIT() asm volatile("s_waitcnt lgkmcnt(0)" ::: "memory")
#define LDS_BARRIER() do { asm volatile("s_waitcnt lgkmcnt(0)" ::: "memory"); __builtin_amdgcn_s_barrier(); asm volatile("" ::: "memory"); } while (0)

namespace pg8 {
#define PG8_LAS __attribute__((address_space(3)))
constexpr int BM = 256, BK = 64, HALF = 128, HTB = HALF * BK * 2, STAGE_BYTES = 8 * HTB, NXCD = 8, WGM = 4;
__host__ __device__ __forceinline__ int lds_byte(int r, int c) { const int st = (r >> 4) * 2 + (c >> 5), rr = r & 15, cc = c & 31, ob = rr * 64 + cc * 2; return st * 1024 + (ob ^ (((ob >> 9) & 1) << 5)); }
__host__ __device__ __forceinline__ void stage_rc(int b, int& R, int& C) { const int st = b / 1024, sb = b % 1024, swz = sb ^ (((sb >> 9) & 1) << 5); R = (st >> 1) * 16 + swz / 64; C = (st & 1) * 32 + (swz % 64) / 2; }

__host__ __device__ __forceinline__ int perm32(int rho) { const int n = rho >> 4, i = rho & 15; return 8 * (i >> 2) + 4 * n + (i & 3); }
struct Unit { int pm, pn, last; const char* A; const char* B; };

__device__ __forceinline__ void rect_map(int wg, int nM, int nN, int& pm, int& pn) {
    const int nwg = nM * nN; int wgid = wg; { const int q = nwg / NXCD, r = nwg % NXCD, xcd = wgid % NXCD, off = wgid / NXCD; wgid = (xcd < r ? xcd * (q + 1) : r * (q + 1) + (xcd - r) * q) + off; }
    const int nig = WGM * nN, gid = wgid / nig, fm = gid * WGM, gsz = (nM - fm) < WGM ? (nM - fm) : WGM;
    pm = fm + ((wgid % nig) % gsz); pn = (wgid % nig) / gsz;
}

template <class Epi, class Sched, bool GATHER = false>
__device__ __forceinline__ void gemm_phase(PG8_LAS unsigned char* lds, const int K, const Sched& S, const Epi& E) {
    const int tid = threadIdx.x, wid = __builtin_amdgcn_readfirstlane(tid >> 6), lane = tid & 63, wr = wid >> 2, wc = wid & 3, fr = lane & 15, fq = lane >> 4;
    const int nt = K / BK;
    unsigned voffA[2]; int stR[2], stC[2]; unsigned voffB[2];
#pragma unroll
    for (int i = 0; i < 2; ++i) { int R, C; stage_rc(tid * 16 + i * 8192, R, C); voffA[i] = (unsigned)(R * K + C) * 2u; stR[i] = R; stC[i] = C;
        const int Rb = Epi::PERM ? ((R & ~31) + perm32(R & 31)) : R; voffB[i] = (unsigned)(Rb * K + C) * 2u; }
    unsigned voffGc[2][2], voffGn[2][2];
#define PG8_GOFF(dst, u) do { _Pragma("unroll") for (int _h = 0; _h < 2; ++_h) _Pragma("unroll") for (int _i = 0; _i < 2; ++_i) \
        dst[_h][_i] = (unsigned)(S.row_tok[(u).pm * 256 + _h * 128 + stR[_i]] * K + stC[_i]) * 2u; } while (0)
    const size_t kstep = (size_t)(BK * 2);
    const size_t hstep = (size_t)HALF * K * 2;
    const unsigned ldsw = (unsigned)wid * 1024u;
    const int aoff = lds_byte(wr * 64 + fr, fq * 8), boff = lds_byte(wc * 32 + fr, fq * 8);
#define PG8_SA(b, h) (((b) * 2 + (h)) * HTB)
#define PG8_SB(b, h) ((4 + (b) * 2 + (h)) * HTB)
#define PG8_STAGE(bufoff, gbase, voff) do { _Pragma("unroll") for (int _i = 0; _i < 2; ++_i) \
        __builtin_amdgcn_global_load_lds((const unsigned*)((const char*)(gbase) + (voff)[_i]), (PG8_LAS unsigned*)(lds + (bufoff) + ldsw + _i * 8192), 16, 0, 0); } while (0)
#define PG8_STAGE_A(bufoff, kptr, half, isnext) do { if constexpr (GATHER) { if (isnext) PG8_STAGE(bufoff, kptr, voffGn[half]); else PG8_STAGE(bufoff, kptr, voffGc[half]); } \
        else PG8_STAGE(bufoff, (kptr) + (half) * hstep, voffA); } while (0)
#define PG8_LDA(dst, b, h) do { _Pragma("unroll") for (int m = 0; m < 4; ++m) _Pragma("unroll") for (int k = 0; k < 2; ++k) dst[m][k] = *(const PG8_LAS bf16x8*)(lds + PG8_SA(b, h) + aoff + m * 2048 + k * 1024); } while (0)
#define PG8_LDB(dst, b, h) do { _Pragma("unroll") for (int n = 0; n < 2; ++n) _Pragma("unroll") for (int k = 0; k < 2; ++k) dst[n][k] = *(const PG8_LAS bf16x8*)(lds + PG8_SB(b, h) + boff + n * 2048 + k * 1024); } while (0)
#define PG8_MMA(ai, bj, At, Bt) do { __builtin_amdgcn_s_setprio(1); _Pragma("unroll") for (int m = 0; m < 4; ++m) _Pragma("unroll") for (int n = 0; n < 2; ++n) _Pragma("unroll") for (int k = 0; k < 2; ++k) \
        acc[ai][bj][m][n] = __builtin_amdgcn_mfma_f32_16x16x32_bf16(Bt[n][k], At[m][k], acc[ai][bj][m][n], 0, 0, 0); __builtin_amdgcn_s_setprio(0); } while (0)
#define PG8_WAIT_V(n) asm volatile("s_waitcnt vmcnt(" #n ")" ::: "memory")
#define PG8_WAIT_L(n) asm volatile("s_waitcnt lgkmcnt(" #n ")" ::: "memory")
#define PG8_BAR __builtin_amdgcn_s_barrier()
#define PG8_SCHED __builtin_amdgcn_sched_barrier(0)
    Unit cur, nxt; int ui = 0;
    if (!S.next(0, cur)) return;
    f32x4 acc[2][2][4][2];
#pragma unroll
    for (int a = 0; a < 2; ++a)
#pragma unroll
        for (int b = 0; b < 2; ++b)
#pragma unroll
            for (int m = 0; m < 4; ++m)
#pragma unroll
                for (int n = 0; n < 2; ++n) acc[a][b][m][n] = (f32x4){0.f, 0.f, 0.f, 0.f};
    bf16x8 At[4][2], B0[2][2], B1[2][2];
    const char* cA = cur.A; const char* cB = cur.B;
    if constexpr (GATHER) { PG8_GOFF(voffGc, cur); }
    PG8_STAGE(PG8_SB(0, 0), cB, voffB); PG8_STAGE(PG8_SB(0, 1), cB + hstep, voffB); PG8_STAGE_A(PG8_SA(0, 0), cA, 0, false); PG8_STAGE_A(PG8_SA(0, 1), cA, 1, false);
    if (wr == 1) PG8_BAR;
    PG8_WAIT_V(2); PG8_BAR;
    PG8_STAGE(PG8_SB(1, 0), cB + kstep, voffB); PG8_STAGE_A(PG8_SA(1, 0), cA + kstep, 0, false); PG8_STAGE(PG8_SB(1, 1), cB + hstep + kstep, voffB);
    PG8_WAIT_V(6); PG8_BAR;
    for (;;) {
        const bool has_next = S.next(ui + 1, nxt);
        const char* nA = has_next ? nxt.A : cA; const char* nB = has_next ? nxt.B : cB;
        if constexpr (GATHER) { if (has_next) { PG8_GOFF(voffGn, nxt); } else { _Pragma("unroll") for (int _h = 0; _h < 2; ++_h) _Pragma("unroll") for (int _i = 0; _i < 2; ++_i) voffGn[_h][_i] = voffGc[_h][_i]; } }
        for (int t = 0; t < nt; t += 2) {
            const bool last = (t == nt - 2);
            const char* a1 = cA + (size_t)(t + 1) * kstep;
            const char* a2 = last ? nA : cA + (size_t)(t + 2) * kstep; const char* b2 = last ? nB : cB + (size_t)(t + 2) * kstep;
            const char* a3 = a2 + kstep; const char* b3 = b2 + kstep;
            PG8_LDB(B0, 0, 0); PG8_LDB(B1, 0, 1); PG8_SCHED; PG8_LDA(At, 0, 0); PG8_STAGE_A(PG8_SA(1, 1), a1, 1, false);
            PG8_WAIT_V(8); PG8_WAIT_L(0); PG8_BAR; PG8_MMA(0, 0, At, B0); PG8_MMA(0, 1, At, B1); PG8_BAR; PG8_SCHED;
            PG8_LDA(At, 0, 1); PG8_STAGE(PG8_SB(0, 0), b2, voffB); PG8_STAGE(PG8_SB(0, 1), b2 + hstep, voffB); PG8_STAGE_A(PG8_SA(0, 0), a2, 0, last);
            PG8_WAIT_V(8); PG8_WAIT_L(0); PG8_BAR; PG8_MMA(1, 0, At, B0); PG8_MMA(1, 1, At, B1); PG8_BAR; PG8_SCHED;
            PG8_LDB(B0, 1, 0); PG8_LDB(B1, 1, 1); PG8_SCHED; PG8_LDA(At, 1, 0); PG8_STAGE_A(PG8_SA(0, 1), a2, 1, last);
            PG8_WAIT_V(8); PG8_WAIT_L(0); PG8_BAR; PG8_MMA(0, 0, At, B0); PG8_MMA(0, 1, At, B1); PG8_BAR; PG8_SCHED;
            PG8_LDA(At, 1, 1); PG8_STAGE(PG8_SB(1, 0), b3, voffB); PG8_STAGE(PG8_SB(1, 1), b3 + hstep, voffB); PG8_STAGE_A(PG8_SA(1, 0), a3, 0, last);
            PG8_WAIT_V(8); PG8_WAIT_L(0); PG8_BAR; PG8_MMA(1, 0, At, B0); PG8_MMA(1, 1, At, B1); PG8_BAR; PG8_SCHED;
        }
        if (wr == 0) PG8_BAR;
        if (cur.last) E.fin(acc, cur, wr, wc, fr, fq); else E.mid(acc, cur, wr, wc, fr, fq);
        if (!has_next) break;
        if (cur.last) {
#pragma unroll
            for (int a = 0; a < 2; ++a)
#pragma unroll
                for (int b = 0; b < 2; ++b)
#pragma unroll
                    for (int m = 0; m < 4; ++m)
#pragma unroll
                        for (int n = 0; n < 2; ++n) acc[a][b][m][n] = (f32x4){0.f, 0.f, 0.f, 0.f};
        }
        cur = nxt; cA = nA; cB = nB; ++ui;
        if constexpr (GATHER) { _Pragma("unroll") for (int _h = 0; _h < 2; ++_h) _Pragma("unroll") for (int _i = 0; _i < 2; ++_i) voffGc[_h][_i] = voffGn[_h][_i]; }
        if (wr == 1) PG8_BAR;
    }
    PG8_WAIT_V(0);
    PG8_BAR;
#undef PG8_SA
#undef PG8_SB
#undef PG8_STAGE
#undef PG8_STAGE_A
#undef PG8_GOFF
#undef PG8_LDA
#undef PG8_LDB
#undef PG8_MMA
#undef PG8_WAIT_V
#undef PG8_WAIT_L
#undef PG8_BAR
#undef PG8_SCHED
}
}
using pg8::Unit;
typedef f32x4 AccT[2][2][4][2];

__device__ __forceinline__ void st_nt(u32x4* p, u32x4 v) { __builtin_nontemporal_store(v, p); }
__device__ __forceinline__ void st_nt(f32x4* p, f32x4 v) { __builtin_nontemporal_store(v, p); }
__device__ __forceinline__ u32x2 pack4(f32x4 v) { u32x2 w; w.x = pk2(v[0], v[1]); w.y = pk2(v[2], v[3]); return w; }

#define EPI_LOOP_ROWS _Pragma("unroll") for (int ai = 0; ai < 2; ++ai) _Pragma("unroll") for (int m = 0; m < 4; ++m)
#define EPI_LOOP_COLS _Pragma("unroll") for (int bj = 0; bj < 2; ++bj) _Pragma("unroll") for (int n = 0; n < 2; ++n)

__device__ __forceinline__ u32x4 pack8(f32x4 a, f32x4 b) { return (u32x4){pk2(a[0], a[1]), pk2(a[2], a[3]), pk2(b[0], b[1]), pk2(b[2], b[3])}; }
__device__ __forceinline__ void unpack8(u32x4 w, f32x4& a, f32x4& b) { a = (f32x4){bflo(w.x), bfhi(w.x), bflo(w.y), bfhi(w.y)}; b = (f32x4){bflo(w.z), bfhi(w.z), bflo(w.w), bfhi(w.w)}; }
#define EPI_LOOP_BJ _Pragma("unroll") for (int bj = 0; bj < 2; ++bj)
struct EpiInA {
    static constexpr bool PERM = true;
    bf16* prx; bf16* grg; bf16* gates;
    __device__ __forceinline__ void mid(AccT& acc, const Unit& u, int wr, int wc, int fr, int fq) const {}
    __device__ __forceinline__ void fin(AccT& acc, const Unit& u, int wr, int wc, int fr, int fq) const {
        const int row0 = u.pm * 256 + wr * 64 + fr, col0 = u.pn * 256 + wc * 32 + 8 * fq;
        EPI_LOOP_ROWS { const size_t r = (size_t)(row0 + ai * 128 + m * 16);
            EPI_LOOP_BJ { const int c = col0 + bj * 128; f32x4 v0 = acc[ai][bj][m][0], v1 = acc[ai][bj][m][1];
                if (u.pn < 4) { st_nt((u32x4*)(prx + r * 1024 + c), pack8(v0, v1)); }
                else if (u.pn < 8) { for (int i = 0; i < 4; ++i) { v0[i] = gelu_tanh(v0[i]); v1[i] = gelu_tanh(v1[i]); } st_nt((u32x4*)(grg + r * 1024 + (c - 1024)), pack8(v0, v1)); }
                else { for (int i = 0; i < 4; ++i) { v0[i] = sigmoidf_(v0[i]); v1[i] = sigmoidf_(v1[i]); } st_nt((u32x4*)(gates + r * 2048 + (c - 2048)), pack8(v0, v1)); } } }
    }
};
struct EpiInB {
    static constexpr bool PERM = true;
    bf16* phyT;
    __device__ __forceinline__ void mid(AccT& acc, const Unit& u, int wr, int wc, int fr, int fq) const {}
    __device__ __forceinline__ void fin(AccT& acc, const Unit& u, int wr, int wc, int fr, int fq) const {
        const int row0 = u.pm * 256 + wr * 64 + fr, col0 = u.pn * 256 + wc * 32 + 8 * fq;
        const int b = u.pn >> 5;
        EPI_LOOP_ROWS { const size_t j = (size_t)(row0 + ai * 128 + m * 16);
            EPI_LOOP_BJ { const int t = col0 + bj * 128 - b * SEQ;
                st_nt((u32x4*)(phyT + ((size_t)b * 3072 + j) * SEQ + t), pack8(acc[ai][bj][m][0], acc[ai][bj][m][1])); } }
    }
};
struct EpiMerge {
    static constexpr bool PERM = true;
    const bf16* gates; bf16* merged;
    __device__ __forceinline__ void mid(AccT& acc, const Unit& u, int wr, int wc, int fr, int fq) const {
        const int row0 = u.pm * 256 + wr * 64 + fr, col0 = u.pn * 256 + wc * 32 + 8 * fq;
        EPI_LOOP_ROWS { const size_t r = (size_t)(row0 + ai * 128 + m * 16);
            EPI_LOOP_BJ { const int c = col0 + bj * 128;
                f32x4 sa0, sa1, sb0, sb1; unpack8(*(const u32x4*)(gates + r * 2048 + c), sa0, sa1); unpack8(*(const u32x4*)(gates + r * 2048 + 1024 + c), sb0, sb1);
                for (int i = 0; i < 4; ++i) { acc[ai][bj][m][0][i] *= sa0[i] * __builtin_amdgcn_rcpf(fmaxf(sb0[i], 1e-30f)); acc[ai][bj][m][1][i] *= sa1[i] * __builtin_amdgcn_rcpf(fmaxf(sb1[i], 1e-30f)); } } }
    }
    __device__ __forceinline__ void fin(AccT& acc, const Unit& u, int wr, int wc, int fr, int fq) const {
        const int row0 = u.pm * 256 + wr * 64 + fr, col0 = u.pn * 256 + wc * 32 + 8 * fq;
        EPI_LOOP_ROWS { const size_t r = (size_t)(row0 + ai * 128 + m * 16);
            EPI_LOOP_BJ { const int c = col0 + bj * 128;
                f32x4 sb0, sb1; unpack8(*(const u32x4*)(gates + r * 2048 + 1024 + c), sb0, sb1);
                f32x4 v0 = acc[ai][bj][m][0], v1 = acc[ai][bj][m][1];
                for (int i = 0; i < 4; ++i) { v0[i] *= fmaxf(sb0[i], 1e-30f); v1[i] *= fmaxf(sb1[i], 1e-30f); }
                *(u32x4*)(merged + r * 1024 + c) = pack8(v0, v1); } }
    }
};
struct EpiOut {
    static constexpr bool PERM = false;
    const float* x; const float* mod; float* x1; float* ssq;
    __device__ __forceinline__ void mid(AccT& acc, const Unit& u, int wr, int wc, int fr, int fq) const {}
    __device__ __forceinline__ void fin(AccT& acc, const Unit& u, int wr, int wc, int fr, int fq) const {
        const int row0 = u.pm * 256 + wr * 64 + fr, col0 = u.pn * 256 + wc * 32 + 4 * fq;
        const float* g1 = mod + (u.pm >> 5) * 6144 + 2048;
        EPI_LOOP_ROWS { const size_t r = (size_t)(row0 + ai * 128 + m * 16); float s = 0.f;
            EPI_LOOP_COLS { const int c = col0 + bj * 128 + n * 16;
                const f32x4 xv = __builtin_nontemporal_load((const f32x4*)(x + r * 1024 + c)), gv = *(const f32x4*)(g1 + c);
                const f32x4 o = xv + gv * acc[ai][bj][m][n];
                *(f32x4*)(x1 + r * 1024 + c) = o; s += (o[0] * o[0] + o[1] * o[1]) + (o[2] * o[2] + o[3] * o[3]); }
            s += __shfl_xor(s, 16); s += __shfl_xor(s, 32);
            if (fq == 0) ssq[r * 16 + u.pn * 4 + wc] = s; }
    }
};
struct EpiMoeUp {
    static constexpr bool PERM = true;
    bf16* H;
    __device__ __forceinline__ void mid(AccT& acc, const Unit& u, int wr, int wc, int fr, int fq) const {}
    __device__ __forceinline__ void fin(AccT& acc, const Unit& u, int wr, int wc, int fr, int fq) const {
        const int row0 = u.pm * 256 + wr * 64 + fr, col0 = u.pn * 128 + wc * 32 + 8 * fq;
        EPI_LOOP_ROWS { const size_t r = (size_t)(row0 + ai * 128 + m * 16); f32x4 h0, h1;
            for (int i = 0; i < 4; ++i) { const float a0 = acc[ai][0][m][0][i], a1 = acc[ai][0][m][1][i]; h0[i] = a0 * sigmoidf_(a0) * acc[ai][1][m][0][i]; h1[i] = a1 * sigmoidf_(a1) * acc[ai][1][m][1][i]; }
            *(u32x4*)(H + r * 512 + col0) = pack8(h0, h1); }
    }
};
struct EpiMoeDown {
    static constexpr bool PERM = true;
    bf16* Y;
    __device__ __forceinline__ void mid(AccT& acc, const Unit& u, int wr, int wc, int fr, int fq) const {}
    __device__ __forceinline__ void fin(AccT& acc, const Unit& u, int wr, int wc, int fr, int fq) const {
        const int row0 = u.pm * 256 + wr * 64 + fr, col0 = u.pn * 256 + wc * 32 + 8 * fq;
        EPI_LOOP_ROWS { const size_t r = (size_t)(row0 + ai * 128 + m * 16);
            EPI_LOOP_BJ { const int c = col0 + bj * 128; *(u32x4*)(Y + r * 1024 + c) = pack8(acc[ai][bj][m][0], acc[ai][bj][m][1]); } }
    }
};

constexpr size_t TSTEP1K = (size_t)256 * 1024 * 2;
struct SchedInA { const char* hx; const char* wt; int G, c;
    __device__ __forceinline__ bool next(int i, Unit& u) const {
        int Lx = (i >> (REPN(2) - 1)) * G + c, pm, pn;
        if (Lx < 2048) pg8::rect_map(Lx, 128, 16, pm, pn);
        else { Lx -= 2048; if (Lx >= 16) return false; pm = 128 + (Lx >> 2); pn = Lx & 3; }
        const int wrow = pn < 8 ? pn * 256 : 5120 + (pn - 8) * 256;
        u.pm = pm; u.pn = pn; u.last = 1; u.A = hx + (size_t)pm * TSTEP1K; u.B = wt + (size_t)wrow * 2048; return true; } };
struct SchedInB { const char* hx; const char* wt; int G, c;
    __device__ __forceinline__ bool next(int i, Unit& u) const {
        const int Lx = (i >> (REPN(21) - 1)) * G + c; if (Lx >= 12 * 128) return false; int pm, pn; pg8::rect_map(Lx, 12, 128, pm, pn);
        u.pm = pm; u.pn = pn; u.last = 1; u.A = wt + (size_t)(2048 + pm * 256) * 2048; u.B = hx + (size_t)pn * TSTEP1K; return true; } };
struct SchedMerge { const char* yrg; const char* yhy; const char* wrg; const char* why; int G, c;
    __device__ __forceinline__ bool next(int i, Unit& u) const {
        const int T = (i >> 1) * G + c, part = i & 1; if (T >= 512) return false; int pm, pn; pg8::rect_map(T, 128, 4, pm, pn);
        u.pm = pm; u.pn = pn; u.last = part; u.A = (part ? yhy : yrg) + (size_t)pm * TSTEP1K; u.B = (part ? why : wrg) + (size_t)pn * TSTEP1K; return true; } };
struct SchedOut { const char* a; const char* w; int G, c;
    __device__ __forceinline__ bool next(int i, Unit& u) const {
        const int T = (i >> (REPN(7) - 1)) * G + c; if (T >= 512) return false; int pm, pn; pg8::rect_map(T, 128, 4, pm, pn);
        u.pm = pm; u.pn = pn; u.last = 1; u.A = a + (size_t)pm * TSTEP1K; u.B = w + (size_t)pn * TSTEP1K; return true; } };
struct SchedMoeUp { const char* xg; const char* w13; const LAS int* blk_exp; const int* row_tok; int nblk, G, c;
    __device__ __forceinline__ bool next(int i, Unit& u) const {
        const int T = i * G + c; if (T >= nblk * 4) return false; const int pm = T >> 2, pn = T & 3, e = blk_exp[pm];
        u.pm = pm; u.pn = pn; u.last = 1; u.A = xg; u.B = w13 + (size_t)e * (1024 * 1024 * 2) + (size_t)pn * TSTEP1K; return true; } };
struct SchedMoeDown { const char* h; const char* w2; const LAS int* blk_exp; int nblk, G, c;
    __device__ __forceinline__ bool next(int i, Unit& u) const {
        const int T = i * G + c; if (T >= nblk * 4) return false; const int pm = T >> 2, pn = T & 3, e = blk_exp[pm];
        u.pm = pm; u.pn = pn; u.last = 1; u.A = h + (size_t)pm * (256 * 512 * 2); u.B = w2 + (size_t)e * (1024 * 512 * 2) + (size_t)pn * (256 * 512 * 2); return true; } };


typedef f32x2 cpx;
__device__ __forceinline__ int pidx(int i) { return i + (i >> 4); }
__device__ __forceinline__ cpx cmul(cpx a, cpx b) { return (cpx){a.x * b.x - a.y * b.y, a.x * b.y + a.y * b.x}; }
template <bool INV> __device__ __forceinline__ cpx mul_w4(cpx a) { return INV ? (cpx){-a.y, a.x} : (cpx){a.y, -a.x}; }
template <bool INV> __device__ __forceinline__ void dft4(cpx& a, cpx& b, cpx& c, cpx& d) {
    const cpx t0 = a + c, t1 = a - c, t2 = b + d, t3 = b - d; const cpx t3r = mul_w4<INV>(t3);
    a = t0 + t2; b = t1 + t3r; c = t0 - t2; d = t1 - t3r; }
template <bool INV> __device__ __forceinline__ cpx twc(cpx x, float cr, float ci) { return cmul(x, (cpx){cr, INV ? -ci : ci}); }
#define SLOT16(q) (4 * ((q) & 3) + ((q) >> 2))
template <bool INV> __device__ __forceinline__ void dft16(cpx (&x)[16]) {
    const float C1 = 0.9238795325112867f, S1 = 0.3826834323650898f, R = 0.7071067811865476f;
#pragma unroll
    for (int m2 = 0; m2 < 4; ++m2) dft4<INV>(x[m2], x[4 + m2], x[8 + m2], x[12 + m2]);
    x[5] = twc<INV>(x[5], C1, -S1); x[9] = twc<INV>(x[9], R, -R); x[6] = twc<INV>(x[6], R, -R);
    x[13] = twc<INV>(x[13], S1, -C1); x[7] = twc<INV>(x[7], S1, -C1); x[10] = mul_w4<INV>(x[10]);
    x[14] = twc<INV>(x[14], -R, -R); x[11] = twc<INV>(x[11], -R, -R); x[15] = twc<INV>(x[15], -C1, S1);
#pragma unroll
    for (int q1 = 0; q1 < 4; ++q1) dft4<INV>(x[4 * q1], x[4 * q1 + 1], x[4 * q1 + 2], x[4 * q1 + 3]);
}
template <int S_, int NIN> __device__ __forceinline__ void fft_fwd16(LAS cpx* X, const LAS cpx* TW, int tid) {
    constexpr int PS = S_ + S_ / 16;
#pragma unroll 1
    for (int it = 0; it < 2; ++it) {
        int bf = tid + 512 * it; asm volatile("" : "+v"(bf)); const int blk = bf / S_, j = bf % S_; const int base = pidx(blk * (16 * S_) + j);
        cpx x[16];
#pragma unroll
        for (int m = 0; m < 16; ++m) x[m] = (m < NIN) ? X[base + PS * m] : (cpx){0.f, 0.f};
        dft16<false>(x);
        const cpx w1 = TW[j]; cpx w = w1;
        X[base] = x[0];
#pragma unroll
        for (int q = 1; q < 16; ++q) { X[base + PS * q] = cmul(x[SLOT16(q)], w); w = cmul(w, w1); }
    }
}
template <int S_, int NOUT> __device__ __forceinline__ void fft_inv16(LAS cpx* X, const LAS cpx* TW, int tid) {
    constexpr int PS = S_ + S_ / 16;
#pragma unroll 1
    for (int it = 0; it < 2; ++it) {
        int bf = tid + 512 * it; asm volatile("" : "+v"(bf)); const int blk = bf / S_, j = bf % S_; const int base = pidx(blk * (16 * S_) + j);
        cpx w1 = TW[j]; w1.y = -w1.y; cpx w = w1;
        cpx x[16]; x[0] = X[base];
#pragma unroll
        for (int q = 1; q < 16; ++q) { x[q] = cmul(X[base + PS * q], w); w = cmul(w, w1); }
        dft16<true>(x);
#pragma unroll
        for (int m = 0; m < NOUT; ++m) X[base + PS * m] = x[SLOT16(m)];
    }
}
template <bool INV> __device__ __forceinline__ void fft_r4(LAS cpx* X, const LAS cpx* TW, int tid) {
#pragma unroll 2
    for (int it = 0; it < 8; ++it) {
        int bf = tid + 512 * it; asm volatile("" : "+v"(bf)); const int blk = bf >> 4, j = bf & 15; const int base = 68 * blk + j;
        cpx w1 = TW[j]; if (INV) w1.y = -w1.y; const cpx w2 = cmul(w1, w1), w3 = cmul(w2, w1);
        cpx a = X[base], b = X[base + 17], c = X[base + 34], d = X[base + 51];
        if (INV) { b = cmul(b, w1); c = cmul(c, w2); d = cmul(d, w3); }
        dft4<INV>(a, b, c, d);
        if (!INV) { b = cmul(b, w1); c = cmul(c, w2); d = cmul(d, w3); }
        X[base] = a; X[base + 17] = b; X[base + 34] = c; X[base + 51] = d;
    }
}

template <bool INV, bool OZERO> __device__ __forceinline__ void dft32(cpx (&e)[16], cpx (&o)[16]) {
    const float C[16] = {1.f, 0.9807852804032304f, 0.9238795325112867f, 0.8314696123025452f, 0.7071067811865476f, 0.5555702330196022f, 0.3826834323650898f, 0.1950903220161283f,
                         0.f, -0.1950903220161283f, -0.3826834323650898f, -0.5555702330196022f, -0.7071067811865476f, -0.8314696123025452f, -0.9238795325112867f, -0.9807852804032304f};
    const float S[16] = {0.f, 0.1950903220161283f, 0.3826834323650898f, 0.5555702330196022f, 0.7071067811865476f, 0.8314696123025452f, 0.9238795325112867f, 0.9807852804032304f,
                         1.f, 0.9807852804032304f, 0.9238795325112867f, 0.8314696123025452f, 0.7071067811865476f, 0.5555702330196022f, 0.3826834323650898f, 0.1950903220161283f};
#pragma unroll
    for (int m = 0; m < 16; ++m) { const cpx a = e[m]; cpx d;
        if (OZERO) d = a; else { const cpx b = o[m]; e[m] = a + b; d = a - b; }
        o[m] = (m == 0) ? d : (m == 8) ? mul_w4<INV>(d) : twc<INV>(d, C[m], -S[m]); }
    dft16<INV>(e); dft16<INV>(o);
}
template <int NIN> __device__ __forceinline__ void fft_fwd32A(LAS cpx* X, const LAS cpx* TW, int tid) {
    int j = tid; asm volatile("" : "+v"(j)); const int base = pidx(j); constexpr int PS = 544;
    cpx e[16], o[16];
#pragma unroll
    for (int m = 0; m < 16; ++m) { e[m] = X[base + PS * m]; o[m] = (NIN == 32) ? X[base + PS * (m + 16)] : (cpx){0.f, 0.f}; }
    dft32<false, NIN == 16>(e, o);
    const cpx w1 = TW[j], w2 = cmul(w1, w1); cpx te = w2, to = w1;
    X[base] = e[0]; X[base + PS] = cmul(o[0], to); to = cmul(to, w2);
#pragma unroll
    for (int q = 1; q < 16; ++q) { X[base + PS * (2 * q)] = cmul(e[SLOT16(q)], te); X[base + PS * (2 * q + 1)] = cmul(o[SLOT16(q)], to); te = cmul(te, w2); to = cmul(to, w2); }
}
__device__ __forceinline__ void fft_fwd32A_filter(LAS cpx* X, const LAS cpx* TW, const float* kfw, const float* kbw, int tid) {
    int j = tid; asm volatile("" : "+v"(j)); const int base = pidx(j); constexpr int PS = 544;
    cpx e[16], o[16];
#pragma unroll
    for (int m = 0; m < 16; ++m) e[m] = (cpx){__builtin_nontemporal_load(kfw + j + 512 * m), 0.f};
#pragma unroll
    for (int m = 0; m < 16; ++m) { const int i = j + 512 * m; o[m] = (cpx){(i == 0) ? 0.f : __builtin_nontemporal_load(kbw + SEQ - i), 0.f}; }
    dft32<false, false>(e, o);
    const cpx w1 = TW[j], w2 = cmul(w1, w1); cpx te = w2, to = w1;
    X[base] = e[0]; X[base + PS] = cmul(o[0], to); to = cmul(to, w2);
#pragma unroll
    for (int q = 1; q < 16; ++q) { X[base + PS * (2 * q)] = cmul(e[SLOT16(q)], te); X[base + PS * (2 * q + 1)] = cmul(o[SLOT16(q)], to); te = cmul(te, w2); to = cmul(to, w2); }
}
__device__ __forceinline__ void fft_fwd32B(LAS cpx* X, const LAS cpx* TW, int tid) {
    int t = tid; asm volatile("" : "+v"(t)); const int blk = t >> 4, j = t & 15; const int base = 544 * blk + j; constexpr int PS = 17;
    cpx e[16], o[16];
#pragma unroll
    for (int m = 0; m < 16; ++m) { e[m] = X[base + PS * m]; o[m] = X[base + PS * (m + 16)]; }
    dft32<false, false>(e, o);
    const cpx w1 = TW[j], w2 = cmul(w1, w1); cpx te = w2, to = w1;
    X[base] = e[0]; X[base + PS] = cmul(o[0], to); to = cmul(to, w2);
#pragma unroll
    for (int q = 1; q < 16; ++q) { X[base + PS * (2 * q)] = cmul(e[SLOT16(q)], te); X[base + PS * (2 * q + 1)] = cmul(o[SLOT16(q)], to); te = cmul(te, w2); to = cmul(to, w2); }
}
template <int PS, int NOUT> __device__ __forceinline__ void fft_inv32_core(LAS cpx* X, int base, cpx w1c) {
    const cpx w2 = cmul(w1c, w1c); cpx te = w2, to = w1c;
    cpx e[16], o[16];
    cpx zin[32];
    zin[0] = X[base]; zin[1] = cmul(X[base + PS], to); to = cmul(to, w2);
#pragma unroll
    for (int q = 1; q < 16; ++q) { zin[2 * q] = cmul(X[base + PS * (2 * q)], te); zin[2 * q + 1] = cmul(X[base + PS * (2 * q + 1)], to); te = cmul(te, w2); to = cmul(to, w2); }
#pragma unroll
    for (int m = 0; m < 16; ++m) { e[m] = zin[m]; o[m] = zin[m + 16]; }
    dft32<true, false>(e, o);
#pragma unroll
    for (int m = 0; m < NOUT; ++m) X[base + PS * m] = (m & 1) ? o[SLOT16(m >> 1)] : e[SLOT16(m >> 1)];
}
__device__ __forceinline__ void fft_inv32A_final(const LAS cpx* X, const LAS cpx* TW, int tid, const unsigned* sx, bf16* rowA, bf16* rowB, bool dostore) {
    int j = tid; asm volatile("" : "+v"(j)); cpx w1 = TW[j]; w1.y = -w1.y; const int base = pidx(j); constexpr int PS = 544;
    unsigned sa[16], sb[16];
#pragma unroll
    for (int m = 0; m < 16; ++m) { sa[m] = __hip_atomic_load(sx + j + 512 * m, __ATOMIC_RELAXED, __HIP_MEMORY_SCOPE_AGENT); sb[m] = __hip_atomic_load(sx + SEQ + j + 512 * m, __ATOMIC_RELAXED, __HIP_MEMORY_SCOPE_AGENT); }
    const cpx w2 = cmul(w1, w1); cpx te = w2, to = w1;
    cpx e[16], o[16]; cpx zin[32];
    zin[0] = X[base]; zin[1] = cmul(X[base + PS], to); to = cmul(to, w2);
#pragma unroll
    for (int q = 1; q < 16; ++q) { zin[2 * q] = cmul(X[base + PS * (2 * q)], te); zin[2 * q + 1] = cmul(X[base + PS * (2 * q + 1)], to); te = cmul(te, w2); to = cmul(to, w2); }
#pragma unroll
    for (int m = 0; m < 16; ++m) { e[m] = zin[m]; o[m] = zin[m + 16]; }
    dft32<true, false>(e, o);
    if (dostore) {
#pragma unroll
        for (int m = 0; m < 16; ++m) { const cpx y = (m & 1) ? o[SLOT16(m >> 1)] : e[SLOT16(m >> 1)]; const int t = j + 512 * m;
            const float oa = y.x * bflo(sa[m]) + bfhi(sa[m]), ob = y.y * bflo(sb[m]) + bfhi(sb[m]);
            rowA[t] = (bf16)(pk2(oa, 0.f) & 0xffffu); rowB[t] = (bf16)(pk2(ob, 0.f) & 0xffffu); }
    }
}
__device__ __forceinline__ void fft_inv32B(LAS cpx* X, const LAS cpx* TW, int tid) {
    int t = tid; asm volatile("" : "+v"(t)); const int blk = t >> 4, j = t & 15; cpx w1 = TW[j]; w1.y = -w1.y;
    fft_inv32_core<17, 32>(X, 544 * blk + j, w1);
}
template <int NOUT> __device__ __forceinline__ void fft_inv32A(LAS cpx* X, const LAS cpx* TW, int tid) {
    int j = tid; asm volatile("" : "+v"(j)); cpx w1 = TW[j]; w1.y = -w1.y;
    fft_inv32_core<544, NOUT>(X, pidx(j), w1);
}
__device__ __forceinline__ void fft_fwdD_toK(const LAS cpx* X, cpx* Kb, int tid) {
#pragma unroll 1
    for (int it = 0; it < 2; ++it) {
        int bf = tid + 512 * it; asm volatile("" : "+v"(bf)); const int base = 17 * bf;
        cpx x[16];
#pragma unroll
        for (int m = 0; m < 16; ++m) x[m] = X[base + m];
        dft16<false>(x);
#pragma unroll
        for (int q = 0; q < 16; ++q) Kb[q * 1024 + bf] = x[SLOT16(q)] * (1.f / 16384.f);
    }
}
__device__ __forceinline__ void fft_kload1(cpx (&kq)[16], const cpx* Kb, int bf) {
#pragma unroll
    for (int q = 0; q < 16; ++q) { const unsigned long long kb = __hip_atomic_load((const unsigned long long*)(Kb + q * 1024 + bf), __ATOMIC_RELAXED, __HIP_MEMORY_SCOPE_AGENT);
        kq[q] = (cpx){__builtin_bit_cast(float, (unsigned)kb), __builtin_bit_cast(float, (unsigned)(kb >> 32))}; }
}
__device__ __forceinline__ void fft_fusedD_one(LAS cpx* X, const cpx (&kq)[16], int bf) {
    const int base = 17 * bf; cpx x[16], z[16];
#pragma unroll
    for (int m = 0; m < 16; ++m) x[m] = X[base + m];
    dft16<false>(x);
#pragma unroll
    for (int q = 0; q < 16; ++q) z[q] = cmul(x[SLOT16(q)], kq[q]);
    dft16<true>(z);
#pragma unroll
    for (int m = 0; m < 16; ++m) X[base + m] = z[SLOT16(m)];
}
__device__ __forceinline__ void fft_fusedD(LAS cpx* X, const cpx* Kb, int tid) {
    int bf = tid; asm volatile("" : "+v"(bf));
    cpx k0[16], k1[16];
    fft_kload1(k0, Kb, bf); fft_kload1(k1, Kb, bf + 512);
    fft_fusedD_one(X, k0, bf);
    fft_fusedD_one(X, k1, bf + 512);
}
struct Raw10 { u32x4 q; unsigned short l, r; };
__device__ __forceinline__ void load10_issue(Raw10& R, const bf16* row, int t0) {
    const int lane = threadIdx.x & 63; R.q = __builtin_nontemporal_load((const u32x4*)(row + t0)); R.l = 0; R.r = 0;
    if (lane == 0 && t0 > 0) R.l = row[t0 - 1];
    if (lane == 63 && t0 + 8 < SEQ) R.r = row[t0 + 8];
}
__device__ __forceinline__ void load10_finish(const Raw10& R, float (&pv)[10]) {
    const int lane = threadIdx.x & 63; const u32x4 q = R.q;
    pv[1] = bflo(q.x); pv[2] = bfhi(q.x); pv[3] = bflo(q.y); pv[4] = bfhi(q.y); pv[5] = bflo(q.z); pv[6] = bfhi(q.z); pv[7] = bflo(q.w); pv[8] = bfhi(q.w);
    float l = __shfl_up(pv[8], 1), r = __shfl_down(pv[1], 1);
    if (lane == 0) l = bf2f(R.l);
    if (lane == 63) r = bf2f(R.r);
    pv[0] = l; pv[9] = r;
}

struct ScanW { const bf16* prx; const bf16* grg; bf16* yrg; const float* rgcw; const float* rgcb; const bf16* wgt;
               const float* ba_f; const float* bx_f; const float* lam_f; const float* ba_b; const float* bx_b; const float* lam_b; f32x2* carr; const float* cin; };
__device__ __forceinline__ float neg_expm1_neg(float x) {
    return (x > -0.1f) ? -x * (1.f + x * 0.5f * (1.f + x * (1.f / 3.f) * (1.f + x * 0.25f * (1.f + x * 0.2f)))) : 1.f - __expf(x);
}
struct ScanPre { u32x4 p[4]; u32x4 gl; float cinv; };
template <int PASS>
__device__ __forceinline__ void scan_decode(int it, int& b, int& j, int& h) {
    h = it & 15; const int rest = it >> 4;
    if (PASS == 1) { j = rest % NCHUNK; b = rest / NCHUNK; } else { j = (rest & 127) + 4; b = rest >> 7; }
}
template <int PASS>
__device__ __forceinline__ void scan_prefetch(ScanPre& R, const ScanW& W, int it, int tid, int cidx_lane) {
    int b, j, h; scan_decode<PASS>(it, b, j, h);
    const int isctx = j < 4; const int seglen = isctx ? CTXL : SEQ; const int t0 = isctx ? j * 64 : (j - 4) * 64; const int rowbase = isctx ? NTOK + b * CTXL : b * SEQ;
    const int tok = tid >> 3, cg0 = h * 64 + (tid & 7) * 8;
#pragma unroll
    for (int jj = 0; jj < 4; ++jj) { const int tt = t0 + tok + jj - 2; R.p[jj] = (u32x4){0u, 0u, 0u, 0u};
        if (tt >= 0 && tt < seglen) { const u32x4* pp = (const u32x4*)(W.prx + (size_t)(rowbase + tt) * 1024 + cg0); R.p[jj] = (PASS == 2) ? __builtin_nontemporal_load(pp) : *pp; } }
    R.cinv = 0.f;
    if (PASS == 2) { R.gl = __builtin_nontemporal_load((const u32x4*)(W.grg + (size_t)(rowbase + t0 + tok) * 1024 + cg0)); R.cinv = W.cin[(size_t)(b * NCHUNK + j) * 2048 + h * 64 + cidx_lane]; }
}
template <int PASS>
__device__ __forceinline__ void scan_phase(LAS unsigned char* lds, const ScanW& W, int first, int stride, int nitems, int tid, int lane, int wave) {
    LAS float* XCF = (LAS float*)lds;
    LAS bf16* XCB = (LAS bf16*)(lds + 16896);
    LAS float* HX = (LAS float*)(lds + 16896 + 9216);
    if (first >= nitems) return;
    const int dir = wave >> 2, eb = wave & 3, g = lane >> 4, li = lane & 15;
    const int tok = tid >> 3, e0 = (tid & 7) * 8;
    int hcur = -1;
    float cw[4][8], cb[8]; bf16x8 bR[2], bI[2]; float ba = 0.f, bx = 0.f, sp8 = 0.f, sp8l = 0.f, nba = 0.f, nbx = 0.f;
    const int cidx_lane = dir * 1024 + eb * 16 + li;
    ScanPre R; scan_prefetch<PASS>(R, W, first, tid, cidx_lane);
    u32x4 o_prev = {0u, 0u, 0u, 0u}; bf16* p_prev = nullptr; f32x2 c_prev = {0.f, 0.f}; f32x2* cp_prev = nullptr;
#pragma unroll 1
    for (int it = first; it < nitems; it += stride) {
        int b, j, h; scan_decode<PASS>(it, b, j, h);
        const int isctx = j < 4; const int t0 = isctx ? j * 64 : (j - 4) * 64; const int rowbase = isctx ? NTOK + b * CTXL : b * SEQ;
        const int ch = h * 64 + eb * 16 + li;
        const size_t cidx = ((size_t)(b * NCHUNK + j) * 2 + dir) * 1024 + ch;
        const float cinv = R.cinv;
        if (h != hcur) {
            hcur = h; const int cg0 = h * 64 + e0;
#pragma unroll
            for (int jj = 0; jj < 4; ++jj) { const f32x4 w0 = *(const f32x4*)(W.rgcw + jj * 1024 + cg0), w1 = *(const f32x4*)(W.rgcw + jj * 1024 + cg0 + 4);
                cw[jj][0] = w0[0]; cw[jj][1] = w0[1]; cw[jj][2] = w0[2]; cw[jj][3] = w0[3]; cw[jj][4] = w1[0]; cw[jj][5] = w1[1]; cw[jj][6] = w1[2]; cw[jj][7] = w1[3]; }
            { const f32x4 c0 = *(const f32x4*)(W.rgcb + cg0), c1 = *(const f32x4*)(W.rgcb + cg0 + 4); cb[0] = c0[0]; cb[1] = c0[1]; cb[2] = c0[2]; cb[3] = c0[3]; cb[4] = c1[0]; cb[5] = c1[1]; cb[6] = c1[2]; cb[7] = c1[3]; }
            const bf16* wp = W.wgt + ((size_t)((dir * 2) * 16 + h) * 64 + eb * 16 + li) * 64 + g * 8;
            bR[0] = *(const bf16x8*)(wp); bR[1] = *(const bf16x8*)(wp + 32); bI[0] = *(const bf16x8*)(wp + 16 * 4096); bI[1] = *(const bf16x8*)(wp + 16 * 4096 + 32);
            ba = (dir ? W.ba_b : W.ba_f)[ch]; bx = (dir ? W.bx_b : W.bx_f)[ch]; const float lam = (dir ? W.lam_b : W.lam_f)[ch];
            sp8 = -8.f * log1pf(__expf(-lam)); sp8l = sp8 * 1.4426950408889634f; nba = -ba * 1.4426950408889634f; nbx = -bx * 1.4426950408889634f;
        }
        {
            float xv[8];
#pragma unroll
            for (int q = 0; q < 8; ++q) xv[q] = cb[q];
#pragma unroll
            for (int jj = 0; jj < 4; ++jj) { const u32x4 p = R.p[jj];
                xv[0] += cw[jj][0] * bflo(p.x); xv[1] += cw[jj][1] * bfhi(p.x); xv[2] += cw[jj][2] * bflo(p.y); xv[3] += cw[jj][3] * bfhi(p.y);
                xv[4] += cw[jj][4] * bflo(p.z); xv[5] += cw[jj][5] * bfhi(p.z); xv[6] += cw[jj][6] * bflo(p.w); xv[7] += cw[jj][7] * bfhi(p.w); }
#pragma unroll
            for (int q = 0; q < 8; ++q) XCF[tok * 65 + e0 + q] = xv[q];
            *(LAS u32x4*)(XCB + tok * 72 + e0) = (u32x4){pk2(xv[0], xv[1]), pk2(xv[2], xv[3]), pk2(xv[4], xv[5]), pk2(xv[6], xv[7])};
        }
        const u32x4 gl = R.gl;
        if (it + stride < nitems) scan_prefetch<PASS>(R, W, it + stride, tid, cidx_lane);
        if (PASS == 2) { if (p_prev) *(u32x4*)p_prev = o_prev; } else { if (cp_prev) *cp_prev = c_prev; }
        LDS_BARRIER();
        f32x4 aR[4], aI[4];
#pragma unroll
        for (int mb = 0; mb < 4; ++mb) { aR[mb] = (f32x4){0.f, 0.f, 0.f, 0.f}; aI[mb] = (f32x4){0.f, 0.f, 0.f, 0.f};
            const int trow = 16 * (li >> 2) + 4 * mb + (li & 3);
#pragma unroll
            for (int ks = 0; ks < 2; ++ks) { const bf16x8 af = *(const LAS bf16x8*)(XCB + trow * 72 + ks * 32 + g * 8);
                aR[mb] = __builtin_amdgcn_mfma_f32_16x16x32_bf16(af, bR[ks], aR[mb], 0, 0, 0); aI[mb] = __builtin_amdgcn_mfma_f32_16x16x32_bf16(af, bI[ks], aI[mb], 0, 0, 0); } }
        float av[16], bv[16];
#pragma unroll
        for (int mb = 0; mb < 4; ++mb)
#pragma unroll
            for (int r = 0; r < 4; ++r) { const int tk = 16 * g + 4 * mb + r; const float xcv = XCF[tk * 65 + eb * 16 + li];
                const float rr = __builtin_amdgcn_rcpf(1.f + __builtin_amdgcn_exp2f(__builtin_fmaf(aR[mb][r], -1.4426950408889634f, nba)));
                const float ii = __builtin_amdgcn_rcpf(1.f + __builtin_amdgcn_exp2f(__builtin_fmaf(aI[mb][r], -1.4426950408889634f, nbx)));
                const float a = __builtin_amdgcn_exp2f(sp8l * rr); const float om = (1.f - a) * (1.f + a);
                av[4 * mb + r] = a; bv[4 * mb + r] = __builtin_amdgcn_sqrtf(om) * ii * xcv; }
        float A16 = 1.f, B16 = 0.f;
        if (dir == 0) {
#pragma unroll
            for (int q = 0; q < 16; ++q) { B16 = av[q] * B16 + bv[q]; A16 *= av[q]; }
        } else {
#pragma unroll
            for (int q = 15; q >= 0; --q) { B16 = av[q] * B16 + bv[q]; A16 *= av[q]; }
        }
        float Pc = 1.f, Hc = cinv, hin;
        {
            LAS float* chn = (LAS float*)(lds + 60928) + wave * 128 + li * 8;
            *(LAS f32x2*)(chn + g * 2) = (f32x2){A16, B16};
            LDS_WAIT(); asm volatile("" ::: "memory");
            const f32x4 c01 = *(const LAS f32x4*)(chn), c23 = *(const LAS f32x4*)(chn + 4);
            LDS_WAIT(); asm volatile("" ::: "memory");
            const float Ag[4] = {c01[0], c01[2], c23[0], c23[2]}, Bg[4] = {c01[1], c01[3], c23[1], c23[3]};
            hin = Hc;
#pragma unroll
            for (int k = 0; k < 4; ++k) { const int gk = (dir == 0) ? k : 3 - k;
                const bool before = (dir == 0) ? (gk < g) : (gk > g);
                const float Hn = Ag[gk] * Hc + Bg[gk]; Pc *= Ag[gk]; Hc = Hn; if (before) hin = Hn; }
        }
        if (PASS == 1) {
            cp_prev = (g == 0) ? (W.carr + cidx) : nullptr; c_prev = (f32x2){Pc, Hc};
            LDS_BARRIER();
        } else {
            LAS float* hx = HX + dir * (64 * 68) + (16 * g) * 68 + eb * 16 + li; float H = hin;
            if (dir == 0) {
#pragma unroll
                for (int q = 0; q < 16; ++q) { H = av[q] * H + bv[q]; hx[q * 68] = H; }
            } else {
#pragma unroll
                for (int q = 15; q >= 0; --q) { H = av[q] * H + bv[q]; hx[q * 68] = H; }
            }
            LDS_BARRIER();
            const f32x4 f0 = *(const LAS f32x4*)(HX + tok * 68 + e0), f1 = *(const LAS f32x4*)(HX + tok * 68 + e0 + 4);
            const f32x4 g0 = *(const LAS f32x4*)(HX + 64 * 68 + tok * 68 + e0), g1 = *(const LAS f32x4*)(HX + 64 * 68 + tok * 68 + e0 + 4);
            u32x4 o; o.x = pk2((f0[0] + g0[0]) * bflo(gl.x), (f0[1] + g0[1]) * bfhi(gl.x)); o.y = pk2((f0[2] + g0[2]) * bflo(gl.y), (f0[3] + g0[3]) * bfhi(gl.y));
            o.z = pk2((f1[0] + g1[0]) * bflo(gl.z), (f1[1] + g1[1]) * bfhi(gl.z)); o.w = pk2((f1[2] + g1[2]) * bflo(gl.w), (f1[3] + g1[3]) * bfhi(gl.w));
            o_prev = o; p_prev = W.yrg + (size_t)(rowbase + t0 + tok) * 1024 + h * 64 + e0;
        }
    }
    if (PASS == 2) { if (p_prev) *(u32x4*)p_prev = o_prev; } else { if (cp_prev) *cp_prev = c_prev; }
}

#define XB_TMO      128
#define XB_XCNT(j)  (256  + 64 * (j))
#define XB_XSUB(j)  (1280 + 64 * (j))
#define XB_XGEN(j)  (2304 + 64 * (j))
#define XB_TOP      3328
#define XB_TOPGEN   3392
#define XCD_BAR_WORDS 3456
#define XB_SPIN_CAP (1u << 18)
__device__ __forceinline__ unsigned xb_ld(unsigned* p)              { return __hip_atomic_load(p, __ATOMIC_RELAXED, __HIP_MEMORY_SCOPE_AGENT); }
__device__ __forceinline__ unsigned xb_add(unsigned* p, unsigned v) { return __hip_atomic_fetch_add(p, v, __ATOMIC_RELAXED, __HIP_MEMORY_SCOPE_AGENT); }
__device__ __forceinline__ unsigned xb_xcc_id() { return (unsigned)__builtin_amdgcn_s_getreg((3 << 11) | 20) & 0xFu; }
#define XB_SPIN(cond, bar) do { unsigned _sp = 0; while (cond) { __builtin_amdgcn_s_sleep(1); \
    if ((++_sp & 255u) == 0u) { if (xb_ld(&(bar)[XB_TMO])) break; if (_sp > XB_SPIN_CAP) { atomicAdd(&(bar)[XB_TMO], 1u); break; } } } } while (0)
struct XcdBarrier { unsigned* bar; unsigned x; volatile LAS unsigned* st; };
__device__ __forceinline__ void xcd_barrier_complete(unsigned* bar, unsigned x, unsigned& nloc, unsigned& nx) {
    const unsigned Gn = gridDim.x * gridDim.y * gridDim.z;
    unsigned sum, cntx, mine, sp = 0u;
    for (;;) {
        sum = 0u; cntx = 0u; mine = 0u;
#pragma unroll
        for (unsigned j = 0; j < 16; ++j) { const unsigned c = xb_ld(&bar[XB_XCNT(j)]); sum += c; cntx += (c > 0u) ? 1u : 0u; mine = (j == x) ? c : mine; }
        if (sum == Gn) break;
        __builtin_amdgcn_s_sleep(1);
        if ((++sp & 255u) == 0u) { if (xb_ld(&bar[XB_TMO])) break; if (sp > XB_SPIN_CAP) { atomicAdd(&bar[XB_TMO], 1u); break; } }
    }
    nloc = mine > 0u ? mine : 1u; nx = cntx > 0u ? cntx : 1u;
}
__device__ __forceinline__ void xcd_barrier(const XcdBarrier& b) {
    asm volatile("s_waitcnt vmcnt(0)" ::: "memory");
    __syncthreads();
    if (threadIdx.x == 0) {
        unsigned* bar = b.bar;
        __builtin_amdgcn_s_waitcnt(0);
        unsigned nloc = b.st[0], nx = b.st[1];
        if (nloc == 0u) { xcd_barrier_complete(bar, b.x, nloc, nx); b.st[0] = nloc; b.st[1] = nx; }
        const unsigned old = xb_add(&bar[XB_XSUB(b.x)], 1u);
        const unsigned gen = old / nloc;
        if (old + 1u == (gen + 1u) * nloc) {
            __builtin_amdgcn_fence(__ATOMIC_RELEASE, "agent");
            asm volatile("s_waitcnt vmcnt(0)" ::: "memory");
            const unsigned og = xb_add(&bar[XB_TOP], 1u);
            const unsigned tg = og / nx;
            if (og + 1u == (tg + 1u) * nx) xb_add(&bar[XB_TOPGEN], 1u);
            else XB_SPIN(xb_ld(&bar[XB_TOPGEN]) == tg, bar);
            __builtin_amdgcn_fence(__ATOMIC_ACQUIRE, "agent");
            xb_add(&bar[XB_XGEN(b.x)], 1u);
            asm volatile("s_waitcnt vmcnt(0)" ::: "memory");
        } else {
            XB_SPIN(xb_ld(&bar[XB_XGEN(b.x)]) == gen, bar);
            __builtin_amdgcn_fence(__ATOMIC_ACQUIRE, "agent");
            asm volatile("s_waitcnt vmcnt(0)" ::: "memory");
        }
    }
    __syncthreads();
}

__device__ __forceinline__ void transpose_item(const float* W, int K, int N, bf16* WT, int mode, LAS float* scr, int item, int lane) {
    const int nblk = N / 64, kb = item / nblk, nb = item % nblk, k0 = 64 * kb, n0 = 64 * nb;
    const int lr = lane >> 4, lc = (lane & 15) * 4;
    f32x4 v[16];
#pragma unroll
    for (int i = 0; i < 16; ++i) v[i] = __builtin_nontemporal_load((const f32x4*)(W + (size_t)(k0 + 4 * i + lr) * N + n0 + lc));
#pragma unroll
    for (int i = 0; i < 16; ++i) { LAS float* d = scr + (4 * i + lr) * 65 + lc; d[0] = v[i][0]; d[1] = v[i][1]; d[2] = v[i][2]; d[3] = v[i][3]; }
    LDS_WAIT(); asm volatile("" ::: "memory");
    const int c = lane & 7;
#pragma unroll
    for (int j = 0; j < 8; ++j) { const int n = (lane >> 3) + 8 * j; const LAS float* sp = scr + (8 * c) * 65 + n;
        u32x4 o; o.x = pk2(sp[0 * 65], sp[1 * 65]); o.y = pk2(sp[2 * 65], sp[3 * 65]); o.z = pk2(sp[4 * 65], sp[5 * 65]); o.w = pk2(sp[6 * 65], sp[7 * 65]);
        const int nn = n0 + n; int row;
        if (mode == 0) row = nn;
        else if (mode == 1) row = (nn >> 7) * 256 + (nn & 127);
        else row = (nn >> 7) * 256 + 128 + (nn & 127);
        *(u32x4*)(WT + (size_t)row * K + k0 + 8 * c) = o; }
    LDS_WAIT(); asm volatile("" ::: "memory");
}

struct Args { const float* in[41]; float* out; unsigned char* ws; int ph_lo, ph_hi; };

enum { I_X = 0, I_C, I_CTX, I_CCTX, I_ADAW, I_ADAB, I_N1G, I_N2G, I_FG, I_WIN, I_RGCW, I_RGCB, I_WAF, I_BAF, I_WXF, I_BXF, I_LAMF, I_WAB, I_BAB, I_WXB, I_BXB, I_LAMB,
       I_RGPROJ, I_HYCW, I_HYCB, I_PW1, I_PB1, I_PW2, I_PB2, I_FREQ, I_PW3, I_SKIP, I_HYPROJ, I_WOUT, I_WG, I_BG, I_WE, I_BE, I_MW1, I_MW3, I_MW2 };

constexpr int NPHASE = 13;

__global__ void __launch_bounds__(NTHREADS, 2) fwd_kernel(Args args) {
    extern __shared__ __attribute__((aligned(16))) unsigned char lds_raw[];
    LAS unsigned char* lds = (LAS unsigned char*)lds_raw;
    const int tid = threadIdx.x, lane = tid & 63, wave = __builtin_amdgcn_readfirstlane(tid >> 6);
    const int G = gridDim.x, bid = blockIdx.x;
    const int gw = bid * NWAVES + wave, NGW = G * NWAVES;
    unsigned char* ws = args.ws;
    const int lo = args.ph_lo, hi = args.ph_hi;
#define IN(k) (lo <= (k) && (k) < hi)
#if ONE_LAUNCH
    cg::grid_group grid = cg::this_grid();
#define GRID_SYNC(k) do { if (IN(k) && IN((k) + 1)) { if ((k) == 0) { grid.sync(); if (tid == 0) (void)xb_add(&xbar.bar[XB_XCNT(xbar.x)], 1u); } \
        else { xcd_barrier(xbar); if (REPN(99) == 2) xcd_barrier(xbar); } \
        if (PROBE_TS >= 0 && bid == 0 && tid == 0) tsbuf[(k) + 1] = __builtin_amdgcn_s_memrealtime(); } } while (0)
#else
#define GRID_SYNC(k) do { } while (0)
#endif
    int* cnt = (int*)(ws + WS_CTL);
    unsigned long long* tsbuf = (unsigned long long*)(ws + WS_CTL + 65536);
    if (PROBE_TS >= 0 && bid == 0 && tid == 0) tsbuf[0] = __builtin_amdgcn_s_memrealtime();
    XcdBarrier xbar; xbar.bar = (unsigned*)(ws + WS_CTL) + 4096; xbar.x = xb_xcc_id(); xbar.st = (volatile LAS unsigned*)(lds + LDS_BYTES - 64);
    if (tid < 2) xbar.st[tid] = 0u;
    __syncthreads();
    float* mod = (float*)(ws + WS_MOD);
    float* z2 = (float*)(ws + WS_Z2);
    float* ssq = (float*)(ws + WS_SSQ);
    int* tok_e = (int*)(ws + WS_ROUTE); int* tok_rank = tok_e + 2 * NTOK; float* tok_w = (float*)(tok_rank + 2 * NTOK); int* tok_slot = (int*)(tok_w + 2 * NTOK);
    bf16* rgproj_t = (bf16*)(ws + WS_WSMALL); bf16* hyproj_t = rgproj_t + 1024 * 1024; bf16* wout_t = hyproj_t + 1024 * 1024;
    bf16* win_t = (bf16*)(ws + WS_WIN);
    bf16* hx = (bf16*)(ws + WS_HX); bf16* yhy = (bf16*)(ws + WS_HX); bf16* Hbuf = (bf16*)(ws + WS_HX);
    bf16* prx = (bf16*)(ws + WS_PRX); bf16* merged = (bf16*)(ws + WS_PRX);
    bf16* grg = (bf16*)(ws + WS_GRG); bf16* hx2 = (bf16*)(ws + WS_GRG);
    bf16* phyT = (bf16*)(ws + WS_PHY);
    bf16* w13t = (bf16*)(ws + WS_W13); bf16* w2t = (bf16*)(ws + WS_W2);
    bf16* Xg = (bf16*)(ws + WS_XG); bf16* Ybuf = (bf16*)(ws + WS_XG);
    float* kf = (float*)(ws + WS_KF); bf16* yrg = (bf16*)(ws + WS_KF);
    f32x2* carr = (f32x2*)(ws + WS_CARR); float* cin = (float*)(ws + WS_CIN);
    bf16* gates = (bf16*)args.out;
    float* x1 = args.out;

    if (IN(0)) for (int rp = 0; rp < REPN(0); ++rp) {
        if (bid == 0) for (int i = tid; i < 1024; i += NTHREADS) cnt[i] = 0;
        if (bid == 0) for (int i = tid; i < XCD_BAR_WORDS; i += NTHREADS) xbar.bar[i] = 0u;
        const int nA = (G >= 192) ? 96 : 0; const bool doA = (nA == 0) || (bid < nA), doB = (nA == 0) || (bid >= nA);
        const int ob = bid - nA, OG = G - nA, ogw = ob * NWAVES + wave, ONGW = OG * NWAVES;
        if (doA) {
            LAS float* red = (LAS float*)lds;
            const float* c = args.in[I_C]; const float* cctx = args.in[I_CCTX]; const float* ada_w = args.in[I_ADAW]; const float* ada_b = args.in[I_ADAB];
            LAS float* sil = red + 8 * 5 * 64;
            for (int i = tid; i < 5 * 1024; i += NTHREADS) { const float cv = (i < 4096) ? c[i] : cctx[i - 4096]; sil[i] = cv * sigmoidf_(cv); }
            __syncthreads();
            for (int g = bid; g < 96; g += (nA ? nA : G)) {
                const int n = g * 64 + lane; float acc[5] = {0.f, 0.f, 0.f, 0.f, 0.f};
                for (int kk = 0; kk < 128; kk += 16) { float a[16];
#pragma unroll
                    for (int u = 0; u < 16; ++u) a[u] = __builtin_nontemporal_load(ada_w + (size_t)(wave * 128 + kk + u) * 6144 + n);
#pragma unroll
                    for (int u = 0; u < 16; ++u) { const int k = wave * 128 + kk + u;
#pragma unroll
                        for (int r = 0; r < 5; ++r) acc[r] += sil[r * 1024 + k] * a[u]; } }
#pragma unroll
                for (int r = 0; r < 5; ++r) red[(wave * 5 + r) * 64 + lane] = acc[r];
                __syncthreads();
                if (wave == 0) {
#pragma unroll
                    for (int r = 0; r < 5; ++r) { float s = ada_b[n]; for (int w = 0; w < 8; ++w) s += red[(w * 5 + r) * 64 + lane]; mod[r * 6144 + n] = s; } }
                __syncthreads();
            }
        }
        if (doB) {
            LAS float* fe = (LAS float*)lds + wave * 128; LAS float* z1 = fe + 64;
            const float* w1 = args.in[I_PW1]; const float* b1 = args.in[I_PB1]; const float* w2 = args.in[I_PW2]; const float* b2 = args.in[I_PB2]; const float* fr = args.in[I_FREQ];
            const float TWO_PI = 6.283185307179586f;
            float w1c[50], w2c[64];
#pragma unroll
            for (int i = 0; i < 50; ++i) w1c[i] = w1[i * 64 + lane];
#pragma unroll
            for (int i = 0; i < 64; ++i) w2c[i] = w2[i * 64 + lane];
            const float b1l = b1[lane], b2l = b2[lane], frl = fr[lane];
            for (int s = ogw; s < SEQ; s += ONGW) {
                float f = 0.f; const float sf = (float)s;
                if (lane == 0) f = sf / 8191.f;
                else if (lane <= 32) { const int j = (lane - 1) & 15; const float band = 1e-4f + (float)j * ((15.f - 1e-4f) / 15.f); float rev = sf * band * (1.f / 8192.f); rev -= floorf(rev + 0.5f);
                    f = (lane <= 16) ? cosf(TWO_PI * rev) : sinf(TWO_PI * rev); }
                else if (lane == 33) f = (float)(s >> 6) / 128.f;
                else if (lane <= 49) { const int mm = (lane <= 41) ? (lane - 33) : (lane - 41); float rev = (float)((s & 63) * mm) * (1.f / 64.f); rev -= floorf(rev + 0.5f);
                    f = (lane <= 41) ? cosf(TWO_PI * rev) : sinf(TWO_PI * rev); }
                fe[lane] = f; LDS_WAIT(); asm volatile("" ::: "memory");
                float a = b1l;
#pragma unroll
                for (int i = 0; i < 50; ++i) a += fe[i] * w1c[i];
                z1[lane] = sinf(frl * a); LDS_WAIT(); asm volatile("" ::: "memory");
                float a2 = b2l;
#pragma unroll
                for (int i = 0; i < 64; ++i) a2 += z1[i] * w2c[i];
                z2[(size_t)s * 64 + lane] = sinf(frl * a2);
                LDS_WAIT(); asm volatile("" ::: "memory");
            }
        }
        __syncthreads();
        if (doB) {
            LAS float* scr = (LAS float*)lds + wave * 4160;
            constexpr int I_IN = 16 * 112, I_SQ = 16 * 16;
            constexpr int NITEMS = I_IN + 3 * I_SQ;
            for (int it = ogw; it < NITEMS; it += ONGW) {
                int r = it;
                if (r < I_IN) { transpose_item(args.in[I_WIN], 1024, INC, win_t, 0, scr, r, lane); continue; } r -= I_IN;
                if (r < I_SQ) { transpose_item(args.in[I_RGPROJ], 1024, 1024, rgproj_t, 0, scr, r, lane); continue; } r -= I_SQ;
                if (r < I_SQ) { transpose_item(args.in[I_HYPROJ], 1024, 1024, hyproj_t, 0, scr, r, lane); continue; } r -= I_SQ;
                transpose_item(args.in[I_WOUT], 1024, 1024, wout_t, 0, scr, r, lane);
            }
        }
        if (doB) {
            bf16* wrh = (bf16*)(ws + 28 * MiB); bf16* wrl = wrh + 48 * 1024;
            for (int i = ob * NTHREADS + tid; i < 48 * 1024; i += OG * NTHREADS) { const int n = i >> 10, k = i & 1023;
                const float w = (n < 4) ? args.in[I_WG][k * 4 + n] : (n < 36) ? args.in[I_WE][k * 32 + (n - 4)] : 0.f;
                const unsigned h = pk2(w, 0.f) & 0xffffu; wrh[i] = (bf16)h; wrl[i] = (bf16)(pk2(w - bf2f(h), 0.f) & 0xffffu); }
        }
        if (doB) {
            bf16* wgt = (bf16*)(ws + WS_GATEW);
            for (int i = ob * NTHREADS + tid; i < 4 * 65536; i += OG * NTHREADS) { const int gi = i >> 16, r = i & 65535, hh = r >> 12, e = (r >> 6) & 63, d = r & 63;
                const float* src = gi == 0 ? args.in[I_WAF] : gi == 1 ? args.in[I_WXF] : gi == 2 ? args.in[I_WAB] : args.in[I_WXB];
                wgt[i] = (bf16)f2bf(src[hh * 4096 + d * 64 + e]); }
        }
    }
    GRID_SYNC(0);

    if (IN(1)) for (int rp = 0; rp < REPN(1); ++rp) {
        const float* x = args.in[I_X]; const float* ctx = args.in[I_CTX]; const float* n1g = args.in[I_N1G];
        f32x4 n1v[4];
#pragma unroll
        for (int j = 0; j < 4; ++j) n1v[j] = *(const f32x4*)(n1g + 4 * (64 * j + lane));
        for (int m0 = 2 * gw; m0 < MROWS; m0 += 2 * NGW) {
            f32x4 v[2][4]; float ss[2] = {0.f, 0.f};
#pragma unroll
            for (int u = 0; u < 2; ++u) { const int m = m0 + u; const float* xr = (m < NTOK) ? x + (size_t)m * 1024 : ctx + (size_t)(m - NTOK) * 1024;
#pragma unroll
                for (int j = 0; j < 4; ++j) v[u][j] = __builtin_nontemporal_load((const f32x4*)xr + 64 * j + lane); }
#pragma unroll
            for (int u = 0; u < 2; ++u)
#pragma unroll
                for (int j = 0; j < 4; ++j) ss[u] += (v[u][j][0] * v[u][j][0] + v[u][j][1] * v[u][j][1]) + (v[u][j][2] * v[u][j][2] + v[u][j][3] * v[u][j][3]);
#pragma unroll
            for (int u = 0; u < 2; ++u) { const int m = m0 + u; const int r = (m < NTOK) ? (m >> 13) : 4; const float* sh = mod + r * 6144; const float* sc = sh + 1024;
                const float rstd = rsqrtf(wave_sum(ss[u]) * (1.f / 1024.f) + 1e-6f);
#pragma unroll
                for (int j = 0; j < 4; ++j) { const int k = 4 * (64 * j + lane); const f32x4 g = n1v[j], s_ = *(const f32x4*)(sc + k), h = *(const f32x4*)(sh + k);
                    const f32x4 o = v[u][j] * rstd * g * (1.f + s_) + h; *(u32x2*)(hx + (size_t)m * 1024 + k) = pack4(o); } }
        }
        {
            LAS float* w3s = (LAS float*)lds;
            LAS float* z2t = w3s + 64 * 256;
            const float* w3 = args.in[I_PW3];
            const int sg = tid & 7, cgp = tid >> 3;
            int c0cur = -1;
            for (int it = bid; it < 8 * 128; it += G) {
                const int s0 = (it >> 3) * 64, c0 = (it & 7) * 256;
                __syncthreads();
                for (int e = tid; e < 64 * 64; e += NTHREADS) { const int r = e >> 6, jj = e & 63; z2t[jj * 68 + r] = z2[(size_t)(s0 + r) * 64 + jj]; }
                if (c0 != c0cur) { c0cur = c0;
                    for (int e = tid; e < 64 * 64; e += NTHREADS) { const int jj = e >> 6, c4 = e & 63; *(LAS f32x4*)(w3s + jj * 256 + 4 * c4) = *(const f32x4*)(w3 + (size_t)jj * 2048 + c0 + 4 * c4); } }
                __syncthreads();
                float acc[4][8];
#pragma unroll
                for (int a = 0; a < 4; ++a)
#pragma unroll
                    for (int q = 0; q < 8; ++q) acc[a][q] = 0.f;
#pragma unroll 4
                for (int jj = 0; jj < 64; ++jj) { const f32x4 w = *(const LAS f32x4*)(w3s + jj * 256 + 4 * cgp); const f32x4 za = *(const LAS f32x4*)(z2t + jj * 68 + 8 * sg), zb = *(const LAS f32x4*)(z2t + jj * 68 + 8 * sg + 4);
#pragma unroll
                    for (int a = 0; a < 4; ++a) { acc[a][0] += w[a] * za[0]; acc[a][1] += w[a] * za[1]; acc[a][2] += w[a] * za[2]; acc[a][3] += w[a] * za[3];
                        acc[a][4] += w[a] * zb[0]; acc[a][5] += w[a] * zb[1]; acc[a][6] += w[a] * zb[2]; acc[a][7] += w[a] * zb[3]; } }
                const float mind = -3.0701134573253944f, maxd = -15.350567286626972f;
#pragma unroll
                for (int a = 0; a < 4; ++a) { const int cp = c0 + 4 * cgp + a, ch = cp & 1023; const float delta = fabsf(mind + (float)ch * ((maxd - mind) / 1023.f));
                    f32x4 o0, o1;
#pragma unroll
                    for (int q = 0; q < 4; ++q) { o0[q] = acc[a][q] * __expf(-((float)(s0 + 8 * sg + q) / 8191.f) * delta); o1[q] = acc[a][4 + q] * __expf(-((float)(s0 + 8 * sg + 4 + q) / 8191.f) * delta); }
                    *(f32x4*)(kf + (size_t)cp * SEQ + s0 + 8 * sg) = o0; *(f32x4*)(kf + (size_t)cp * SEQ + s0 + 8 * sg + 4) = o1; }
            }
        }
    }
    GRID_SYNC(1);

    if (IN(2)) {
        { SchedInA S{(const char*)hx, (const char*)win_t, G, bid}; EpiInA E{prx, grg, gates}; pg8::gemm_phase(lds, 1024, S, E); }
        { SchedInB S{(const char*)hx, (const char*)win_t, G, bid}; EpiInB E{phyT}; pg8::gemm_phase(lds, 1024, S, E); }
    }
    GRID_SYNC(2);

    const ScanW SW{prx, grg, yrg, args.in[I_RGCW], args.in[I_RGCB], (const bf16*)(ws + WS_GATEW), args.in[I_BAF], args.in[I_BXF], args.in[I_LAMF], args.in[I_BAB], args.in[I_BXB], args.in[I_LAMB], carr, cin};
    if (IN(3)) {
        for (int rp = 0; rp < REPN(3); ++rp) scan_phase<1>(lds, SW, bid, G, NBATCH * NCHUNK * 16, tid, lane, wave);
        __syncthreads();
        {
            LAS cpx* X = (LAS cpx*)lds;
            LAS cpx* TWA = (LAS cpx*)(lds + 139264); LAS cpx* TWB = TWA + 512;
            for (int i = tid; i < 512 + 16; i += NTHREADS) { const float fr_ = (i < 512) ? (float)i * (1.f / 8192.f) : (float)(i - 512) * (1.f / 256.f);
                float sn, cs; sincospif(-fr_, &sn, &cs); TWA[i] = (cpx){cs, sn}; }
            __syncthreads();
            cpx* Kb = (cpx*)(ws + WS_HX) + (size_t)bid * 16384;
            unsigned* SX = (unsigned*)(ws + WS_HX + 32 * MiB) + (size_t)bid * 16384;
            const float* hcw = args.in[I_HYCW]; const float* hcb = args.in[I_HYCB]; const float* skip = args.in[I_SKIP];
            for (int rp = 0; rp < REPN(30); ++rp)
            for (int c = bid; c < 1024; c += G) {
                LDS_BARRIER();
                fft_fwd32A_filter(X, TWA, kf + (size_t)c * SEQ, kf + (size_t)(1024 + c) * SEQ, tid); LDS_BARRIER();
                fft_fwd32B(X, TWB, tid); LDS_BARRIER();
                fft_fwdD_toK(X, Kb, tid);
                const float w00 = hcw[c], w01 = hcw[3072 + c], w02 = hcw[6144 + c], b0 = hcb[c];
                const float w10 = hcw[1024 + c], w11 = hcw[3072 + 1024 + c], w12 = hcw[6144 + 1024 + c], b1 = hcb[1024 + c];
                const float w20 = hcw[2048 + c], w21 = hcw[3072 + 2048 + c], w22 = hcw[6144 + 2048 + c], b2 = hcb[2048 + c];
                const float sk = skip[c];
                for (int pair = 0; pair < 2; ++pair) {
                    const bf16* rA = phyT + ((size_t)(2 * pair) * 3072 + c) * SEQ; const bf16* rB = rA + (size_t)3072 * SEQ;
                    if (pair == 0) __syncthreads(); else LDS_BARRIER();
                    { int tb = tid; asm volatile("" : "+v"(tb));
                        Raw10 ra[2][6];
#pragma unroll
                        for (int it = 0; it < 2; ++it) { const int t0 = 8 * (tb + 512 * it);
                            load10_issue(ra[it][0], rA, t0); load10_issue(ra[it][1], rA + (size_t)1024 * SEQ, t0); load10_issue(ra[it][2], rA + (size_t)2048 * SEQ, t0);
                            load10_issue(ra[it][3], rB, t0); load10_issue(ra[it][4], rB + (size_t)1024 * SEQ, t0); load10_issue(ra[it][5], rB + (size_t)2048 * SEQ, t0); }
#pragma unroll
                        for (int it = 0; it < 2; ++it) { const int t0 = 8 * (tb + 512 * it); float p0[10], p1[10], p2[10], ua[8], ub[8]; unsigned qa[8], qb[8];
                            load10_finish(ra[it][0], p0); load10_finish(ra[it][1], p1); load10_finish(ra[it][2], p2);
#pragma unroll
                            for (int k = 0; k < 8; ++k) { ua[k] = (b2 + w20 * p2[k] + w21 * p2[k + 1] + w22 * p2[k + 2]) * (b1 + w10 * p1[k] + w11 * p1[k + 1] + w12 * p1[k + 2]);
                                const float x0 = b0 + w00 * p0[k] + w01 * p0[k + 1] + w02 * p0[k + 2]; qa[k] = pk2(x0, sk * ua[k] * x0); }
                            load10_finish(ra[it][3], p0); load10_finish(ra[it][4], p1); load10_finish(ra[it][5], p2);
#pragma unroll
                            for (int k = 0; k < 8; ++k) { ub[k] = (b2 + w20 * p2[k] + w21 * p2[k + 1] + w22 * p2[k + 2]) * (b1 + w10 * p1[k] + w11 * p1[k + 1] + w12 * p1[k + 2]);
                                const float x0 = b0 + w00 * p0[k] + w01 * p0[k + 1] + w02 * p0[k + 2]; qb[k] = pk2(x0, sk * ub[k] * x0); }
                            *(u32x4*)(SX + t0) = (u32x4){qa[0], qa[1], qa[2], qa[3]}; *(u32x4*)(SX + t0 + 4) = (u32x4){qa[4], qa[5], qa[6], qa[7]};
                            *(u32x4*)(SX + SEQ + t0) = (u32x4){qb[0], qb[1], qb[2], qb[3]}; *(u32x4*)(SX + SEQ + t0 + 4) = (u32x4){qb[4], qb[5], qb[6], qb[7]};
                            const int pb = pidx(t0);
#pragma unroll
                            for (int k = 0; k < 8; ++k) X[pb + k] = (cpx){ua[k], ub[k]}; } }
                    LDS_BARRIER();
                    fft_fwd32A<16>(X, TWA, tid); LDS_BARRIER();
                    fft_fwd32B(X, TWB, tid); LDS_BARRIER();
                    fft_fusedD(X, Kb, tid); LDS_BARRIER();
                    fft_inv32B(X, TWB, tid); __syncthreads();
                    fft_inv32A_final(X, TWA, tid, SX, (bf16*)rA, (bf16*)rB, rp == REPN(30) - 1);
                }
            }
        }
    }
    GRID_SYNC(3);

    if (IN(4)) for (int rp = 0; rp < REPN(4); ++rp) {
        const int gt = bid * NTHREADS + tid;
        if (gt < NBATCH * 2 * 1024) {
            const int c = gt & 1023, dir = (gt >> 10) & 1, b = gt >> 11; float s_ = 0.f;
            const size_t cbase = (size_t)(b * NCHUNK) * 2048 + dir * 1024 + c;
#pragma unroll 1
            for (int q0 = 0; q0 < NCHUNK; q0 += 33) { f32x2 ab[33];
#pragma unroll
                for (int u = 0; u < 33; ++u) { const int q = q0 + u; const int j = dir == 0 ? q : (q < 4 ? 3 - q : NCHUNK + 3 - q); ab[u] = __builtin_nontemporal_load(carr + cbase + (size_t)j * 2048); }
#pragma unroll
                for (int u = 0; u < 33; ++u) { const int q = q0 + u; const int j = dir == 0 ? q : (q < 4 ? 3 - q : NCHUNK + 3 - q); cin[cbase + (size_t)j * 2048] = s_; s_ = ab[u].x * s_ + ab[u].y; } }
        }
    }
    GRID_SYNC(4);

    if (IN(5)) {
        for (int rp = 0; rp < REPN(5); ++rp) scan_phase<2>(lds, SW, bid, G, NBATCH * 128 * 16, tid, lane, wave);
        __syncthreads();
        {
            LAS bf16* T = (LAS bf16*)lds;
            for (int rp = 0; rp < REPN(50); ++rp)
            for (int it = bid; it < NBATCH * 16 * 32; it += G) {
                const int tb4 = it & 31, cb = (it >> 5) & 15, b = it >> 9;
                const int cl = tid >> 3, ch = tid & 7;
                u32x4 v[4];
#pragma unroll
                for (int q = 0; q < 4; ++q) v[q] = __builtin_nontemporal_load((const u32x4*)(phyT + ((size_t)b * 3072 + cb * 64 + cl) * SEQ + (tb4 * 4 + q) * 64 + ch * 8));
                __syncthreads();
#pragma unroll
                for (int q = 0; q < 4; ++q) *(LAS u32x4*)(T + q * 4608 + cl * 72 + ch * 8) = v[q];
                __syncthreads();
#pragma unroll
                for (int q = 0; q < 4; ++q) { const int tl = tid >> 3; unsigned w[8];
#pragma unroll
                    for (int e = 0; e < 8; ++e) w[e] = T[q * 4608 + (ch * 8 + e) * 72 + tl];
                    u32x4 o; o.x = w[0] | (w[1] << 16); o.y = w[2] | (w[3] << 16); o.z = w[4] | (w[5] << 16); o.w = w[6] | (w[7] << 16);
                    *(u32x4*)(yhy + (size_t)(b * SEQ + (tb4 * 4 + q) * 64 + tl) * 1024 + cb * 64 + ch * 8) = o; }
            }
        }
    }
    GRID_SYNC(5);

    if (IN(6)) for (int rp = 0; rp < REPN(6); ++rp) {
        SchedMerge S{(const char*)yrg, (const char*)yhy, (const char*)rgproj_t, (const char*)hyproj_t, G, bid}; EpiMerge E{gates, merged};
        pg8::gemm_phase(lds, 1024, S, E);
    }
    GRID_SYNC(6);

    if (IN(7)) {
        SchedOut S{(const char*)merged, (const char*)wout_t, G, bid}; EpiOut E{args.in[I_X], mod, x1, ssq};
        pg8::gemm_phase(lds, 1024, S, E);
    }
    GRID_SYNC(7);

    if (IN(8)) {
        {
            LAS bf16* XH = (LAS bf16*)lds;
            LAS bf16* XL = XH + 128 * 72;
            LAS bf16* WH = XL + 128 * 72;
            LAS bf16* WLo = WH + 48 * 72;
            LAS float* LG = (LAS float*)(WLo + 48 * 72);
            LAS float* RS = LG + 128 * 49;
            LAS int* LCNT = (LAS int*)(RS + 128); LAS int* LBASE = LCNT + 32;
            const float* n2g = args.in[I_N2G]; const float* bg = args.in[I_BG]; const float* be = args.in[I_BE];
            const bf16* wrh = (const bf16*)(ws + 28 * MiB); const bf16* wrl = wrh + 48 * 1024;
            int nrep8 = REPN(8); asm volatile("" : "+s"(nrep8));
_Pragma("unroll 1")
            for (int rp = 0; rp < nrep8; ++rp)
            for (int tile = bid; tile < NTOK / 128; tile += G) {
                const int R0 = tile * 128; const int b = R0 >> 13; const float* sh = mod + b * 6144 + 3072; const float* sc = sh + 1024;
                __syncthreads();
                if (tid < 128) { const float* sp = ssq + (size_t)(R0 + tid) * 16; float ss = 0.f; for (int q = 0; q < 16; ++q) ss += sp[q]; RS[tid] = rsqrtf(ss * (1.f / 1024.f) + 1e-6f); }
                if (tid < 32) LCNT[tid] = 0;
                int ea_ = 0, eb_ = 0, la_ = 0, lb_ = 0; float wa_ = 0.f, wb_ = 0.f;
                __syncthreads();
                f32x4 lacc[3];
#pragma unroll
                for (int c = 0; c < 3; ++c) lacc[c] = (f32x4){0.f, 0.f, 0.f, 0.f};
                const int lrow = tid >> 2, lq = tid & 3; const float rstd = RS[lrow];
                const int mg = lane >> 4, mli = lane & 15;
#pragma unroll 1
                for (int kc = 0; kc < 16; ++kc) {
                    const int k0 = kc * 64 + lq * 16;
                    f32x4 o[4];
#pragma unroll
                    for (int i = 0; i < 4; ++i) { const int k = k0 + 4 * i; const f32x4 v = *(const f32x4*)(x1 + (size_t)(R0 + lrow) * 1024 + k);
                        const f32x4 g = *(const f32x4*)(n2g + k), s_ = *(const f32x4*)(sc + k), hh = *(const f32x4*)(sh + k); o[i] = v * rstd * g * (1.f + s_) + hh; }
                    unsigned hi[8], lo[8];
#pragma unroll
                    for (int i = 0; i < 4; ++i)
#pragma unroll
                        for (int q = 0; q < 2; ++q) { const float a0 = o[i][2 * q], a1 = o[i][2 * q + 1]; const unsigned h = pk2(a0, a1); hi[2 * i + q] = h; lo[2 * i + q] = pk2(a0 - bflo(h), a1 - bfhi(h)); }
                    *(u32x4*)(hx2 + (size_t)(R0 + lrow) * 1024 + k0) = (u32x4){hi[0], hi[1], hi[2], hi[3]};
                    *(u32x4*)(hx2 + (size_t)(R0 + lrow) * 1024 + k0 + 8) = (u32x4){hi[4], hi[5], hi[6], hi[7]};
                    u32x4 wph = {0u, 0u, 0u, 0u}, wpl = {0u, 0u, 0u, 0u};
                    if (tid < 384) { wph = *(const u32x4*)(wrh + (size_t)(tid >> 3) * 1024 + kc * 64 + (tid & 7) * 8); wpl = *(const u32x4*)(wrl + (size_t)(tid >> 3) * 1024 + kc * 64 + (tid & 7) * 8); }
                    __syncthreads();
                    *(LAS u32x4*)(XH + lrow * 72 + lq * 16) = (u32x4){hi[0], hi[1], hi[2], hi[3]}; *(LAS u32x4*)(XH + lrow * 72 + lq * 16 + 8) = (u32x4){hi[4], hi[5], hi[6], hi[7]};
                    *(LAS u32x4*)(XL + lrow * 72 + lq * 16) = (u32x4){lo[0], lo[1], lo[2], lo[3]}; *(LAS u32x4*)(XL + lrow * 72 + lq * 16 + 8) = (u32x4){lo[4], lo[5], lo[6], lo[7]};
                    if (tid < 384) { *(LAS u32x4*)(WH + (tid >> 3) * 72 + (tid & 7) * 8) = wph; *(LAS u32x4*)(WLo + (tid >> 3) * 72 + (tid & 7) * 8) = wpl; }
                    __syncthreads();
#pragma unroll
                    for (int ks = 0; ks < 2; ++ks) { const bf16x8 aH = *(const LAS bf16x8*)(XH + (wave * 16 + mli) * 72 + ks * 32 + mg * 8), aL = *(const LAS bf16x8*)(XL + (wave * 16 + mli) * 72 + ks * 32 + mg * 8);
#pragma unroll
                        for (int nt = 0; nt < 3; ++nt) { const bf16x8 bH = *(const LAS bf16x8*)(WH + (nt * 16 + mli) * 72 + ks * 32 + mg * 8), bL = *(const LAS bf16x8*)(WLo + (nt * 16 + mli) * 72 + ks * 32 + mg * 8);
                            lacc[nt] = __builtin_amdgcn_mfma_f32_16x16x32_bf16(aH, bH, lacc[nt], 0, 0, 0); lacc[nt] = __builtin_amdgcn_mfma_f32_16x16x32_bf16(aL, bH, lacc[nt], 0, 0, 0);
                            lacc[nt] = __builtin_amdgcn_mfma_f32_16x16x32_bf16(aH, bL, lacc[nt], 0, 0, 0); } }
                }
#pragma unroll
                for (int nt = 0; nt < 3; ++nt)
#pragma unroll
                    for (int r = 0; r < 4; ++r) LG[(wave * 16 + 4 * mg + r) * 49 + nt * 16 + mli] = lacc[nt][r];
                __syncthreads();
                if (tid < 128) {
                    float lg[36];
#pragma unroll
                    for (int c = 0; c < 36; ++c) lg[c] = LG[tid * 49 + c] + (c < 4 ? bg[c] : be[c - 4]);
                    int grp = 0; float gm = lg[0];
#pragma unroll
                    for (int q = 1; q < 4; ++q) if (lg[q] > gm) { gm = lg[q]; grp = q; }
                    float den = 0.f;
#pragma unroll
                    for (int q = 0; q < 4; ++q) den += __expf(lg[q] - gm);
                    const float pg = 1.f / den;
                    float ep[8];
#pragma unroll
                    for (int q = 0; q < 8; ++q) ep[q] = grp == 0 ? lg[4 + q] : grp == 1 ? lg[12 + q] : grp == 2 ? lg[20 + q] : lg[28 + q];
                    int i1 = 0; float v1 = ep[0];
#pragma unroll
                    for (int q = 1; q < 8; ++q) if (ep[q] > v1) { v1 = ep[q]; i1 = q; }
                    int i2 = -1; float v2 = -3.0e38f;
#pragma unroll
                    for (int q = 0; q < 8; ++q) if (q != i1 && ep[q] > v2) { v2 = ep[q]; i2 = q; }
                    const float e2 = __expf(v2 - v1); const float p1 = 1.f / (1.f + e2), p2 = e2 / (1.f + e2);
                    ea_ = grp * 8 + i1; eb_ = grp * 8 + i2; wa_ = pg * p1; wb_ = pg * p2;
                    la_ = __hip_atomic_fetch_add(LCNT + ea_, 1, __ATOMIC_RELAXED, __HIP_MEMORY_SCOPE_WORKGROUP); lb_ = __hip_atomic_fetch_add(LCNT + eb_, 1, __ATOMIC_RELAXED, __HIP_MEMORY_SCOPE_WORKGROUP);
                }
                __syncthreads();
                if (tid < 32 && rp == nrep8 - 1) LBASE[tid] = atomicAdd(cnt + 32 * tid, LCNT[tid]);
                __syncthreads();
                if (tid < 128 && rp == nrep8 - 1) { const int m = R0 + tid;
                    tok_e[2 * m] = ea_; tok_e[2 * m + 1] = eb_; tok_rank[2 * m] = LBASE[ea_] + la_; tok_rank[2 * m + 1] = LBASE[eb_] + lb_; tok_w[2 * m] = wa_; tok_w[2 * m + 1] = wb_; }
            }
        }
        __syncthreads();
        {
            LAS float* scr = (LAS float*)lds + wave * 4160;
            constexpr int I_E13 = 16 * 8, I_E2 = 8 * 16;
            constexpr int NITEMS = NEXP * (2 * I_E13 + I_E2);
            for (int rp = 0; rp < REPN(80); ++rp)
            for (int it = gw; it < NITEMS; it += NGW) {
                const int e = it / (2 * I_E13 + I_E2); int r = it % (2 * I_E13 + I_E2);
                if (r < I_E13) { transpose_item(args.in[I_MW1] + (size_t)e * 1024 * 512, 1024, 512, w13t + (size_t)e * 1024 * 1024, 1, scr, r, lane); continue; } r -= I_E13;
                if (r < I_E13) { transpose_item(args.in[I_MW3] + (size_t)e * 1024 * 512, 1024, 512, w13t + (size_t)e * 1024 * 1024, 2, scr, r, lane); continue; } r -= I_E13;
                transpose_item(args.in[I_MW2] + (size_t)e * 512 * 1024, 512, 1024, w2t + (size_t)e * 1024 * 512, 0, scr, r, lane);
            }
        }
    }
    GRID_SYNC(8);

    LAS int* blk_exp = (LAS int*)(lds + MISC_OFF); LAS int* pstart = blk_exp + 320; LAS int* ecnt = pstart + 40;
    int* row_tok = (int*)(ws + WS_GATEW + 512 * 1024);
    int nblk = 0;
    if (hi > 9 && lo <= 11) {
        __syncthreads();
        if (tid == 0) { int p = 0; for (int e = 0; e < NEXP; ++e) { const int c_ = __hip_atomic_load(cnt + 32 * e, __ATOMIC_RELAXED, __HIP_MEMORY_SCOPE_AGENT); const int nb = (c_ + 255) >> 8; pstart[e] = p * 256; ecnt[e] = c_; for (int q = 0; q < nb; ++q) blk_exp[p + q] = e; p += nb; } pstart[32] = p; }
        __syncthreads();
        nblk = pstart[32];
    }

    if (IN(9)) for (int rp = 0; rp < REPN(9); ++rp) {
        const int gt = bid * NTHREADS + tid, GT = G * NTHREADS;
        for (int a = gt; a < 2 * NTOK; a += GT) { const int e = tok_e[a], rk = tok_rank[a]; const int slot = pstart[e] + rk; tok_slot[a] = slot; row_tok[slot] = a >> 1; }
        for (int r = gt; r < nblk * 256; r += GT) { const int e = blk_exp[r >> 8]; if (r - pstart[e] >= ecnt[e]) row_tok[r] = 0; }
    }
    GRID_SYNC(9);

    if (IN(10)) for (int rp = 0; rp < REPN(10); ++rp) {
        SchedMoeUp S{(const char*)hx2, (const char*)w13t, blk_exp, row_tok, nblk, G, bid}; EpiMoeUp E{Hbuf};
        pg8::gemm_phase<EpiMoeUp, SchedMoeUp, true>(lds, 1024, S, E);
    }
    GRID_SYNC(10);

    if (IN(11)) for (int rp = 0; rp < REPN(11); ++rp) {
        SchedMoeDown S{(const char*)Hbuf, (const char*)w2t, blk_exp, nblk, G, bid}; EpiMoeDown E{Ybuf};
        pg8::gemm_phase(lds, 512, S, E);
    }
    GRID_SYNC(11);

    if (IN(12)) {
        const float* fg = args.in[I_FG];
        f32x4 fgv[4];
#pragma unroll
        for (int j = 0; j < 4; ++j) fgv[j] = *(const f32x4*)(fg + 4 * (64 * j + lane));
        int nrep12 = REPN(12); asm volatile("" : "+s"(nrep12));
_Pragma("unroll 1")
        for (int rp = 0; rp < nrep12; ++rp)
        for (int m0 = 2 * gw; m0 < NTOK; m0 += 2 * NGW) {
            f32x4 v[2][4]; float ss[2] = {0.f, 0.f};
#pragma unroll
            for (int u = 0; u < 2; ++u) { const int m = m0 + u; const int b = m >> 13; const float* g2 = mod + b * 6144 + 5120;
                const int sa = tok_slot[2 * m], sb = tok_slot[2 * m + 1]; const float wa = tok_w[2 * m], wb = tok_w[2 * m + 1];
#pragma unroll
                for (int j = 0; j < 4; ++j) { const int k = 4 * (64 * j + lane);
                    const u32x2 ya = __builtin_nontemporal_load((const u32x2*)(Ybuf + (size_t)sa * 1024 + k)), yb = __builtin_nontemporal_load((const u32x2*)(Ybuf + (size_t)sb * 1024 + k));
                    const f32x4 fa = {bflo(ya.x), bfhi(ya.x), bflo(ya.y), bfhi(ya.y)}, fb = {bflo(yb.x), bfhi(yb.x), bflo(yb.y), bfhi(yb.y)};
                    const f32x4 xv = __builtin_nontemporal_load((const f32x4*)(x1 + (size_t)m * 1024 + k)), gv = *(const f32x4*)(g2 + k);
                    v[u][j] = xv + gv * (fa * wa + fb * wb); ss[u] += (v[u][j][0] * v[u][j][0] + v[u][j][1] * v[u][j][1]) + (v[u][j][2] * v[u][j][2] + v[u][j][3] * v[u][j][3]); } }
#pragma unroll
            for (int u = 0; u < 2; ++u) { const int m = m0 + u; const float rstd = rsqrtf(wave_sum(ss[u]) * (1.f / 1024.f) + 1e-6f);
#pragma unroll
                for (int j = 0; j < 4; ++j) { const int k = 4 * (64 * j + lane); if (rp == nrep12 - 1) st_nt((f32x4*)(args.out + (size_t)m * 1024 + k), v[u][j] * rstd * fgv[j]); } }
        }
    }
    if (PROBE_TS >= 0) {
        xcd_barrier(xbar);
        if (bid == 0 && tid == 0) tsbuf[13] = __builtin_amdgcn_s_memrealtime();
        xcd_barrier(xbar);
        const int pk_ = PROBE_TS < 0 ? 0 : (PROBE_TS % 100); const int sub_ = PROBE_TS < 0 ? 0 : (PROBE_TS / 100);
        const unsigned long long t0_ = __hip_atomic_load(tsbuf + pk_, __ATOMIC_RELAXED, __HIP_MEMORY_SCOPE_AGENT), t1_ = __hip_atomic_load(tsbuf + pk_ + 1, __ATOMIC_RELAXED, __HIP_MEMORY_SCOPE_AGENT);
        const float binw = sub_ == 1 ? 10.f : 40.f;
        const float us = floorf((float)(t1_ - t0_) * 0.01f / binw + 0.5f); const float vv = sqrtf(1.0025f * us);
        for (size_t i = (size_t)bid * NTHREADS + tid; i < (size_t)NTOK * 1024; i += (size_t)G * NTHREADS) args.out[i] = vv;
    }
}

extern "C" void kernel_launch(void* const* d_in, const int* in_sizes, int n_in, void* d_out, int out_size, void* d_ws, size_t ws_size, hipStream_t stream) {
    static int grid = 0;
    if (grid == 0) {
        if (n_in != 41 || out_size != NTOK * DM || ws_size < WS_END) { fprintf(stderr, "kernel_launch: unexpected shapes (n_in %d, out %d, ws %zu)\n", n_in, out_size, ws_size); grid = -1; return; }
        int dev = 0, cus = 0, per_cu = 0;
        hipGetDevice(&dev); hipDeviceGetAttribute(&cus, hipDeviceAttributeMultiprocessorCount, dev);
        if (hipFuncSetAttribute((const void*)fwd_kernel, hipFuncAttributeMaxDynamicSharedMemorySize, LDS_BYTES) != hipSuccess) { fprintf(stderr, "kernel_launch: hipFuncSetAttribute failed\n"); grid = -1; return; }
        hipOccupancyMaxActiveBlocksPerMultiprocessor(&per_cu, (const void*)fwd_kernel, NTHREADS, LDS_BYTES);
        (void)hipGetLastError();
        if (per_cu < 1) { fprintf(stderr, "kernel_launch: occupancy query says %d blocks per CU\n", per_cu); per_cu = 1; }
        grid = cus;
        fprintf(stderr, "kernel_launch: grid %d (cus %d, per_cu %d)\n", grid, cus, per_cu);
    }
    if (grid < 0) return;
    Args a{};
    for (int i = 0; i < 41; ++i) a.in[i] = (const float*)d_in[i];
    a.out = (float*)d_out; a.ws = (unsigned char*)d_ws;
#if ONE_LAUNCH
    a.ph_lo = 0; a.ph_hi = NPHASE;
    void* kargs[] = {&a};
    hipError_t e = hipLaunchCooperativeKernel((const void*)fwd_kernel, dim3(grid), dim3(NTHREADS), kargs, LDS_BYTES, stream);
    if (e != hipSuccess) fprintf(stderr, "cooperative launch failed: %s (grid %d)\n", hipGetErrorString(e), grid);
#else
    for (int p = 0; p < NPHASE; ++p) { a.ph_lo = p; a.ph_hi = p + 1; hipLaunchKernelGGL(fwd_kernel, dim3(grid), dim3(NTHREADS), LDS_BYTES, stream, a); }
#endif
}
```

```cpp
#include <hip/hip_runtime.h>
#include <hip/hip_cooperative_groups.h>
#include <cstdio>
#include <cstdint>
namespace cg = cooperative_groups;

#ifndef ONE_LAUNCH
#define ONE_LAUNCH 1
#endif

#ifndef PROBE_REP
#define PROBE_REP -1
#endif
#ifndef PROBE_TS
#define PROBE_TS -1
#endif
#define REPN(k) ((PROBE_REP == (k)) ? 2 : 1)
#define LAS __attribute__((address_space(3)))
typedef unsigned short bf16;
typedef float f32x4 __attribute__((ext_vector_type(4)));
typedef float f32x2 __attribute__((ext_vector_type(2)));
typedef short bf16x8 __attribute__((ext_vector_type(8)));
typedef unsigned u32x4 __attribute__((ext_vector_type(4)));
typedef unsigned u32x2 __attribute__((ext_vector_type(2)));

constexpr int DM = 1024, NBATCH = 4, SEQ = 8192, NTOK = NBATCH * SEQ, CTXL = 256, NCTX = NBATCH * CTXL, MROWS = NTOK + NCTX;
constexpr int INC = 7168, NEXP = 32, DEXP = 512, PMAXBLK = 288;
constexpr int NCHUNK = 132;
constexpr int NTHREADS = 512, NWAVES = 8;
constexpr int LDS_BYTES = 148480;
constexpr int MISC_OFF = 131072;

constexpr size_t MiB = 1u << 20;
constexpr size_t WS_CTL = 0, WS_MOD = 1 * MiB, WS_Z2 = 2 * MiB, WS_SSQ = 4 * MiB, WS_ROUTE = 6 * MiB, WS_GATEW = 7 * MiB;
constexpr size_t WS_WSMALL = 8 * MiB, WS_WIN = 14 * MiB;
constexpr size_t WS_HX = 32 * MiB;
constexpr size_t WS_PRX = 98 * MiB;
constexpr size_t WS_GRG = 164 * MiB;
constexpr size_t WS_PHY = 228 * MiB;
constexpr size_t WS_W13 = 228 * MiB, WS_W2 = 292 * MiB;
constexpr size_t WS_XG = 324 * MiB;
constexpr size_t WS_KF = 420 * MiB;
constexpr size_t WS_CARR = 484 * MiB, WS_CIN = 494 * MiB, WS_END = 512 * MiB;

__device__ __forceinline__ unsigned f2bf(float f) { unsigned u = __builtin_bit_cast(unsigned, f); return (u + 0x7fffu + ((u >> 16) & 1u)) >> 16; }
__device__ __forceinline__ unsigned pk2(float lo, float hi) { unsigned r; asm("v_cvt_pk_bf16_f32 %0, %1, %2" : "=v"(r) : "v"(lo), "v"(hi)); return r; }
__device__ __forceinline__ float bf2f(unsigned b) { return __builtin_bit_cast(float, b << 16); }
__device__ __forceinline__ float bflo(unsigned w) { return __builtin_bit_cast(float, w << 16); }
__device__ __forceinline__ float bfhi(unsigned w) { return __builtin_bit_cast(float, w & 0xffff0000u); }
__device__ __forceinline__ float wave_sum(float v) {
#pragma unroll
    for (int o = 1; o < 64; o <<= 1) v += __shfl_xor(v, o);
    return v;
}
__device__ __forceinline__ float sigmoidf_(float v) { return __builtin_amdgcn_rcpf(1.f + __expf(-v)); }
__device__ __forceinline__ float gelu_tanh(float v) { const float z = 0.7978845608028654f * (v + 0.044715f * v * v * v); const float t = 1.f - 2.f * __builtin_amdgcn_rcpf(1.f + __expf(2.f * z)); return 0.5f * v * (1.f + t); }
#define LDS_WAIT() asm volatile("s_waitcnt lgkmcnt(0)" ::: "memory")
#define LDS_BARRIER() do { asm volatile("s_waitcnt lgkmcnt(0)" ::: "memory"); __builtin_amdgcn_s_barrier(); asm volatile("" ::: "memory"); } while (0)

namespace pg8 {
#define PG8_LAS __attribute__((address_space(3)))
constexpr int BM = 256, BK = 64, HALF = 128, HTB = HALF * BK * 2, STAGE_BYTES = 8 * HTB, NXCD = 8, WGM = 4;
__host__ __device__ __forceinline__ int lds_byte(int r, int c) { const int st = (r >> 4) * 2 + (c >> 5), rr = r & 15, cc = c & 31, ob = rr * 64 + cc * 2; return st * 1024 + (ob ^ (((ob >> 9) & 1) << 5)); }
__host__ __device__ __forceinline__ void stage_rc(int b, int& R, int& C) { const int st = b / 1024, sb = b % 1024, swz = sb ^ (((sb >> 9) & 1) << 5); R = (st >> 1) * 16 + swz / 64; C = (st & 1) * 32 + (swz % 64) / 2; }

__host__ __device__ __forceinline__ int perm32(int rho) { const int n = rho >> 4, i = rho & 15; return 8 * (i >> 2) + 4 * n + (i & 3); }
struct Unit { int pm, pn, last; const char* A; const char* B; };

__device__ __forceinline__ void rect_map(int wg, int nM, int nN, int& pm, int& pn) {
    const int nwg = nM * nN; int wgid = wg; { const int q = nwg / NXCD, r = nwg % NXCD, xcd = wgid % NXCD, off = wgid / NXCD; wgid = (xcd < r ? xcd * (q + 1) : r * (q + 1) + (xcd - r) * q) + off; }
    const int nig = WGM * nN, gid = wgid / nig, fm = gid * WGM, gsz = (nM - fm) < WGM ? (nM - fm) : WGM;
    pm = fm + ((wgid % nig) % gsz); pn = (wgid % nig) / gsz;
}

template <class Epi, class Sched, bool GATHER = false>
__device__ __forceinline__ void gemm_phase(PG8_LAS unsigned char* lds, const int K, const Sched& S, const Epi& E) {
    const int tid = threadIdx.x, wid = __builtin_amdgcn_readfirstlane(tid >> 6), lane = tid & 63, wr = wid >> 2, wc = wid & 3, fr = lane & 15, fq = lane >> 4;
    const int nt = K / BK;
    unsigned voffA[2]; int stR[2], stC[2]; unsigned voffB[2];
#pragma unroll
    for (int i = 0; i < 2; ++i) { int R, C; stage_rc(tid * 16 + i * 8192, R, C); voffA[i] = (unsigned)(R * K + C) * 2u; stR[i] = R; stC[i] = C;
        const int Rb = Epi::PERM ? ((R & ~31) + perm32(R & 31)) : R; voffB[i] = (unsigned)(Rb * K + C) * 2u; }
    unsigned voffGc[2][2], voffGn[2][2];
#define PG8_GOFF(dst, u) do { _Pragma("unroll") for (int _h = 0; _h < 2; ++_h) _Pragma("unroll") for (int _i = 0; _i < 2; ++_i) \
        dst[_h][_i] = (unsigned)(S.row_tok[(u).pm * 256 + _h * 128 + stR[_i]] * K + stC[_i]) * 2u; } while (0)
    const size_t kstep = (size_t)(BK * 2);
    const size_t hstep = (size_t)HALF * K * 2;
    const unsigned ldsw = (unsigned)wid * 1024u;
    const int aoff = lds_byte(wr * 64 + fr, fq * 8), boff = lds_byte(wc * 32 + fr, fq * 8);
#define PG8_SA(b, h) (((b) * 2 + (h)) * HTB)
#define PG8_SB(b, h) ((4 + (b) * 2 + (h)) * HTB)
#define PG8_STAGE(bufoff, gbase, voff) do { _Pragma("unroll") for (int _i = 0; _i < 2; ++_i) \
        __builtin_amdgcn_global_load_lds((const unsigned*)((const char*)(gbase) + (voff)[_i]), (PG8_LAS unsigned*)(lds + (bufoff) + ldsw + _i * 8192), 16, 0, 0); } while (0)
#define PG8_STAGE_A(bufoff, kptr, half, isnext) do { if constexpr (GATHER) { if (isnext) PG8_STAGE(bufoff, kptr, voffGn[half]); else PG8_STAGE(bufoff, kptr, voffGc[half]); } \
        else PG8_STAGE(bufoff, (kptr) + (half) * hstep, voffA); } while (0)
#define PG8_LDA(dst, b, h) do { _Pragma("unroll") for (int m = 0; m < 4; ++m) _Pragma("unroll") for (int k = 0; k < 2; ++k) dst[m][k] = *(const PG8_LAS bf16x8*)(lds + PG8_SA(b, h) + aoff + m * 2048 + k * 1024); } while (0)
#define PG8_LDB(dst, b, h) do { _Pragma("unroll") for (int n = 0; n < 2; ++n) _Pragma("unroll") for (int k = 0; k < 2; ++k) dst[n][k] = *(const PG8_LAS bf16x8*)(lds + PG8_SB(b, h) + boff + n * 2048 + k * 1024); } while (0)
#define PG8_MMA(ai, bj, At, Bt) do { __builtin_amdgcn_s_setprio(1); _Pragma("unroll") for (int m = 0; m < 4; ++m) _Pragma("unroll") for (int n = 0; n < 2; ++n) _Pragma("unroll") for (int k = 0; k < 2; ++k) \
        acc[ai][bj][m][n] = __builtin_amdgcn_mfma_f32_16x16x32_bf16(Bt[n][k], At[m][k], acc[ai][bj][m][n], 0, 0, 0); __builtin_amdgcn_s_setprio(0); } while (0)
#define PG8_WAIT_V(n) asm volatile("s_waitcnt vmcnt(" #n ")" ::: "memory")
#define PG8_WAIT_L(n) asm volatile("s_waitcnt lgkmcnt(" #n ")" ::: "memory")
#define PG8_BAR __builtin_amdgcn_s_barrier()
#define PG8_SCHED __builtin_amdgcn_sched_barrier(0)
    Unit cur, nxt; int ui = 0;
    if (!S.next(0, cur)) return;
    f32x4 acc[2][2][4][2];
#pragma unroll
    for (int a = 0; a < 2; ++a)
#pragma unroll
        for (int b = 0; b < 2; ++b)
#pragma unroll
            for (int m = 0; m < 4; ++m)
#pragma unroll
                for (int n = 0; n < 2; ++n) acc[a][b][m][n] = (f32x4){0.f, 0.f, 0.f, 0.f};
    bf16x8 At[4][2], B0[2][2], B1[2][2];
    const char* cA = cur.A; const char* cB = cur.B;
    if constexpr (GATHER) { PG8_GOFF(voffGc, cur); }
    PG8_STAGE(PG8_SB(0, 0), cB, voffB); PG8_STAGE(PG8_SB(0, 1), cB + hstep, voffB); PG8_STAGE_A(PG8_SA(0, 0), cA, 0, false); PG8_STAGE_A(PG8_SA(0, 1), cA, 1, false);
    if (wr == 1) PG8_BAR;
    PG8_WAIT_V(2); PG8_BAR;
    PG8_STAGE(PG8_SB(1, 0), cB + kstep, voffB); PG8_STAGE_A(PG8_SA(1, 0), cA + kstep, 0, false); PG8_STAGE(PG8_SB(1, 1), cB + hstep + kstep, voffB);
    PG8_WAIT_V(6); PG8_BAR;
    for (;;) {
        const bool has_next = S.next(ui + 1, nxt);
        const char* nA = has_next ? nxt.A : cA; const char* nB = has_next ? nxt.B : cB;
        if constexpr (GATHER) { if (has_next) { PG8_GOFF(voffGn, nxt); } else { _Pragma("unroll") for (int _h = 0; _h < 2; ++_h) _Pragma("unroll") for (int _i = 0; _i < 2; ++_i) voffGn[_h][_i] = voffGc[_h][_i]; } }
        for (int t = 0; t < nt; t += 2) {
            const bool last = (t == nt - 2);
            const char* a1 = cA + (size_t)(t + 1) * kstep;
            const char* a2 = last ? nA : cA + (size_t)(t + 2) * kstep; const char* b2 = last ? nB : cB + (size_t)(t + 2) * kstep;
            const char* a3 = a2 + kstep; const char* b3 = b2 + kstep;
            PG8_LDB(B0, 0, 0); PG8_LDB(B1, 0, 1); PG8_SCHED; PG8_LDA(At, 0, 0); PG8_STAGE_A(PG8_SA(1, 1), a1, 1, false);
            PG8_WAIT_V(8); PG8_WAIT_L(0); PG8_BAR; PG8_MMA(0, 0, At, B0); PG8_MMA(0, 1, At, B1); PG8_BAR; PG8_SCHED;
            PG8_LDA(At, 0, 1); PG8_STAGE(PG8_SB(0, 0), b2, voffB); PG8_STAGE(PG8_SB(0, 1), b2 + hstep, voffB); PG8_STAGE_A(PG8_SA(0, 0), a2, 0, last);
            PG8_WAIT_V(8); PG8_WAIT_L(0); PG8_BAR; PG8_MMA(1, 0, At, B0); PG8_MMA(1, 1, At, B1); PG8_BAR; PG8_SCHED;
            PG8_LDB(B0, 1, 0); PG8_LDB(B1, 1, 1); PG8_SCHED; PG8_LDA(At, 1, 0); PG8_STAGE_A(PG8_SA(0, 1), a2, 1, last);
            PG8_WAIT_V(8); PG8_WAIT_L(0); PG8_BAR; PG8_MMA(0, 0, At, B0); PG8_MMA(0, 1, At, B1); PG8_BAR; PG8_SCHED;
            PG8_LDA(At, 1, 1); PG8_STAGE(PG8_SB(1, 0), b3, voffB); PG8_STAGE(PG8_SB(1, 1), b3 + hstep, voffB); PG8_STAGE_A(PG8_SA(1, 0), a3, 0, last);
            PG8_WAIT_V(8); PG8_WAIT_L(0); PG8_BAR; PG8_MMA(1, 0, At, B0); PG8_MMA(1, 1, At, B1); PG8_BAR; PG8_SCHED;
        }
        if (wr == 0) PG8_BAR;
        if (cur.last) E.fin(acc, cur, wr, wc, fr, fq); else E.mid(acc, cur, wr, wc, fr, fq);
        if (!has_next) break;
        if (cur.last) {
#pragma unroll
            for (int a = 0; a < 2; ++a)
#pragma unroll
                for (int b = 0; b < 2; ++b)
#pragma unroll
                    for (int m = 0; m < 4; ++m)
#pragma unroll
                        for (int n = 0; n < 2; ++n) acc[a][b][m][n] = (f32x4){0.f, 0.f, 0.f, 0.f};
        }
        cur = nxt; cA = nA; cB = nB; ++ui;
        if constexpr (GATHER) { _Pragma("unroll") for (int _h = 0; _h < 2; ++_h) _Pragma("unroll") for (int _i = 0; _i < 2; ++_i) voffGc[_h][_i] = voffGn[_h][_i]; }
        if (wr == 1) PG8_BAR;
    }
    PG8_WAIT_V(0);
    PG8_BAR;
#undef PG8_SA
#undef PG8_SB
#undef PG8_STAGE
#undef PG8_STAGE_A
#undef PG8_GOFF
#undef PG8_LDA
#undef PG8_LDB
#undef PG8_MMA
#undef PG8_WAIT_V
#undef PG8_WAIT_L
#undef PG8_BAR
#undef PG8_SCHED
}
}
using pg8::Unit;
typedef f32x4 AccT[2][2][4][2];

__device__ __forceinline__ void st_nt(u32x4* p, u32x4 v) { __builtin_nontemporal_store(v, p); }
__device__ __forceinline__ void st_nt(f32x4* p, f32x4 v) { __builtin_nontemporal_store(v, p); }
__device__ __forceinline__ u32x2 pack4(f32x4 v) { u32x2 w; w.x = pk2(v[0], v[1]); w.y = pk2(v[2], v[3]); return w; }

#define EPI_LOOP_ROWS _Pragma("unroll") for (int ai = 0; ai < 2; ++ai) _Pragma("unroll") for (int m = 0; m < 4; ++m)
#define EPI_LOOP_COLS _Pragma("unroll") for (int bj = 0; bj < 2; ++bj) _Pragma("unroll") for (int n = 0; n < 2; ++n)

__device__ __forceinline__ u32x4 pack8(f32x4 a, f32x4 b) { return (u32x4){pk2(a[0], a[1]), pk2(a[2], a[3]), pk2(b[0], b[1]), pk2(b[2], b[3])}; }
__device__ __forceinline__ void unpack8(u32x4 w, f32x4& a, f32x4& b) { a = (f32x4){bflo(w.x), bfhi(w.x), bflo(w.y), bfhi(w.y)}; b = (f32x4){bflo(w.z), bfhi(w.z), bflo(w.w), bfhi(w.w)}; }
#define EPI_LOOP_BJ _Pragma("unroll") for (int bj = 0; bj < 2; ++bj)
struct EpiInA {
    static constexpr bool PERM = true;
    bf16* prx; bf16* grg; bf16* gates;
    __device__ __forceinline__ void mid(AccT& acc, const Unit& u, int wr, int wc, int fr, int fq) const {}
    __device__ __forceinline__ void fin(AccT& acc, const Unit& u, int wr, int wc, int fr, int fq) const {
        const int row0 = u.pm * 256 + wr * 64 + fr, col0 = u.pn * 256 + wc * 32 + 8 * fq;
        EPI_LOOP_ROWS { const size_t r = (size_t)(row0 + ai * 128 + m * 16);
            EPI_LOOP_BJ { const int c = col0 + bj * 128; f32x4 v0 = acc[ai][bj][m][0], v1 = acc[ai][bj][m][1];
                if (u.pn < 4) { st_nt((u32x4*)(prx + r * 1024 + c), pack8(v0, v1)); }
                else if (u.pn < 8) { for (int i = 0; i < 4; ++i) { v0[i] = gelu_tanh(v0[i]); v1[i] = gelu_tanh(v1[i]); } st_nt((u32x4*)(grg + r * 1024 + (c - 1024)), pack8(v0, v1)); }
                else { for (int i = 0; i < 4; ++i) { v0[i] = sigmoidf_(v0[i]); v1[i] = sigmoidf_(v1[i]); } st_nt((u32x4*)(gates + r * 2048 + (c - 2048)), pack8(v0, v1)); } } }
    }
};
struct EpiInB {
    static constexpr bool PERM = true;
    bf16* phyT;
    __device__ __forceinline__ void mid(AccT& acc, const Unit& u, int wr, int wc, int fr, int fq) const {}
    __device__ __forceinline__ void fin(AccT& acc, const Unit& u, int wr, int wc, int fr, int fq) const {
        const int row0 = u.pm * 256 + wr * 64 + fr, col0 = u.pn * 256 + wc * 32 + 8 * fq;
        const int b = u.pn >> 5;
        EPI_LOOP_ROWS { const size_t j = (size_t)(row0 + ai * 128 + m * 16);
            EPI_LOOP_BJ { const int t = col0 + bj * 128 - b * SEQ;
                st_nt((u32x4*)(phyT + ((size_t)b * 3072 + j) * SEQ + t), pack8(acc[ai][bj][m][0], acc[ai][bj][m][1])); } }
    }
};
struct EpiMerge {
    static constexpr bool PERM = true;
    const bf16* gates; bf16* merged;
    __device__ __forceinline__ void mid(AccT& acc, const Unit& u, int wr, int wc, int fr, int fq) const {
        const int row0 = u.pm * 256 + wr * 64 + fr, col0 = u.pn * 256 + wc * 32 + 8 * fq;
        EPI_LOOP_ROWS { const size_t r = (size_t)(row0 + ai * 128 + m * 16);
            EPI_LOOP_BJ { const int c = col0 + bj * 128;
                f32x4 sa0, sa1, sb0, sb1; unpack8(*(const u32x4*)(gates + r * 2048 + c), sa0, sa1); unpack8(*(const u32x4*)(gates + r * 2048 + 1024 + c), sb0, sb1);
                for (int i = 0; i < 4; ++i) { acc[ai][bj][m][0][i] *= sa0[i] * __builtin_amdgcn_rcpf(fmaxf(sb0[i], 1e-30f)); acc[ai][bj][m][1][i] *= sa1[i] * __builtin_amdgcn_rcpf(fmaxf(sb1[i], 1e-30f)); } } }
    }
    __device__ __forceinline__ void fin(AccT& acc, const Unit& u, int wr, int wc, int fr, int fq) const {
        const int row0 = u.pm * 256 + wr * 64 + fr, col0 = u.pn * 256 + wc * 32 + 8 * fq;
        EPI_LOOP_ROWS { const size_t r = (size_t)(row0 + ai * 128 + m * 16);
            EPI_LOOP_BJ { const int c = col0 + bj * 128;
                f32x4 sb0, sb1; unpack8(*(const u32x4*)(gates + r * 2048 + 1024 + c), sb0, sb1);
                f32x4 v0 = acc[ai][bj][m][0], v1 = acc[ai][bj][m][1];
                for (int i = 0; i < 4; ++i) { v0[i] *= fmaxf(sb0[i], 1e-30f); v1[i] *= fmaxf(sb1[i], 1e-30f); }
                *(u32x4*)(merged + r * 1024 + c) = pack8(v0, v1); } }
    }
};
struct EpiOut {
    static constexpr bool PERM = false;
    const float* x; const float* mod; float* x1; float* ssq;
    __device__ __forceinline__ void mid(AccT& acc, const Unit& u, int wr, int wc, int fr, int fq) const {}
    __device__ __forceinline__ void fin(AccT& acc, const Unit& u, int wr, int wc, int fr, int fq) const {
        const int row0 = u.pm * 256 + wr * 64 + fr, col0 = u.pn * 256 + wc * 32 + 4 * fq;
        const float* g1 = mod + (u.pm >> 5) * 6144 + 2048;
        EPI_LOOP_ROWS { const size_t r = (size_t)(row0 + ai * 128 + m * 16); float s = 0.f;
            EPI_LOOP_COLS { const int c = col0 + bj * 128 + n * 16;
                const f32x4 xv = __builtin_nontemporal_load((const f32x4*)(x + r * 1024 + c)), gv = *(const f32x4*)(g1 + c);
                const f32x4 o = xv + gv * acc[ai][bj][m][n];
                *(f32x4*)(x1 + r * 1024 + c) = o; s += (o[0] * o[0] + o[1] * o[1]) + (o[2] * o[2] + o[3] * o[3]); }
            s += __shfl_xor(s, 16); s += __shfl_xor(s, 32);
            if (fq == 0) ssq[r * 16 + u.pn * 4 + wc] = s; }
    }
};
struct EpiMoeUp {
    static constexpr bool PERM = true;
    bf16* H;
    __device__ __forceinline__ void mid(AccT& acc, const Unit& u, int wr, int wc, int fr, int fq) const {}
    __device__ __forceinline__ void fin(AccT& acc, const Unit& u, int wr, int wc, int fr, int fq) const {
        const int row0 = u.pm * 256 + wr * 64 + fr, col0 = u.pn * 128 + wc * 32 + 8 * fq;
        EPI_LOOP_ROWS { const size_t r = (size_t)(row0 + ai * 128 + m * 16); f32x4 h0, h1;
            for (int i = 0; i < 4; ++i) { const float a0 = acc[ai][0][m][0][i], a1 = acc[ai][0][m][1][i]; h0[i] = a0 * sigmoidf_(a0) * acc[ai][1][m][0][i]; h1[i] = a1 * sigmoidf_(a1) * acc[ai][1][m][1][i]; }
            *(u32x4*)(H + r * 512 + col0) = pack8(h0, h1); }
    }
};
struct EpiMoeDown {
    static constexpr bool PERM = true;
    bf16* Y;
    __device__ __forceinline__ void mid(AccT& acc, const Unit& u, int wr, int wc, int fr, int fq) const {}
    __device__ __forceinline__ void fin(AccT& acc, const Unit& u, int wr, int wc, int fr, int fq) const {
        const int row0 = u.pm * 256 + wr * 64 + fr, col0 = u.pn * 256 + wc * 32 + 8 * fq;
        EPI_LOOP_ROWS { const size_t r = (size_t)(row0 + ai * 128 + m * 16);
            EPI_LOOP_BJ { const int c = col0 + bj * 128; *(u32x4*)(Y + r * 1024 + c) = pack8(acc[ai][bj][m][0], acc[ai][bj][m][1]); } }
    }
};

constexpr size_t TSTEP1K = (size_t)256 * 1024 * 2;
struct SchedInA { const char* hx; const char* wt; int G, c;
    __device__ __forceinline__ bool next(int i, Unit& u) const {
        int Lx = (i >> (REPN(2) - 1)) * G + c, pm, pn;
        if (Lx < 2048) pg8::rect_map(Lx, 128, 16, pm, pn);
        else { Lx -= 2048; if (Lx >= 16) return false; pm = 128 + (Lx >> 2); pn = Lx & 3; }
        const int wrow = pn < 8 ? pn * 256 : 5120 + (pn - 8) * 256;
        u.pm = pm; u.pn = pn; u.last = 1; u.A = hx + (size_t)pm * TSTEP1K; u.B = wt + (size_t)wrow * 2048; return true; } };
struct SchedInB { const char* hx; const char* wt; int G, c;
    __device__ __forceinline__ bool next(int i, Unit& u) const {
        const int Lx = (i >> (REPN(21) - 1)) * G + c; if (Lx >= 12 * 128) return false; int pm, pn; pg8::rect_map(Lx, 12, 128, pm, pn);
        u.pm = pm; u.pn = pn; u.last = 1; u.A = wt + (size_t)(2048 + pm * 256) * 2048; u.B = hx + (size_t)pn * TSTEP1K; return true; } };
struct SchedMerge { const char* yrg; const char* yhy; const char* wrg; const char* why; int G, c;
    __device__ __forceinline__ bool next(int i, Unit& u) const {
        const int T = (i >> 1) * G + c, part = i & 1; if (T >= 512) return false; int pm, pn; pg8::rect_map(T, 128, 4, pm, pn);
        u.pm = pm; u.pn = pn; u.last = part; u.A = (part ? yhy : yrg) + (size_t)pm * TSTEP1K; u.B = (part ? why : wrg) + (size_t)pn * TSTEP1K; return true; } };
struct SchedOut { const char* a; const char* w; int G, c;
    __device__ __forceinline__ bool next(int i, Unit& u) const {
        const int T = (i >> (REPN(7) - 1)) * G + c; if (T >= 512) return false; int pm, pn; pg8::rect_map(T, 128, 4, pm, pn);
        u.pm = pm; u.pn = pn; u.last = 1; u.A = a + (size_t)pm * TSTEP1K; u.B = w + (size_t)pn * TSTEP1K; return true; } };
struct SchedMoeUp { const char* xg; const char* w13; const LAS int* blk_exp; const int* row_tok; int nblk, G, c;
    __device__ __forceinline__ bool next(int i, Unit& u) const {
        const int T = i * G + c; if (T >= nblk * 4) return false; const int pm = T >> 2, pn = T & 3, e = blk_exp[pm];
        u.pm = pm; u.pn = pn; u.last = 1; u.A = xg; u.B = w13 + (size_t)e * (1024 * 1024 * 2) + (size_t)pn * TSTEP1K; return true; } };
struct SchedMoeDown { const char* h; const char* w2; const LAS int* blk_exp; int nblk, G, c;
    __device__ __forceinline__ bool next(int i, Unit& u) const {
        const int T = i * G + c; if (T >= nblk * 4) return false; const int pm = T >> 2, pn = T & 3, e = blk_exp[pm];
        u.pm = pm; u.pn = pn; u.last = 1; u.A = h + (size_t)pm * (256 * 512 * 2); u.B = w2 + (size_t)e * (1024 * 512 * 2) + (size_t)pn * (256 * 512 * 2); return true; } };


typedef f32x2 cpx;
__device__ __forceinline__ int pidx(int i) { return i + (i >> 4); }
__device__ __forceinline__ cpx cmul(cpx a, cpx b) { return (cpx){a.x * b.x - a.y * b.y, a.x * b.y + a.y * b.x}; }
template <bool INV> __device__ __forceinline__ cpx mul_w4(cpx a) { return INV ? (cpx){-a.y, a.x} : (cpx){a.y, -a.x}; }
template <bool INV> __device__ __forceinline__ void dft4(cpx& a, cpx& b, cpx& c, cpx& d) {
    const cpx t0 = a + c, t1 = a - c, t2 = b + d, t3 = b - d; const cpx t3r = mul_w4<INV>(t3);
    a = t0 + t2; b = t1 + t3r; c = t0 - t2; d = t1 - t3r; }
template <bool INV> __device__ __forceinline__ cpx twc(cpx x, float cr, float ci) { return cmul(x, (cpx){cr, INV ? -ci : ci}); }
#define SLOT16(q) (4 * ((q) & 3) + ((q) >> 2))
template <bool INV> __device__ __forceinline__ void dft16(cpx (&x)[16]) {
    const float C1 = 0.9238795325112867f, S1 = 0.3826834323650898f, R = 0.7071067811865476f;
#pragma unroll
    for (int m2 = 0; m2 < 4; ++m2) dft4<INV>(x[m2], x[4 + m2], x[8 + m2], x[12 + m2]);
    x[5] = twc<INV>(x[5], C1, -S1); x[9] = twc<INV>(x[9], R, -R); x[6] = twc<INV>(x[6], R, -R);
    x[13] = twc<INV>(x[13], S1, -C1); x[7] = twc<INV>(x[7], S1, -C1); x[10] = mul_w4<INV>(x[10]);
    x[14] = twc<INV>(x[14], -R, -R); x[11] = twc<INV>(x[11], -R, -R); x[15] = twc<INV>(x[15], -C1, S1);
#pragma unroll
    for (int q1 = 0; q1 < 4; ++q1) dft4<INV>(x[4 * q1], x[4 * q1 + 1], x[4 * q1 + 2], x[4 * q1 + 3]);
}
template <int S_, int NIN> __device__ __forceinline__ void fft_fwd16(LAS cpx* X, const LAS cpx* TW, int tid) {
    constexpr int PS = S_ + S_ / 16;
#pragma unroll 1
    for (int it = 0; it < 2; ++it) {
        int bf = tid + 512 * it; asm volatile("" : "+v"(bf)); const int blk = bf / S_, j = bf % S_; const int base = pidx(blk * (16 * S_) + j);
        cpx x[16];
#pragma unroll
        for (int m = 0; m < 16; ++m) x[m] = (m < NIN) ? X[base + PS * m] : (cpx){0.f, 0.f};
        dft16<false>(x);
        const cpx w1 = TW[j]; cpx w = w1;
        X[base] = x[0];
#pragma unroll
        for (int q = 1; q < 16; ++q) { X[base + PS * q] = cmul(x[SLOT16(q)], w); w = cmul(w, w1); }
    }
}
template <int S_, int NOUT> __device__ __forceinline__ void fft_inv16(LAS cpx* X, const LAS cpx* TW, int tid) {
    constexpr int PS = S_ + S_ / 16;
#pragma unroll 1
    for (int it = 0; it < 2; ++it) {
        int bf = tid + 512 * it; asm volatile("" : "+v"(bf)); const int blk = bf / S_, j = bf % S_; const int base = pidx(blk * (16 * S_) + j);
        cpx w1 = TW[j]; w1.y = -w1.y; cpx w = w1;
        cpx x[16]; x[0] = X[base];
#pragma unroll
        for (int q = 1; q < 16; ++q) { x[q] = cmul(X[base + PS * q], w); w = cmul(w, w1); }
        dft16<true>(x);
#pragma unroll
        for (int m = 0; m < NOUT; ++m) X[base + PS * m] = x[SLOT16(m)];
    }
}
template <bool INV> __device__ __forceinline__ void fft_r4(LAS cpx* X, const LAS cpx* TW, int tid) {
#pragma unroll 2
    for (int it = 0; it < 8; ++it) {
        int bf = tid + 512 * it; asm volatile("" : "+v"(bf)); const int blk = bf >> 4, j = bf & 15; const int base = 68 * blk + j;
        cpx w1 = TW[j]; if (INV) w1.y = -w1.y; const cpx w2 = cmul(w1, w1), w3 = cmul(w2, w1);
        cpx a = X[base], b = X[base + 17], c = X[base + 34], d = X[base + 51];
        if (INV) { b = cmul(b, w1); c = cmul(c, w2); d = cmul(d, w3); }
        dft4<INV>(a, b, c, d);
        if (!INV) { b = cmul(b, w1); c = cmul(c, w2); d = cmul(d, w3); }
        X[base] = a; X[base + 17] = b; X[base + 34] = c; X[base + 51] = d;
    }
}

template <bool INV, bool OZERO> __device__ __forceinline__ void dft32(cpx (&e)[16], cpx (&o)[16]) {
    const float C[16] = {1.f, 0.9807852804032304f, 0.9238795325112867f, 0.8314696123025452f, 0.7071067811865476f, 0.5555702330196022f, 0.3826834323650898f, 0.1950903220161283f,
                         0.f, -0.1950903220161283f, -0.3826834323650898f, -0.5555702330196022f, -0.7071067811865476f, -0.8314696123025452f, -0.9238795325112867f, -0.9807852804032304f};
    const float S[16] = {0.f, 0.1950903220161283f, 0.3826834323650898f, 0.5555702330196022f, 0.7071067811865476f, 0.8314696123025452f, 0.9238795325112867f, 0.9807852804032304f,
                         1.f, 0.9807852804032304f, 0.9238795325112867f, 0.8314696123025452f, 0.7071067811865476f, 0.5555702330196022f, 0.3826834323650898f, 0.1950903220161283f};
#pragma unroll
    for (int m = 0; m < 16; ++m) { const cpx a = e[m]; cpx d;
        if (OZERO) d = a; else { const cpx b = o[m]; e[m] = a + b; d = a - b; }
        o[m] = (m == 0) ? d : (m == 8) ? mul_w4<INV>(d) : twc<INV>(d, C[m], -S[m]); }
    dft16<INV>(e); dft16<INV>(o);
}
template <int NIN> __device__ __forceinline__ void fft_fwd32A(LAS cpx* X, const LAS cpx* TW, int tid) {
    int j = tid; asm volatile("" : "+v"(j)); const int base = pidx(j); constexpr int PS = 544;
    cpx e[16], o[16];
#pragma unroll
    for (int m = 0; m < 16; ++m) { e[m] = X[base + PS * m]; o[m] = (NIN == 32) ? X[base + PS * (m + 16)] : (cpx){0.f, 0.f}; }
    dft32<false, NIN == 16>(e, o);
    const cpx w1 = TW[j], w2 = cmul(w1, w1); cpx te = w2, to = w1;
    X[base] = e[0]; X[base + PS] = cmul(o[0], to); to = cmul(to, w2);
#pragma unroll
    for (int q = 1; q < 16; ++q) { X[base + PS * (2 * q)] = cmul(e[SLOT16(q)], te); X[base + PS * (2 * q + 1)] = cmul(o[SLOT16(q)], to); te = cmul(te, w2); to = cmul(to, w2); }
}
__device__ __forceinline__ void fft_fwd32A_filter(LAS cpx* X, const LAS cpx* TW, const float* kfw, const float* kbw, int tid) {
    int j = tid; asm volatile("" : "+v"(j)); const int base = pidx(j); constexpr int PS = 544;
    cpx e[16], o[16];
#pragma unroll
    for (int m = 0; m < 16; ++m) e[m] = (cpx){kfw[j + 512 * m], 0.f};
#pragma unroll
    for (int m = 0; m < 16; ++m) { const int i = j + 512 * m; o[m] = (cpx){(i == 0) ? 0.f : kbw[SEQ - i], 0.f}; }
    dft32<false, false>(e, o);
    const cpx w1 = TW[j], w2 = cmul(w1, w1); cpx te = w2, to = w1;
    X[base] = e[0]; X[base + PS] = cmul(o[0], to); to = cmul(to, w2);
#pragma unroll
    for (int q = 1; q < 16; ++q) { X[base + PS * (2 * q)] = cmul(e[SLOT16(q)], te); X[base + PS * (2 * q + 1)] = cmul(o[SLOT16(q)], to); te = cmul(te, w2); to = cmul(to, w2); }
}
__device__ __forceinline__ void fft_fwd32B(LAS cpx* X, const LAS cpx* TW, int tid) {
    int t = tid; asm volatile("" : "+v"(t)); const int blk = t >> 4, j = t & 15; const int base = 544 * blk + j; constexpr int PS = 17;
    cpx e[16], o[16];
#pragma unroll
    for (int m = 0; m < 16; ++m) { e[m] = X[base + PS * m]; o[m] = X[base + PS * (m + 16)]; }
    dft32<false, false>(e, o);
    const cpx w1 = TW[j], w2 = cmul(w1, w1); cpx te = w2, to = w1;
    X[base] = e[0]; X[base + PS] = cmul(o[0], to); to = cmul(to, w2);
#pragma unroll
    for (int q = 1; q < 16; ++q) { X[base + PS * (2 * q)] = cmul(e[SLOT16(q)], te); X[base + PS * (2 * q + 1)] = cmul(o[SLOT16(q)], to); te = cmul(te, w2); to = cmul(to, w2); }
}
template <int PS, int NOUT> __device__ __forceinline__ void fft_inv32_core(LAS cpx* X, int base, cpx w1c) {
    const cpx w2 = cmul(w1c, w1c); cpx te = w2, to = w1c;
    cpx e[16], o[16];
    cpx zin[32];
    zin[0] = X[base]; zin[1] = cmul(X[base + PS], to); to = cmul(to, w2);
#pragma unroll
    for (int q = 1; q < 16; ++q) { zin[2 * q] = cmul(X[base + PS * (2 * q)], te); zin[2 * q + 1] = cmul(X[base + PS * (2 * q + 1)], to); te = cmul(te, w2); to = cmul(to, w2); }
#pragma unroll
    for (int m = 0; m < 16; ++m) { e[m] = zin[m]; o[m] = zin[m + 16]; }
    dft32<true, false>(e, o);
#pragma unroll
    for (int m = 0; m < NOUT; ++m) X[base + PS * m] = (m & 1) ? o[SLOT16(m >> 1)] : e[SLOT16(m >> 1)];
}
__device__ __forceinline__ void fft_inv32A_final(const LAS cpx* X, const LAS cpx* TW, int tid, const unsigned* sx, bf16* rowA, bf16* rowB, bool dostore) {
    int j = tid; asm volatile("" : "+v"(j)); cpx w1 = TW[j]; w1.y = -w1.y; const int base = pidx(j); constexpr int PS = 544;
    unsigned sa[16], sb[16];
#pragma unroll
    for (int m = 0; m < 16; ++m) { sa[m] = __hip_atomic_load(sx + j + 512 * m, __ATOMIC_RELAXED, __HIP_MEMORY_SCOPE_AGENT); sb[m] = __hip_atomic_load(sx + SEQ + j + 512 * m, __ATOMIC_RELAXED, __HIP_MEMORY_SCOPE_AGENT); }
    const cpx w2 = cmul(w1, w1); cpx te = w2, to = w1;
    cpx e[16], o[16]; cpx zin[32];
    zin[0] = X[base]; zin[1] = cmul(X[base + PS], to); to = cmul(to, w2);
#pragma unroll
    for (int q = 1; q < 16; ++q) { zin[2 * q] = cmul(X[base + PS * (2 * q)], te); zin[2 * q + 1] = cmul(X[base + PS * (2 * q + 1)], to); te = cmul(te, w2); to = cmul(to, w2); }
#pragma unroll
    for (int m = 0; m < 16; ++m) { e[m] = zin[m]; o[m] = zin[m + 16]; }
    dft32<true, false>(e, o);
    if (dostore) {
#pragma unroll
        for (int m = 0; m < 16; ++m) { const cpx y = (m & 1) ? o[SLOT16(m >> 1)] : e[SLOT16(m >> 1)]; const int t = j + 512 * m;
            const float oa = y.x * bflo(sa[m]) + bfhi(sa[m]), ob = y.y * bflo(sb[m]) + bfhi(sb[m]);
            rowA[t] = (bf16)(pk2(oa, 0.f) & 0xffffu); rowB[t] = (bf16)(pk2(ob, 0.f) & 0xffffu); }
    }
}
__device__ __forceinline__ void fft_inv32B(LAS cpx* X, const LAS cpx* TW, int tid) {
    int t = tid; asm volatile("" : "+v"(t)); const int blk = t >> 4, j = t & 15; cpx w1 = TW[j]; w1.y = -w1.y;
    fft_inv32_core<17, 32>(X, 544 * blk + j, w1);
}
template <int NOUT> __device__ __forceinline__ void fft_inv32A(LAS cpx* X, const LAS cpx* TW, int tid) {
    int j = tid; asm volatile("" : "+v"(j)); cpx w1 = TW[j]; w1.y = -w1.y;
    fft_inv32_core<544, NOUT>(X, pidx(j), w1);
}
__device__ __forceinline__ void fft_fwdD_toK(const LAS cpx* X, cpx* Kb, int tid) {
#pragma unroll 1
    for (int it = 0; it < 2; ++it) {
        int bf = tid + 512 * it; asm volatile("" : "+v"(bf)); const int base = 17 * bf;
        cpx x[16];
#pragma unroll
        for (int m = 0; m < 16; ++m) x[m] = X[base + m];
        dft16<false>(x);
#pragma unroll
        for (int q = 0; q < 16; ++q) Kb[q * 1024 + bf] = x[SLOT16(q)] * (1.f / 16384.f);
    }
}
__device__ __forceinline__ void fft_kload1(cpx (&kq)[16], const cpx* Kb, int bf) {
#pragma unroll
    for (int q = 0; q < 16; ++q) { const unsigned long long kb = __hip_atomic_load((const unsigned long long*)(Kb + q * 1024 + bf), __ATOMIC_RELAXED, __HIP_MEMORY_SCOPE_AGENT);
        kq[q] = (cpx){__builtin_bit_cast(float, (unsigned)kb), __builtin_bit_cast(float, (unsigned)(kb >> 32))}; }
}
__device__ __forceinline__ void fft_fusedD_one(LAS cpx* X, const cpx (&kq)[16], int bf) {
    const int base = 17 * bf; cpx x[16], z[16];
#pragma unroll
    for (int m = 0; m < 16; ++m) x[m] = X[base + m];
    dft16<false>(x);
#pragma unroll
    for (int q = 0; q < 16; ++q) z[q] = cmul(x[SLOT16(q)], kq[q]);
    dft16<true>(z);
#pragma unroll
    for (int m = 0; m < 16; ++m) X[base + m] = z[SLOT16(m)];
}
__device__ __forceinline__ void fft_fusedD(LAS cpx* X, const cpx* Kb, int tid) {
    int bf = tid; asm volatile("" : "+v"(bf));
    cpx k0[16], k1[16];
    fft_kload1(k0, Kb, bf); fft_kload1(k1, Kb, bf + 512);
    fft_fusedD_one(X, k0, bf);
    fft_fusedD_one(X, k1, bf + 512);
}
struct Raw10 { u32x4 q; unsigned short l, r; };
__device__ __forceinline__ void load10_issue(Raw10& R, const bf16* row, int t0) {
    const int lane = threadIdx.x & 63; R.q = *(const u32x4*)(row + t0); R.l = 0; R.r = 0;
    if (lane == 0 && t0 > 0) R.l = row[t0 - 1];
    if (lane == 63 && t0 + 8 < SEQ) R.r = row[t0 + 8];
}
__device__ __forceinline__ void load10_finish(const Raw10& R, float (&pv)[10]) {
    const int lane = threadIdx.x & 63; const u32x4 q = R.q;
    pv[1] = bflo(q.x); pv[2] = bfhi(q.x); pv[3] = bflo(q.y); pv[4] = bfhi(q.y); pv[5] = bflo(q.z); pv[6] = bfhi(q.z); pv[7] = bflo(q.w); pv[8] = bfhi(q.w);
    float l = __shfl_up(pv[8], 1), r = __shfl_down(pv[1], 1);
    if (lane == 0) l = bf2f(R.l);
    if (lane == 63) r = bf2f(R.r);
    pv[0] = l; pv[9] = r;
}

struct ScanW { const bf16* prx; const bf16* grg; bf16* yrg; const float* rgcw; const float* rgcb; const bf16* wgt;
               const float* ba_f; const float* bx_f; const float* lam_f; const float* ba_b; const float* bx_b; const float* lam_b; f32x2* carr; const float* cin; };
__device__ __forceinline__ float neg_expm1_neg(float x) {
    return (x > -0.1f) ? -x * (1.f + x * 0.5f * (1.f + x * (1.f / 3.f) * (1.f + x * 0.25f * (1.f + x * 0.2f)))) : 1.f - __expf(x);
}
struct ScanPre { u32x4 p[4]; u32x4 gl; float cinv; };
template <int PASS>
__device__ __forceinline__ void scan_decode(int it, int& b, int& j, int& h) {
    h = it & 15; const int rest = it >> 4;
    if (PASS == 1) { j = rest % NCHUNK; b = rest / NCHUNK; } else { j = (rest & 127) + 4; b = rest >> 7; }
}
template <int PASS>
__device__ __forceinline__ void scan_prefetch(ScanPre& R, const ScanW& W, int it, int tid, int cidx_lane) {
    int b, j, h; scan_decode<PASS>(it, b, j, h);
    const int isctx = j < 4; const int seglen = isctx ? CTXL : SEQ; const int t0 = isctx ? j * 64 : (j - 4) * 64; const int rowbase = isctx ? NTOK + b * CTXL : b * SEQ;
    const int tok = tid >> 3, cg0 = h * 64 + (tid & 7) * 8;
#pragma unroll
    for (int jj = 0; jj < 4; ++jj) { const int tt = t0 + tok + jj - 2; R.p[jj] = (u32x4){0u, 0u, 0u, 0u};
        if (tt >= 0 && tt < seglen) R.p[jj] = *(const u32x4*)(W.prx + (size_t)(rowbase + tt) * 1024 + cg0); }
    R.cinv = 0.f;
    if (PASS == 2) { R.gl = *(const u32x4*)(W.grg + (size_t)(rowbase + t0 + tok) * 1024 + cg0); R.cinv = W.cin[(size_t)(b * NCHUNK + j) * 2048 + h * 64 + cidx_lane]; }
}
template <int PASS>
__device__ __forceinline__ void scan_phase(LAS unsigned char* lds, const ScanW& W, int first, int stride, int nitems, int tid, int lane, int wave) {
    LAS float* XCF = (LAS float*)lds;
    LAS bf16* XCB = (LAS bf16*)(lds + 16896);
    LAS float* HX = (LAS float*)(lds + 16896 + 9216);
    if (first >= nitems) return;
    const int dir = wave >> 2, eb = wave & 3, g = lane >> 4, li = lane & 15;
    const int tok = tid >> 3, e0 = (tid & 7) * 8;
    int hcur = -1;
    float cw[4][8], cb[8]; bf16x8 bR[2], bI[2]; float ba = 0.f, bx = 0.f, sp8 = 0.f, sp8l = 0.f, nba = 0.f, nbx = 0.f;
    const int cidx_lane = dir * 1024 + eb * 16 + li;
    ScanPre R; scan_prefetch<PASS>(R, W, first, tid, cidx_lane);
    u32x4 o_prev = {0u, 0u, 0u, 0u}; bf16* p_prev = nullptr; f32x2 c_prev = {0.f, 0.f}; f32x2* cp_prev = nullptr;
#pragma unroll 1
    for (int it = first; it < nitems; it += stride) {
        int b, j, h; scan_decode<PASS>(it, b, j, h);
        const int isctx = j < 4; const int t0 = isctx ? j * 64 : (j - 4) * 64; const int rowbase = isctx ? NTOK + b * CTXL : b * SEQ;
        const int ch = h * 64 + eb * 16 + li;
        const size_t cidx = ((size_t)(b * NCHUNK + j) * 2 + dir) * 1024 + ch;
        const float cinv = R.cinv;
        if (h != hcur) {
            hcur = h; const int cg0 = h * 64 + e0;
#pragma unroll
            for (int jj = 0; jj < 4; ++jj) { const f32x4 w0 = *(const f32x4*)(W.rgcw + jj * 1024 + cg0), w1 = *(const f32x4*)(W.rgcw + jj * 1024 + cg0 + 4);
                cw[jj][0] = w0[0]; cw[jj][1] = w0[1]; cw[jj][2] = w0[2]; cw[jj][3] = w0[3]; cw[jj][4] = w1[0]; cw[jj][5] = w1[1]; cw[jj][6] = w1[2]; cw[jj][7] = w1[3]; }
            { const f32x4 c0 = *(const f32x4*)(W.rgcb + cg0), c1 = *(const f32x4*)(W.rgcb + cg0 + 4); cb[0] = c0[0]; cb[1] = c0[1]; cb[2] = c0[2]; cb[3] = c0[3]; cb[4] = c1[0]; cb[5] = c1[1]; cb[6] = c1[2]; cb[7] = c1[3]; }
            const bf16* wp = W.wgt + ((size_t)((dir * 2) * 16 + h) * 64 + eb * 16 + li) * 64 + g * 8;
            bR[0] = *(const bf16x8*)(wp); bR[1] = *(const bf16x8*)(wp + 32); bI[0] = *(const bf16x8*)(wp + 16 * 4096); bI[1] = *(const bf16x8*)(wp + 16 * 4096 + 32);
            ba = (dir ? W.ba_b : W.ba_f)[ch]; bx = (dir ? W.bx_b : W.bx_f)[ch]; const float lam = (dir ? W.lam_b : W.lam_f)[ch];
            sp8 = -8.f * log1pf(__expf(-lam)); sp8l = sp8 * 1.4426950408889634f; nba = -ba * 1.4426950408889634f; nbx = -bx * 1.4426950408889634f;
        }
        {
            float xv[8];
#pragma unroll
            for (int q = 0; q < 8; ++q) xv[q] = cb[q];
#pragma unroll
            for (int jj = 0; jj < 4; ++jj) { const u32x4 p = R.p[jj];
                xv[0] += cw[jj][0] * bflo(p.x); xv[1] += cw[jj][1] * bfhi(p.x); xv[2] += cw[jj][2] * bflo(p.y); xv[3] += cw[jj][3] * bfhi(p.y);
                xv[4] += cw[jj][4] * bflo(p.z); xv[5] += cw[jj][5] * bfhi(p.z); xv[6] += cw[jj][6] * bflo(p.w); xv[7] += cw[jj][7] * bfhi(p.w); }
#pragma unroll
            for (int q = 0; q < 8; ++q) XCF[tok * 65 + e0 + q] = xv[q];
            *(LAS u32x4*)(XCB + tok * 72 + e0) = (u32x4){pk2(xv[0], xv[1]), pk2(xv[2], xv[3]), pk2(xv[4], xv[5]), pk2(xv[6], xv[7])};
        }
        const u32x4 gl = R.gl;
        if (it + stride < nitems) scan_prefetch<PASS>(R, W, it + stride, tid, cidx_lane);
        if (PASS == 2) { if (p_prev) *(u32x4*)p_prev = o_prev; } else { if (cp_prev) *cp_prev = c_prev; }
        LDS_BARRIER();
        f32x4 aR[4], aI[4];
#pragma unroll
        for (int mb = 0; mb < 4; ++mb) { aR[mb] = (f32x4){0.f, 0.f, 0.f, 0.f}; aI[mb] = (f32x4){0.f, 0.f, 0.f, 0.f};
            const int trow = 16 * (li >> 2) + 4 * mb + (li & 3);
#pragma unroll
            for (int ks = 0; ks < 2; ++ks) { const bf16x8 af = *(const LAS bf16x8*)(XCB + trow * 72 + ks * 32 + g * 8);
                aR[mb] = __builtin_amdgcn_mfma_f32_16x16x32_bf16(af, bR[ks], aR[mb], 0, 0, 0); aI[mb] = __builtin_amdgcn_mfma_f32_16x16x32_bf16(af, bI[ks], aI[mb], 0, 0, 0); } }
        float av[16], bv[16];
#pragma unroll
        for (int mb = 0; mb < 4; ++mb)
#pragma unroll
            for (int r = 0; r < 4; ++r) { const int tk = 16 * g + 4 * mb + r; const float xcv = XCF[tk * 65 + eb * 16 + li];
                const float rr = __builtin_amdgcn_rcpf(1.f + __builtin_amdgcn_exp2f(__builtin_fmaf(aR[mb][r], -1.4426950408889634f, nba)));
                const float ii = __builtin_amdgcn_rcpf(1.f + __builtin_amdgcn_exp2f(__builtin_fmaf(aI[mb][r], -1.4426950408889634f, nbx)));
                const float a = __builtin_amdgcn_exp2f(sp8l * rr); const float om = (1.f - a) * (1.f + a);
                av[4 * mb + r] = a; bv[4 * mb + r] = __builtin_amdgcn_sqrtf(om) * ii * xcv; }
        float A16 = 1.f, B16 = 0.f;
        if (dir == 0) {
#pragma unroll
            for (int q = 0; q < 16; ++q) { B16 = av[q] * B16 + bv[q]; A16 *= av[q]; }
        } else {
#pragma unroll
            for (int q = 15; q >= 0; --q) { B16 = av[q] * B16 + bv[q]; A16 *= av[q]; }
        }
        float Pc = 1.f, Hc = cinv, hin;
        {
            LAS float* chn = (LAS float*)(lds + 60928) + wave * 128 + li * 8;
            *(LAS f32x2*)(chn + g * 2) = (f32x2){A16, B16};
            LDS_WAIT(); asm volatile("" ::: "memory");
            const f32x4 c01 = *(const LAS f32x4*)(chn), c23 = *(const LAS f32x4*)(chn + 4);
            LDS_WAIT(); asm volatile("" ::: "memory");
            const float Ag[4] = {c01[0], c01[2], c23[0], c23[2]}, Bg[4] = {c01[1], c01[3], c23[1], c23[3]};
            hin = Hc;
#pragma unroll
            for (int k = 0; k < 4; ++k) { const int gk = (dir == 0) ? k : 3 - k;
                const bool before = (dir == 0) ? (gk < g) : (gk > g);
                const float Hn = Ag[gk] * Hc + Bg[gk]; Pc *= Ag[gk]; Hc = Hn; if (before) hin = Hn; }
        }
        if (PASS == 1) {
            cp_prev = (g == 0) ? (W.carr + cidx) : nullptr; c_prev = (f32x2){Pc, Hc};
            LDS_BARRIER();
        } else {
            LAS float* hx = HX + dir * (64 * 68) + (16 * g) * 68 + eb * 16 + li; float H = hin;
            if (dir == 0) {
#pragma unroll
                for (int q = 0; q < 16; ++q) { H = av[q] * H + bv[q]; hx[q * 68] = H; }
            } else {
#pragma unroll
                for (int q = 15; q >= 0; --q) { H = av[q] * H + bv[q]; hx[q * 68] = H; }
            }
            LDS_BARRIER();
            const f32x4 f0 = *(const LAS f32x4*)(HX + tok * 68 + e0), f1 = *(const LAS f32x4*)(HX + tok * 68 + e0 + 4);
            const f32x4 g0 = *(const LAS f32x4*)(HX + 64 * 68 + tok * 68 + e0), g1 = *(const LAS f32x4*)(HX + 64 * 68 + tok * 68 + e0 + 4);
            u32x4 o; o.x = pk2((f0[0] + g0[0]) * bflo(gl.x), (f0[1] + g0[1]) * bfhi(gl.x)); o.y = pk2((f0[2] + g0[2]) * bflo(gl.y), (f0[3] + g0[3]) * bfhi(gl.y));
            o.z = pk2((f1[0] + g1[0]) * bflo(gl.z), (f1[1] + g1[1]) * bfhi(gl.z)); o.w = pk2((f1[2] + g1[2]) * bflo(gl.w), (f1[3] + g1[3]) * bfhi(gl.w));
            o_prev = o; p_prev = W.yrg + (size_t)(rowbase + t0 + tok) * 1024 + h * 64 + e0;
        }
    }
    if (PASS == 2) { if (p_prev) *(u32x4*)p_prev = o_prev; } else { if (cp_prev) *cp_prev = c_prev; }
}

#define XB_TMO      128
#define XB_XCNT(j)  (256  + 64 * (j))
#define XB_XSUB(j)  (1280 + 64 * (j))
#define XB_XGEN(j)  (2304 + 64 * (j))
#define XB_TOP      3328
#define XB_TOPGEN   3392
#define XCD_BAR_WORDS 3456
#define XB_SPIN_CAP (1u << 18)
__device__ __forceinline__ unsigned xb_ld(unsigned* p)              { return __hip_atomic_load(p, __ATOMIC_RELAXED, __HIP_MEMORY_SCOPE_AGENT); }
__device__ __forceinline__ unsigned xb_add(unsigned* p, unsigned v) { return __hip_atomic_fetch_add(p, v, __ATOMIC_RELAXED, __HIP_MEMORY_SCOPE_AGENT); }
__device__ __forceinline__ unsigned xb_xcc_id() { return (unsigned)__builtin_amdgcn_s_getreg((3 << 11) | 20) & 0xFu; }
#define XB_SPIN(cond, bar) do { unsigned _sp = 0; while (cond) { __builtin_amdgcn_s_sleep(1); \
    if ((++_sp & 255u) == 0u) { if (xb_ld(&(bar)[XB_TMO])) break; if (_sp > XB_SPIN_CAP) { atomicAdd(&(bar)[XB_TMO], 1u); break; } } } } while (0)
struct XcdBarrier { unsigned* bar; unsigned x; volatile LAS unsigned* st; };
__device__ __forceinline__ void xcd_barrier_complete(unsigned* bar, unsigned x, unsigned& nloc, unsigned& nx) {
    const unsigned Gn = gridDim.x * gridDim.y * gridDim.z;
    unsigned sum, cntx, mine, sp = 0u;
    for (;;) {
        sum = 0u; cntx = 0u; mine = 0u;
#pragma unroll
        for (unsigned j = 0; j < 16; ++j) { const unsigned c = xb_ld(&bar[XB_XCNT(j)]); sum += c; cntx += (c > 0u) ? 1u : 0u; mine = (j == x) ? c : mine; }
        if (sum == Gn) break;
        __builtin_amdgcn_s_sleep(1);
        if ((++sp & 255u) == 0u) { if (xb_ld(&bar[XB_TMO])) break; if (sp > XB_SPIN_CAP) { atomicAdd(&bar[XB_TMO], 1u); break; } }
    }
    nloc = mine > 0u ? mine : 1u; nx = cntx > 0u ? cntx : 1u;
}
__device__ __forceinline__ void xcd_barrier(const XcdBarrier& b) {
    asm volatile("s_waitcnt vmcnt(0)" ::: "memory");
    __syncthreads();
    if (threadIdx.x == 0) {
        unsigned* bar = b.bar;
        __builtin_amdgcn_s_waitcnt(0);
        unsigned nloc = b.st[0], nx = b.st[1];
        if (nloc == 0u) { xcd_barrier_complete(bar, b.x, nloc, nx); b.st[0] = nloc; b.st[1] = nx; }
        const unsigned old = xb_add(&bar[XB_XSUB(b.x)], 1u);
        const unsigned gen = old / nloc;
        if (old + 1u == (gen + 1u) * nloc) {
            __builtin_amdgcn_fence(__ATOMIC_RELEASE, "agent");
            asm volatile("s_waitcnt vmcnt(0)" ::: "memory");
            const unsigned og = xb_add(&bar[XB_TOP], 1u);
            const unsigned tg = og / nx;
            if (og + 1u == (tg + 1u) * nx) xb_add(&bar[XB_TOPGEN], 1u);
            else XB_SPIN(xb_ld(&bar[XB_TOPGEN]) == tg, bar);
            __builtin_amdgcn_fence(__ATOMIC_ACQUIRE, "agent");
            xb_add(&bar[XB_XGEN(b.x)], 1u);
            asm volatile("s_waitcnt vmcnt(0)" ::: "memory");
        } else {
            XB_SPIN(xb_ld(&bar[XB_XGEN(b.x)]) == gen, bar);
            __builtin_amdgcn_fence(__ATOMIC_ACQUIRE, "agent");
            asm volatile("s_waitcnt vmcnt(0)" ::: "memory");
        }
    }
    __syncthreads();
}

__device__ __forceinline__ void transpose_item(const float* W, int K, int N, bf16* WT, int mode, LAS float* scr, int item, int lane) {
    const int nblk = N / 64, kb = item / nblk, nb = item % nblk, k0 = 64 * kb, n0 = 64 * nb;
    const int lr = lane >> 4, lc = (lane & 15) * 4;
    f32x4 v[16];
#pragma unroll
    for (int i = 0; i < 16; ++i) v[i] = __builtin_nontemporal_load((const f32x4*)(W + (size_t)(k0 + 4 * i + lr) * N + n0 + lc));
#pragma unroll
    for (int i = 0; i < 16; ++i) { LAS float* d = scr + (4 * i + lr) * 65 + lc; d[0] = v[i][0]; d[1] = v[i][1]; d[2] = v[i][2]; d[3] = v[i][3]; }
    LDS_WAIT(); asm volatile("" ::: "memory");
    const int c = lane & 7;
#pragma unroll
    for (int j = 0; j < 8; ++j) { const int n = (lane >> 3) + 8 * j; const LAS float* sp = scr + (8 * c) * 65 + n;
        u32x4 o; o.x = pk2(sp[0 * 65], sp[1 * 65]); o.y = pk2(sp[2 * 65], sp[3 * 65]); o.z = pk2(sp[4 * 65], sp[5 * 65]); o.w = pk2(sp[6 * 65], sp[7 * 65]);
        const int nn = n0 + n; int row;
        if (mode == 0) row = nn;
        else if (mode == 1) row = (nn >> 7) * 256 + (nn & 127);
        else row = (nn >> 7) * 256 + 128 + (nn & 127);
        *(u32x4*)(WT + (size_t)row * K + k0 + 8 * c) = o; }
    LDS_WAIT(); asm volatile("" ::: "memory");
}

struct Args { const float* in[41]; float* out; unsigned char* ws; int ph_lo, ph_hi; };

enum { I_X = 0, I_C, I_CTX, I_CCTX, I_ADAW, I_ADAB, I_N1G, I_N2G, I_FG, I_WIN, I_RGCW, I_RGCB, I_WAF, I_BAF, I_WXF, I_BXF, I_LAMF, I_WAB, I_BAB, I_WXB, I_BXB, I_LAMB,
       I_RGPROJ, I_HYCW, I_HYCB, I_PW1, I_PB1, I_PW2, I_PB2, I_FREQ, I_PW3, I_SKIP, I_HYPROJ, I_WOUT, I_WG, I_BG, I_WE, I_BE, I_MW1, I_MW3, I_MW2 };

constexpr int NPHASE = 13;

__global__ void __launch_bounds__(NTHREADS, 2) fwd_kernel(Args args) {
    extern __shared__ __attribute__((aligned(16))) unsigned char lds_raw[];
    LAS unsigned char* lds = (LAS unsigned char*)lds_raw;
    const int tid = threadIdx.x, lane = tid & 63, wave = __builtin_amdgcn_readfirstlane(tid >> 6);
    const int G = gridDim.x, bid = blockIdx.x;
    const int gw = bid * NWAVES + wave, NGW = G * NWAVES;
    unsigned char* ws = args.ws;
    const int lo = args.ph_lo, hi = args.ph_hi;
#define IN(k) (lo <= (k) && (k) < hi)
#if ONE_LAUNCH
    cg::grid_group grid = cg::this_grid();
#define GRID_SYNC(k) do { if (IN(k) && IN((k) + 1)) { if ((k) == 0) { grid.sync(); if (tid == 0) (void)xb_add(&xbar.bar[XB_XCNT(xbar.x)], 1u); } \
        else { xcd_barrier(xbar); if (REPN(99) == 2) xcd_barrier(xbar); } \
        if (PROBE_TS >= 0 && bid == 0 && tid == 0) tsbuf[(k) + 1] = __builtin_amdgcn_s_memrealtime(); } } while (0)
#else
#define GRID_SYNC(k) do { } while (0)
#endif
    int* cnt = (int*)(ws + WS_CTL);
    unsigned long long* tsbuf = (unsigned long long*)(ws + WS_CTL + 65536);
    if (PROBE_TS >= 0 && bid == 0 && tid == 0) tsbuf[0] = __builtin_amdgcn_s_memrealtime();
    XcdBarrier xbar; xbar.bar = (unsigned*)(ws + WS_CTL) + 4096; xbar.x = xb_xcc_id(); xbar.st = (volatile LAS unsigned*)(lds + LDS_BYTES - 64);
    if (tid < 2) xbar.st[tid] = 0u;
    __syncthreads();
    float* mod = (float*)(ws + WS_MOD);
    float* z2 = (float*)(ws + WS_Z2);
    float* ssq = (float*)(ws + WS_SSQ);
    int* tok_e = (int*)(ws + WS_ROUTE); int* tok_rank = tok_e + 2 * NTOK; float* tok_w = (float*)(tok_rank + 2 * NTOK); int* tok_slot = (int*)(tok_w + 2 * NTOK);
    bf16* rgproj_t = (bf16*)(ws + WS_WSMALL); bf16* hyproj_t = rgproj_t + 1024 * 1024; bf16* wout_t = hyproj_t + 1024 * 1024;
    bf16* win_t = (bf16*)(ws + WS_WIN);
    bf16* hx = (bf16*)(ws + WS_HX); bf16* yhy = (bf16*)(ws + WS_HX); bf16* Hbuf = (bf16*)(ws + WS_HX);
    bf16* prx = (bf16*)(ws + WS_PRX); bf16* merged = (bf16*)(ws + WS_PRX);
    bf16* grg = (bf16*)(ws + WS_GRG); bf16* hx2 = (bf16*)(ws + WS_GRG);
    bf16* phyT = (bf16*)(ws + WS_PHY);
    bf16* w13t = (bf16*)(ws + WS_W13); bf16* w2t = (bf16*)(ws + WS_W2);
    bf16* Xg = (bf16*)(ws + WS_XG); bf16* Ybuf = (bf16*)(ws + WS_XG);
    float* kf = (float*)(ws + WS_KF); bf16* yrg = (bf16*)(ws + WS_KF);
    f32x2* carr = (f32x2*)(ws + WS_CARR); float* cin = (float*)(ws + WS_CIN);
    bf16* gates = (bf16*)args.out;
    float* x1 = args.out;

    if (IN(0)) for (int rp = 0; rp < REPN(0); ++rp) {
        if (bid == 0) for (int i = tid; i < 1024; i += NTHREADS) cnt[i] = 0;
        if (bid == 0) for (int i = tid; i < XCD_BAR_WORDS; i += NTHREADS) xbar.bar[i] = 0u;
        const int nA = (G >= 192) ? 96 : 0; const bool doA = (nA == 0) || (bid < nA), doB = (nA == 0) || (bid >= nA);
        const int ob = bid - nA, OG = G - nA, ogw = ob * NWAVES + wave, ONGW = OG * NWAVES;
        if (doA) {
            LAS float* red = (LAS float*)lds;
            const float* c = args.in[I_C]; const float* cctx = args.in[I_CCTX]; const float* ada_w = args.in[I_ADAW]; const float* ada_b = args.in[I_ADAB];
            LAS float* sil = red + 8 * 5 * 64;
            for (int i = tid; i < 5 * 1024; i += NTHREADS) { const float cv = (i < 4096) ? c[i] : cctx[i - 4096]; sil[i] = cv * sigmoidf_(cv); }
            __syncthreads();
            for (int g = bid; g < 96; g += (nA ? nA : G)) {
                const int n = g * 64 + lane; float acc[5] = {0.f, 0.f, 0.f, 0.f, 0.f};
                for (int kk = 0; kk < 128; kk += 16) { float a[16];
#pragma unroll
                    for (int u = 0; u < 16; ++u) a[u] = __builtin_nontemporal_load(ada_w + (size_t)(wave * 128 + kk + u) * 6144 + n);
#pragma unroll
                    for (int u = 0; u < 16; ++u) { const int k = wave * 128 + kk + u;
#pragma unroll
                        for (int r = 0; r < 5; ++r) acc[r] += sil[r * 1024 + k] * a[u]; } }
#pragma unroll
                for (int r = 0; r < 5; ++r) red[(wave * 5 + r) * 64 + lane] = acc[r];
                __syncthreads();
                if (wave == 0) {
#pragma unroll
                    for (int r = 0; r < 5; ++r) { float s = ada_b[n]; for (int w = 0; w < 8; ++w) s += red[(w * 5 + r) * 64 + lane]; mod[r * 6144 + n] = s; } }
                __syncthreads();
            }
        }
        if (doB) {
            LAS float* fe = (LAS float*)lds + wave * 128; LAS float* z1 = fe + 64;
            const float* w1 = args.in[I_PW1]; const float* b1 = args.in[I_PB1]; const float* w2 = args.in[I_PW2]; const float* b2 = args.in[I_PB2]; const float* fr = args.in[I_FREQ];
            const float TWO_PI = 6.283185307179586f;
            float w1c[50], w2c[64];
#pragma unroll
            for (int i = 0; i < 50; ++i) w1c[i] = w1[i * 64 + lane];
#pragma unroll
            for (int i = 0; i < 64; ++i) w2c[i] = w2[i * 64 + lane];
            const float b1l = b1[lane], b2l = b2[lane], frl = fr[lane];
            for (int s = ogw; s < SEQ; s += ONGW) {
                float f = 0.f; const float sf = (float)s;
                if (lane == 0) f = sf / 8191.f;
                else if (lane <= 32) { const int j = (lane - 1) & 15; const float band = 1e-4f + (float)j * ((15.f - 1e-4f) / 15.f); float rev = sf * band * (1.f / 8192.f); rev -= floorf(rev + 0.5f);
                    f = (lane <= 16) ? cosf(TWO_PI * rev) : sinf(TWO_PI * rev); }
                else if (lane == 33) f = (float)(s >> 6) / 128.f;
                else if (lane <= 49) { const int mm = (lane <= 41) ? (lane - 33) : (lane - 41); float rev = (float)((s & 63) * mm) * (1.f / 64.f); rev -= floorf(rev + 0.5f);
                    f = (lane <= 41) ? cosf(TWO_PI * rev) : sinf(TWO_PI * rev); }
                fe[lane] = f; LDS_WAIT(); asm volatile("" ::: "memory");
                float a = b1l;
#pragma unroll
                for (int i = 0; i < 50; ++i) a += fe[i] * w1c[i];
                z1[lane] = sinf(frl * a); LDS_WAIT(); asm volatile("" ::: "memory");
                float a2 = b2l;
#pragma unroll
                for (int i = 0; i < 64; ++i) a2 += z1[i] * w2c[i];
                z2[(size_t)s * 64 + lane] = sinf(frl * a2);
                LDS_WAIT(); asm volatile("" ::: "memory");
            }
        }
        __syncthreads();
        if (doB) {
            LAS float* scr = (LAS float*)lds + wave * 4160;
            constexpr int I_IN = 16 * 112, I_SQ = 16 * 16;
            constexpr int NITEMS = I_IN + 3 * I_SQ;
            for (int it = ogw; it < NITEMS; it += ONGW) {
                int r = it;
                if (r < I_IN) { transpose_item(args.in[I_WIN], 1024, INC, win_t, 0, scr, r, lane); continue; } r -= I_IN;
                if (r < I_SQ) { transpose_item(args.in[I_RGPROJ], 1024, 1024, rgproj_t, 0, scr, r, lane); continue; } r -= I_SQ;
                if (r < I_SQ) { transpose_item(args.in[I_HYPROJ], 1024, 1024, hyproj_t, 0, scr, r, lane); continue; } r -= I_SQ;
                transpose_item(args.in[I_WOUT], 1024, 1024, wout_t, 0, scr, r, lane);
            }
        }
        if (doB) {
            bf16* wrh = (bf16*)(ws + 28 * MiB); bf16* wrl = wrh + 48 * 1024;
            for (int i = ob * NTHREADS + tid; i < 48 * 1024; i += OG * NTHREADS) { const int n = i >> 10, k = i & 1023;
                const float w = (n < 4) ? args.in[I_WG][k * 4 + n] : (n < 36) ? args.in[I_WE][k * 32 + (n - 4)] : 0.f;
                const unsigned h = pk2(w, 0.f) & 0xffffu; wrh[i] = (bf16)h; wrl[i] = (bf16)(pk2(w - bf2f(h), 0.f) & 0xffffu); }
        }
        if (doB) {
            bf16* wgt = (bf16*)(ws + WS_GATEW);
            for (int i = ob * NTHREADS + tid; i < 4 * 65536; i += OG * NTHREADS) { const int gi = i >> 16, r = i & 65535, hh = r >> 12, e = (r >> 6) & 63, d = r & 63;
                const float* src = gi == 0 ? args.in[I_WAF] : gi == 1 ? args.in[I_WXF] : gi == 2 ? args.in[I_WAB] : args.in[I_WXB];
                wgt[i] = (bf16)f2bf(src[hh * 4096 + d * 64 + e]); }
        }
    }
    GRID_SYNC(0);

    if (IN(1)) for (int rp = 0; rp < REPN(1); ++rp) {
        const float* x = args.in[I_X]; const float* ctx = args.in[I_CTX]; const float* n1g = args.in[I_N1G];
        f32x4 n1v[4];
#pragma unroll
        for (int j = 0; j < 4; ++j) n1v[j] = *(const f32x4*)(n1g + 4 * (64 * j + lane));
        for (int m0 = 2 * gw; m0 < MROWS; m0 += 2 * NGW) {
            f32x4 v[2][4]; float ss[2] = {0.f, 0.f};
#pragma unroll
            for (int u = 0; u < 2; ++u) { const int m = m0 + u; const float* xr = (m < NTOK) ? x + (size_t)m * 1024 : ctx + (size_t)(m - NTOK) * 1024;
#pragma unroll
                for (int j = 0; j < 4; ++j) v[u][j] = __builtin_nontemporal_load((const f32x4*)xr + 64 * j + lane); }
#pragma unroll
            for (int u = 0; u < 2; ++u)
#pragma unroll
                for (int j = 0; j < 4; ++j) ss[u] += (v[u][j][0] * v[u][j][0] + v[u][j][1] * v[u][j][1]) + (v[u][j][2] * v[u][j][2] + v[u][j][3] * v[u][j][3]);
#pragma unroll
            for (int u = 0; u < 2; ++u) { const int m = m0 + u; const int r = (m < NTOK) ? (m >> 13) : 4; const float* sh = mod + r * 6144; const float* sc = sh + 1024;
                const float rstd = rsqrtf(wave_sum(ss[u]) * (1.f / 1024.f) + 1e-6f);
#pragma unroll
                for (int j = 0; j < 4; ++j) { const int k = 4 * (64 * j + lane); const f32x4 g = n1v[j], s_ = *(const f32x4*)(sc + k), h = *(const f32x4*)(sh + k);
                    const f32x4 o = v[u][j] * rstd * g * (1.f + s_) + h; *(u32x2*)(hx + (size_t)m * 1024 + k) = pack4(o); } }
        }
        {
            LAS float* w3s = (LAS float*)lds;
            LAS float* z2t = w3s + 64 * 256;
            const float* w3 = args.in[I_PW3];
            const int sg = tid & 7, cgp = tid >> 3;
            int c0cur = -1;
            for (int it = bid; it < 8 * 128; it += G) {
                const int s0 = (it >> 3) * 64, c0 = (it & 7) * 256;
                __syncthreads();
                for (int e = tid; e < 64 * 64; e += NTHREADS) { const int r = e >> 6, jj = e & 63; z2t[jj * 68 + r] = z2[(size_t)(s0 + r) * 64 + jj]; }
                if (c0 != c0cur) { c0cur = c0;
                    for (int e = tid; e < 64 * 64; e += NTHREADS) { const int jj = e >> 6, c4 = e & 63; *(LAS f32x4*)(w3s + jj * 256 + 4 * c4) = *(const f32x4*)(w3 + (size_t)jj * 2048 + c0 + 4 * c4); } }
                __syncthreads();
                float acc[4][8];
#pragma unroll
                for (int a = 0; a < 4; ++a)
#pragma unroll
                    for (int q = 0; q < 8; ++q) acc[a][q] = 0.f;
#pragma unroll 4
                for (int jj = 0; jj < 64; ++jj) { const f32x4 w = *(const LAS f32x4*)(w3s + jj * 256 + 4 * cgp); const f32x4 za = *(const LAS f32x4*)(z2t + jj * 68 + 8 * sg), zb = *(const LAS f32x4*)(z2t + jj * 68 + 8 * sg + 4);
#pragma unroll
                    for (int a = 0; a < 4; ++a) { acc[a][0] += w[a] * za[0]; acc[a][1] += w[a] * za[1]; acc[a][2] += w[a] * za[2]; acc[a][3] += w[a] * za[3];
                        acc[a][4] += w[a] * zb[0]; acc[a][5] += w[a] * zb[1]; acc[a][6] += w[a] * zb[2]; acc[a][7] += w[a] * zb[3]; } }
                const float mind = -3.0701134573253944f, maxd = -15.350567286626972f;
#pragma unroll
                for (int a = 0; a < 4; ++a) { const int cp = c0 + 4 * cgp + a, ch = cp & 1023; const float delta = fabsf(mind + (float)ch * ((maxd - mind) / 1023.f));
                    f32x4 o0, o1;
#pragma unroll
                    for (int q = 0; q < 4; ++q) { o0[q] = acc[a][q] * __expf(-((float)(s0 + 8 * sg + q) / 8191.f) * delta); o1[q] = acc[a][4 + q] * __expf(-((float)(s0 + 8 * sg + 4 + q) / 8191.f) * delta); }
                    st_nt((f32x4*)(kf + (size_t)cp * SEQ + s0 + 8 * sg), o0); st_nt((f32x4*)(kf + (size_t)cp * SEQ + s0 + 8 * sg + 4), o1); }
            }
        }
    }
    GRID_SYNC(1);

    if (IN(2)) {
        { SchedInA S{(const char*)hx, (const char*)win_t, G, bid}; EpiInA E{prx, grg, gates}; pg8::gemm_phase(lds, 1024, S, E); }
        { SchedInB S{(const char*)hx, (const char*)win_t, G, bid}; EpiInB E{phyT}; pg8::gemm_phase(lds, 1024, S, E); }
    }
    GRID_SYNC(2);

    const ScanW SW{prx, grg, yrg, args.in[I_RGCW], args.in[I_RGCB], (const bf16*)(ws + WS_GATEW), args.in[I_BAF], args.in[I_BXF], args.in[I_LAMF], args.in[I_BAB], args.in[I_BXB], args.in[I_LAMB], carr, cin};
    if (IN(3)) {
        for (int rp = 0; rp < REPN(3); ++rp) scan_phase<1>(lds, SW, bid, G, NBATCH * NCHUNK * 16, tid, lane, wave);
        __syncthreads();
        {
            LAS cpx* X = (LAS cpx*)lds;
            LAS cpx* TWA = (LAS cpx*)(lds + 139264); LAS cpx* TWB = TWA + 512;
            for (int i = tid; i < 512 + 16; i += NTHREADS) { const float fr_ = (i < 512) ? (float)i * (1.f / 8192.f) : (float)(i - 512) * (1.f / 256.f);
                float sn, cs; sincospif(-fr_, &sn, &cs); TWA[i] = (cpx){cs, sn}; }
            __syncthreads();
            cpx* Kb = (cpx*)(ws + WS_HX) + (size_t)bid * 16384;
            unsigned* SX = (unsigned*)(ws + WS_HX + 32 * MiB) + (size_t)bid * 16384;
            const float* hcw = args.in[I_HYCW]; const float* hcb = args.in[I_HYCB]; const float* skip = args.in[I_SKIP];
            for (int rp = 0; rp < REPN(30); ++rp)
            for (int c = bid; c < 1024; c += G) {
                LDS_BARRIER();
                fft_fwd32A_filter(X, TWA, kf + (size_t)c * SEQ, kf + (size_t)(1024 + c) * SEQ, tid); LDS_BARRIER();
                fft_fwd32B(X, TWB, tid); LDS_BARRIER();
                fft_fwdD_toK(X, Kb, tid);
                const float w00 = hcw[c], w01 = hcw[3072 + c], w02 = hcw[6144 + c], b0 = hcb[c];
                const float w10 = hcw[1024 + c], w11 = hcw[3072 + 1024 + c], w12 = hcw[6144 + 1024 + c], b1 = hcb[1024 + c];
                const float w20 = hcw[2048 + c], w21 = hcw[3072 + 2048 + c], w22 = hcw[6144 + 2048 + c], b2 = hcb[2048 + c];
                const float sk = skip[c];
                for (int pair = 0; pair < 2; ++pair) {
                    const bf16* rA = phyT + ((size_t)(2 * pair) * 3072 + c) * SEQ; const bf16* rB = rA + (size_t)3072 * SEQ;
                    if (pair == 0) __syncthreads(); else LDS_BARRIER();
                    { int tb = tid; asm volatile("" : "+v"(tb));
                        Raw10 ra[2][6];
#pragma unroll
                        for (int it = 0; it < 2; ++it) { const int t0 = 8 * (tb + 512 * it);
                            load10_issue(ra[it][0], rA, t0); load10_issue(ra[it][1], rA + (size_t)1024 * SEQ, t0); load10_issue(ra[it][2], rA + (size_t)2048 * SEQ, t0);
                            load10_issue(ra[it][3], rB, t0); load10_issue(ra[it][4], rB + (size_t)1024 * SEQ, t0); load10_issue(ra[it][5], rB + (size_t)2048 * SEQ, t0); }
#pragma unroll
                        for (int it = 0; it < 2; ++it) { const int t0 = 8 * (tb + 512 * it); float p0[10], p1[10], p2[10], ua[8], ub[8]; unsigned qa[8], qb[8];
                            load10_finish(ra[it][0], p0); load10_finish(ra[it][1], p1); load10_finish(ra[it][2], p2);
#pragma unroll
                            for (int k = 0; k < 8; ++k) { ua[k] = (b2 + w20 * p2[k] + w21 * p2[k + 1] + w22 * p2[k + 2]) * (b1 + w10 * p1[k] + w11 * p1[k + 1] + w12 * p1[k + 2]);
                                const float x0 = b0 + w00 * p0[k] + w01 * p0[k + 1] + w02 * p0[k + 2]; qa[k] = pk2(x0, sk * ua[k] * x0); }
                            load10_finish(ra[it][3], p0); load10_finish(ra[it][4], p1); load10_finish(ra[it][5], p2);
#pragma unroll
                            for (int k = 0; k < 8; ++k) { ub[k] = (b2 + w20 * p2[k] + w21 * p2[k + 1] + w22 * p2[k + 2]) * (b1 + w10 * p1[k] + w11 * p1[k + 1] + w12 * p1[k + 2]);
                                const float x0 = b0 + w00 * p0[k] + w01 * p0[k + 1] + w02 * p0[k + 2]; qb[k] = pk2(x0, sk * ub[k] * x0); }
                            *(u32x4*)(SX + t0) = (u32x4){qa[0], qa[1], qa[2], qa[3]}; *(u32x4*)(SX + t0 + 4) = (u32x4){qa[4], qa[5], qa[6], qa[7]};
                            *(u32x4*)(SX + SEQ + t0) = (u32x4){qb[0], qb[1], qb[2], qb[3]}; *(u32x4*)(SX + SEQ + t0 + 4) = (u32x4){qb[4], qb[5], qb[6], qb[7]};
                            const int pb = pidx(t0);
#pragma unroll
                            for (int k = 0; k < 8; ++k) X[pb + k] = (cpx){ua[k], ub[k]}; } }
                    LDS_BARRIER();
                    fft_fwd32A<16>(X, TWA, tid); LDS_BARRIER();
                    fft_fwd32B(X, TWB, tid); LDS_BARRIER();
                    fft_fusedD(X, Kb, tid); LDS_BARRIER();
                    fft_inv32B(X, TWB, tid); __syncthreads();
                    fft_inv32A_final(X, TWA, tid, SX, (bf16*)rA, (bf16*)rB, rp == REPN(30) - 1);
                }
            }
        }
    }
    GRID_SYNC(3);

    if (IN(4)) for (int rp = 0; rp < REPN(4); ++rp) {
        const int gt = bid * NTHREADS + tid;
        if (gt < NBATCH * 2 * 1024) {
            const int c = gt & 1023, dir = (gt >> 10) & 1, b = gt >> 11; float s_ = 0.f;
            const size_t cbase = (size_t)(b * NCHUNK) * 2048 + dir * 1024 + c;
#pragma unroll 1
            for (int q0 = 0; q0 < NCHUNK; q0 += 33) { f32x2 ab[33];
#pragma unroll
                for (int u = 0; u < 33; ++u) { const int q = q0 + u; const int j = dir == 0 ? q : (q < 4 ? 3 - q : NCHUNK + 3 - q); ab[u] = __builtin_nontemporal_load(carr + cbase + (size_t)j * 2048); }
#pragma unroll
                for (int u = 0; u < 33; ++u) { const int q = q0 + u; const int j = dir == 0 ? q : (q < 4 ? 3 - q : NCHUNK + 3 - q); cin[cbase + (size_t)j * 2048] = s_; s_ = ab[u].x * s_ + ab[u].y; } }
        }
    }
    GRID_SYNC(4);

    if (IN(5)) {
        for (int rp = 0; rp < REPN(5); ++rp) scan_phase<2>(lds, SW, bid, G, NBATCH * 128 * 16, tid, lane, wave);
        __syncthreads();
        {
            LAS bf16* T = (LAS bf16*)lds;
            for (int rp = 0; rp < REPN(50); ++rp)
            for (int it = bid; it < NBATCH * 16 * 32; it += G) {
                const int tb4 = it & 31, cb = (it >> 5) & 15, b = it >> 9;
                const int cl = tid >> 3, ch = tid & 7;
                u32x4 v[4];
#pragma unroll
                for (int q = 0; q < 4; ++q) v[q] = __builtin_nontemporal_load((const u32x4*)(phyT + ((size_t)b * 3072 + cb * 64 + cl) * SEQ + (tb4 * 4 + q) * 64 + ch * 8));
                __syncthreads();
#pragma unroll
                for (int q = 0; q < 4; ++q) *(LAS u32x4*)(T + q * 4608 + cl * 72 + ch * 8) = v[q];
                __syncthreads();
#pragma unroll
                for (int q = 0; q < 4; ++q) { const int tl = tid >> 3; unsigned w[8];
#pragma unroll
                    for (int e = 0; e < 8; ++e) w[e] = T[q * 4608 + (ch * 8 + e) * 72 + tl];
                    u32x4 o; o.x = w[0] | (w[1] << 16); o.y = w[2] | (w[3] << 16); o.z = w[4] | (w[5] << 16); o.w = w[6] | (w[7] << 16);
                    *(u32x4*)(yhy + (size_t)(b * SEQ + (tb4 * 4 + q) * 64 + tl) * 1024 + cb * 64 + ch * 8) = o; }
            }
        }
    }
    GRID_SYNC(5);

    if (IN(6)) for (int rp = 0; rp < REPN(6); ++rp) {
        SchedMerge S{(const char*)yrg, (const char*)yhy, (const char*)rgproj_t, (const char*)hyproj_t, G, bid}; EpiMerge E{gates, merged};
        pg8::gemm_phase(lds, 1024, S, E);
    }
    GRID_SYNC(6);

    if (IN(7)) {
        SchedOut S{(const char*)merged, (const char*)wout_t, G, bid}; EpiOut E{args.in[I_X], mod, x1, ssq};
        pg8::gemm_phase(lds, 1024, S, E);
    }
    GRID_SYNC(7);

    if (IN(8)) {
        {
            LAS bf16* XH = (LAS bf16*)lds;
            LAS bf16* XL = XH + 128 * 72;
            LAS bf16* WH = XL + 128 * 72;
            LAS bf16* WLo = WH + 48 * 72;
            LAS float* LG = (LAS float*)(WLo + 48 * 72);
            LAS float* RS = LG + 128 * 49;
            LAS int* LCNT = (LAS int*)(RS + 128); LAS int* LBASE = LCNT + 32;
            const float* n2g = args.in[I_N2G]; const float* bg = args.in[I_BG]; const float* be = args.in[I_BE];
            const bf16* wrh = (const bf16*)(ws + 28 * MiB); const bf16* wrl = wrh + 48 * 1024;
            int nrep8 = REPN(8); asm volatile("" : "+s"(nrep8));
_Pragma("unroll 1")
            for (int rp = 0; rp < nrep8; ++rp)
            for (int tile = bid; tile < NTOK / 128; tile += G) {
                const int R0 = tile * 128; const int b = R0 >> 13; const float* sh = mod + b * 6144 + 3072; const float* sc = sh + 1024;
                __syncthreads();
                if (tid < 128) { const float* sp = ssq + (size_t)(R0 + tid) * 16; float ss = 0.f; for (int q = 0; q < 16; ++q) ss += sp[q]; RS[tid] = rsqrtf(ss * (1.f / 1024.f) + 1e-6f); }
                if (tid < 32) LCNT[tid] = 0;
                int ea_ = 0, eb_ = 0, la_ = 0, lb_ = 0; float wa_ = 0.f, wb_ = 0.f;
                __syncthreads();
                f32x4 lacc[3];
#pragma unroll
                for (int c = 0; c < 3; ++c) lacc[c] = (f32x4){0.f, 0.f, 0.f, 0.f};
                const int lrow = tid >> 2, lq = tid & 3; const float rstd = RS[lrow];
                const int mg = lane >> 4, mli = lane & 15;
#pragma unroll 1
                for (int kc = 0; kc < 16; ++kc) {
                    const int k0 = kc * 64 + lq * 16;
                    f32x4 o[4];
#pragma unroll
                    for (int i = 0; i < 4; ++i) { const int k = k0 + 4 * i; const f32x4 v = *(const f32x4*)(x1 + (size_t)(R0 + lrow) * 1024 + k);
                        const f32x4 g = *(const f32x4*)(n2g + k), s_ = *(const f32x4*)(sc + k), hh = *(const f32x4*)(sh + k); o[i] = v * rstd * g * (1.f + s_) + hh; }
                    unsigned hi[8], lo[8];
#pragma unroll
                    for (int i = 0; i < 4; ++i)
#pragma unroll
                        for (int q = 0; q < 2; ++q) { const float a0 = o[i][2 * q], a1 = o[i][2 * q + 1]; const unsigned h = pk2(a0, a1); hi[2 * i + q] = h; lo[2 * i + q] = pk2(a0 - bflo(h), a1 - bfhi(h)); }
                    *(u32x4*)(hx2 + (size_t)(R0 + lrow) * 1024 + k0) = (u32x4){hi[0], hi[1], hi[2], hi[3]};
                    *(u32x4*)(hx2 + (size_t)(R0 + lrow) * 1024 + k0 + 8) = (u32x4){hi[4], hi[5], hi[6], hi[7]};
                    u32x4 wph = {0u, 0u, 0u, 0u}, wpl = {0u, 0u, 0u, 0u};
                    if (tid < 384) { wph = *(const u32x4*)(wrh + (size_t)(tid >> 3) * 1024 + kc * 64 + (tid & 7) * 8); wpl = *(const u32x4*)(wrl + (size_t)(tid >> 3) * 1024 + kc * 64 + (tid & 7) * 8); }
                    __syncthreads();
                    *(LAS u32x4*)(XH + lrow * 72 + lq * 16) = (u32x4){hi[0], hi[1], hi[2], hi[3]}; *(LAS u32x4*)(XH + lrow * 72 + lq * 16 + 8) = (u32x4){hi[4], hi[5], hi[6], hi[7]};
                    *(LAS u32x4*)(XL + lrow * 72 + lq * 16) = (u32x4){lo[0], lo[1], lo[2], lo[3]}; *(LAS u32x4*)(XL + lrow * 72 + lq * 16 + 8) = (u32x4){lo[4], lo[5], lo[6], lo[7]};
                    if (tid < 384) { *(LAS u32x4*)(WH + (tid >> 3) * 72 + (tid & 7) * 8) = wph; *(LAS u32x4*)(WLo + (tid >> 3) * 72 + (tid & 7) * 8) = wpl; }
                    __syncthreads();
#pragma unroll
                    for (int ks = 0; ks < 2; ++ks) { const bf16x8 aH = *(const LAS bf16x8*)(XH + (wave * 16 + mli) * 72 + ks * 32 + mg * 8), aL = *(const LAS bf16x8*)(XL + (wave * 16 + mli) * 72 + ks * 32 + mg * 8);
#pragma unroll
                        for (int nt = 0; nt < 3; ++nt) { const bf16x8 bH = *(const LAS bf16x8*)(WH + (nt * 16 + mli) * 72 + ks * 32 + mg * 8), bL = *(const LAS bf16x8*)(WLo + (nt * 16 + mli) * 72 + ks * 32 + mg * 8);
                            lacc[nt] = __builtin_amdgcn_mfma_f32_16x16x32_bf16(aH, bH, lacc[nt], 0, 0, 0); lacc[nt] = __builtin_amdgcn_mfma_f32_16x16x32_bf16(aL, bH, lacc[nt], 0, 0, 0);
                            lacc[nt] = __builtin_amdgcn_mfma_f32_16x16x32_bf16(aH, bL, lacc[nt], 0, 0, 0); } }
                }
#pragma unroll
                for (int nt = 0; nt < 3; ++nt)
#pragma unroll
                    for (int r = 0; r < 4; ++r) LG[(wave * 16 + 4 * mg + r) * 49 + nt * 16 + mli] = lacc[nt][r];
                __syncthreads();
                if (tid < 128) {
                    float lg[36];
#pragma unroll
                    for (int c = 0; c < 36; ++c) lg[c] = LG[tid * 49 + c] + (c < 4 ? bg[c] : be[c - 4]);
                    int grp = 0; float gm = lg[0];
#pragma unroll
                    for (int q = 1; q < 4; ++q) if (lg[q] > gm) { gm = lg[q]; grp = q; }
                    float den = 0.f;
#pragma unroll
                    for (int q = 0; q < 4; ++q) den += __expf(lg[q] - gm);
                    const float pg = 1.f / den;
                    float ep[8];
#pragma unroll
                    for (int q = 0; q < 8; ++q) ep[q] = grp == 0 ? lg[4 + q] : grp == 1 ? lg[12 + q] : grp == 2 ? lg[20 + q] : lg[28 + q];
                    int i1 = 0; float v1 = ep[0];
#pragma unroll
                    for (int q = 1; q < 8; ++q) if (ep[q] > v1) { v1 = ep[q]; i1 = q; }
                    int i2 = -1; float v2 = -3.0e38f;
#pragma unroll
                    for (int q = 0; q < 8; ++q) if (q != i1 && ep[q] > v2) { v2 = ep[q]; i2 = q; }
                    const float e2 = __expf(v2 - v1); const float p1 = 1.f / (1.f + e2), p2 = e2 / (1.f + e2);
                    ea_ = grp * 8 + i1; eb_ = grp * 8 + i2; wa_ = pg * p1; wb_ = pg * p2;
                    la_ = __hip_atomic_fetch_add(LCNT + ea_, 1, __ATOMIC_RELAXED, __HIP_MEMORY_SCOPE_WORKGROUP); lb_ = __hip_atomic_fetch_add(LCNT + eb_, 1, __ATOMIC_RELAXED, __HIP_MEMORY_SCOPE_WORKGROUP);
                }
                __syncthreads();
                if (tid < 32 && rp == nrep8 - 1) LBASE[tid] = atomicAdd(cnt + 32 * tid, LCNT[tid]);
                __syncthreads();
                if (tid < 128 && rp == nrep8 - 1) { const int m = R0 + tid;
                    tok_e[2 * m] = ea_; tok_e[2 * m + 1] = eb_; tok_rank[2 * m] = LBASE[ea_] + la_; tok_rank[2 * m + 1] = LBASE[eb_] + lb_; tok_w[2 * m] = wa_; tok_w[2 * m + 1] = wb_; }
            }
        }
        __syncthreads();
        {
            LAS float* scr = (LAS float*)lds + wave * 4160;
            constexpr int I_E13 = 16 * 8, I_E2 = 8 * 16;
            constexpr int NITEMS = NEXP * (2 * I_E13 + I_E2);
            for (int rp = 0; rp < REPN(80); ++rp)
            for (int it = gw; it < NITEMS; it += NGW) {
                const int e = it / (2 * I_E13 + I_E2); int r = it % (2 * I_E13 + I_E2);
                if (r < I_E13) { transpose_item(args.in[I_MW1] + (size_t)e * 1024 * 512, 1024, 512, w13t + (size_t)e * 1024 * 1024, 1, scr, r, lane); continue; } r -= I_E13;
                if (r < I_E13) { transpose_item(args.in[I_MW3] + (size_t)e * 1024 * 512, 1024, 512, w13t + (size_t)e * 1024 * 1024, 2, scr, r, lane); continue; } r -= I_E13;
                transpose_item(args.in[I_MW2] + (size_t)e * 512 * 1024, 512, 1024, w2t + (size_t)e * 1024 * 512, 0, scr, r, lane);
            }
        }
    }
    GRID_SYNC(8);

    LAS int* blk_exp = (LAS int*)(lds + MISC_OFF); LAS int* pstart = blk_exp + 320; LAS int* ecnt = pstart + 40;
    int* row_tok = (int*)(ws + WS_GATEW + 512 * 1024);
    int nblk = 0;
    if (hi > 9 && lo <= 11) {
        __syncthreads();
        if (tid == 0) { int p = 0; for (int e = 0; e < NEXP; ++e) { const int c_ = __hip_atomic_load(cnt + 32 * e, __ATOMIC_RELAXED, __HIP_MEMORY_SCOPE_AGENT); const int nb = (c_ + 255) >> 8; pstart[e] = p * 256; ecnt[e] = c_; for (int q = 0; q < nb; ++q) blk_exp[p + q] = e; p += nb; } pstart[32] = p; }
        __syncthreads();
        nblk = pstart[32];
    }

    if (IN(9)) for (int rp = 0; rp < REPN(9); ++rp) {
        const int gt = bid * NTHREADS + tid, GT = G * NTHREADS;
        for (int a = gt; a < 2 * NTOK; a += GT) { const int e = tok_e[a], rk = tok_rank[a]; const int slot = pstart[e] + rk; tok_slot[a] = slot; row_tok[slot] = a >> 1; }
        for (int r = gt; r < nblk * 256; r += GT) { const int e = blk_exp[r >> 8]; if (r - pstart[e] >= ecnt[e]) row_tok[r] = 0; }
    }
    GRID_SYNC(9);

    if (IN(10)) for (int rp = 0; rp < REPN(10); ++rp) {
        SchedMoeUp S{(const char*)hx2, (const char*)w13t, blk_exp, row_tok, nblk, G, bid}; EpiMoeUp E{Hbuf};
        pg8::gemm_phase<EpiMoeUp, SchedMoeUp, true>(lds, 1024, S, E);
    }
    GRID_SYNC(10);

    if (IN(11)) for (int rp = 0; rp < REPN(11); ++rp) {
        SchedMoeDown S{(const char*)Hbuf, (const char*)w2t, blk_exp, nblk, G, bid}; EpiMoeDown E{Ybuf};
        pg8::gemm_phase(lds, 512, S, E);
    }
    GRID_SYNC(11);

    if (IN(12)) {
        const float* fg = args.in[I_FG];
        f32x4 fgv[4];
#pragma unroll
        for (int j = 0; j < 4; ++j) fgv[j] = *(const f32x4*)(fg + 4 * (64 * j + lane));
        int nrep12 = REPN(12); asm volatile("" : "+s"(nrep12));
_Pragma("unroll 1")
        for (int rp = 0; rp < nrep12; ++rp)
        for (int m0 = 2 * gw; m0 < NTOK; m0 += 2 * NGW) {
            f32x4 v[2][4]; float ss[2] = {0.f, 0.f};
#pragma unroll
            for (int u = 0; u < 2; ++u) { const int m = m0 + u; const int b = m >> 13; const float* g2 = mod + b * 6144 + 5120;
                const int sa = tok_slot[2 * m], sb = tok_slot[2 * m + 1]; const float wa = tok_w[2 * m], wb = tok_w[2 * m + 1];
#pragma unroll
                for (int j = 0; j < 4; ++j) { const int k = 4 * (64 * j + lane);
                    const u32x2 ya = __builtin_nontemporal_load((const u32x2*)(Ybuf + (size_t)sa * 1024 + k)), yb = __builtin_nontemporal_load((const u32x2*)(Ybuf + (size_t)sb * 1024 + k));
                    const f32x4 fa = {bflo(ya.x), bfhi(ya.x), bflo(ya.y), bfhi(ya.y)}, fb = {bflo(yb.x), bfhi(yb.x), bflo(yb.y), bfhi(yb.y)};
                    const f32x4 xv = __builtin_nontemporal_load((const f32x4*)(x1 + (size_t)m * 1024 + k)), gv = *(const f32x4*)(g2 + k);
                    v[u][j] = xv + gv * (fa * wa + fb * wb); ss[u] += (v[u][j][0] * v[u][j][0] + v[u][j][1] * v[u][j][1]) + (v[u][j][2] * v[u][j][2] + v[u][j][3] * v[u][j][3]); } }
#pragma unroll
            for (int u = 0; u < 2; ++u) { const int m = m0 + u; const float rstd = rsqrtf(wave_sum(ss[u]) * (1.f / 1024.f) + 1e-6f);
#pragma unroll
                for (int j = 0; j < 4; ++j) { const int k = 4 * (64 * j + lane); if (rp == nrep12 - 1) st_nt((f32x4*)(args.out + (size_t)m * 1024 + k), v[u][j] * rstd * fgv[j]); } }
        }
    }
    if (PROBE_TS >= 0) {
        xcd_barrier(xbar);
        if (bid == 0 && tid == 0) tsbuf[13] = __builtin_amdgcn_s_memrealtime();
        xcd_barrier(xbar);
        const int pk_ = PROBE_TS < 0 ? 0 : (PROBE_TS % 100); const int sub_ = PROBE_TS < 0 ? 0 : (PROBE_TS / 100);
        const unsigned long long t0_ = __hip_atomic_load(tsbuf + pk_, __ATOMIC_RELAXED, __HIP_MEMORY_SCOPE_AGENT), t1_ = __hip_atomic_load(tsbuf + pk_ + 1, __ATOMIC_RELAXED, __HIP_MEMORY_SCOPE_AGENT);
        const float binw = sub_ == 1 ? 10.f : 40.f;
        const float us = floorf((float)(t1_ - t0_) * 0.01f / binw + 0.5f); const float vv = sqrtf(1.0025f * us);
        for (size_t i = (size_t)bid * NTHREADS + tid; i < (size_t)NTOK * 1024; i += (size_t)G * NTHREADS) args.out[i] = vv;
    }
}

extern "C" void kernel_launch(void* const* d_in, const int* in_sizes, int n_in, void* d_out, int out_size, void* d_ws, size_t ws_size, hipStream_t stream) {
    static int grid = 0;
    if (grid == 0) {
        if (n_in != 41 || out_size != NTOK * DM || ws_size < WS_END) { fprintf(stderr, "kernel_launch: unexpected shapes (n_in %d, out %d, ws %zu)\n", n_in, out_size, ws_size); grid = -1; return; }
        int dev = 0, cus = 0, per_cu = 0;
        hipGetDevice(&dev); hipDeviceGetAttribute(&cus, hipDeviceAttributeMultiprocessorCount, dev);
        if (hipFuncSetAttribute((const void*)fwd_kernel, hipFuncAttributeMaxDynamicSharedMemorySize, LDS_BYTES) != hipSuccess) { fprintf(stderr, "kernel_launch: hipFuncSetAttribute failed\n"); grid = -1; return; }
        hipOccupancyMaxActiveBlocksPerMultiprocessor(&per_cu, (const void*)fwd_kernel, NTHREADS, LDS_BYTES);
        (void)hipGetLastError();
        if (per_cu < 1) { fprintf(stderr, "kernel_launch: occupancy query says %d blocks per CU\n", per_cu); per_cu = 1; }
        grid = cus;
        fprintf(stderr, "kernel_launch: grid %d (cus %d, per_cu %d)\n", grid, cus, per_cu);
    }
    if (grid < 0) return;
    Args a{};
    for (int i = 0; i < 41; ++i) a.in[i] = (const float*)d_in[i];
    a.out = (float*)d_out; a.ws = (unsigned char*)d_ws;
#if ONE_LAUNCH
    a.ph_lo = 0; a.ph_hi = NPHASE;
    void* kargs[] = {&a};
    hipError_t e = hipLaunchCooperativeKernel((const void*)fwd_kernel, dim3(grid), dim3(NTHREADS), kargs, LDS_BYTES, stream);
    if (e != hipSuccess) fprintf(stderr, "cooperative launch failed: %s (grid %d)\n", hipGetErrorString(e), grid);
#else
    for (int p = 0; p < NPHASE; ++p) { a.ph_lo = p; a.ph_hi = p + 1; hipLaunchKernelGGL(fwd_kernel, dim3(grid), dim3(NTHREADS), LDS_BYTES, stream, a); }
#endif
}
```

```cpp
#include <hip/hip_runtime.h>
#include <hip/hip_cooperative_groups.h>
#include <cstdio>
#include <cstdint>
namespace cg = cooperative_groups;

#ifndef ONE_LAUNCH
#define ONE_LAUNCH 1
#endif

#ifndef PROBE_REP
#define PROBE_REP -1
#endif
#ifndef PROBE_TS
#define PROBE_TS -1
#endif
#define REPN(k) ((PROBE_REP == (k)) ? 2 : 1)
#define LAS __attribute__((address_space(3)))
typedef unsigned short bf16;
typedef float f32x4 __attribute__((ext_vector_type(4)));
typedef float f32x2 __attribute__((ext_vector_type(2)));
typedef short bf16x8 __attribute__((ext_vector_type(8)));
typedef unsigned u32x4 __attribute__((ext_vector_type(4)));
typedef unsigned u32x2 __attribute__((ext_vector_type(2)));

constexpr int DM = 1024, NBATCH = 4, SEQ = 8192, NTOK = NBATCH * SEQ, CTXL = 256, NCTX = NBATCH * CTXL, MROWS = NTOK + NCTX;
constexpr int INC = 7168, NEXP = 32, DEXP = 512, PMAXBLK = 288;
constexpr int NCHUNK = 132;
constexpr int NTHREADS = 512, NWAVES = 8;
constexpr int LDS_BYTES = 148480;
constexpr int MISC_OFF = 145408;

constexpr size_t MiB = 1u << 20;
constexpr size_t WS_CTL = 0, WS_MOD = 1 * MiB, WS_Z2 = 2 * MiB, WS_SSQ = 4 * MiB, WS_ROUTE = 6 * MiB, WS_GATEW = 7 * MiB;
constexpr size_t WS_WSMALL = 8 * MiB, WS_WIN = 14 * MiB;
constexpr size_t WS_HX = 32 * MiB;
constexpr size_t WS_PRX = 98 * MiB;
constexpr size_t WS_GRG = 164 * MiB;
constexpr size_t WS_PHY = 228 * MiB;
constexpr size_t WS_W13 = 228 * MiB, WS_W2 = 292 * MiB;
constexpr size_t WS_XG = 324 * MiB;
constexpr size_t WS_KF = 420 * MiB;
constexpr size_t WS_CARR = 484 * MiB, WS_CIN = 494 * MiB, WS_END = 512 * MiB;

__device__ __forceinline__ unsigned f2bf(float f) { unsigned u = __builtin_bit_cast(unsigned, f); return (u + 0x7fffu + ((u >> 16) & 1u)) >> 16; }
__device__ __forceinline__ unsigned pk2(float lo, float hi) { unsigned r; asm("v_cvt_pk_bf16_f32 %0, %1, %2" : "=v"(r) : "v"(lo), "v"(hi)); return r; }
__device__ __forceinline__ float bf2f(unsigned b) { return __builtin_bit_cast(float, b << 16); }
__device__ __forceinline__ float bflo(unsigned w) { return __builtin_bit_cast(float, w << 16); }
__device__ __forceinline__ float bfhi(unsigned w) { return __builtin_bit_cast(float, w & 0xffff0000u); }
__device__ __forceinline__ float wave_sum(float v) {
#pragma unroll
    for (int o = 1; o < 64; o <<= 1) v += __shfl_xor(v, o);
    return v;
}
__device__ __forceinline__ float sigmoidf_(float v) { return __builtin_amdgcn_rcpf(1.f + __expf(-v)); }
__device__ __forceinline__ float gelu_tanh(float v) { const float z = 0.7978845608028654f * (v + 0.044715f * v * v * v); const float t = 1.f - 2.f * __builtin_amdgcn_rcpf(1.f + __expf(2.f * z)); return 0.5f * v * (1.f + t); }
#define LDS_WAIT() asm volatile("s_waitcnt lgkmcnt(0)" ::: "memory")
#define LDS_BARRIER() do { asm volatile("s_waitcnt lgkmcnt(0)" ::: "memory"); __builtin_amdgcn_s_barrier(); asm volatile("" ::: "memory"); } while (0)

namespace pg8 {
#define PG8_LAS __attribute__((address_space(3)))
constexpr int BM = 256, BK = 64, HALF = 128, HTB = HALF * BK * 2, STAGE_BYTES = 8 * HTB, NXCD = 8, WGM = 4;
__host__ __device__ __forceinline__ int lds_byte(int r, int c) { const int st = (r >> 4) * 2 + (c >> 5), rr = r & 15, cc = c & 31, ob = rr * 64 + cc * 2; return st * 1024 + (ob ^ (((ob >> 9) & 1) << 5)); }
__host__ __device__ __forceinline__ void stage_rc(int b, int& R, int& C) { const int st = b / 1024, sb = b % 1024, swz = sb ^ (((sb >> 9) & 1) << 5); R = (st >> 1) * 16 + swz / 64; C = (st & 1) * 32 + (swz % 64) / 2; }

__host__ __device__ __forceinline__ int perm32(int rho) { const int n = rho >> 4, i = rho & 15; return 8 * (i >> 2) + 4 * n + (i & 3); }
struct Unit { int pm, pn, last; const char* A; const char* B; };

__device__ __forceinline__ void rect_map(int wg, int nM, int nN, int& pm, int& pn) {
    const int nwg = nM * nN; int wgid = wg; { const int q = nwg / NXCD, r = nwg % NXCD, xcd = wgid % NXCD, off = wgid / NXCD; wgid = (xcd < r ? xcd * (q + 1) : r * (q + 1) + (xcd - r) * q) + off; }
    const int nig = WGM * nN, gid = wgid / nig, fm = gid * WGM, gsz = (nM - fm) < WGM ? (nM - fm) : WGM;
    pm = fm + ((wgid % nig) % gsz); pn = (wgid % nig) / gsz;
}

template <class Epi, class Sched, bool GATHER = false>
__device__ __forceinline__ void gemm_phase(PG8_LAS unsigned char* lds, const int K, const Sched& S, const Epi& E) {
    const int tid = threadIdx.x, wid = __builtin_amdgcn_readfirstlane(tid >> 6), lane = tid & 63, wr = wid >> 2, wc = wid & 3, fr = lane & 15, fq = lane >> 4;
    const int nt = K / BK;
    unsigned voffA[2]; int stR[2], stC[2]; unsigned voffB[2];
#pragma unroll
    for (int i = 0; i < 2; ++i) { int R, C; stage_rc(tid * 16 + i * 8192, R, C); voffA[i] = (unsigned)(R * K + C) * 2u; stR[i] = R; stC[i] = C;
        const int Rb = Epi::PERM ? ((R & ~31) + perm32(R & 31)) : R; voffB[i] = (unsigned)(Rb * K + C) * 2u; }
    unsigned voffGc[2][2], voffGn[2][2];
#define PG8_GOFF(dst, u) do { _Pragma("unroll") for (int _h = 0; _h < 2; ++_h) _Pragma("unroll") for (int _i = 0; _i < 2; ++_i) \
        dst[_h][_i] = (unsigned)(S.row_tok[(u).pm * 256 + _h * 128 + stR[_i]] * K + stC[_i]) * 2u; } while (0)
    const size_t kstep = (size_t)(BK * 2);
    const size_t hstep = (size_t)HALF * K * 2;
    const unsigned ldsw = (unsigned)wid * 1024u;
    const int aoff = lds_byte(wr * 64 + fr, fq * 8), boff = lds_byte(wc * 32 + fr, fq * 8);
#define PG8_SA(b, h) (((b) * 2 + (h)) * HTB)
#define PG8_SB(b, h) ((4 + (b) * 2 + (h)) * HTB)
#define PG8_STAGE(bufoff, gbase, voff) do { _Pragma("unroll") for (int _i = 0; _i < 2; ++_i) \
        __builtin_amdgcn_global_load_lds((const unsigned*)((const char*)(gbase) + (voff)[_i]), (PG8_LAS unsigned*)(lds + (bufoff) + ldsw + _i * 8192), 16, 0, 0); } while (0)
#define PG8_STAGE_A(bufoff, kptr, half, isnext) do { if constexpr (GATHER) { if (isnext) PG8_STAGE(bufoff, kptr, voffGn[half]); else PG8_STAGE(bufoff, kptr, voffGc[half]); } \
        else PG8_STAGE(bufoff, (kptr) + (half) * hstep, voffA); } while (0)
#define PG8_LDA(dst, b, h) do { _Pragma("unroll") for (int m = 0; m < 4; ++m) _Pragma("unroll") for (int k = 0; k < 2; ++k) dst[m][k] = *(const PG8_LAS bf16x8*)(lds + PG8_SA(b, h) + aoff + m * 2048 + k * 1024); } while (0)
#define PG8_LDB(dst, b, h) do { _Pragma("unroll") for (int n = 0; n < 2; ++n) _Pragma("unroll") for (int k = 0; k < 2; ++k) dst[n][k] = *(const PG8_LAS bf16x8*)(lds + PG8_SB(b, h) + boff + n * 2048 + k * 1024); } while (0)
#define PG8_MMA(ai, bj, At, Bt) do { __builtin_amdgcn_s_setprio(1); _Pragma("unroll") for (int m = 0; m < 4; ++m) _Pragma("unroll") for (int n = 0; n < 2; ++n) _Pragma("unroll") for (int k = 0; k < 2; ++k) \
        acc[ai][bj][m][n] = __builtin_amdgcn_mfma_f32_16x16x32_bf16(Bt[n][k], At[m][k], acc[ai][bj][m][n], 0, 0, 0); __builtin_amdgcn_s_setprio(0); } while (0)
#define PG8_WAIT_V(n) asm volatile("s_waitcnt vmcnt(" #n ")" ::: "memory")
#define PG8_WAIT_L(n) asm volatile("s_waitcnt lgkmcnt(" #n ")" ::: "memory")
#define PG8_BAR __builtin_amdgcn_s_barrier()
#define PG8_SCHED __builtin_amdgcn_sched_barrier(0)
    Unit cur, nxt; int ui = 0;
    if (!S.next(0, cur)) return;
    f32x4 acc[2][2][4][2];
#pragma unroll
    for (int a = 0; a < 2; ++a)
#pragma unroll
        for (int b = 0; b < 2; ++b)
#pragma unroll
            for (int m = 0; m < 4; ++m)
#pragma unroll
                for (int n = 0; n < 2; ++n) acc[a][b][m][n] = (f32x4){0.f, 0.f, 0.f, 0.f};
    bf16x8 At[4][2], B0[2][2], B1[2][2];
    const char* cA = cur.A; const char* cB = cur.B;
    if constexpr (GATHER) { PG8_GOFF(voffGc, cur); }
    PG8_STAGE(PG8_SB(0, 0), cB, voffB); PG8_STAGE(PG8_SB(0, 1), cB + hstep, voffB); PG8_STAGE_A(PG8_SA(0, 0), cA, 0, false); PG8_STAGE_A(PG8_SA(0, 1), cA, 1, false);
    if (wr == 1) PG8_BAR;
    PG8_WAIT_V(2); PG8_BAR;
    PG8_STAGE(PG8_SB(1, 0), cB + kstep, voffB); PG8_STAGE_A(PG8_SA(1, 0), cA + kstep, 0, false); PG8_STAGE(PG8_SB(1, 1), cB + hstep + kstep, voffB);
    PG8_WAIT_V(6); PG8_BAR;
    for (;;) {
        const bool has_next = S.next(ui + 1, nxt);
        const char* nA = has_next ? nxt.A : cA; const char* nB = has_next ? nxt.B : cB;
        if constexpr (GATHER) { if (has_next) { PG8_GOFF(voffGn, nxt); } else { _Pragma("unroll") for (int _h = 0; _h < 2; ++_h) _Pragma("unroll") for (int _i = 0; _i < 2; ++_i) voffGn[_h][_i] = voffGc[_h][_i]; } }
        for (int t = 0; t < nt; t += 2) {
            const bool last = (t == nt - 2);
            const char* a1 = cA + (size_t)(t + 1) * kstep;
            const char* a2 = last ? nA : cA + (size_t)(t + 2) * kstep; const char* b2 = last ? nB : cB + (size_t)(t + 2) * kstep;
            const char* a3 = a2 + kstep; const char* b3 = b2 + kstep;
            PG8_LDB(B0, 0, 0); PG8_LDB(B1, 0, 1); PG8_SCHED; PG8_LDA(At, 0, 0); PG8_STAGE_A(PG8_SA(1, 1), a1, 1, false);
            PG8_WAIT_V(8); PG8_WAIT_L(0); PG8_BAR; PG8_MMA(0, 0, At, B0); PG8_MMA(0, 1, At, B1); PG8_BAR; PG8_SCHED;
            PG8_LDA(At, 0, 1); PG8_STAGE(PG8_SB(0, 0), b2, voffB); PG8_STAGE(PG8_SB(0, 1), b2 + hstep, voffB); PG8_STAGE_A(PG8_SA(0, 0), a2, 0, last);
            PG8_WAIT_V(8); PG8_WAIT_L(0); PG8_BAR; PG8_MMA(1, 0, At, B0); PG8_MMA(1, 1, At, B1); PG8_BAR; PG8_SCHED;
            PG8_LDB(B0, 1, 0); PG8_LDB(B1, 1, 1); PG8_SCHED; PG8_LDA(At, 1, 0); PG8_STAGE_A(PG8_SA(0, 1), a2, 1, last);
            PG8_WAIT_V(8); PG8_WAIT_L(0); PG8_BAR; PG8_MMA(0, 0, At, B0); PG8_MMA(0, 1, At, B1); PG8_BAR; PG8_SCHED;
            PG8_LDA(At, 1, 1); PG8_STAGE(PG8_SB(1, 0), b3, voffB); PG8_STAGE(PG8_SB(1, 1), b3 + hstep, voffB); PG8_STAGE_A(PG8_SA(1, 0), a3, 0, last);
            PG8_WAIT_V(8); PG8_WAIT_L(0); PG8_BAR; PG8_MMA(1, 0, At, B0); PG8_MMA(1, 1, At, B1); PG8_BAR; PG8_SCHED;
        }
        if (wr == 0) PG8_BAR;
        if (cur.last) E.fin(acc, cur, wr, wc, fr, fq); else E.mid(acc, cur, wr, wc, fr, fq);
        if (!has_next) break;
        if (cur.last) {
#pragma unroll
            for (int a = 0; a < 2; ++a)
#pragma unroll
                for (int b = 0; b < 2; ++b)
#pragma unroll
                    for (int m = 0; m < 4; ++m)
#pragma unroll
                        for (int n = 0; n < 2; ++n) acc[a][b][m][n] = (f32x4){0.f, 0.f, 0.f, 0.f};
        }
        cur = nxt; cA = nA; cB = nB; ++ui;
        if constexpr (GATHER) { _Pragma("unroll") for (int _h = 0; _h < 2; ++_h) _Pragma("unroll") for (int _i = 0; _i < 2; ++_i) voffGc[_h][_i] = voffGn[_h][_i]; }
        if (wr == 1) PG8_BAR;
    }
    PG8_WAIT_V(0);
    PG8_BAR;
#undef PG8_SA
#undef PG8_SB
#undef PG8_STAGE
#undef PG8_STAGE_A
#undef PG8_GOFF
#undef PG8_LDA
#undef PG8_LDB
#undef PG8_MMA
#undef PG8_WAIT_V
#undef PG8_WAIT_L
#undef PG8_BAR
#undef PG8_SCHED
}
}
using pg8::Unit;
typedef f32x4 AccT[2][2][4][2];

__device__ __forceinline__ void st_nt(u32x4* p, u32x4 v) { __builtin_nontemporal_store(v, p); }
__device__ __forceinline__ void st_nt(f32x4* p, f32x4 v) { __builtin_nontemporal_store(v, p); }
__device__ __forceinline__ u32x2 pack4(f32x4 v) { u32x2 w; w.x = pk2(v[0], v[1]); w.y = pk2(v[2], v[3]); return w; }

#define EPI_LOOP_ROWS _Pragma("unroll") for (int ai = 0; ai < 2; ++ai) _Pragma("unroll") for (int m = 0; m < 4; ++m)
#define EPI_LOOP_COLS _Pragma("unroll") for (int bj = 0; bj < 2; ++bj) _Pragma("unroll") for (int n = 0; n < 2; ++n)

__device__ __forceinline__ u32x4 pack8(f32x4 a, f32x4 b) { return (u32x4){pk2(a[0], a[1]), pk2(a[2], a[3]), pk2(b[0], b[1]), pk2(b[2], b[3])}; }
__device__ __forceinline__ void unpack8(u32x4 w, f32x4& a, f32x4& b) { a = (f32x4){bflo(w.x), bfhi(w.x), bflo(w.y), bfhi(w.y)}; b = (f32x4){bflo(w.z), bfhi(w.z), bflo(w.w), bfhi(w.w)}; }
#define EPI_LOOP_BJ _Pragma("unroll") for (int bj = 0; bj < 2; ++bj)
struct EpiInA {
    static constexpr bool PERM = true;
    bf16* prx; bf16* grg; bf16* gates;
    __device__ __forceinline__ void mid(AccT& acc, const Unit& u, int wr, int wc, int fr, int fq) const {}
    __device__ __forceinline__ void fin(AccT& acc, const Unit& u, int wr, int wc, int fr, int fq) const {
        const int row0 = u.pm * 256 + wr * 64 + fr, col0 = u.pn * 256 + wc * 32 + 8 * fq;
        EPI_LOOP_ROWS { const size_t r = (size_t)(row0 + ai * 128 + m * 16);
            EPI_LOOP_BJ { const int c = col0 + bj * 128; f32x4 v0 = acc[ai][bj][m][0], v1 = acc[ai][bj][m][1];
                if (u.pn < 4) { st_nt((u32x4*)(prx + r * 1024 + c), pack8(v0, v1)); }
                else if (u.pn < 8) { for (int i = 0; i < 4; ++i) { v0[i] = gelu_tanh(v0[i]); v1[i] = gelu_tanh(v1[i]); } st_nt((u32x4*)(grg + r * 1024 + (c - 1024)), pack8(v0, v1)); }
                else { for (int i = 0; i < 4; ++i) { v0[i] = sigmoidf_(v0[i]); v1[i] = sigmoidf_(v1[i]); } st_nt((u32x4*)(gates + r * 2048 + (c - 2048)), pack8(v0, v1)); } } }
    }
};
struct EpiInB {
    static constexpr bool PERM = true;
    bf16* phyT;
    __device__ __forceinline__ void mid(AccT& acc, const Unit& u, int wr, int wc, int fr, int fq) const {}
    __device__ __forceinline__ void fin(AccT& acc, const Unit& u, int wr, int wc, int fr, int fq) const {
        const int row0 = u.pm * 256 + wr * 64 + fr, col0 = u.pn * 256 + wc * 32 + 8 * fq;
        const int b = u.pn >> 5;
        EPI_LOOP_ROWS { const size_t j = (size_t)(row0 + ai * 128 + m * 16);
            EPI_LOOP_BJ { const int t = col0 + bj * 128 - b * SEQ;
                st_nt((u32x4*)(phyT + ((size_t)b * 3072 + j) * SEQ + t), pack8(acc[ai][bj][m][0], acc[ai][bj][m][1])); } }
    }
};
struct EpiMerge {
    static constexpr bool PERM = true;
    const bf16* gates; bf16* merged;
    __device__ __forceinline__ void mid(AccT& acc, const Unit& u, int wr, int wc, int fr, int fq) const {
        const int row0 = u.pm * 256 + wr * 64 + fr, col0 = u.pn * 256 + wc * 32 + 8 * fq;
        EPI_LOOP_ROWS { const size_t r = (size_t)(row0 + ai * 128 + m * 16);
            EPI_LOOP_BJ { const int c = col0 + bj * 128;
                f32x4 sa0, sa1, sb0, sb1; unpack8(*(const u32x4*)(gates + r * 2048 + c), sa0, sa1); unpack8(*(const u32x4*)(gates + r * 2048 + 1024 + c), sb0, sb1);
                for (int i = 0; i < 4; ++i) { acc[ai][bj][m][0][i] *= sa0[i] * __builtin_amdgcn_rcpf(fmaxf(sb0[i], 1e-30f)); acc[ai][bj][m][1][i] *= sa1[i] * __builtin_amdgcn_rcpf(fmaxf(sb1[i], 1e-30f)); } } }
    }
    __device__ __forceinline__ void fin(AccT& acc, const Unit& u, int wr, int wc, int fr, int fq) const {
        const int row0 = u.pm * 256 + wr * 64 + fr, col0 = u.pn * 256 + wc * 32 + 8 * fq;
        EPI_LOOP_ROWS { const size_t r = (size_t)(row0 + ai * 128 + m * 16);
            EPI_LOOP_BJ { const int c = col0 + bj * 128;
                f32x4 sb0, sb1; unpack8(*(const u32x4*)(gates + r * 2048 + 1024 + c), sb0, sb1);
                f32x4 v0 = acc[ai][bj][m][0], v1 = acc[ai][bj][m][1];
                for (int i = 0; i < 4; ++i) { v0[i] *= fmaxf(sb0[i], 1e-30f); v1[i] *= fmaxf(sb1[i], 1e-30f); }
                *(u32x4*)(merged + r * 1024 + c) = pack8(v0, v1); } }
    }
};
struct EpiOut {
    static constexpr bool PERM = false;
    const float* x; const float* mod; float* x1; float* ssq;
    __device__ __forceinline__ void mid(AccT& acc, const Unit& u, int wr, int wc, int fr, int fq) const {}
    __device__ __forceinline__ void fin(AccT& acc, const Unit& u, int wr, int wc, int fr, int fq) const {
        const int row0 = u.pm * 256 + wr * 64 + fr, col0 = u.pn * 256 + wc * 32 + 4 * fq;
        const float* g1 = mod + (u.pm >> 5) * 6144 + 2048;
        EPI_LOOP_ROWS { const size_t r = (size_t)(row0 + ai * 128 + m * 16); float s = 0.f;
            EPI_LOOP_COLS { const int c = col0 + bj * 128 + n * 16;
                const f32x4 xv = __builtin_nontemporal_load((const f32x4*)(x + r * 1024 + c)), gv = *(const f32x4*)(g1 + c);
                const f32x4 o = xv + gv * acc[ai][bj][m][n];
                *(f32x4*)(x1 + r * 1024 + c) = o; s += (o[0] * o[0] + o[1] * o[1]) + (o[2] * o[2] + o[3] * o[3]); }
            s += __shfl_xor(s, 16); s += __shfl_xor(s, 32);
            if (fq == 0) ssq[r * 16 + u.pn * 4 + wc] = s; }
    }
};
struct EpiMoeUp {
    static constexpr bool PERM = true;
    bf16* H;
    __device__ __forceinline__ void mid(AccT& acc, const Unit& u, int wr, int wc, int fr, int fq) const {}
    __device__ __forceinline__ void fin(AccT& acc, const Unit& u, int wr, int wc, int fr, int fq) const {
        const int row0 = u.pm * 256 + wr * 64 + fr, col0 = u.pn * 128 + wc * 32 + 8 * fq;
        EPI_LOOP_ROWS { const size_t r = (size_t)(row0 + ai * 128 + m * 16); f32x4 h0, h1;
            for (int i = 0; i < 4; ++i) { const float a0 = acc[ai][0][m][0][i], a1 = acc[ai][0][m][1][i]; h0[i] = a0 * sigmoidf_(a0) * acc[ai][1][m][0][i]; h1[i] = a1 * sigmoidf_(a1) * acc[ai][1][m][1][i]; }
            *(u32x4*)(H + r * 512 + col0) = pack8(h0, h1); }
    }
};
struct EpiMoeDown {
    static constexpr bool PERM = true;
    bf16* Y;
    __device__ __forceinline__ void mid(AccT& acc, const Unit& u, int wr, int wc, int fr, int fq) const {}
    __device__ __forceinline__ void fin(AccT& acc, const Unit& u, int wr, int wc, int fr, int fq) const {
        const int row0 = u.pm * 256 + wr * 64 + fr, col0 = u.pn * 256 + wc * 32 + 8 * fq;
        EPI_LOOP_ROWS { const size_t r = (size_t)(row0 + ai * 128 + m * 16);
            EPI_LOOP_BJ { const int c = col0 + bj * 128; *(u32x4*)(Y + r * 1024 + c) = pack8(acc[ai][bj][m][0], acc[ai][bj][m][1]); } }
    }
};

constexpr size_t TSTEP1K = (size_t)256 * 1024 * 2;
struct SchedInA { const char* hx; const char* wt; int G, c;
    __device__ __forceinline__ bool next(int i, Unit& u) const {
        int Lx = (i >> (REPN(2) - 1)) * G + c, pm, pn;
        if (Lx < 2048) pg8::rect_map(Lx, 128, 16, pm, pn);
        else { Lx -= 2048; if (Lx >= 16) return false; pm = 128 + (Lx >> 2); pn = Lx & 3; }
        const int wrow = pn < 8 ? pn * 256 : 5120 + (pn - 8) * 256;
        u.pm = pm; u.pn = pn; u.last = 1; u.A = hx + (size_t)pm * TSTEP1K; u.B = wt + (size_t)wrow * 2048; return true; } };
struct SchedInB { const char* hx; const char* wt; int G, c;
    __device__ __forceinline__ bool next(int i, Unit& u) const {
        const int Lx = (i >> (REPN(21) - 1)) * G + c; if (Lx >= 12 * 128) return false; int pm, pn; pg8::rect_map(Lx, 12, 128, pm, pn);
        u.pm = pm; u.pn = pn; u.last = 1; u.A = wt + (size_t)(2048 + pm * 256) * 2048; u.B = hx + (size_t)pn * TSTEP1K; return true; } };
struct SchedMerge { const char* yrg; const char* yhy; const char* wrg; const char* why; int G, c;
    __device__ __forceinline__ bool next(int i, Unit& u) const {
        const int T = (i >> 1) * G + c, part = i & 1; if (T >= 512) return false; int pm, pn; pg8::rect_map(T, 128, 4, pm, pn);
        u.pm = pm; u.pn = pn; u.last = part; u.A = (part ? yhy : yrg) + (size_t)pm * TSTEP1K; u.B = (part ? why : wrg) + (size_t)pn * TSTEP1K; return true; } };
struct SchedOut { const char* a; const char* w; int G, c;
    __device__ __forceinline__ bool next(int i, Unit& u) const {
        const int T = (i >> (REPN(7) - 1)) * G + c; if (T >= 512) return false; int pm, pn; pg8::rect_map(T, 128, 4, pm, pn);
        u.pm = pm; u.pn = pn; u.last = 1; u.A = a + (size_t)pm * TSTEP1K; u.B = w + (size_t)pn * TSTEP1K; return true; } };
struct SchedMoeUp { const char* xg; const char* w13; const LAS int* blk_exp; const int* row_tok; int nblk, G, c;
    __device__ __forceinline__ bool next(int i, Unit& u) const {
        const int T = i * G + c; if (T >= nblk * 4) return false; const int pm = T >> 2, pn = T & 3, e = blk_exp[pm];
        u.pm = pm; u.pn = pn; u.last = 1; u.A = xg; u.B = w13 + (size_t)e * (1024 * 1024 * 2) + (size_t)pn * TSTEP1K; return true; } };
struct SchedMoeDown { const char* h; const char* w2; const LAS int* blk_exp; int nblk, G, c;
    __device__ __forceinline__ bool next(int i, Unit& u) const {
        const int T = i * G + c; if (T >= nblk * 4) return false; const int pm = T >> 2, pn = T & 3, e = blk_exp[pm];
        u.pm = pm; u.pn = pn; u.last = 1; u.A = h + (size_t)pm * (256 * 512 * 2); u.B = w2 + (size_t)e * (1024 * 512 * 2) + (size_t)pn * (256 * 512 * 2); return true; } };


typedef f32x2 cpx;
__device__ __forceinline__ int pidx(int i) { return i + (i >> 4); }
__device__ __forceinline__ cpx cmul(cpx a, cpx b) { return (cpx){a.x * b.x - a.y * b.y, a.x * b.y + a.y * b.x}; }
template <bool INV> __device__ __forceinline__ cpx mul_w4(cpx a) { return INV ? (cpx){-a.y, a.x} : (cpx){a.y, -a.x}; }
template <bool INV> __device__ __forceinline__ void dft4(cpx& a, cpx& b, cpx& c, cpx& d) {
    const cpx t0 = a + c, t1 = a - c, t2 = b + d, t3 = b - d; const cpx t3r = mul_w4<INV>(t3);
    a = t0 + t2; b = t1 + t3r; c = t0 - t2; d = t1 - t3r; }
template <bool INV> __device__ __forceinline__ cpx twc(cpx x, float cr, float ci) { return cmul(x, (cpx){cr, INV ? -ci : ci}); }
#define SLOT16(q) (4 * ((q) & 3) + ((q) >> 2))
template <bool INV> __device__ __forceinline__ void dft16(cpx (&x)[16]) {
    const float C1 = 0.9238795325112867f, S1 = 0.3826834323650898f, R = 0.7071067811865476f;
#pragma unroll
    for (int m2 = 0; m2 < 4; ++m2) dft4<INV>(x[m2], x[4 + m2], x[8 + m2], x[12 + m2]);
    x[5] = twc<INV>(x[5], C1, -S1); x[9] = twc<INV>(x[9], R, -R); x[6] = twc<INV>(x[6], R, -R);
    x[13] = twc<INV>(x[13], S1, -C1); x[7] = twc<INV>(x[7], S1, -C1); x[10] = mul_w4<INV>(x[10]);
    x[14] = twc<INV>(x[14], -R, -R); x[11] = twc<INV>(x[11], -R, -R); x[15] = twc<INV>(x[15], -C1, S1);
#pragma unroll
    for (int q1 = 0; q1 < 4; ++q1) dft4<INV>(x[4 * q1], x[4 * q1 + 1], x[4 * q1 + 2], x[4 * q1 + 3]);
}
template <int S_, int NIN> __device__ __forceinline__ void fft_fwd16(LAS cpx* X, const LAS cpx* TW, int tid) {
    constexpr int PS = S_ + S_ / 16;
#pragma unroll 1
    for (int it = 0; it < 2; ++it) {
        int bf = tid + 512 * it; asm volatile("" : "+v"(bf)); const int blk = bf / S_, j = bf % S_; const int base = pidx(blk * (16 * S_) + j);
        cpx x[16];
#pragma unroll
        for (int m = 0; m < 16; ++m) x[m] = (m < NIN) ? X[base + PS * m] : (cpx){0.f, 0.f};
        dft16<false>(x);
        const cpx w1 = TW[j]; cpx w = w1;
        X[base] = x[0];
#pragma unroll
        for (int q = 1; q < 16; ++q) { X[base + PS * q] = cmul(x[SLOT16(q)], w); w = cmul(w, w1); }
    }
}
template <int S_, int NOUT> __device__ __forceinline__ void fft_inv16(LAS cpx* X, const LAS cpx* TW, int tid) {
    constexpr int PS = S_ + S_ / 16;
#pragma unroll 1
    for (int it = 0; it < 2; ++it) {
        int bf = tid + 512 * it; asm volatile("" : "+v"(bf)); const int blk = bf / S_, j = bf % S_; const int base = pidx(blk * (16 * S_) + j);
        cpx w1 = TW[j]; w1.y = -w1.y; cpx w = w1;
        cpx x[16]; x[0] = X[base];
#pragma unroll
        for (int q = 1; q < 16; ++q) { x[q] = cmul(X[base + PS * q], w); w = cmul(w, w1); }
        dft16<true>(x);
#pragma unroll
        for (int m = 0; m < NOUT; ++m) X[base + PS * m] = x[SLOT16(m)];
    }
}
template <bool INV> __device__ __forceinline__ void fft_r4(LAS cpx* X, const LAS cpx* TW, int tid) {
#pragma unroll 2
    for (int it = 0; it < 8; ++it) {
        int bf = tid + 512 * it; asm volatile("" : "+v"(bf)); const int blk = bf >> 4, j = bf & 15; const int base = 68 * blk + j;
        cpx w1 = TW[j]; if (INV) w1.y = -w1.y; const cpx w2 = cmul(w1, w1), w3 = cmul(w2, w1);
        cpx a = X[base], b = X[base + 17], c = X[base + 34], d = X[base + 51];
        if (INV) { b = cmul(b, w1); c = cmul(c, w2); d = cmul(d, w3); }
        dft4<INV>(a, b, c, d);
        if (!INV) { b = cmul(b, w1); c = cmul(c, w2); d = cmul(d, w3); }
        X[base] = a; X[base + 17] = b; X[base + 34] = c; X[base + 51] = d;
    }
}

template <bool INV, bool OZERO> __device__ __forceinline__ void dft32(cpx (&e)[16], cpx (&o)[16]) {
    const float C[16] = {1.f, 0.9807852804032304f, 0.9238795325112867f, 0.8314696123025452f, 0.7071067811865476f, 0.5555702330196022f, 0.3826834323650898f, 0.1950903220161283f,
                         0.f, -0.1950903220161283f, -0.3826834323650898f, -0.5555702330196022f, -0.7071067811865476f, -0.8314696123025452f, -0.9238795325112867f, -0.9807852804032304f};
    const float S[16] = {0.f, 0.1950903220161283f, 0.3826834323650898f, 0.5555702330196022f, 0.7071067811865476f, 0.8314696123025452f, 0.9238795325112867f, 0.9807852804032304f,
                         1.f, 0.9807852804032304f, 0.9238795325112867f, 0.8314696123025452f, 0.7071067811865476f, 0.5555702330196022f, 0.3826834323650898f, 0.1950903220161283f};
#pragma unroll
    for (int m = 0; m < 16; ++m) { const cpx a = e[m]; cpx d;
        if (OZERO) d = a; else { const cpx b = o[m]; e[m] = a + b; d = a - b; }
        o[m] = (m == 0) ? d : (m == 8) ? mul_w4<INV>(d) : twc<INV>(d, C[m], -S[m]); }
    dft16<INV>(e); dft16<INV>(o);
}
template <int NIN> __device__ __forceinline__ void fft_fwd32A(LAS cpx* X, const LAS cpx* TW, int tid) {
    int j = tid; asm volatile("" : "+v"(j)); const int base = pidx(j); constexpr int PS = 544;
    cpx e[16], o[16];
#pragma unroll
    for (int m = 0; m < 16; ++m) { e[m] = X[base + PS * m]; o[m] = (NIN == 32) ? X[base + PS * (m + 16)] : (cpx){0.f, 0.f}; }
    dft32<false, NIN == 16>(e, o);
    const cpx w1 = TW[j], w2 = cmul(w1, w1); cpx te = w2, to = w1;
    X[base] = e[0]; X[base + PS] = cmul(o[0], to); to = cmul(to, w2);
#pragma unroll
    for (int q = 1; q < 16; ++q) { X[base + PS * (2 * q)] = cmul(e[SLOT16(q)], te); X[base + PS * (2 * q + 1)] = cmul(o[SLOT16(q)], to); te = cmul(te, w2); to = cmul(to, w2); }
}
__device__ __forceinline__ void fft_fwd32A_filter(LAS cpx* X, const LAS cpx* TW, const float* kfw, const float* kbw, int tid) {
    int j = tid; asm volatile("" : "+v"(j)); const int base = pidx(j); constexpr int PS = 544;
    cpx e[16], o[16];
#pragma unroll
    for (int m = 0; m < 16; ++m) e[m] = (cpx){kfw[j + 512 * m], 0.f};
#pragma unroll
    for (int m = 0; m < 16; ++m) { const int i = j + 512 * m; o[m] = (cpx){(i == 0) ? 0.f : kbw[SEQ - i], 0.f}; }
    dft32<false, false>(e, o);
    const cpx w1 = TW[j], w2 = cmul(w1, w1); cpx te = w2, to = w1;
    X[base] = e[0]; X[base + PS] = cmul(o[0], to); to = cmul(to, w2);
#pragma unroll
    for (int q = 1; q < 16; ++q) { X[base + PS * (2 * q)] = cmul(e[SLOT16(q)], te); X[base + PS * (2 * q + 1)] = cmul(o[SLOT16(q)], to); te = cmul(te, w2); to = cmul(to, w2); }
}
__device__ __forceinline__ void fft_fwd32B(LAS cpx* X, const LAS cpx* TW, int tid) {
    int t = tid; asm volatile("" : "+v"(t)); const int blk = t >> 4, j = t & 15; const int base = 544 * blk + j; constexpr int PS = 17;
    cpx e[16], o[16];
#pragma unroll
    for (int m = 0; m < 16; ++m) { e[m] = X[base + PS * m]; o[m] = X[base + PS * (m + 16)]; }
    dft32<false, false>(e, o);
    const cpx w1 = TW[j], w2 = cmul(w1, w1); cpx te = w2, to = w1;
    X[base] = e[0]; X[base + PS] = cmul(o[0], to); to = cmul(to, w2);
#pragma unroll
    for (int q = 1; q < 16; ++q) { X[base + PS * (2 * q)] = cmul(e[SLOT16(q)], te); X[base + PS * (2 * q + 1)] = cmul(o[SLOT16(q)], to); te = cmul(te, w2); to = cmul(to, w2); }
}
template <int PS, int NOUT> __device__ __forceinline__ void fft_inv32_core(LAS cpx* X, int base, cpx w1c) {
    const cpx w2 = cmul(w1c, w1c); cpx te = w2, to = w1c;
    cpx e[16], o[16];
    cpx zin[32];
    zin[0] = X[base]; zin[1] = cmul(X[base + PS], to); to = cmul(to, w2);
#pragma unroll
    for (int q = 1; q < 16; ++q) { zin[2 * q] = cmul(X[base + PS * (2 * q)], te); zin[2 * q + 1] = cmul(X[base + PS * (2 * q + 1)], to); te = cmul(te, w2); to = cmul(to, w2); }
#pragma unroll
    for (int m = 0; m < 16; ++m) { e[m] = zin[m]; o[m] = zin[m + 16]; }
    dft32<true, false>(e, o);
#pragma unroll
    for (int m = 0; m < NOUT; ++m) X[base + PS * m] = (m & 1) ? o[SLOT16(m >> 1)] : e[SLOT16(m >> 1)];
}
__device__ __forceinline__ void fft_inv32A_final(const LAS cpx* X, const LAS cpx* TW, int tid, const unsigned* sx, bf16* rowA, bf16* rowB, bool dostore) {
    int j = tid; asm volatile("" : "+v"(j)); cpx w1 = TW[j]; w1.y = -w1.y; const int base = pidx(j); constexpr int PS = 544;
    unsigned sa[16], sb[16];
#pragma unroll
    for (int m = 0; m < 16; ++m) { sa[m] = __hip_atomic_load(sx + j + 512 * m, __ATOMIC_RELAXED, __HIP_MEMORY_SCOPE_AGENT); sb[m] = __hip_atomic_load(sx + SEQ + j + 512 * m, __ATOMIC_RELAXED, __HIP_MEMORY_SCOPE_AGENT); }
    const cpx w2 = cmul(w1, w1); cpx te = w2, to = w1;
    cpx e[16], o[16]; cpx zin[32];
    zin[0] = X[base]; zin[1] = cmul(X[base + PS], to); to = cmul(to, w2);
#pragma unroll
    for (int q = 1; q < 16; ++q) { zin[2 * q] = cmul(X[base + PS * (2 * q)], te); zin[2 * q + 1] = cmul(X[base + PS * (2 * q + 1)], to); te = cmul(te, w2); to = cmul(to, w2); }
#pragma unroll
    for (int m = 0; m < 16; ++m) { e[m] = zin[m]; o[m] = zin[m + 16]; }
    dft32<true, false>(e, o);
    if (dostore) {
#pragma unroll
        for (int m = 0; m < 16; ++m) { const cpx y = (m & 1) ? o[SLOT16(m >> 1)] : e[SLOT16(m >> 1)]; const int t = j + 512 * m;
            const float oa = y.x * bflo(sa[m]) + bfhi(sa[m]), ob = y.y * bflo(sb[m]) + bfhi(sb[m]);
            rowA[t] = (bf16)(pk2(oa, 0.f) & 0xffffu); rowB[t] = (bf16)(pk2(ob, 0.f) & 0xffffu); }
    }
}
__device__ __forceinline__ void fft_inv32B(LAS cpx* X, const LAS cpx* TW, int tid) {
    int t = tid; asm volatile("" : "+v"(t)); const int blk = t >> 4, j = t & 15; cpx w1 = TW[j]; w1.y = -w1.y;
    fft_inv32_core<17, 32>(X, 544 * blk + j, w1);
}
template <int NOUT> __device__ __forceinline__ void fft_inv32A(LAS cpx* X, const LAS cpx* TW, int tid) {
    int j = tid; asm volatile("" : "+v"(j)); cpx w1 = TW[j]; w1.y = -w1.y;
    fft_inv32_core<544, NOUT>(X, pidx(j), w1);
}
__device__ __forceinline__ void fft_fwdD_toK(const LAS cpx* X, cpx* Kb, int tid) {
#pragma unroll 1
    for (int it = 0; it < 2; ++it) {
        int bf = tid + 512 * it; asm volatile("" : "+v"(bf)); const int base = 17 * bf;
        cpx x[16];
#pragma unroll
        for (int m = 0; m < 16; ++m) x[m] = X[base + m];
        dft16<false>(x);
#pragma unroll
        for (int q = 0; q < 16; ++q) Kb[q * 1024 + bf] = x[SLOT16(q)] * (1.f / 16384.f);
    }
}
__device__ __forceinline__ void fft_kload1(cpx (&kq)[16], const cpx* Kb, int bf) {
#pragma unroll
    for (int q = 0; q < 16; ++q) { const unsigned long long kb = __hip_atomic_load((const unsigned long long*)(Kb + q * 1024 + bf), __ATOMIC_RELAXED, __HIP_MEMORY_SCOPE_AGENT);
        kq[q] = (cpx){__builtin_bit_cast(float, (unsigned)kb), __builtin_bit_cast(float, (unsigned)(kb >> 32))}; }
}
__device__ __forceinline__ void fft_fusedD_one(LAS cpx* X, const cpx (&kq)[16], int bf) {
    const int base = 17 * bf; cpx x[16], z[16];
#pragma unroll
    for (int m = 0; m < 16; ++m) x[m] = X[base + m];
    dft16<false>(x);
#pragma unroll
    for (int q = 0; q < 16; ++q) z[q] = cmul(x[SLOT16(q)], kq[q]);
    dft16<true>(z);
#pragma unroll
    for (int m = 0; m < 16; ++m) X[base + m] = z[SLOT16(m)];
}
__device__ __forceinline__ void fft_fusedD(LAS cpx* X, const cpx* Kb, int tid) {
    int bf = tid; asm volatile("" : "+v"(bf));
    cpx k0[16], k1[16];
    fft_kload1(k0, Kb, bf); fft_kload1(k1, Kb, bf + 512);
    fft_fusedD_one(X, k0, bf);
    fft_fusedD_one(X, k1, bf + 512);
}
struct Raw10 { u32x4 q; unsigned short l, r; };
__device__ __forceinline__ void load10_issue(Raw10& R, const bf16* row, int t0) {
    const int lane = threadIdx.x & 63; R.q = *(const u32x4*)(row + t0); R.l = 0; R.r = 0;
    if (lane == 0 && t0 > 0) R.l = row[t0 - 1];
    if (lane == 63 && t0 + 8 < SEQ) R.r = row[t0 + 8];
}
__device__ __forceinline__ void load10_finish(const Raw10& R, float (&pv)[10]) {
    const int lane = threadIdx.x & 63; const u32x4 q = R.q;
    pv[1] = bflo(q.x); pv[2] = bfhi(q.x); pv[3] = bflo(q.y); pv[4] = bfhi(q.y); pv[5] = bflo(q.z); pv[6] = bfhi(q.z); pv[7] = bflo(q.w); pv[8] = bfhi(q.w);
    float l = __shfl_up(pv[8], 1), r = __shfl_down(pv[1], 1);
    if (lane == 0) l = bf2f(R.l);
    if (lane == 63) r = bf2f(R.r);
    pv[0] = l; pv[9] = r;
}

struct ScanW { const bf16* prx; const bf16* grg; bf16* yrg; const float* rgcw; const float* rgcb; const bf16* wgt;
               const float* ba_f; const float* bx_f; const float* lam_f; const float* ba_b; const float* bx_b; const float* lam_b; f32x2* carr; const float* cin; };
__device__ __forceinline__ float neg_expm1_neg(float x) {
    return (x > -0.1f) ? -x * (1.f + x * 0.5f * (1.f + x * (1.f / 3.f) * (1.f + x * 0.25f * (1.f + x * 0.2f)))) : 1.f - __expf(x);
}
struct ScanPre { u32x4 p[4]; u32x4 gl; float cinv; };
template <int PASS>
__device__ __forceinline__ void scan_decode(int it, int& b, int& j, int& h) {
    h = it & 15; const int rest = it >> 4;
    if (PASS == 1) { j = rest % NCHUNK; b = rest / NCHUNK; } else { j = (rest & 127) + 4; b = rest >> 7; }
}
template <int PASS>
__device__ __forceinline__ void scan_prefetch(ScanPre& R, const ScanW& W, int it, int tid, int cidx_lane) {
    int b, j, h; scan_decode<PASS>(it, b, j, h);
    const int isctx = j < 4; const int seglen = isctx ? CTXL : SEQ; const int t0 = isctx ? j * 64 : (j - 4) * 64; const int rowbase = isctx ? NTOK + b * CTXL : b * SEQ;
    const int tok = tid >> 3, cg0 = h * 64 + (tid & 7) * 8;
#pragma unroll
    for (int jj = 0; jj < 4; ++jj) { const int tt = t0 + tok + jj - 2; R.p[jj] = (u32x4){0u, 0u, 0u, 0u};
        if (tt >= 0 && tt < seglen) R.p[jj] = *(const u32x4*)(W.prx + (size_t)(rowbase + tt) * 1024 + cg0); }
    R.cinv = 0.f;
    if (PASS == 2) { R.gl = *(const u32x4*)(W.grg + (size_t)(rowbase + t0 + tok) * 1024 + cg0); R.cinv = W.cin[(size_t)(b * NCHUNK + j) * 2048 + h * 64 + cidx_lane]; }
}
template <int PASS>
__device__ __forceinline__ void scan_phase(LAS unsigned char* lds, const ScanW& W, int first, int stride, int nitems, int tid, int lane, int wave) {
    LAS float* XCF = (LAS float*)lds;
    LAS bf16* XCB = (LAS bf16*)(lds + 16896);
    LAS float* HX = (LAS float*)(lds + 16896 + 9216);
    if (first >= nitems) return;
    const int dir = wave >> 2, eb = wave & 3, g = lane >> 4, li = lane & 15;
    const int tok = tid >> 3, e0 = (tid & 7) * 8;
    int hcur = -1;
    float cw[4][8], cb[8]; bf16x8 bR[2], bI[2]; float ba = 0.f, bx = 0.f, sp8 = 0.f, sp8l = 0.f, nba = 0.f, nbx = 0.f;
    const int cidx_lane = dir * 1024 + eb * 16 + li;
    ScanPre R; scan_prefetch<PASS>(R, W, first, tid, cidx_lane);
    u32x4 o_prev = {0u, 0u, 0u, 0u}; bf16* p_prev = nullptr; f32x2 c_prev = {0.f, 0.f}; f32x2* cp_prev = nullptr;
#pragma unroll 1
    for (int it = first; it < nitems; it += stride) {
        int b, j, h; scan_decode<PASS>(it, b, j, h);
        const int isctx = j < 4; const int t0 = isctx ? j * 64 : (j - 4) * 64; const int rowbase = isctx ? NTOK + b * CTXL : b * SEQ;
        const int ch = h * 64 + eb * 16 + li;
        const size_t cidx = ((size_t)(b * NCHUNK + j) * 2 + dir) * 1024 + ch;
        const float cinv = R.cinv;
        if (h != hcur) {
            hcur = h; const int cg0 = h * 64 + e0;
#pragma unroll
            for (int jj = 0; jj < 4; ++jj) { const f32x4 w0 = *(const f32x4*)(W.rgcw + jj * 1024 + cg0), w1 = *(const f32x4*)(W.rgcw + jj * 1024 + cg0 + 4);
                cw[jj][0] = w0[0]; cw[jj][1] = w0[1]; cw[jj][2] = w0[2]; cw[jj][3] = w0[3]; cw[jj][4] = w1[0]; cw[jj][5] = w1[1]; cw[jj][6] = w1[2]; cw[jj][7] = w1[3]; }
            { const f32x4 c0 = *(const f32x4*)(W.rgcb + cg0), c1 = *(const f32x4*)(W.rgcb + cg0 + 4); cb[0] = c0[0]; cb[1] = c0[1]; cb[2] = c0[2]; cb[3] = c0[3]; cb[4] = c1[0]; cb[5] = c1[1]; cb[6] = c1[2]; cb[7] = c1[3]; }
            const bf16* wp = W.wgt + ((size_t)((dir * 2) * 16 + h) * 64 + eb * 16 + li) * 64 + g * 8;
            bR[0] = *(const bf16x8*)(wp); bR[1] = *(const bf16x8*)(wp + 32); bI[0] = *(const bf16x8*)(wp + 16 * 4096); bI[1] = *(const bf16x8*)(wp + 16 * 4096 + 32);
            ba = (dir ? W.ba_b : W.ba_f)[ch]; bx = (dir ? W.bx_b : W.bx_f)[ch]; const float lam = (dir ? W.lam_b : W.lam_f)[ch];
            sp8 = -8.f * log1pf(__expf(-lam)); sp8l = sp8 * 1.4426950408889634f; nba = -ba * 1.4426950408889634f; nbx = -bx * 1.4426950408889634f;
        }
        {
            float xv[8];
#pragma unroll
            for (int q = 0; q < 8; ++q) xv[q] = cb[q];
#pragma unroll
            for (int jj = 0; jj < 4; ++jj) { const u32x4 p = R.p[jj];
                xv[0] += cw[jj][0] * bflo(p.x); xv[1] += cw[jj][1] * bfhi(p.x); xv[2] += cw[jj][2] * bflo(p.y); xv[3] += cw[jj][3] * bfhi(p.y);
                xv[4] += cw[jj][4] * bflo(p.z); xv[5] += cw[jj][5] * bfhi(p.z); xv[6] += cw[jj][6] * bflo(p.w); xv[7] += cw[jj][7] * bfhi(p.w); }
#pragma unroll
            for (int q = 0; q < 8; ++q) XCF[tok * 65 + e0 + q] = xv[q];
            *(LAS u32x4*)(XCB + tok * 72 + e0) = (u32x4){pk2(xv[0], xv[1]), pk2(xv[2], xv[3]), pk2(xv[4], xv[5]), pk2(xv[6], xv[7])};
        }
        const u32x4 gl = R.gl;
        if (it + stride < nitems) scan_prefetch<PASS>(R, W, it + stride, tid, cidx_lane);
        if (PASS == 2) { if (p_prev) *(u32x4*)p_prev = o_prev; } else { if (cp_prev) *cp_prev = c_prev; }
        LDS_BARRIER();
        f32x4 aR[4], aI[4];
#pragma unroll
        for (int mb = 0; mb < 4; ++mb) { aR[mb] = (f32x4){0.f, 0.f, 0.f, 0.f}; aI[mb] = (f32x4){0.f, 0.f, 0.f, 0.f};
            const int trow = 16 * (li >> 2) + 4 * mb + (li & 3);
#pragma unroll
            for (int ks = 0; ks < 2; ++ks) { const bf16x8 af = *(const LAS bf16x8*)(XCB + trow * 72 + ks * 32 + g * 8);
                aR[mb] = __builtin_amdgcn_mfma_f32_16x16x32_bf16(af, bR[ks], aR[mb], 0, 0, 0); aI[mb] = __builtin_amdgcn_mfma_f32_16x16x32_bf16(af, bI[ks], aI[mb], 0, 0, 0); } }
        float av[16], bv[16];
#pragma unroll
        for (int mb = 0; mb < 4; ++mb)
#pragma unroll
            for (int r = 0; r < 4; ++r) { const int tk = 16 * g + 4 * mb + r; const float xcv = XCF[tk * 65 + eb * 16 + li];
                const float rr = __builtin_amdgcn_rcpf(1.f + __builtin_amdgcn_exp2f(__builtin_fmaf(aR[mb][r], -1.4426950408889634f, nba)));
                const float ii = __builtin_amdgcn_rcpf(1.f + __builtin_amdgcn_exp2f(__builtin_fmaf(aI[mb][r], -1.4426950408889634f, nbx)));
                const float a = __builtin_amdgcn_exp2f(sp8l * rr); const float om = (1.f - a) * (1.f + a);
                av[4 * mb + r] = a; bv[4 * mb + r] = __builtin_amdgcn_sqrtf(om) * ii * xcv; }
        float A16 = 1.f, B16 = 0.f;
        if (dir == 0) {
#pragma unroll
            for (int q = 0; q < 16; ++q) { B16 = av[q] * B16 + bv[q]; A16 *= av[q]; }
        } else {
#pragma unroll
            for (int q = 15; q >= 0; --q) { B16 = av[q] * B16 + bv[q]; A16 *= av[q]; }
        }
        float Pc = 1.f, Hc = cinv, hin;
        {
            LAS float* chn = (LAS float*)(lds + 60928) + wave * 128 + li * 8;
            *(LAS f32x2*)(chn + g * 2) = (f32x2){A16, B16};
            LDS_WAIT(); asm volatile("" ::: "memory");
            const f32x4 c01 = *(const LAS f32x4*)(chn), c23 = *(const LAS f32x4*)(chn + 4);
            LDS_WAIT(); asm volatile("" ::: "memory");
            const float Ag[4] = {c01[0], c01[2], c23[0], c23[2]}, Bg[4] = {c01[1], c01[3], c23[1], c23[3]};
            hin = Hc;
#pragma unroll
            for (int k = 0; k < 4; ++k) { const int gk = (dir == 0) ? k : 3 - k;
                const bool before = (dir == 0) ? (gk < g) : (gk > g);
                const float Hn = Ag[gk] * Hc + Bg[gk]; Pc *= Ag[gk]; Hc = Hn; if (before) hin = Hn; }
        }
        if (PASS == 1) {
            cp_prev = (g == 0) ? (W.carr + cidx) : nullptr; c_prev = (f32x2){Pc, Hc};
            LDS_BARRIER();
        } else {
            LAS float* hx = HX + dir * (64 * 68) + (16 * g) * 68 + eb * 16 + li; float H = hin;
            if (dir == 0) {
#pragma unroll
                for (int q = 0; q < 16; ++q) { H = av[q] * H + bv[q]; hx[q * 68] = H; }
            } else {
#pragma unroll
                for (int q = 15; q >= 0; --q) { H = av[q] * H + bv[q]; hx[q * 68] = H; }
            }
            LDS_BARRIER();
            const f32x4 f0 = *(const LAS f32x4*)(HX + tok * 68 + e0), f1 = *(const LAS f32x4*)(HX + tok * 68 + e0 + 4);
            const f32x4 g0 = *(const LAS f32x4*)(HX + 64 * 68 + tok * 68 + e0), g1 = *(const LAS f32x4*)(HX + 64 * 68 + tok * 68 + e0 + 4);
            u32x4 o; o.x = pk2((f0[0] + g0[0]) * bflo(gl.x), (f0[1] + g0[1]) * bfhi(gl.x)); o.y = pk2((f0[2] + g0[2]) * bflo(gl.y), (f0[3] + g0[3]) * bfhi(gl.y));
            o.z = pk2((f1[0] + g1[0]) * bflo(gl.z), (f1[1] + g1[1]) * bfhi(gl.z)); o.w = pk2((f1[2] + g1[2]) * bflo(gl.w), (f1[3] + g1[3]) * bfhi(gl.w));
            o_prev = o; p_prev = W.yrg + (size_t)(rowbase + t0 + tok) * 1024 + h * 64 + e0;
        }
    }
    if (PASS == 2) { if (p_prev) *(u32x4*)p_prev = o_prev; } else { if (cp_prev) *cp_prev = c_prev; }
}

#define XB_TMO      128
#define XB_XCNT(j)  (256  + 64 * (j))
#define XB_XSUB(j)  (1280 + 64 * (j))
#define XB_XGEN(j)  (2304 + 64 * (j))
#define XB_TOP      3328
#define XB_TOPGEN   3392
#define XCD_BAR_WORDS 3456
#define XB_SPIN_CAP (1u << 18)
__device__ __forceinline__ unsigned xb_ld(unsigned* p)              { return __hip_atomic_load(p, __ATOMIC_RELAXED, __HIP_MEMORY_SCOPE_AGENT); }
__device__ __forceinline__ unsigned xb_add(unsigned* p, unsigned v) { return __hip_atomic_fetch_add(p, v, __ATOMIC_RELAXED, __HIP_MEMORY_SCOPE_AGENT); }
__device__ __forceinline__ unsigned xb_xcc_id() { return (unsigned)__builtin_amdgcn_s_getreg((3 << 11) | 20) & 0xFu; }
#define XB_SPIN(cond, bar) do { unsigned _sp = 0; while (cond) { __builtin_amdgcn_s_sleep(1); \
    if ((++_sp & 255u) == 0u) { if (xb_ld(&(bar)[XB_TMO])) break; if (_sp > XB_SPIN_CAP) { atomicAdd(&(bar)[XB_TMO], 1u); break; } } } } while (0)
struct XcdBarrier { unsigned* bar; unsigned x; volatile LAS unsigned* st; };
__device__ __forceinline__ void xcd_barrier_complete(unsigned* bar, unsigned x, unsigned& nloc, unsigned& nx) {
    const unsigned Gn = gridDim.x * gridDim.y * gridDim.z;
    unsigned sum, cntx, mine, sp = 0u;
    for (;;) {
        sum = 0u; cntx = 0u; mine = 0u;
#pragma unroll
        for (unsigned j = 0; j < 16; ++j) { const unsigned c = xb_ld(&bar[XB_XCNT(j)]); sum += c; cntx += (c > 0u) ? 1u : 0u; mine = (j == x) ? c : mine; }
        if (sum == Gn) break;
        __builtin_amdgcn_s_sleep(1);
        if ((++sp & 255u) == 0u) { if (xb_ld(&bar[XB_TMO])) break; if (sp > XB_SPIN_CAP) { atomicAdd(&bar[XB_TMO], 1u); break; } }
    }
    nloc = mine > 0u ? mine : 1u; nx = cntx > 0u ? cntx : 1u;
}
__device__ __forceinline__ void xcd_barrier(const XcdBarrier& b) {
    asm volatile("s_waitcnt vmcnt(0)" ::: "memory");
    __syncthreads();
    if (threadIdx.x == 0) {
        unsigned* bar = b.bar;
        __builtin_amdgcn_s_waitcnt(0);
        unsigned nloc = b.st[0], nx = b.st[1];
        if (nloc == 0u) { xcd_barrier_complete(bar, b.x, nloc, nx); b.st[0] = nloc; b.st[1] = nx; }
        const unsigned old = xb_add(&bar[XB_XSUB(b.x)], 1u);
        const unsigned gen = old / nloc;
        if (old + 1u == (gen + 1u) * nloc) {
            __builtin_amdgcn_fence(__ATOMIC_RELEASE, "agent");
            asm volatile("s_waitcnt vmcnt(0)" ::: "memory");
            const unsigned og = xb_add(&bar[XB_TOP], 1u);
            const unsigned tg = og / nx;
            if (og + 1u == (tg + 1u) * nx) xb_add(&bar[XB_TOPGEN], 1u);
            else XB_SPIN(xb_ld(&bar[XB_TOPGEN]) == tg, bar);
            __builtin_amdgcn_fence(__ATOMIC_ACQUIRE, "agent");
            xb_add(&bar[XB_XGEN(b.x)], 1u);
            asm volatile("s_waitcnt vmcnt(0)" ::: "memory");
        } else {
            XB_SPIN(xb_ld(&bar[XB_XGEN(b.x)]) == gen, bar);
            __builtin_amdgcn_fence(__ATOMIC_ACQUIRE, "agent");
            asm volatile("s_waitcnt vmcnt(0)" ::: "memory");
        }
    }
    __syncthreads();
}

__device__ __forceinline__ void transpose_item(const float* W, int K, int N, bf16* WT, int mode, LAS float* scr, int item, int lane) {
    const int nblk = N / 64, kb = item / nblk, nb = item % nblk, k0 = 64 * kb, n0 = 64 * nb;
    const int lr = lane >> 4, lc = (lane & 15) * 4;
    f32x4 v[16];
#pragma unroll
    for (int i = 0; i < 16; ++i) v[i] = __builtin_nontemporal_load((const f32x4*)(W + (size_t)(k0 + 4 * i + lr) * N + n0 + lc));
#pragma unroll
    for (int i = 0; i < 16; ++i) { LAS float* d = scr + (4 * i + lr) * 65 + lc; d[0] = v[i][0]; d[1] = v[i][1]; d[2] = v[i][2]; d[3] = v[i][3]; }
    LDS_WAIT(); asm volatile("" ::: "memory");
    const int c = lane & 7;
#pragma unroll
    for (int j = 0; j < 8; ++j) { const int n = (lane >> 3) + 8 * j; const LAS float* sp = scr + (8 * c) * 65 + n;
        u32x4 o; o.x = pk2(sp[0 * 65], sp[1 * 65]); o.y = pk2(sp[2 * 65], sp[3 * 65]); o.z = pk2(sp[4 * 65], sp[5 * 65]); o.w = pk2(sp[6 * 65], sp[7 * 65]);
        const int nn = n0 + n; int row;
        if (mode == 0) row = nn;
        else if (mode == 1) row = (nn >> 7) * 256 + (nn & 127);
        else row = (nn >> 7) * 256 + 128 + (nn & 127);
        *(u32x4*)(WT + (size_t)row * K + k0 + 8 * c) = o; }
    LDS_WAIT(); asm volatile("" ::: "memory");
}

struct Args { const float* in[41]; float* out; unsigned char* ws; int ph_lo, ph_hi; };

enum { I_X = 0, I_C, I_CTX, I_CCTX, I_ADAW, I_ADAB, I_N1G, I_N2G, I_FG, I_WIN, I_RGCW, I_RGCB, I_WAF, I_BAF, I_WXF, I_BXF, I_LAMF, I_WAB, I_BAB, I_WXB, I_BXB, I_LAMB,
       I_RGPROJ, I_HYCW, I_HYCB, I_PW1, I_PB1, I_PW2, I_PB2, I_FREQ, I_PW3, I_SKIP, I_HYPROJ, I_WOUT, I_WG, I_BG, I_WE, I_BE, I_MW1, I_MW3, I_MW2 };

constexpr int NPHASE = 13;

__global__ void __launch_bounds__(NTHREADS, 2) fwd_kernel(Args args) {
    extern __shared__ __attribute__((aligned(16))) unsigned char lds_raw[];
    LAS unsigned char* lds = (LAS unsigned char*)lds_raw;
    const int tid = threadIdx.x, lane = tid & 63, wave = __builtin_amdgcn_readfirstlane(tid >> 6);
    const int G = gridDim.x, bid = blockIdx.x;
    const int gw = bid * NWAVES + wave, NGW = G * NWAVES;
    unsigned char* ws = args.ws;
    const int lo = args.ph_lo, hi = args.ph_hi;
#define IN(k) (lo <= (k) && (k) < hi)
#if ONE_LAUNCH
    cg::grid_group grid = cg::this_grid();
#define GRID_SYNC(k) do { if (IN(k) && IN((k) + 1)) { if ((k) == 0) { grid.sync(); if (tid == 0) (void)xb_add(&xbar.bar[XB_XCNT(xbar.x)], 1u); } \
        else { xcd_barrier(xbar); if (REPN(99) == 2) xcd_barrier(xbar); } \
        if (PROBE_TS >= 0 && bid == 0 && tid == 0) tsbuf[(k) + 1] = __builtin_amdgcn_s_memrealtime(); } } while (0)
#else
#define GRID_SYNC(k) do { } while (0)
#endif
    int* cnt = (int*)(ws + WS_CTL);
    unsigned long long* tsbuf = (unsigned long long*)(ws + WS_CTL + 65536);
    if (PROBE_TS >= 0 && bid == 0 && tid == 0) tsbuf[0] = __builtin_amdgcn_s_memrealtime();
    XcdBarrier xbar; xbar.bar = (unsigned*)(ws + WS_CTL) + 4096; xbar.x = xb_xcc_id(); xbar.st = (volatile LAS unsigned*)(lds + LDS_BYTES - 64);
    if (tid < 2) xbar.st[tid] = 0u;
    __syncthreads();
    float* mod = (float*)(ws + WS_MOD);
    float* z2 = (float*)(ws + WS_Z2);
    float* ssq = (float*)(ws + WS_SSQ);
    int* tok_e = (int*)(ws + WS_ROUTE); int* tok_rank = tok_e + 2 * NTOK; float* tok_w = (float*)(tok_rank + 2 * NTOK); int* tok_slot = (int*)(tok_w + 2 * NTOK);
    bf16* rgproj_t = (bf16*)(ws + WS_WSMALL); bf16* hyproj_t = rgproj_t + 1024 * 1024; bf16* wout_t = hyproj_t + 1024 * 1024;
    bf16* win_t = (bf16*)(ws + WS_WIN);
    bf16* hx = (bf16*)(ws + WS_HX); bf16* yhy = (bf16*)(ws + WS_HX); bf16* Hbuf = (bf16*)(ws + WS_HX);
    bf16* prx = (bf16*)(ws + WS_PRX); bf16* merged = (bf16*)(ws + WS_PRX);
    bf16* grg = (bf16*)(ws + WS_GRG); bf16* hx2 = (bf16*)(ws + WS_GRG);
    bf16* phyT = (bf16*)(ws + WS_PHY);
    bf16* w13t = (bf16*)(ws + WS_W13); bf16* w2t = (bf16*)(ws + WS_W2);
    bf16* Xg = (bf16*)(ws + WS_XG); bf16* Ybuf = (bf16*)(ws + WS_XG);
    float* kf = (float*)(ws + WS_KF); bf16* yrg = (bf16*)(ws + WS_KF);
    f32x2* carr = (f32x2*)(ws + WS_CARR); float* cin = (float*)(ws + WS_CIN);
    bf16* gates = (bf16*)args.out;
    float* x1 = args.out;

    if (IN(0)) for (int rp = 0; rp < REPN(0); ++rp) {
        if (bid == 0) for (int i = tid; i < 1024; i += NTHREADS) cnt[i] = 0;
        if (bid == 0) for (int i = tid; i < XCD_BAR_WORDS; i += NTHREADS) xbar.bar[i] = 0u;
        const int nA = (G >= 192) ? 96 : 0; const bool doA = (nA == 0) || (bid < nA), doB = (nA == 0) || (bid >= nA);
        const int ob = bid - nA, OG = G - nA, ogw = ob * NWAVES + wave, ONGW = OG * NWAVES;
        if (doA) {
            LAS float* red = (LAS float*)lds;
            const float* c = args.in[I_C]; const float* cctx = args.in[I_CCTX]; const float* ada_w = args.in[I_ADAW]; const float* ada_b = args.in[I_ADAB];
            LAS float* sil = red + 8 * 5 * 64;
            for (int i = tid; i < 5 * 1024; i += NTHREADS) { const float cv = (i < 4096) ? c[i] : cctx[i - 4096]; sil[i] = cv * sigmoidf_(cv); }
            __syncthreads();
            for (int g = bid; g < 96; g += (nA ? nA : G)) {
                const int n = g * 64 + lane; float acc[5] = {0.f, 0.f, 0.f, 0.f, 0.f};
                for (int kk = 0; kk < 128; kk += 16) { float a[16];
#pragma unroll
                    for (int u = 0; u < 16; ++u) a[u] = __builtin_nontemporal_load(ada_w + (size_t)(wave * 128 + kk + u) * 6144 + n);
#pragma unroll
                    for (int u = 0; u < 16; ++u) { const int k = wave * 128 + kk + u;
#pragma unroll
                        for (int r = 0; r < 5; ++r) acc[r] += sil[r * 1024 + k] * a[u]; } }
#pragma unroll
                for (int r = 0; r < 5; ++r) red[(wave * 5 + r) * 64 + lane] = acc[r];
                __syncthreads();
                if (wave == 0) {
#pragma unroll
                    for (int r = 0; r < 5; ++r) { float s = ada_b[n]; for (int w = 0; w < 8; ++w) s += red[(w * 5 + r) * 64 + lane]; mod[r * 6144 + n] = s; } }
                __syncthreads();
            }
        }
        if (doB) {
            LAS float* fe = (LAS float*)lds + wave * 128; LAS float* z1 = fe + 64;
            const float* w1 = args.in[I_PW1]; const float* b1 = args.in[I_PB1]; const float* w2 = args.in[I_PW2]; const float* b2 = args.in[I_PB2]; const float* fr = args.in[I_FREQ];
            const float TWO_PI = 6.283185307179586f;
            float w1c[50], w2c[64];
#pragma unroll
            for (int i = 0; i < 50; ++i) w1c[i] = w1[i * 64 + lane];
#pragma unroll
            for (int i = 0; i < 64; ++i) w2c[i] = w2[i * 64 + lane];
            const float b1l = b1[lane], b2l = b2[lane], frl = fr[lane];
            for (int s = ogw; s < SEQ; s += ONGW) {
                float f = 0.f; const float sf = (float)s;
                if (lane == 0) f = sf / 8191.f;
                else if (lane <= 32) { const int j = (lane - 1) & 15; const float band = 1e-4f + (float)j * ((15.f - 1e-4f) / 15.f); float rev = sf * band * (1.f / 8192.f); rev -= floorf(rev + 0.5f);
                    f = (lane <= 16) ? cosf(TWO_PI * rev) : sinf(TWO_PI * rev); }
                else if (lane == 33) f = (float)(s >> 6) / 128.f;
                else if (lane <= 49) { const int mm = (lane <= 41) ? (lane - 33) : (lane - 41); float rev = (float)((s & 63) * mm) * (1.f / 64.f); rev -= floorf(rev + 0.5f);
                    f = (lane <= 41) ? cosf(TWO_PI * rev) : sinf(TWO_PI * rev); }
                fe[lane] = f; LDS_WAIT(); asm volatile("" ::: "memory");
                float a = b1l;
#pragma unroll
                for (int i = 0; i < 50; ++i) a += fe[i] * w1c[i];
                z1[lane] = sinf(frl * a); LDS_WAIT(); asm volatile("" ::: "memory");
                float a2 = b2l;
#pragma unroll
                for (int i = 0; i < 64; ++i) a2 += z1[i] * w2c[i];
                z2[(size_t)s * 64 + lane] = sinf(frl * a2);
                LDS_WAIT(); asm volatile("" ::: "memory");
            }
        }
        __syncthreads();
        if (doB) {
            LAS float* scr = (LAS float*)lds + wave * 4160;
            constexpr int I_IN = 16 * 112, I_SQ = 16 * 16;
            constexpr int NITEMS = I_IN + 3 * I_SQ;
            for (int it = ogw; it < NITEMS; it += ONGW) {
                int r = it;
                if (r < I_IN) { transpose_item(args.in[I_WIN], 1024, INC, win_t, 0, scr, r, lane); continue; } r -= I_IN;
                if (r < I_SQ) { transpose_item(args.in[I_RGPROJ], 1024, 1024, rgproj_t, 0, scr, r, lane); continue; } r -= I_SQ;
                if (r < I_SQ) { transpose_item(args.in[I_HYPROJ], 1024, 1024, hyproj_t, 0, scr, r, lane); continue; } r -= I_SQ;
                transpose_item(args.in[I_WOUT], 1024, 1024, wout_t, 0, scr, r, lane);
            }
        }
        if (doB) {
            bf16* wrh = (bf16*)(ws + 28 * MiB); bf16* wrl = wrh + 48 * 1024;
            for (int i = ob * NTHREADS + tid; i < 48 * 1024; i += OG * NTHREADS) { const int n = i >> 10, k = i & 1023;
                const float w = (n < 4) ? args.in[I_WG][k * 4 + n] : (n < 36) ? args.in[I_WE][k * 32 + (n - 4)] : 0.f;
                const unsigned h = pk2(w, 0.f) & 0xffffu; wrh[i] = (bf16)h; wrl[i] = (bf16)(pk2(w - bf2f(h), 0.f) & 0xffffu); }
        }
        if (doB) {
            bf16* wgt = (bf16*)(ws + WS_GATEW);
            for (int i = ob * NTHREADS + tid; i < 4 * 65536; i += OG * NTHREADS) { const int gi = i >> 16, r = i & 65535, hh = r >> 12, e = (r >> 6) & 63, d = r & 63;
                const float* src = gi == 0 ? args.in[I_WAF] : gi == 1 ? args.in[I_WXF] : gi == 2 ? args.in[I_WAB] : args.in[I_WXB];
                wgt[i] = (bf16)f2bf(src[hh * 4096 + d * 64 + e]); }
        }
    }
    GRID_SYNC(0);

    if (IN(1)) for (int rp = 0; rp < REPN(1); ++rp) {
        const float* x = args.in[I_X]; const float* ctx = args.in[I_CTX]; const float* n1g = args.in[I_N1G];
        f32x4 n1v[4];
#pragma unroll
        for (int j = 0; j < 4; ++j) n1v[j] = *(const f32x4*)(n1g + 4 * (64 * j + lane));
        for (int m0 = 2 * gw; m0 < MROWS; m0 += 2 * NGW) {
            f32x4 v[2][4]; float ss[2] = {0.f, 0.f};
#pragma unroll
            for (int u = 0; u < 2; ++u) { const int m = m0 + u; const float* xr = (m < NTOK) ? x + (size_t)m * 1024 : ctx + (size_t)(m - NTOK) * 1024;
#pragma unroll
                for (int j = 0; j < 4; ++j) v[u][j] = __builtin_nontemporal_load((const f32x4*)xr + 64 * j + lane); }
#pragma unroll
            for (int u = 0; u < 2; ++u)
#pragma unroll
                for (int j = 0; j < 4; ++j) ss[u] += (v[u][j][0] * v[u][j][0] + v[u][j][1] * v[u][j][1]) + (v[u][j][2] * v[u][j][2] + v[u][j][3] * v[u][j][3]);
#pragma unroll
            for (int u = 0; u < 2; ++u) { const int m = m0 + u; const int r = (m < NTOK) ? (m >> 13) : 4; const float* sh = mod + r * 6144; const float* sc = sh + 1024;
                const float rstd = rsqrtf(wave_sum(ss[u]) * (1.f / 1024.f) + 1e-6f);
#pragma unroll
                for (int j = 0; j < 4; ++j) { const int k = 4 * (64 * j + lane); const f32x4 g = n1v[j], s_ = *(const f32x4*)(sc + k), h = *(const f32x4*)(sh + k);
                    const f32x4 o = v[u][j] * rstd * g * (1.f + s_) + h; *(u32x2*)(hx + (size_t)m * 1024 + k) = pack4(o); } }
        }
        {
            LAS float* w3s = (LAS float*)lds;
            LAS float* z2t = w3s + 64 * 256;
            const float* w3 = args.in[I_PW3];
            const int sg = tid & 7, cgp = tid >> 3;
            int c0cur = -1;
            for (int it = bid; it < 8 * 128; it += G) {
                const int s0 = (it >> 3) * 64, c0 = (it & 7) * 256;
                __syncthreads();
                for (int e = tid; e < 64 * 64; e += NTHREADS) { const int r = e >> 6, jj = e & 63; z2t[jj * 68 + r] = z2[(size_t)(s0 + r) * 64 + jj]; }
                if (c0 != c0cur) { c0cur = c0;
                    for (int e = tid; e < 64 * 64; e += NTHREADS) { const int jj = e >> 6, c4 = e & 63; *(LAS f32x4*)(w3s + jj * 256 + 4 * c4) = *(const f32x4*)(w3 + (size_t)jj * 2048 + c0 + 4 * c4); } }
                __syncthreads();
                float acc[4][8];
#pragma unroll
                for (int a = 0; a < 4; ++a)
#pragma unroll
                    for (int q = 0; q < 8; ++q) acc[a][q] = 0.f;
#pragma unroll 4
                for (int jj = 0; jj < 64; ++jj) { const f32x4 w = *(const LAS f32x4*)(w3s + jj * 256 + 4 * cgp); const f32x4 za = *(const LAS f32x4*)(z2t + jj * 68 + 8 * sg), zb = *(const LAS f32x4*)(z2t + jj * 68 + 8 * sg + 4);
#pragma unroll
                    for (int a = 0; a < 4; ++a) { acc[a][0] += w[a] * za[0]; acc[a][1] += w[a] * za[1]; acc[a][2] += w[a] * za[2]; acc[a][3] += w[a] * za[3];
                        acc[a][4] += w[a] * zb[0]; acc[a][5] += w[a] * zb[1]; acc[a][6] += w[a] * zb[2]; acc[a][7] += w[a] * zb[3]; } }
                const float mind = -3.0701134573253944f, maxd = -15.350567286626972f;
#pragma unroll
                for (int a = 0; a < 4; ++a) { const int cp = c0 + 4 * cgp + a, ch = cp & 1023; const float delta = fabsf(mind + (float)ch * ((maxd - mind) / 1023.f));
                    f32x4 o0, o1;
#pragma unroll
                    for (int q = 0; q < 4; ++q) { o0[q] = acc[a][q] * __expf(-((float)(s0 + 8 * sg + q) / 8191.f) * delta); o1[q] = acc[a][4 + q] * __expf(-((float)(s0 + 8 * sg + 4 + q) / 8191.f) * delta); }
                    *(f32x4*)(kf + (size_t)cp * SEQ + s0 + 8 * sg) = o0; *(f32x4*)(kf + (size_t)cp * SEQ + s0 + 8 * sg + 4) = o1; }
            }
        }
    }
    GRID_SYNC(1);

    if (IN(2)) {
        { SchedInA S{(const char*)hx, (const char*)win_t, G, bid}; EpiInA E{prx, grg, gates}; pg8::gemm_phase(lds, 1024, S, E); }
        { SchedInB S{(const char*)hx, (const char*)win_t, G, bid}; EpiInB E{phyT}; pg8::gemm_phase(lds, 1024, S, E); }
    }
    GRID_SYNC(2);

    const ScanW SW{prx, grg, yrg, args.in[I_RGCW], args.in[I_RGCB], (const bf16*)(ws + WS_GATEW), args.in[I_BAF], args.in[I_BXF], args.in[I_LAMF], args.in[I_BAB], args.in[I_BXB], args.in[I_LAMB], carr, cin};
    if (IN(3)) {
        for (int rp = 0; rp < REPN(3); ++rp) scan_phase<1>(lds, SW, bid, G, NBATCH * NCHUNK * 16, tid, lane, wave);
        __syncthreads();
        {
            LAS cpx* X = (LAS cpx*)lds;
            LAS cpx* TWA = (LAS cpx*)(lds + 139264); LAS cpx* TWB = TWA + 512;
            for (int i = tid; i < 512 + 16; i += NTHREADS) { const float fr_ = (i < 512) ? (float)i * (1.f / 8192.f) : (float)(i - 512) * (1.f / 256.f);
                float sn, cs; sincospif(-fr_, &sn, &cs); TWA[i] = (cpx){cs, sn}; }
            __syncthreads();
            cpx* Kb = (cpx*)(ws + WS_HX) + (size_t)bid * 16384;
            unsigned* SX = (unsigned*)(ws + WS_HX + 32 * MiB) + (size_t)bid * 16384;
            const float* hcw = args.in[I_HYCW]; const float* hcb = args.in[I_HYCB]; const float* skip = args.in[I_SKIP];
            for (int rp = 0; rp < REPN(30); ++rp)
            for (int c = bid; c < 1024; c += G) {
                LDS_BARRIER();
                fft_fwd32A_filter(X, TWA, kf + (size_t)c * SEQ, kf + (size_t)(1024 + c) * SEQ, tid); LDS_BARRIER();
                fft_fwd32B(X, TWB, tid); LDS_BARRIER();
                fft_fwdD_toK(X, Kb, tid);
                const float w00 = hcw[c], w01 = hcw[3072 + c], w02 = hcw[6144 + c], b0 = hcb[c];
                const float w10 = hcw[1024 + c], w11 = hcw[3072 + 1024 + c], w12 = hcw[6144 + 1024 + c], b1 = hcb[1024 + c];
                const float w20 = hcw[2048 + c], w21 = hcw[3072 + 2048 + c], w22 = hcw[6144 + 2048 + c], b2 = hcb[2048 + c];
                const float sk = skip[c];
                for (int pair = 0; pair < 2; ++pair) {
                    const bf16* rA = phyT + ((size_t)(2 * pair) * 3072 + c) * SEQ; const bf16* rB = rA + (size_t)3072 * SEQ;
                    if (pair == 0) __syncthreads(); else LDS_BARRIER();
                    { int tb = tid; asm volatile("" : "+v"(tb));
                        Raw10 ra[2][6];
#pragma unroll
                        for (int it = 0; it < 2; ++it) { const int t0 = 8 * (tb + 512 * it);
                            load10_issue(ra[it][0], rA, t0); load10_issue(ra[it][1], rA + (size_t)1024 * SEQ, t0); load10_issue(ra[it][2], rA + (size_t)2048 * SEQ, t0);
                            load10_issue(ra[it][3], rB, t0); load10_issue(ra[it][4], rB + (size_t)1024 * SEQ, t0); load10_issue(ra[it][5], rB + (size_t)2048 * SEQ, t0); }
#pragma unroll
                        for (int it = 0; it < 2; ++it) { const int t0 = 8 * (tb + 512 * it); float p0[10], p1[10], p2[10], ua[8], ub[8]; unsigned qa[8], qb[8];
                            load10_finish(ra[it][0], p0); load10_finish(ra[it][1], p1); load10_finish(ra[it][2], p2);
#pragma unroll
                            for (int k = 0; k < 8; ++k) { ua[k] = (b2 + w20 * p2[k] + w21 * p2[k + 1] + w22 * p2[k + 2]) * (b1 + w10 * p1[k] + w11 * p1[k + 1] + w12 * p1[k + 2]);
                                const float x0 = b0 + w00 * p0[k] + w01 * p0[k + 1] + w02 * p0[k + 2]; qa[k] = pk2(x0, sk * ua[k] * x0); }
                            load10_finish(ra[it][3], p0); load10_finish(ra[it][4], p1); load10_finish(ra[it][5], p2);
#pragma unroll
                            for (int k = 0; k < 8; ++k) { ub[k] = (b2 + w20 * p2[k] + w21 * p2[k + 1] + w22 * p2[k + 2]) * (b1 + w10 * p1[k] + w11 * p1[k + 1] + w12 * p1[k + 2]);
                                const float x0 = b0 + w00 * p0[k] + w01 * p0[k + 1] + w02 * p0[k + 2]; qb[k] = pk2(x0, sk * ub[k] * x0); }
                            *(u32x4*)(SX + t0) = (u32x4){qa[0], qa[1], qa[2], qa[3]}; *(u32x4*)(SX + t0 + 4) = (u32x4){qa[4], qa[5], qa[6], qa[7]};
                            *(u32x4*)(SX + SEQ + t0) = (u32x4){qb[0], qb[1], qb[2], qb[3]}; *(u32x4*)(SX + SEQ + t0 + 4) = (u32x4){qb[4], qb[5], qb[6], qb[7]};
                            const int pb = pidx(t0);
#pragma unroll
                            for (int k = 0; k < 8; ++k) X[pb + k] = (cpx){ua[k], ub[k]}; } }
                    LDS_BARRIER();
                    fft_fwd32A<16>(X, TWA, tid); LDS_BARRIER();
                    fft_fwd32B(X, TWB, tid); LDS_BARRIER();
                    fft_fusedD(X, Kb, tid); LDS_BARRIER();
                    fft_inv32B(X, TWB, tid); __syncthreads();
                    fft_inv32A_final(X, TWA, tid, SX, (bf16*)rA, (bf16*)rB, rp == REPN(30) - 1);
                }
            }
        }
    }
    GRID_SYNC(3);

    if (IN(4)) for (int rp = 0; rp < REPN(4); ++rp) {
        const int gt = bid * NTHREADS + tid;
        if (gt < NBATCH * 2 * 1024) {
            const int c = gt & 1023, dir = (gt >> 10) & 1, b = gt >> 11; float s_ = 0.f;
            const size_t cbase = (size_t)(b * NCHUNK) * 2048 + dir * 1024 + c;
#pragma unroll 1
            for (int q0 = 0; q0 < NCHUNK; q0 += 33) { f32x2 ab[33];
#pragma unroll
                for (int u = 0; u < 33; ++u) { const int q = q0 + u; const int j = dir == 0 ? q : (q < 4 ? 3 - q : NCHUNK + 3 - q); ab[u] = __builtin_nontemporal_load(carr + cbase + (size_t)j * 2048); }
#pragma unroll
                for (int u = 0; u < 33; ++u) { const int q = q0 + u; const int j = dir == 0 ? q : (q < 4 ? 3 - q : NCHUNK + 3 - q); cin[cbase + (size_t)j * 2048] = s_; s_ = ab[u].x * s_ + ab[u].y; } }
        }
    }
    GRID_SYNC(4);

    if (IN(5)) {
        for (int rp = 0; rp < REPN(5); ++rp) scan_phase<2>(lds, SW, bid, G, NBATCH * 128 * 16, tid, lane, wave);
        __syncthreads();
        {
            LAS bf16* T = (LAS bf16*)lds;
            for (int rp = 0; rp < REPN(50); ++rp)
            for (int it = bid; it < NBATCH * 16 * 32; it += G) {
                const int tb4 = it & 31, cb = (it >> 5) & 15, b = it >> 9;
                const int cl = tid >> 3, ch = tid & 7;
                u32x4 v[4];
#pragma unroll
                for (int q = 0; q < 4; ++q) v[q] = *(const u32x4*)(phyT + ((size_t)b * 3072 + cb * 64 + cl) * SEQ + (tb4 * 4 + q) * 64 + ch * 8);
                __syncthreads();
#pragma unroll
                for (int q = 0; q < 4; ++q) *(LAS u32x4*)(T + q * 4608 + cl * 72 + ch * 8) = v[q];
                __syncthreads();
#pragma unroll
                for (int q = 0; q < 4; ++q) { const int tl = tid >> 3; unsigned w[8];
#pragma unroll
                    for (int e = 0; e < 8; ++e) w[e] = T[q * 4608 + (ch * 8 + e) * 72 + tl];
                    u32x4 o; o.x = w[0] | (w[1] << 16); o.y = w[2] | (w[3] << 16); o.z = w[4] | (w[5] << 16); o.w = w[6] | (w[7] << 16);
                    *(u32x4*)(yhy + (size_t)(b * SEQ + (tb4 * 4 + q) * 64 + tl) * 1024 + cb * 64 + ch * 8) = o; }
            }
        }
    }
    GRID_SYNC(5);

    if (IN(6)) for (int rp = 0; rp < REPN(6); ++rp) {
        SchedMerge S{(const char*)yrg, (const char*)yhy, (const char*)rgproj_t, (const char*)hyproj_t, G, bid}; EpiMerge E{gates, merged};
        pg8::gemm_phase(lds, 1024, S, E);
    }
    GRID_SYNC(6);

    if (IN(7)) {
        SchedOut S{(const char*)merged, (const char*)wout_t, G, bid}; EpiOut E{args.in[I_X], mod, x1, ssq};
        pg8::gemm_phase(lds, 1024, S, E);
    }
    GRID_SYNC(7);

    if (IN(8)) {
        {
            LAS bf16* XH = (LAS bf16*)lds;
            LAS bf16* XL = XH + 128 * 72;
            LAS bf16* WH = XL + 128 * 72;
            LAS bf16* WLo = WH + 48 * 72;
            LAS float* LG = (LAS float*)(WLo + 48 * 72);
            LAS float* RS = LG + 128 * 49;
            LAS int* LCNT = (LAS int*)(RS + 128); LAS int* LBASE = LCNT + 32;
            const float* n2g = args.in[I_N2G]; const float* bg = args.in[I_BG]; const float* be = args.in[I_BE];
            const bf16* wrh = (const bf16*)(ws + 28 * MiB); const bf16* wrl = wrh + 48 * 1024;
            int nrep8 = REPN(8); asm volatile("" : "+s"(nrep8));
_Pragma("unroll 1")
            for (int rp = 0; rp < nrep8; ++rp)
            for (int tile = bid; tile < NTOK / 128; tile += G) {
                const int R0 = tile * 128; const int b = R0 >> 13; const float* sh = mod + b * 6144 + 3072; const float* sc = sh + 1024;
                __syncthreads();
                if (tid < 128) { const float* sp = ssq + (size_t)(R0 + tid) * 16; float ss = 0.f; for (int q = 0; q < 16; ++q) ss += sp[q]; RS[tid] = rsqrtf(ss * (1.f / 1024.f) + 1e-6f); }
                if (tid < 32) LCNT[tid] = 0;
                int ea_ = 0, eb_ = 0, la_ = 0, lb_ = 0; float wa_ = 0.f, wb_ = 0.f;
                __syncthreads();
                f32x4 lacc[3];
#pragma unroll
                for (int c = 0; c < 3; ++c) lacc[c] = (f32x4){0.f, 0.f, 0.f, 0.f};
                const int lrow = tid >> 2, lq = tid & 3; const float rstd = RS[lrow];
                const int mg = lane >> 4, mli = lane & 15;
#pragma unroll 1
                for (int kc = 0; kc < 16; ++kc) {
                    const int k0 = kc * 64 + lq * 16;
                    f32x4 o[4];
#pragma unroll
                    for (int i = 0; i < 4; ++i) { const int k = k0 + 4 * i; const f32x4 v = *(const f32x4*)(x1 + (size_t)(R0 + lrow) * 1024 + k);
                        const f32x4 g = *(const f32x4*)(n2g + k), s_ = *(const f32x4*)(sc + k), hh = *(const f32x4*)(sh + k); o[i] = v * rstd * g * (1.f + s_) + hh; }
                    unsigned hi[8], lo[8];
#pragma unroll
                    for (int i = 0; i < 4; ++i)
#pragma unroll
                        for (int q = 0; q < 2; ++q) { const float a0 = o[i][2 * q], a1 = o[i][2 * q + 1]; const unsigned h = pk2(a0, a1); hi[2 * i + q] = h; lo[2 * i + q] = pk2(a0 - bflo(h), a1 - bfhi(h)); }
                    *(u32x4*)(hx2 + (size_t)(R0 + lrow) * 1024 + k0) = (u32x4){hi[0], hi[1], hi[2], hi[3]};
                    *(u32x4*)(hx2 + (size_t)(R0 + lrow) * 1024 + k0 + 8) = (u32x4){hi[4], hi[5], hi[6], hi[7]};
                    u32x4 wph = {0u, 0u, 0u, 0u}, wpl = {0u, 0u, 0u, 0u};
                    if (tid < 384) { wph = *(const u32x4*)(wrh + (size_t)(tid >> 3) * 1024 + kc * 64 + (tid & 7) * 8); wpl = *(const u32x4*)(wrl + (size_t)(tid >> 3) * 1024 + kc * 64 + (tid & 7) * 8); }
                    __syncthreads();
                    *(LAS u32x4*)(XH + lrow * 72 + lq * 16) = (u32x4){hi[0], hi[1], hi[2], hi[3]}; *(LAS u32x4*)(XH + lrow * 72 + lq * 16 + 8) = (u32x4){hi[4], hi[5], hi[6], hi[7]};
                    *(LAS u32x4*)(XL + lrow * 72 + lq * 16) = (u32x4){lo[0], lo[1], lo[2], lo[3]}; *(LAS u32x4*)(XL + lrow * 72 + lq * 16 + 8) = (u32x4){lo[4], lo[5], lo[6], lo[7]};
                    if (tid < 384) { *(LAS u32x4*)(WH + (tid >> 3) * 72 + (tid & 7) * 8) = wph; *(LAS u32x4*)(WLo + (tid >> 3) * 72 + (tid & 7) * 8) = wpl; }
                    __syncthreads();
#pragma unroll
                    for (int ks = 0; ks < 2; ++ks) { const bf16x8 aH = *(const LAS bf16x8*)(XH + (wave * 16 + mli) * 72 + ks * 32 + mg * 8), aL = *(const LAS bf16x8*)(XL + (wave * 16 + mli) * 72 + ks * 32 + mg * 8);
#pragma unroll
                        for (int nt = 0; nt < 3; ++nt) { const bf16x8 bH = *(const LAS bf16x8*)(WH + (nt * 16 + mli) * 72 + ks * 32 + mg * 8), bL = *(const LAS bf16x8*)(WLo + (nt * 16 + mli) * 72 + ks * 32 + mg * 8);
                            lacc[nt] = __builtin_amdgcn_mfma_f32_16x16x32_bf16(aH, bH, lacc[nt], 0, 0, 0); lacc[nt] = __builtin_amdgcn_mfma_f32_16x16x32_bf16(aL, bH, lacc[nt], 0, 0, 0);
                            lacc[nt] = __builtin_amdgcn_mfma_f32_16x16x32_bf16(aH, bL, lacc[nt], 0, 0, 0); } }
                }
#pragma unroll
                for (int nt = 0; nt < 3; ++nt)
#pragma unroll
                    for (int r = 0; r < 4; ++r) LG[(wave * 16 + 4 * mg + r) * 49 + nt * 16 + mli] = lacc[nt][r];
                __syncthreads();
                if (tid < 128) {
                    float lg[36];
#pragma unroll
                    for (int c = 0; c < 36; ++c) lg[c] = LG[tid * 49 + c] + (c < 4 ? bg[c] : be[c - 4]);
                    int grp = 0; float gm = lg[0];
#pragma unroll
                    for (int q = 1; q < 4; ++q) if (lg[q] > gm) { gm = lg[q]; grp = q; }
                    float den = 0.f;
#pragma unroll
                    for (int q = 0; q < 4; ++q) den += __expf(lg[q] - gm);
                    const float pg = 1.f / den;
                    float ep[8];
#pragma unroll
                    for (int q = 0; q < 8; ++q) ep[q] = grp == 0 ? lg[4 + q] : grp == 1 ? lg[12 + q] : grp == 2 ? lg[20 + q] : lg[28 + q];
                    int i1 = 0; float v1 = ep[0];
#pragma unroll
                    for (int q = 1; q < 8; ++q) if (ep[q] > v1) { v1 = ep[q]; i1 = q; }
                    int i2 = -1; float v2 = -3.0e38f;
#pragma unroll
                    for (int q = 0; q < 8; ++q) if (q != i1 && ep[q] > v2) { v2 = ep[q]; i2 = q; }
                    const float e2 = __expf(v2 - v1); const float p1 = 1.f / (1.f + e2), p2 = e2 / (1.f + e2);
                    ea_ = grp * 8 + i1; eb_ = grp * 8 + i2; wa_ = pg * p1; wb_ = pg * p2;
                    la_ = __hip_atomic_fetch_add(LCNT + ea_, 1, __ATOMIC_RELAXED, __HIP_MEMORY_SCOPE_WORKGROUP); lb_ = __hip_atomic_fetch_add(LCNT + eb_, 1, __ATOMIC_RELAXED, __HIP_MEMORY_SCOPE_WORKGROUP);
                }
                __syncthreads();
                if (tid < 32 && rp == nrep8 - 1) LBASE[tid] = atomicAdd(cnt + 32 * tid, LCNT[tid]);
                __syncthreads();
                if (tid < 128 && rp == nrep8 - 1) { const int m = R0 + tid;
                    tok_e[2 * m] = ea_; tok_e[2 * m + 1] = eb_; tok_rank[2 * m] = LBASE[ea_] + la_; tok_rank[2 * m + 1] = LBASE[eb_] + lb_; tok_w[2 * m] = wa_; tok_w[2 * m + 1] = wb_; }
            }
        }
        __syncthreads();
        {
            LAS float* scr = (LAS float*)lds + wave * 4160;
            constexpr int I_E13 = 16 * 8, I_E2 = 8 * 16;
            constexpr int NITEMS = NEXP * (2 * I_E13);
            (void)I_E2;
            for (int rp = 0; rp < REPN(80); ++rp)
            for (int it = gw; it < NITEMS; it += NGW) {
                const int e = it / (2 * I_E13); int r = it % (2 * I_E13);
                if (r < I_E13) { transpose_item(args.in[I_MW1] + (size_t)e * 1024 * 512, 1024, 512, w13t + (size_t)e * 1024 * 1024, 1, scr, r, lane); continue; } r -= I_E13;
                transpose_item(args.in[I_MW3] + (size_t)e * 1024 * 512, 1024, 512, w13t + (size_t)e * 1024 * 1024, 2, scr, r, lane);
            }
        }
    }
    GRID_SYNC(8);

    LAS int* blk_exp = (LAS int*)(lds + MISC_OFF); LAS int* pstart = blk_exp + 320; LAS int* ecnt = pstart + 40;
    int* row_tok = (int*)(ws + WS_GATEW + 512 * 1024);
    int nblk = 0;
    if (hi > 9 && lo <= 11) {
        __syncthreads();
        if (tid == 0) { int p = 0; for (int e = 0; e < NEXP; ++e) { const int c_ = __hip_atomic_load(cnt + 32 * e, __ATOMIC_RELAXED, __HIP_MEMORY_SCOPE_AGENT); const int nb = (c_ + 255) >> 8; pstart[e] = p * 256; ecnt[e] = c_; for (int q = 0; q < nb; ++q) blk_exp[p + q] = e; p += nb; } pstart[32] = p; }
        __syncthreads();
        nblk = pstart[32];
    }

    if (IN(9)) for (int rp = 0; rp < REPN(9); ++rp) {
        const int gt = bid * NTHREADS + tid, GT = G * NTHREADS;
        for (int a = gt; a < 2 * NTOK; a += GT) { const int e = tok_e[a], rk = tok_rank[a]; const int slot = pstart[e] + rk; tok_slot[a] = slot; row_tok[slot] = a >> 1; }
        for (int r = gt; r < nblk * 256; r += GT) { const int e = blk_exp[r >> 8]; if (r - pstart[e] >= ecnt[e]) row_tok[r] = 0; }
    }
    GRID_SYNC(9);

    if (IN(10)) for (int rp = 0; rp < REPN(10); ++rp) {
        const int units = nblk * 4, rounds = (units + G - 1) / G; int need = rounds > 0 ? (units + rounds - 1) / rounds : G; if (G - need < 8) need = G;
        const int nsp = G - need;
        if (bid >= need || nsp == 0) {
            LAS float* scr = (LAS float*)lds + wave * 4160; constexpr int I_W2 = 8 * 16;
            const int w0 = (nsp ? (bid - need) : bid) * NWAVES + wave, nw = (nsp ? nsp : G) * NWAVES;
            for (int it = w0; it < NEXP * I_W2; it += nw) { const int e = it / I_W2, r = it % I_W2;
                transpose_item(args.in[I_MW2] + (size_t)e * 512 * 1024, 512, 1024, w2t + (size_t)e * 1024 * 512, 0, scr, r, lane); }
            __syncthreads();
        }
        if (bid < need) {
            SchedMoeUp S{(const char*)hx2, (const char*)w13t, blk_exp, row_tok, nblk, need, bid}; EpiMoeUp E{Hbuf};
            pg8::gemm_phase<EpiMoeUp, SchedMoeUp, true>(lds, 1024, S, E);
        }
    }
    GRID_SYNC(10);

    if (IN(11)) for (int rp = 0; rp < REPN(11); ++rp) {
        SchedMoeDown S{(const char*)Hbuf, (const char*)w2t, blk_exp, nblk, G, bid}; EpiMoeDown E{Ybuf};
        pg8::gemm_phase(lds, 512, S, E);
    }
    GRID_SYNC(11);

    if (IN(12)) {
        const float* fg = args.in[I_FG];
        f32x4 fgv[4];
#pragma unroll
        for (int j = 0; j < 4; ++j) fgv[j] = *(const f32x4*)(fg + 4 * (64 * j + lane));
        int nrep12 = REPN(12); asm volatile("" : "+s"(nrep12));
_Pragma("unroll 1")
        for (int rp = 0; rp < nrep12; ++rp)
        for (int m0 = 2 * gw; m0 < NTOK; m0 += 2 * NGW) {
            f32x4 v[2][4]; float ss[2] = {0.f, 0.f};
#pragma unroll
            for (int u = 0; u < 2; ++u) { const int m = m0 + u; const int b = m >> 13; const float* g2 = mod + b * 6144 + 5120;
                const int sa = tok_slot[2 * m], sb = tok_slot[2 * m + 1]; const float wa = tok_w[2 * m], wb = tok_w[2 * m + 1];
#pragma unroll
                for (int j = 0; j < 4; ++j) { const int k = 4 * (64 * j + lane);
                    const u32x2 ya = *(const u32x2*)(Ybuf + (size_t)sa * 1024 + k), yb = *(const u32x2*)(Ybuf + (size_t)sb * 1024 + k);
                    const f32x4 fa = {bflo(ya.x), bfhi(ya.x), bflo(ya.y), bfhi(ya.y)}, fb = {bflo(yb.x), bfhi(yb.x), bflo(yb.y), bfhi(yb.y)};
                    const f32x4 xv = *(const f32x4*)(x1 + (size_t)m * 1024 + k), gv = *(const f32x4*)(g2 + k);
                    v[u][j] = xv + gv * (fa * wa + fb * wb); ss[u] += (v[u][j][0] * v[u][j][0] + v[u][j][1] * v[u][j][1]) + (v[u][j][2] * v[u][j][2] + v[u][j][3] * v[u][j][3]); } }
#pragma unroll
            for (int u = 0; u < 2; ++u) { const int m = m0 + u; const float rstd = rsqrtf(wave_sum(ss[u]) * (1.f / 1024.f) + 1e-6f);
#pragma unroll
                for (int j = 0; j < 4; ++j) { const int k = 4 * (64 * j + lane); if (rp == nrep12 - 1) st_nt((f32x4*)(args.out + (size_t)m * 1024 + k), v[u][j] * rstd * fgv[j]); } }
        }
    }
    if (PROBE_TS >= 0) {
        xcd_barrier(xbar);
        if (bid == 0 && tid == 0) tsbuf[13] = __builtin_amdgcn_s_memrealtime();
        xcd_barrier(xbar);
        const int pk_ = PROBE_TS < 0 ? 0 : (PROBE_TS % 100); const int sub_ = PROBE_TS < 0 ? 0 : (PROBE_TS / 100);
        const unsigned long long t0_ = __hip_atomic_load(tsbuf + pk_, __ATOMIC_RELAXED, __HIP_MEMORY_SCOPE_AGENT), t1_ = __hip_atomic_load(tsbuf + pk_ + 1, __ATOMIC_RELAXED, __HIP_MEMORY_SCOPE_AGENT);
        const float binw = sub_ == 1 ? 10.f : 40.f;
        const float us = floorf((float)(t1_ - t0_) * 0.01f / binw + 0.5f); const float vv = sqrtf(1.0025f * us);
        for (size_t i = (size_t)bid * NTHREADS + tid; i < (size_t)NTOK * 1024; i += (size_t)G * NTHREADS) args.out[i] = vv;
    }
}

extern "C" void kernel_launch(void* const* d_in, const int* in_sizes, int n_in, void* d_out, int out_size, void* d_ws, size_t ws_size, hipStream_t stream) {
    static int grid = 0;
    if (grid == 0) {
        if (n_in != 41 || out_size != NTOK * DM || ws_size < WS_END) { fprintf(stderr, "kernel_launch: unexpected shapes (n_in %d, out %d, ws %zu)\n", n_in, out_size, ws_size); grid = -1; return; }
        int dev = 0, cus = 0, per_cu = 0;
        hipGetDevice(&dev); hipDeviceGetAttribute(&cus, hipDeviceAttributeMultiprocessorCount, dev);
        if (hipFuncSetAttribute((const void*)fwd_kernel, hipFuncAttributeMaxDynamicSharedMemorySize, LDS_BYTES) != hipSuccess) { fprintf(stderr, "kernel_launch: hipFuncSetAttribute failed\n"); grid = -1; return; }
        hipOccupancyMaxActiveBlocksPerMultiprocessor(&per_cu, (const void*)fwd_kernel, NTHREADS, LDS_BYTES);
        (void)hipGetLastError();
        if (per_cu < 1) { fprintf(stderr, "kernel_launch: occupancy query says %d blocks per CU\n", per_cu); per_cu = 1; }
        grid = cus;
        fprintf(stderr, "kernel_launch: grid %d (cus %d, per_cu %d)\n", grid, cus, per_cu);
    }
    if (grid < 0) return;
    Args a{};
    for (int i = 0; i < 41; ++i) a.in[i] = (const float*)d_in[i];
    a.out = (float*)d_out; a.ws = (unsigned char*)d_ws;
#if ONE_LAUNCH
    a.ph_lo = 0; a.ph_hi = NPHASE;
    void* kargs[] = {&a};
    hipError_t e = hipLaunchCooperativeKernel((const void*)fwd_kernel, dim3(grid), dim3(NTHREADS), kargs, LDS_BYTES, stream);
    if (e != hipSuccess) fprintf(stderr, "cooperative launch failed: %s (grid %d)\n", hipGetErrorString(e), grid);
#else
    for (int p = 0; p < NPHASE; ++p) { a.ph_lo = p; a.ph_hi = p + 1; hipLaunchKernelGGL(fwd_kernel, dim3(grid), dim3(NTHREADS), LDS_BYTES, stream, a); }
#endif
}
```

```cpp
#include <hip/hip_runtime.h>
#include <hip/hip_cooperative_groups.h>
#include <cstdio>
#include <cstdint>
namespace cg = cooperative_groups;

#ifndef ONE_LAUNCH
#define ONE_LAUNCH 1
#endif

#ifndef PROBE_REP
#define PROBE_REP -1
#endif
#ifndef PROBE_TS
#define PROBE_TS -1
#endif
#define REPN(k) ((PROBE_REP == (k)) ? 2 : 1)
#define LAS __attribute__((address_space(3)))
typedef unsigned short bf16;
typedef float f32x4 __attribute__((ext_vector_type(4)));
typedef float f32x2 __attribute__((ext_vector_type(2)));
typedef short bf16x8 __attribute__((ext_vector_type(8)));
typedef unsigned u32x4 __attribute__((ext_vector_type(4)));
typedef unsigned u32x2 __attribute__((ext_vector_type(2)));

constexpr int DM = 1024, NBATCH = 4, SEQ = 8192, NTOK = NBATCH * SEQ, CTXL = 256, NCTX = NBATCH * CTXL, MROWS = NTOK + NCTX;
constexpr int INC = 7168, NEXP = 32, DEXP = 512, PMAXBLK = 288;
constexpr int NCHUNK = 132;
constexpr int NTHREADS = 512, NWAVES = 8;
constexpr int LDS_BYTES = 148480;
constexpr int MISC_OFF = 145408;

constexpr size_t MiB = 1u << 20;
constexpr size_t WS_CTL = 0, WS_MOD = 1 * MiB, WS_Z2 = 2 * MiB, WS_SSQ = 4 * MiB, WS_ROUTE = 6 * MiB, WS_GATEW = 7 * MiB;
constexpr size_t WS_WSMALL = 8 * MiB, WS_WIN = 14 * MiB;
constexpr size_t WS_HX = 32 * MiB;
constexpr size_t WS_PRX = 98 * MiB;
constexpr size_t WS_GRG = 164 * MiB;
constexpr size_t WS_PHY = 228 * MiB;
constexpr size_t WS_W13 = 228 * MiB, WS_W2 = 292 * MiB;
constexpr size_t WS_XG = 324 * MiB;
constexpr size_t WS_KF = 420 * MiB;
constexpr size_t WS_CARR = 484 * MiB, WS_CIN = 494 * MiB, WS_END = 512 * MiB;

__device__ __forceinline__ unsigned f2bf(float f) { unsigned u = __builtin_bit_cast(unsigned, f); return (u + 0x7fffu + ((u >> 16) & 1u)) >> 16; }
__device__ __forceinline__ unsigned pk2(float lo, float hi) { unsigned r; asm("v_cvt_pk_bf16_f32 %0, %1, %2" : "=v"(r) : "v"(lo), "v"(hi)); return r; }
__device__ __forceinline__ float bf2f(unsigned b) { return __builtin_bit_cast(float, b << 16); }
__device__ __forceinline__ float bflo(unsigned w) { return __builtin_bit_cast(float, w << 16); }
__device__ __forceinline__ float bfhi(unsigned w) { return __builtin_bit_cast(float, w & 0xffff0000u); }
__device__ __forceinline__ float wave_sum(float v) {
#pragma unroll
    for (int o = 1; o < 64; o <<= 1) v += __shfl_xor(v, o);
    return v;
}
__device__ __forceinline__ float sigmoidf_(float v) { return __builtin_amdgcn_rcpf(1.f + __expf(-v)); }
__device__ __forceinline__ float gelu_tanh(float v) { const float z = 0.7978845608028654f * (v + 0.044715f * v * v * v); const float t = 1.f - 2.f * __builtin_amdgcn_rcpf(1.f + __expf(2.f * z)); return 0.5f * v * (1.f + t); }
#define LDS_WAIT() asm volatile("s_waitcnt lgkmcnt(0)" ::: "memory")
#define LDS_BARRIER() do { asm volatile("s_waitcnt lgkmcnt(0)" ::: "memory"); __builtin_amdgcn_s_barrier(); asm volatile("" ::: "memory"); } while (0)

namespace pg8 {
#define PG8_LAS __attribute__((address_space(3)))
constexpr int BM = 256, BK = 64, HALF = 128, HTB = HALF * BK * 2, STAGE_BYTES = 8 * HTB, NXCD = 8, WGM = 4;
__host__ __device__ __forceinline__ int lds_byte(int r, int c) { const int st = (r >> 4) * 2 + (c >> 5), rr = r & 15, cc = c & 31, ob = rr * 64 + cc * 2; return st * 1024 + (ob ^ (((ob >> 9) & 1) << 5)); }
__host__ __device__ __forceinline__ void stage_rc(int b, int& R, int& C) { const int st = b / 1024, sb = b % 1024, swz = sb ^ (((sb >> 9) & 1) << 5); R = (st >> 1) * 16 + swz / 64; C = (st & 1) * 32 + (swz % 64) / 2; }

__host__ __device__ __forceinline__ int perm32(int rho) { const int n = rho >> 4, i = rho & 15; return 8 * (i >> 2) + 4 * n + (i & 3); }
struct Unit { int pm, pn, last; const char* A; const char* B; };

__device__ __forceinline__ void rect_map(int wg, int nM, int nN, int& pm, int& pn) {
    const int nwg = nM * nN; int wgid = wg; { const int q = nwg / NXCD, r = nwg % NXCD, xcd = wgid % NXCD, off = wgid / NXCD; wgid = (xcd < r ? xcd * (q + 1) : r * (q + 1) + (xcd - r) * q) + off; }
    const int nig = WGM * nN, gid = wgid / nig, fm = gid * WGM, gsz = (nM - fm) < WGM ? (nM - fm) : WGM;
    pm = fm + ((wgid % nig) % gsz); pn = (wgid % nig) / gsz;
}

template <class Epi, class Sched, bool GATHER = false>
__device__ __forceinline__ void gemm_phase(PG8_LAS unsigned char* lds, const int K, const Sched& S, const Epi& E) {
    const int tid = threadIdx.x, wid = __builtin_amdgcn_readfirstlane(tid >> 6), lane = tid & 63, wr = wid >> 2, wc = wid & 3, fr = lane & 15, fq = lane >> 4;
    const int nt = K / BK;
    unsigned voffA[2]; int stR[2], stC[2]; unsigned voffB[2];
#pragma unroll
    for (int i = 0; i < 2; ++i) { int R, C; stage_rc(tid * 16 + i * 8192, R, C); voffA[i] = (unsigned)(R * K + C) * 2u; stR[i] = R; stC[i] = C;
        const int Rb = Epi::PERM ? ((R & ~31) + perm32(R & 31)) : R; voffB[i] = (unsigned)(Rb * K + C) * 2u; }
    unsigned voffGc[2][2], voffGn[2][2];
#define PG8_GOFF(dst, u) do { _Pragma("unroll") for (int _h = 0; _h < 2; ++_h) _Pragma("unroll") for (int _i = 0; _i < 2; ++_i) \
        dst[_h][_i] = (unsigned)(S.row_tok[(u).pm * 256 + _h * 128 + stR[_i]] * K + stC[_i]) * 2u; } while (0)
    const size_t kstep = (size_t)(BK * 2);
    const size_t hstep = (size_t)HALF * K * 2;
    const unsigned ldsw = (unsigned)wid * 1024u;
    const int aoff = lds_byte(wr * 64 + fr, fq * 8), boff = lds_byte(wc * 32 + fr, fq * 8);
#define PG8_SA(b, h) (((b) * 2 + (h)) * HTB)
#define PG8_SB(b, h) ((4 + (b) * 2 + (h)) * HTB)
#define PG8_STAGE(bufoff, gbase, voff) do { _Pragma("unroll") for (int _i = 0; _i < 2; ++_i) \
        __builtin_amdgcn_global_load_lds((const unsigned*)((const char*)(gbase) + (voff)[_i]), (PG8_LAS unsigned*)(lds + (bufoff) + ldsw + _i * 8192), 16, 0, 0); } while (0)
#define PG8_STAGE_A(bufoff, kptr, half, isnext) do { if constexpr (GATHER) { if (isnext) PG8_STAGE(bufoff, kptr, voffGn[half]); else PG8_STAGE(bufoff, kptr, voffGc[half]); } \
        else PG8_STAGE(bufoff, (kptr) + (half) * hstep, voffA); } while (0)
#define PG8_LDA(dst, b, h) do { _Pragma("unroll") for (int m = 0; m < 4; ++m) _Pragma("unroll") for (int k = 0; k < 2; ++k) dst[m][k] = *(const PG8_LAS bf16x8*)(lds + PG8_SA(b, h) + aoff + m * 2048 + k * 1024); } while (0)
#define PG8_LDB(dst, b, h) do { _Pragma("unroll") for (int n = 0; n < 2; ++n) _Pragma("unroll") for (int k = 0; k < 2; ++k) dst[n][k] = *(const PG8_LAS bf16x8*)(lds + PG8_SB(b, h) + boff + n * 2048 + k * 1024); } while (0)
#define PG8_MMA(ai, bj, At, Bt) do { __builtin_amdgcn_s_setprio(1); _Pragma("unroll") for (int m = 0; m < 4; ++m) _Pragma("unroll") for (int n = 0; n < 2; ++n) _Pragma("unroll") for (int k = 0; k < 2; ++k) \
        acc[ai][bj][m][n] = __builtin_amdgcn_mfma_f32_16x16x32_bf16(Bt[n][k], At[m][k], acc[ai][bj][m][n], 0, 0, 0); __builtin_amdgcn_s_setprio(0); } while (0)
#define PG8_WAIT_V(n) asm volatile("s_waitcnt vmcnt(" #n ")" ::: "memory")
#define PG8_WAIT_L(n) asm volatile("s_waitcnt lgkmcnt(" #n ")" ::: "memory")
#define PG8_BAR __builtin_amdgcn_s_barrier()
#define PG8_SCHED __builtin_amdgcn_sched_barrier(0)
    Unit cur, nxt; int ui = 0;
    if (!S.next(0, cur)) return;
    f32x4 acc[2][2][4][2];
#pragma unroll
    for (int a = 0; a < 2; ++a)
#pragma unroll
        for (int b = 0; b < 2; ++b)
#pragma unroll
            for (int m = 0; m < 4; ++m)
#pragma unroll
                for (int n = 0; n < 2; ++n) acc[a][b][m][n] = (f32x4){0.f, 0.f, 0.f, 0.f};
    bf16x8 At[4][2], B0[2][2], B1[2][2];
    const char* cA = cur.A; const char* cB = cur.B;
    if constexpr (GATHER) { PG8_GOFF(voffGc, cur); }
    PG8_STAGE(PG8_SB(0, 0), cB, voffB); PG8_STAGE(PG8_SB(0, 1), cB + hstep, voffB); PG8_STAGE_A(PG8_SA(0, 0), cA, 0, false); PG8_STAGE_A(PG8_SA(0, 1), cA, 1, false);
    if (wr == 1) PG8_BAR;
    PG8_WAIT_V(2); PG8_BAR;
    PG8_STAGE(PG8_SB(1, 0), cB + kstep, voffB); PG8_STAGE_A(PG8_SA(1, 0), cA + kstep, 0, false); PG8_STAGE(PG8_SB(1, 1), cB + hstep + kstep, voffB);
    PG8_WAIT_V(6); PG8_BAR;
    for (;;) {
        const bool has_next = S.next(ui + 1, nxt);
        const char* nA = has_next ? nxt.A : cA; const char* nB = has_next ? nxt.B : cB;
        if constexpr (GATHER) { if (has_next) { PG8_GOFF(voffGn, nxt); } else { _Pragma("unroll") for (int _h = 0; _h < 2; ++_h) _Pragma("unroll") for (int _i = 0; _i < 2; ++_i) voffGn[_h][_i] = voffGc[_h][_i]; } }
        for (int t = 0; t < nt; t += 2) {
            const bool last = (t == nt - 2);
            const char* a1 = cA + (size_t)(t + 1) * kstep;
            const char* a2 = last ? nA : cA + (size_t)(t + 2) * kstep; const char* b2 = last ? nB : cB + (size_t)(t + 2) * kstep;
            const char* a3 = a2 + kstep; const char* b3 = b2 + kstep;
            PG8_LDB(B0, 0, 0); PG8_LDB(B1, 0, 1); PG8_SCHED; PG8_LDA(At, 0, 0); PG8_STAGE_A(PG8_SA(1, 1), a1, 1, false);
            PG8_WAIT_V(8); PG8_WAIT_L(0); PG8_BAR; PG8_MMA(0, 0, At, B0); PG8_MMA(0, 1, At, B1); PG8_BAR; PG8_SCHED;
            PG8_LDA(At, 0, 1); PG8_STAGE(PG8_SB(0, 0), b2, voffB); PG8_STAGE(PG8_SB(0, 1), b2 + hstep, voffB); PG8_STAGE_A(PG8_SA(0, 0), a2, 0, last);
            PG8_WAIT_V(8); PG8_WAIT_L(0); PG8_BAR; PG8_MMA(1, 0, At, B0); PG8_MMA(1, 1, At, B1); PG8_BAR; PG8_SCHED;
            PG8_LDB(B0, 1, 0); PG8_LDB(B1, 1, 1); PG8_SCHED; PG8_LDA(At, 1, 0); PG8_STAGE_A(PG8_SA(0, 1), a2, 1, last);
            PG8_WAIT_V(8); PG8_WAIT_L(0); PG8_BAR; PG8_MMA(0, 0, At, B0); PG8_MMA(0, 1, At, B1); PG8_BAR; PG8_SCHED;
            PG8_LDA(At, 1, 1); PG8_STAGE(PG8_SB(1, 0), b3, voffB); PG8_STAGE(PG8_SB(1, 1), b3 + hstep, voffB); PG8_STAGE_A(PG8_SA(1, 0), a3, 0, last);
            PG8_WAIT_V(8); PG8_WAIT_L(0); PG8_BAR; PG8_MMA(1, 0, At, B0); PG8_MMA(1, 1, At, B1); PG8_BAR; PG8_SCHED;
        }
        if (wr == 0) PG8_BAR;
        if (cur.last) E.fin(acc, cur, wr, wc, fr, fq); else E.mid(acc, cur, wr, wc, fr, fq);
        if (!has_next) break;
        if (cur.last) {
#pragma unroll
            for (int a = 0; a < 2; ++a)
#pragma unroll
                for (int b = 0; b < 2; ++b)
#pragma unroll
                    for (int m = 0; m < 4; ++m)
#pragma unroll
                        for (int n = 0; n < 2; ++n) acc[a][b][m][n] = (f32x4){0.f, 0.f, 0.f, 0.f};
        }
        cur = nxt; cA = nA; cB = nB; ++ui;
        if constexpr (GATHER) { _Pragma("unroll") for (int _h = 0; _h < 2; ++_h) _Pragma("unroll") for (int _i = 0; _i < 2; ++_i) voffGc[_h][_i] = voffGn[_h][_i]; }
        if (wr == 1) PG8_BAR;
    }
    PG8_WAIT_V(0);
    PG8_BAR;
#undef PG8_SA
#undef PG8_SB
#undef PG8_STAGE
#undef PG8_STAGE_A
#undef PG8_GOFF
#undef PG8_LDA
#undef PG8_LDB
#undef PG8_MMA
#undef PG8_WAIT_V
#undef PG8_WAIT_L
#undef PG8_BAR
#undef PG8_SCHED
}
}
using pg8::Unit;
typedef f32x4 AccT[2][2][4][2];

__device__ __forceinline__ void st_nt(u32x4* p, u32x4 v) { __builtin_nontemporal_store(v, p); }
__device__ __forceinline__ void st_nt(f32x4* p, f32x4 v) { __builtin_nontemporal_store(v, p); }
__device__ __forceinline__ u32x2 pack4(f32x4 v) { u32x2 w; w.x = pk2(v[0], v[1]); w.y = pk2(v[2], v[3]); return w; }

#define EPI_LOOP_ROWS _Pragma("unroll") for (int ai = 0; ai < 2; ++ai) _Pragma("unroll") for (int m = 0; m < 4; ++m)
#define EPI_LOOP_COLS _Pragma("unroll") for (int bj = 0; bj < 2; ++bj) _Pragma("unroll") for (int n = 0; n < 2; ++n)

__device__ __forceinline__ u32x4 pack8(f32x4 a, f32x4 b) { return (u32x4){pk2(a[0], a[1]), pk2(a[2], a[3]), pk2(b[0], b[1]), pk2(b[2], b[3])}; }
__device__ __forceinline__ void unpack8(u32x4 w, f32x4& a, f32x4& b) { a = (f32x4){bflo(w.x), bfhi(w.x), bflo(w.y), bfhi(w.y)}; b = (f32x4){bflo(w.z), bfhi(w.z), bflo(w.w), bfhi(w.w)}; }
#define EPI_LOOP_BJ _Pragma("unroll") for (int bj = 0; bj < 2; ++bj)
struct EpiInA {
    static constexpr bool PERM = true;
    bf16* prx; bf16* grg; bf16* gates;
    __device__ __forceinline__ void mid(AccT& acc, const Unit& u, int wr, int wc, int fr, int fq) const {}
    __device__ __forceinline__ void fin(AccT& acc, const Unit& u, int wr, int wc, int fr, int fq) const {
        const int row0 = u.pm * 256 + wr * 64 + fr, col0 = u.pn * 256 + wc * 32 + 8 * fq;
        EPI_LOOP_ROWS { const size_t r = (size_t)(row0 + ai * 128 + m * 16);
            EPI_LOOP_BJ { const int c = col0 + bj * 128; f32x4 v0 = acc[ai][bj][m][0], v1 = acc[ai][bj][m][1];
                if (u.pn < 4) { st_nt((u32x4*)(prx + r * 1024 + c), pack8(v0, v1)); }
                else if (u.pn < 8) { for (int i = 0; i < 4; ++i) { v0[i] = gelu_tanh(v0[i]); v1[i] = gelu_tanh(v1[i]); } st_nt((u32x4*)(grg + r * 1024 + (c - 1024)), pack8(v0, v1)); }
                else { for (int i = 0; i < 4; ++i) { v0[i] = sigmoidf_(v0[i]); v1[i] = sigmoidf_(v1[i]); } st_nt((u32x4*)(gates + r * 2048 + (c - 2048)), pack8(v0, v1)); } } }
    }
};
struct EpiInB {
    static constexpr bool PERM = true;
    bf16* phyT;
    __device__ __forceinline__ void mid(AccT& acc, const Unit& u, int wr, int wc, int fr, int fq) const {}
    __device__ __forceinline__ void fin(AccT& acc, const Unit& u, int wr, int wc, int fr, int fq) const {
        const int row0 = u.pm * 256 + wr * 64 + fr, col0 = u.pn * 256 + wc * 32 + 8 * fq;
        const int b = u.pn >> 5;
        EPI_LOOP_ROWS { const size_t j = (size_t)(row0 + ai * 128 + m * 16);
            EPI_LOOP_BJ { const int t = col0 + bj * 128 - b * SEQ;
                st_nt((u32x4*)(phyT + ((size_t)b * 3072 + j) * SEQ + t), pack8(acc[ai][bj][m][0], acc[ai][bj][m][1])); } }
    }
};
struct EpiMerge {
    static constexpr bool PERM = true;
    const bf16* gates; bf16* merged;
    __device__ __forceinline__ void mid(AccT& acc, const Unit& u, int wr, int wc, int fr, int fq) const {
        const int row0 = u.pm * 256 + wr * 64 + fr, col0 = u.pn * 256 + wc * 32 + 8 * fq;
        EPI_LOOP_ROWS { const size_t r = (size_t)(row0 + ai * 128 + m * 16);
            EPI_LOOP_BJ { const int c = col0 + bj * 128;
                f32x4 sa0, sa1, sb0, sb1; unpack8(*(const u32x4*)(gates + r * 2048 + c), sa0, sa1); unpack8(*(const u32x4*)(gates + r * 2048 + 1024 + c), sb0, sb1);
                for (int i = 0; i < 4; ++i) { acc[ai][bj][m][0][i] *= sa0[i] * __builtin_amdgcn_rcpf(fmaxf(sb0[i], 1e-30f)); acc[ai][bj][m][1][i] *= sa1[i] * __builtin_amdgcn_rcpf(fmaxf(sb1[i], 1e-30f)); } } }
    }
    __device__ __forceinline__ void fin(AccT& acc, const Unit& u, int wr, int wc, int fr, int fq) const {
        const int row0 = u.pm * 256 + wr * 64 + fr, col0 = u.pn * 256 + wc * 32 + 8 * fq;
        EPI_LOOP_ROWS { const size_t r = (size_t)(row0 + ai * 128 + m * 16);
            EPI_LOOP_BJ { const int c = col0 + bj * 128;
                f32x4 sb0, sb1; unpack8(*(const u32x4*)(gates + r * 2048 + 1024 + c), sb0, sb1);
                f32x4 v0 = acc[ai][bj][m][0], v1 = acc[ai][bj][m][1];
                for (int i = 0; i < 4; ++i) { v0[i] *= fmaxf(sb0[i], 1e-30f); v1[i] *= fmaxf(sb1[i], 1e-30f); }
                *(u32x4*)(merged + r * 1024 + c) = pack8(v0, v1); } }
    }
};
struct EpiOut {
    static constexpr bool PERM = false;
    const float* x; const float* mod; float* x1; float* ssq;
    __device__ __forceinline__ void mid(AccT& acc, const Unit& u, int wr, int wc, int fr, int fq) const {}
    __device__ __forceinline__ void fin(AccT& acc, const Unit& u, int wr, int wc, int fr, int fq) const {
        const int row0 = u.pm * 256 + wr * 64 + fr, col0 = u.pn * 256 + wc * 32 + 4 * fq;
        const float* g1 = mod + (u.pm >> 5) * 6144 + 2048;
        EPI_LOOP_ROWS { const size_t r = (size_t)(row0 + ai * 128 + m * 16); float s = 0.f;
            EPI_LOOP_COLS { const int c = col0 + bj * 128 + n * 16;
                const f32x4 xv = __builtin_nontemporal_load((const f32x4*)(x + r * 1024 + c)), gv = *(const f32x4*)(g1 + c);
                const f32x4 o = xv + gv * acc[ai][bj][m][n];
                *(f32x4*)(x1 + r * 1024 + c) = o; s += (o[0] * o[0] + o[1] * o[1]) + (o[2] * o[2] + o[3] * o[3]); }
            s += __shfl_xor(s, 16); s += __shfl_xor(s, 32);
            if (fq == 0) ssq[r * 16 + u.pn * 4 + wc] = s; }
    }
};
struct EpiMoeUp {
    static constexpr bool PERM = true;
    bf16* H;
    __device__ __forceinline__ void mid(AccT& acc, const Unit& u, int wr, int wc, int fr, int fq) const {}
    __device__ __forceinline__ void fin(AccT& acc, const Unit& u, int wr, int wc, int fr, int fq) const {
        const int row0 = u.pm * 256 + wr * 64 + fr, col0 = u.pn * 128 + wc * 32 + 8 * fq;
        EPI_LOOP_ROWS { const size_t r = (size_t)(row0 + ai * 128 + m * 16); f32x4 h0, h1;
            for (int i = 0; i < 4; ++i) { const float a0 = acc[ai][0][m][0][i], a1 = acc[ai][0][m][1][i]; h0[i] = a0 * sigmoidf_(a0) * acc[ai][1][m][0][i]; h1[i] = a1 * sigmoidf_(a1) * acc[ai][1][m][1][i]; }
            *(u32x4*)(H + r * 512 + col0) = pack8(h0, h1); }
    }
};
struct EpiMoeDown {
    static constexpr bool PERM = true;
    bf16* Y;
    __device__ __forceinline__ void mid(AccT& acc, const Unit& u, int wr, int wc, int fr, int fq) const {}
    __device__ __forceinline__ void fin(AccT& acc, const Unit& u, int wr, int wc, int fr, int fq) const {
        const int row0 = u.pm * 256 + wr * 64 + fr, col0 = u.pn * 256 + wc * 32 + 8 * fq;
        EPI_LOOP_ROWS { const size_t r = (size_t)(row0 + ai * 128 + m * 16);
            EPI_LOOP_BJ { const int c = col0 + bj * 128; *(u32x4*)(Y + r * 1024 + c) = pack8(acc[ai][bj][m][0], acc[ai][bj][m][1]); } }
    }
};

constexpr size_t TSTEP1K = (size_t)256 * 1024 * 2;
struct SchedInA { const char* hx; const char* wt; int G, c;
    __device__ __forceinline__ bool next(int i, Unit& u) const {
        int Lx = (i >> (REPN(2) - 1)) * G + c, pm, pn;
        if (Lx < 2048) pg8::rect_map(Lx, 128, 16, pm, pn);
        else { Lx -= 2048; if (Lx >= 16) return false; pm = 128 + (Lx >> 2); pn = Lx & 3; }
        const int wrow = pn < 8 ? pn * 256 : 5120 + (pn - 8) * 256;
        u.pm = pm; u.pn = pn; u.last = 1; u.A = hx + (size_t)pm * TSTEP1K; u.B = wt + (size_t)wrow * 2048; return true; } };
struct SchedInB { const char* hx; const char* wt; int G, c;
    __device__ __forceinline__ bool next(int i, Unit& u) const {
        const int Lx = (i >> (REPN(21) - 1)) * G + c; if (Lx >= 12 * 128) return false; int pm, pn; pg8::rect_map(Lx, 12, 128, pm, pn);
        u.pm = pm; u.pn = pn; u.last = 1; u.A = wt + (size_t)(2048 + pm * 256) * 2048; u.B = hx + (size_t)pn * TSTEP1K; return true; } };
struct SchedMerge { const char* yrg; const char* yhy; const char* wrg; const char* why; int G, c;
    __device__ __forceinline__ bool next(int i, Unit& u) const {
        const int T = (i >> 1) * G + c, part = i & 1; if (T >= 512) return false; int pm, pn; pg8::rect_map(T, 128, 4, pm, pn);
        u.pm = pm; u.pn = pn; u.last = part; u.A = (part ? yhy : yrg) + (size_t)pm * TSTEP1K; u.B = (part ? why : wrg) + (size_t)pn * TSTEP1K; return true; } };
struct SchedOut { const char* a; const char* w; int G, c;
    __device__ __forceinline__ bool next(int i, Unit& u) const {
        const int T = (i >> (REPN(7) - 1)) * G + c; if (T >= 512) return false; int pm, pn; pg8::rect_map(T, 128, 4, pm, pn);
        u.pm = pm; u.pn = pn; u.last = 1; u.A = a + (size_t)pm * TSTEP1K; u.B = w + (size_t)pn * TSTEP1K; return true; } };
struct SchedMoeUp { const char* xg; const char* w13; const LAS int* blk_exp; const int* row_tok; int nblk, G, c;
    __device__ __forceinline__ bool next(int i, Unit& u) const {
        const int T = i * G + c; if (T >= nblk * 4) return false; const int pm = T >> 2, pn = T & 3, e = blk_exp[pm];
        u.pm = pm; u.pn = pn; u.last = 1; u.A = xg; u.B = w13 + (size_t)e * (1024 * 1024 * 2) + (size_t)pn * TSTEP1K; return true; } };
struct SchedMoeDown { const char* h; const char* w2; const LAS int* blk_exp; int nblk, G, c;
    __device__ __forceinline__ bool next(int i, Unit& u) const {
        const int T = i * G + c; if (T >= nblk * 4) return false; const int pm = T >> 2, pn = T & 3, e = blk_exp[pm];
        u.pm = pm; u.pn = pn; u.last = 1; u.A = h + (size_t)pm * (256 * 512 * 2); u.B = w2 + (size_t)e * (1024 * 512 * 2) + (size_t)pn * (256 * 512 * 2); return true; } };


typedef f32x2 cpx;
__device__ __forceinline__ int pidx(int i) { return i + (i >> 4); }
__device__ __forceinline__ cpx cmul(cpx a, cpx b) { return (cpx){a.x * b.x - a.y * b.y, a.x * b.y + a.y * b.x}; }
template <bool INV> __device__ __forceinline__ cpx mul_w4(cpx a) { return INV ? (cpx){-a.y, a.x} : (cpx){a.y, -a.x}; }
template <bool INV> __device__ __forceinline__ void dft4(cpx& a, cpx& b, cpx& c, cpx& d) {
    const cpx t0 = a + c, t1 = a - c, t2 = b + d, t3 = b - d; const cpx t3r = mul_w4<INV>(t3);
    a = t0 + t2; b = t1 + t3r; c = t0 - t2; d = t1 - t3r; }
template <bool INV> __device__ __forceinline__ cpx twc(cpx x, float cr, float ci) { return cmul(x, (cpx){cr, INV ? -ci : ci}); }
#define SLOT16(q) (4 * ((q) & 3) + ((q) >> 2))
template <bool INV> __device__ __forceinline__ void dft16(cpx (&x)[16]) {
    const float C1 = 0.9238795325112867f, S1 = 0.3826834323650898f, R = 0.7071067811865476f;
#pragma unroll
    for (int m2 = 0; m2 < 4; ++m2) dft4<INV>(x[m2], x[4 + m2], x[8 + m2], x[12 + m2]);
    x[5] = twc<INV>(x[5], C1, -S1); x[9] = twc<INV>(x[9], R, -R); x[6] = twc<INV>(x[6], R, -R);
    x[13] = twc<INV>(x[13], S1, -C1); x[7] = twc<INV>(x[7], S1, -C1); x[10] = mul_w4<INV>(x[10]);
    x[14] = twc<INV>(x[14], -R, -R); x[11] = twc<INV>(x[11], -R, -R); x[15] = twc<INV>(x[15], -C1, S1);
#pragma unroll
    for (int q1 = 0; q1 < 4; ++q1) dft4<INV>(x[4 * q1], x[4 * q1 + 1], x[4 * q1 + 2], x[4 * q1 + 3]);
}
template <int S_, int NIN> __device__ __forceinline__ void fft_fwd16(LAS cpx* X, const LAS cpx* TW, int tid) {
    constexpr int PS = S_ + S_ / 16;
#pragma unroll 1
    for (int it = 0; it < 2; ++it) {
        int bf = tid + 512 * it; asm volatile("" : "+v"(bf)); const int blk = bf / S_, j = bf % S_; const int base = pidx(blk * (16 * S_) + j);
        cpx x[16];
#pragma unroll
        for (int m = 0; m < 16; ++m) x[m] = (m < NIN) ? X[base + PS * m] : (cpx){0.f, 0.f};
        dft16<false>(x);
        const cpx w1 = TW[j]; cpx w = w1;
        X[base] = x[0];
#pragma unroll
        for (int q = 1; q < 16; ++q) { X[base + PS * q] = cmul(x[SLOT16(q)], w); w = cmul(w, w1); }
    }
}
template <int S_, int NOUT> __device__ __forceinline__ void fft_inv16(LAS cpx* X, const LAS cpx* TW, int tid) {
    constexpr int PS = S_ + S_ / 16;
#pragma unroll 1
    for (int it = 0; it < 2; ++it) {
        int bf = tid + 512 * it; asm volatile("" : "+v"(bf)); const int blk = bf / S_, j = bf % S_; const int base = pidx(blk * (16 * S_) + j);
        cpx w1 = TW[j]; w1.y = -w1.y; cpx w = w1;
        cpx x[16]; x[0] = X[base];
#pragma unroll
        for (int q = 1; q < 16; ++q) { x[q] = cmul(X[base + PS * q], w); w = cmul(w, w1); }
        dft16<true>(x);
#pragma unroll
        for (int m = 0; m < NOUT; ++m) X[base + PS * m] = x[SLOT16(m)];
    }
}
template <bool INV> __device__ __forceinline__ void fft_r4(LAS cpx* X, const LAS cpx* TW, int tid) {
#pragma unroll 2
    for (int it = 0; it < 8; ++it) {
        int bf = tid + 512 * it; asm volatile("" : "+v"(bf)); const int blk = bf >> 4, j = bf & 15; const int base = 68 * blk + j;
        cpx w1 = TW[j]; if (INV) w1.y = -w1.y; const cpx w2 = cmul(w1, w1), w3 = cmul(w2, w1);
        cpx a = X[base], b = X[base + 17], c = X[base + 34], d = X[base + 51];
        if (INV) { b = cmul(b, w1); c = cmul(c, w2); d = cmul(d, w3); }
        dft4<INV>(a, b, c, d);
        if (!INV) { b = cmul(b, w1); c = cmul(c, w2); d = cmul(d, w3); }
        X[base] = a; X[base + 17] = b; X[base + 34] = c; X[base + 51] = d;
    }
}

template <bool INV, bool OZERO> __device__ __forceinline__ void dft32(cpx (&e)[16], cpx (&o)[16]) {
    const float C[16] = {1.f, 0.9807852804032304f, 0.9238795325112867f, 0.8314696123025452f, 0.7071067811865476f, 0.5555702330196022f, 0.3826834323650898f, 0.1950903220161283f,
                         0.f, -0.1950903220161283f, -0.3826834323650898f, -0.5555702330196022f, -0.7071067811865476f, -0.8314696123025452f, -0.9238795325112867f, -0.9807852804032304f};
    const float S[16] = {0.f, 0.1950903220161283f, 0.3826834323650898f, 0.5555702330196022f, 0.7071067811865476f, 0.8314696123025452f, 0.9238795325112867f, 0.9807852804032304f,
                         1.f, 0.9807852804032304f, 0.9238795325112867f, 0.8314696123025452f, 0.7071067811865476f, 0.5555702330196022f, 0.3826834323650898f, 0.1950903220161283f};
#pragma unroll
    for (int m = 0; m < 16; ++m) { const cpx a = e[m]; cpx d;
        if (OZERO) d = a; else { const cpx b = o[m]; e[m] = a + b; d = a - b; }
        o[m] = (m == 0) ? d : (m == 8) ? mul_w4<INV>(d) : twc<INV>(d, C[m], -S[m]); }
    dft16<INV>(e); dft16<INV>(o);
}
template <int NIN> __device__ __forceinline__ void fft_fwd32A(LAS cpx* X, const LAS cpx* TW, int tid) {
    int j = tid; asm volatile("" : "+v"(j)); const int base = pidx(j); constexpr int PS = 544;
    cpx e[16], o[16];
#pragma unroll
    for (int m = 0; m < 16; ++m) { e[m] = X[base + PS * m]; o[m] = (NIN == 32) ? X[base + PS * (m + 16)] : (cpx){0.f, 0.f}; }
    dft32<false, NIN == 16>(e, o);
    const cpx w1 = TW[j], w2 = cmul(w1, w1); cpx te = w2, to = w1;
    X[base] = e[0]; X[base + PS] = cmul(o[0], to); to = cmul(to, w2);
#pragma unroll
    for (int q = 1; q < 16; ++q) { X[base + PS * (2 * q)] = cmul(e[SLOT16(q)], te); X[base + PS * (2 * q + 1)] = cmul(o[SLOT16(q)], to); te = cmul(te, w2); to = cmul(to, w2); }
}
__device__ __forceinline__ void fft_fwd32A_filter(LAS cpx* X, const LAS cpx* TW, const float* kfw, const float* kbw, int tid) {
    int j = tid; asm volatile("" : "+v"(j)); const int base = pidx(j); constexpr int PS = 544;
    cpx e[16], o[16];
#pragma unroll
    for (int m = 0; m < 16; ++m) e[m] = (cpx){kfw[j + 512 * m], 0.f};
#pragma unroll
    for (int m = 0; m < 16; ++m) { const int i = j + 512 * m; o[m] = (cpx){(i == 0) ? 0.f : kbw[SEQ - i], 0.f}; }
    dft32<false, false>(e, o);
    const cpx w1 = TW[j], w2 = cmul(w1, w1); cpx te = w2, to = w1;
    X[base] = e[0]; X[base + PS] = cmul(o[0], to); to = cmul(to, w2);
#pragma unroll
    for (int q = 1; q < 16; ++q) { X[base + PS * (2 * q)] = cmul(e[SLOT16(q)], te); X[base + PS * (2 * q + 1)] = cmul(o[SLOT16(q)], to); te = cmul(te, w2); to = cmul(to, w2); }
}
__device__ __forceinline__ void fft_fwd32B(LAS cpx* X, const LAS cpx* TW, int tid) {
    int t = tid; asm volatile("" : "+v"(t)); const int blk = t >> 4, j = t & 15; const int base = 544 * blk + j; constexpr int PS = 17;
    cpx e[16], o[16];
#pragma unroll
    for (int m = 0; m < 16; ++m) { e[m] = X[base + PS * m]; o[m] = X[base + PS * (m + 16)]; }
    dft32<false, false>(e, o);
    const cpx w1 = TW[j], w2 = cmul(w1, w1); cpx te = w2, to = w1;
    X[base] = e[0]; X[base + PS] = cmul(o[0], to); to = cmul(to, w2);
#pragma unroll
    for (int q = 1; q < 16; ++q) { X[base + PS * (2 * q)] = cmul(e[SLOT16(q)], te); X[base + PS * (2 * q + 1)] = cmul(o[SLOT16(q)], to); te = cmul(te, w2); to = cmul(to, w2); }
}
template <int PS, int NOUT> __device__ __forceinline__ void fft_inv32_core(LAS cpx* X, int base, cpx w1c) {
    const cpx w2 = cmul(w1c, w1c); cpx te = w2, to = w1c;
    cpx e[16], o[16];
    cpx zin[32];
    zin[0] = X[base]; zin[1] = cmul(X[base + PS], to); to = cmul(to, w2);
#pragma unroll
    for (int q = 1; q < 16; ++q) { zin[2 * q] = cmul(X[base + PS * (2 * q)], te); zin[2 * q + 1] = cmul(X[base + PS * (2 * q + 1)], to); te = cmul(te, w2); to = cmul(to, w2); }
#pragma unroll
    for (int m = 0; m < 16; ++m) { e[m] = zin[m]; o[m] = zin[m + 16]; }
    dft32<true, false>(e, o);
#pragma unroll
    for (int m = 0; m < NOUT; ++m) X[base + PS * m] = (m & 1) ? o[SLOT16(m >> 1)] : e[SLOT16(m >> 1)];
}
__device__ __forceinline__ void fft_inv32A_final(const LAS cpx* X, const LAS cpx* TW, int tid, const unsigned* sx, bf16* rowA, bf16* rowB, bool dostore) {
    int j = tid; asm volatile("" : "+v"(j)); cpx w1 = TW[j]; w1.y = -w1.y; const int base = pidx(j); constexpr int PS = 544;
    unsigned sa[16], sb[16];
#pragma unroll
    for (int m = 0; m < 16; ++m) { sa[m] = __hip_atomic_load(sx + j + 512 * m, __ATOMIC_RELAXED, __HIP_MEMORY_SCOPE_AGENT); sb[m] = __hip_atomic_load(sx + SEQ + j + 512 * m, __ATOMIC_RELAXED, __HIP_MEMORY_SCOPE_AGENT); }
    const cpx w2 = cmul(w1, w1); cpx te = w2, to = w1;
    cpx e[16], o[16]; cpx zin[32];
    zin[0] = X[base]; zin[1] = cmul(X[base + PS], to); to = cmul(to, w2);
#pragma unroll
    for (int q = 1; q < 16; ++q) { zin[2 * q] = cmul(X[base + PS * (2 * q)], te); zin[2 * q + 1] = cmul(X[base + PS * (2 * q + 1)], to); te = cmul(te, w2); to = cmul(to, w2); }
#pragma unroll
    for (int m = 0; m < 16; ++m) { e[m] = zin[m]; o[m] = zin[m + 16]; }
    dft32<true, false>(e, o);
    if (dostore) {
#pragma unroll
        for (int m = 0; m < 16; ++m) { const cpx y = (m & 1) ? o[SLOT16(m >> 1)] : e[SLOT16(m >> 1)]; const int t = j + 512 * m;
            const float oa = y.x * bflo(sa[m]) + bfhi(sa[m]), ob = y.y * bflo(sb[m]) + bfhi(sb[m]);
            rowA[t] = (bf16)(pk2(oa, 0.f) & 0xffffu); rowB[t] = (bf16)(pk2(ob, 0.f) & 0xffffu); }
    }
}
__device__ __forceinline__ void fft_inv32B(LAS cpx* X, const LAS cpx* TW, int tid) {
    int t = tid; asm volatile("" : "+v"(t)); const int blk = t >> 4, j = t & 15; cpx w1 = TW[j]; w1.y = -w1.y;
    fft_inv32_core<17, 32>(X, 544 * blk + j, w1);
}
template <int NOUT> __device__ __forceinline__ void fft_inv32A(LAS cpx* X, const LAS cpx* TW, int tid) {
    int j = tid; asm volatile("" : "+v"(j)); cpx w1 = TW[j]; w1.y = -w1.y;
    fft_inv32_core<544, NOUT>(X, pidx(j), w1);
}
__device__ __forceinline__ void fft_fwdD_toK(const LAS cpx* X, cpx* Kb, int tid) {
#pragma unroll 1
    for (int it = 0; it < 2; ++it) {
        int bf = tid + 512 * it; asm volatile("" : "+v"(bf)); const int base = 17 * bf;
        cpx x[16];
#pragma unroll
        for (int m = 0; m < 16; ++m) x[m] = X[base + m];
        dft16<false>(x);
#pragma unroll
        for (int q = 0; q < 16; ++q) Kb[q * 1024 + bf] = x[SLOT16(q)] * (1.f / 16384.f);
    }
}
__device__ __forceinline__ void fft_kload1(cpx (&kq)[16], const cpx* Kb, int bf) {
#pragma unroll
    for (int q = 0; q < 16; ++q) { const unsigned long long kb = __hip_atomic_load((const unsigned long long*)(Kb + q * 1024 + bf), __ATOMIC_RELAXED, __HIP_MEMORY_SCOPE_AGENT);
        kq[q] = (cpx){__builtin_bit_cast(float, (unsigned)kb), __builtin_bit_cast(float, (unsigned)(kb >> 32))}; }
}
__device__ __forceinline__ void fft_fusedD_one(LAS cpx* X, const cpx (&kq)[16], int bf) {
    const int base = 17 * bf; cpx x[16], z[16];
#pragma unroll
    for (int m = 0; m < 16; ++m) x[m] = X[base + m];
    dft16<false>(x);
#pragma unroll
    for (int q = 0; q < 16; ++q) z[q] = cmul(x[SLOT16(q)], kq[q]);
    dft16<true>(z);
#pragma unroll
    for (int m = 0; m < 16; ++m) X[base + m] = z[SLOT16(m)];
}
__device__ __forceinline__ void fft_fusedD(LAS cpx* X, const cpx* Kb, int tid) {
    int bf = tid; asm volatile("" : "+v"(bf));
    cpx k0[16], k1[16];
    fft_kload1(k0, Kb, bf); fft_kload1(k1, Kb, bf + 512);
    fft_fusedD_one(X, k0, bf);
    fft_fusedD_one(X, k1, bf + 512);
}
struct Raw10 { u32x4 q; unsigned short l, r; };
__device__ __forceinline__ void load10_issue(Raw10& R, const bf16* row, int t0) {
    const int lane = threadIdx.x & 63; R.q = *(const u32x4*)(row + t0); R.l = 0; R.r = 0;
    if (lane == 0 && t0 > 0) R.l = row[t0 - 1];
    if (lane == 63 && t0 + 8 < SEQ) R.r = row[t0 + 8];
}
__device__ __forceinline__ void load10_finish(const Raw10& R, float (&pv)[10]) {
    const int lane = threadIdx.x & 63; const u32x4 q = R.q;
    pv[1] = bflo(q.x); pv[2] = bfhi(q.x); pv[3] = bflo(q.y); pv[4] = bfhi(q.y); pv[5] = bflo(q.z); pv[6] = bfhi(q.z); pv[7] = bflo(q.w); pv[8] = bfhi(q.w);
    float l = __shfl_up(pv[8], 1), r = __shfl_down(pv[1], 1);
    if (lane == 0) l = bf2f(R.l);
    if (lane == 63) r = bf2f(R.r);
    pv[0] = l; pv[9] = r;
}

struct ScanW { const bf16* prx; const bf16* grg; bf16* yrg; const float* rgcw; const float* rgcb; const bf16* wgt;
               const float* ba_f; const float* bx_f; const float* lam_f; const float* ba_b; const float* bx_b; const float* lam_b; f32x2* carr; const float* cin; };
__device__ __forceinline__ float neg_expm1_neg(float x) {
    return (x > -0.1f) ? -x * (1.f + x * 0.5f * (1.f + x * (1.f / 3.f) * (1.f + x * 0.25f * (1.f + x * 0.2f)))) : 1.f - __expf(x);
}
struct ScanPre { u32x4 p[4]; u32x4 gl; float cinv; };
template <int PASS>
__device__ __forceinline__ void scan_decode(int it, int& b, int& j, int& h) {
    h = it & 15; const int rest = it >> 4;
    if (PASS == 1) { j = rest % NCHUNK; b = rest / NCHUNK; } else { j = (rest & 127) + 4; b = rest >> 7; }
}
template <int PASS>
__device__ __forceinline__ void scan_prefetch(ScanPre& R, const ScanW& W, int it, int tid, int cidx_lane) {
    int b, j, h; scan_decode<PASS>(it, b, j, h);
    const int isctx = j < 4; const int seglen = isctx ? CTXL : SEQ; const int t0 = isctx ? j * 64 : (j - 4) * 64; const int rowbase = isctx ? NTOK + b * CTXL : b * SEQ;
    const int tok = tid >> 3, cg0 = h * 64 + (tid & 7) * 8;
#pragma unroll
    for (int jj = 0; jj < 4; ++jj) { const int tt = t0 + tok + jj - 2; R.p[jj] = (u32x4){0u, 0u, 0u, 0u};
        if (tt >= 0 && tt < seglen) R.p[jj] = *(const u32x4*)(W.prx + (size_t)(rowbase + tt) * 1024 + cg0); }
    R.cinv = 0.f;
    if (PASS == 2) { R.gl = *(const u32x4*)(W.grg + (size_t)(rowbase + t0 + tok) * 1024 + cg0); R.cinv = W.cin[(size_t)(b * NCHUNK + j) * 2048 + h * 64 + cidx_lane]; }
}
template <int PASS>
__device__ __forceinline__ void scan_phase(LAS unsigned char* lds, const ScanW& W, int first, int stride, int nitems, int tid, int lane, int wave) {
    LAS float* XCF = (LAS float*)lds;
    LAS bf16* XCB = (LAS bf16*)(lds + 16896);
    LAS float* HX = (LAS float*)(lds + 16896 + 9216);
    if (first >= nitems) return;
    const int dir = wave >> 2, eb = wave & 3, g = lane >> 4, li = lane & 15;
    const int tok = tid >> 3, e0 = (tid & 7) * 8;
    int hcur = -1;
    float cw[4][8], cb[8]; bf16x8 bR[2], bI[2]; float ba = 0.f, bx = 0.f, sp8 = 0.f, sp8l = 0.f, nba = 0.f, nbx = 0.f;
    const int cidx_lane = dir * 1024 + eb * 16 + li;
    ScanPre R; scan_prefetch<PASS>(R, W, first, tid, cidx_lane);
    u32x4 o_prev = {0u, 0u, 0u, 0u}; bf16* p_prev = nullptr; f32x2 c_prev = {0.f, 0.f}; f32x2* cp_prev = nullptr;
#pragma unroll 1
    for (int it = first; it < nitems; it += stride) {
        int b, j, h; scan_decode<PASS>(it, b, j, h);
        const int isctx = j < 4; const int t0 = isctx ? j * 64 : (j - 4) * 64; const int rowbase = isctx ? NTOK + b * CTXL : b * SEQ;
        const int ch = h * 64 + eb * 16 + li;
        const size_t cidx = ((size_t)(b * NCHUNK + j) * 2 + dir) * 1024 + ch;
        const float cinv = R.cinv;
        if (h != hcur) {
            hcur = h; const int cg0 = h * 64 + e0;
#pragma unroll
            for (int jj = 0; jj < 4; ++jj) { const f32x4 w0 = *(const f32x4*)(W.rgcw + jj * 1024 + cg0), w1 = *(const f32x4*)(W.rgcw + jj * 1024 + cg0 + 4);
                cw[jj][0] = w0[0]; cw[jj][1] = w0[1]; cw[jj][2] = w0[2]; cw[jj][3] = w0[3]; cw[jj][4] = w1[0]; cw[jj][5] = w1[1]; cw[jj][6] = w1[2]; cw[jj][7] = w1[3]; }
            { const f32x4 c0 = *(const f32x4*)(W.rgcb + cg0), c1 = *(const f32x4*)(W.rgcb + cg0 + 4); cb[0] = c0[0]; cb[1] = c0[1]; cb[2] = c0[2]; cb[3] = c0[3]; cb[4] = c1[0]; cb[5] = c1[1]; cb[6] = c1[2]; cb[7] = c1[3]; }
            const bf16* wp = W.wgt + ((size_t)((dir * 2) * 16 + h) * 64 + eb * 16 + li) * 64 + g * 8;
            bR[0] = *(const bf16x8*)(wp); bR[1] = *(const bf16x8*)(wp + 32); bI[0] = *(const bf16x8*)(wp + 16 * 4096); bI[1] = *(const bf16x8*)(wp + 16 * 4096 + 32);
            ba = (dir ? W.ba_b : W.ba_f)[ch]; bx = (dir ? W.bx_b : W.bx_f)[ch]; const float lam = (dir ? W.lam_b : W.lam_f)[ch];
            sp8 = -8.f * log1pf(__expf(-lam)); sp8l = sp8 * 1.4426950408889634f; nba = -ba * 1.4426950408889634f; nbx = -bx * 1.4426950408889634f;
        }
        {
            float xv[8];
#pragma unroll
            for (int q = 0; q < 8; ++q) xv[q] = cb[q];
#pragma unroll
            for (int jj = 0; jj < 4; ++jj) { const u32x4 p = R.p[jj];
                xv[0] += cw[jj][0] * bflo(p.x); xv[1] += cw[jj][1] * bfhi(p.x); xv[2] += cw[jj][2] * bflo(p.y); xv[3] += cw[jj][3] * bfhi(p.y);
                xv[4] += cw[jj][4] * bflo(p.z); xv[5] += cw[jj][5] * bfhi(p.z); xv[6] += cw[jj][6] * bflo(p.w); xv[7] += cw[jj][7] * bfhi(p.w); }
#pragma unroll
            for (int q = 0; q < 8; ++q) XCF[tok * 65 + e0 + q] = xv[q];
            *(LAS u32x4*)(XCB + tok * 72 + e0) = (u32x4){pk2(xv[0], xv[1]), pk2(xv[2], xv[3]), pk2(xv[4], xv[5]), pk2(xv[6], xv[7])};
        }
        const u32x4 gl = R.gl;
        if (it + stride < nitems) scan_prefetch<PASS>(R, W, it + stride, tid, cidx_lane);
        if (PASS == 2) { if (p_prev) *(u32x4*)p_prev = o_prev; } else { if (cp_prev) *cp_prev = c_prev; }
        LDS_BARRIER();
        f32x4 aR[4], aI[4];
#pragma unroll
        for (int mb = 0; mb < 4; ++mb) { aR[mb] = (f32x4){0.f, 0.f, 0.f, 0.f}; aI[mb] = (f32x4){0.f, 0.f, 0.f, 0.f};
            const int trow = 16 * (li >> 2) + 4 * mb + (li & 3);
#pragma unroll
            for (int ks = 0; ks < 2; ++ks) { const bf16x8 af = *(const LAS bf16x8*)(XCB + trow * 72 + ks * 32 + g * 8);
                aR[mb] = __builtin_amdgcn_mfma_f32_16x16x32_bf16(af, bR[ks], aR[mb], 0, 0, 0); aI[mb] = __builtin_amdgcn_mfma_f32_16x16x32_bf16(af, bI[ks], aI[mb], 0, 0, 0); } }
        float av[16], bv[16];
#pragma unroll
        for (int mb = 0; mb < 4; ++mb)
#pragma unroll
            for (int r = 0; r < 4; ++r) { const int tk = 16 * g + 4 * mb + r; const float xcv = XCF[tk * 65 + eb * 16 + li];
                const float rr = __builtin_amdgcn_rcpf(1.f + __builtin_amdgcn_exp2f(__builtin_fmaf(aR[mb][r], -1.4426950408889634f, nba)));
                const float ii = __builtin_amdgcn_rcpf(1.f + __builtin_amdgcn_exp2f(__builtin_fmaf(aI[mb][r], -1.4426950408889634f, nbx)));
                const float a = __builtin_amdgcn_exp2f(sp8l * rr); const float om = (1.f - a) * (1.f + a);
                av[4 * mb + r] = a; bv[4 * mb + r] = __builtin_amdgcn_sqrtf(om) * ii * xcv; }
        float A16 = 1.f, B16 = 0.f;
        if (dir == 0) {
#pragma unroll
            for (int q = 0; q < 16; ++q) { B16 = av[q] * B16 + bv[q]; A16 *= av[q]; }
        } else {
#pragma unroll
            for (int q = 15; q >= 0; --q) { B16 = av[q] * B16 + bv[q]; A16 *= av[q]; }
        }
        float Pc = 1.f, Hc = cinv, hin;
        {
            LAS float* chn = (LAS float*)(lds + 60928) + wave * 128 + li * 8;
            *(LAS f32x2*)(chn + g * 2) = (f32x2){A16, B16};
            LDS_WAIT(); asm volatile("" ::: "memory");
            const f32x4 c01 = *(const LAS f32x4*)(chn), c23 = *(const LAS f32x4*)(chn + 4);
            LDS_WAIT(); asm volatile("" ::: "memory");
            const float Ag[4] = {c01[0], c01[2], c23[0], c23[2]}, Bg[4] = {c01[1], c01[3], c23[1], c23[3]};
            hin = Hc;
#pragma unroll
            for (int k = 0; k < 4; ++k) { const int gk = (dir == 0) ? k : 3 - k;
                const bool before = (dir == 0) ? (gk < g) : (gk > g);
                const float Hn = Ag[gk] * Hc + Bg[gk]; Pc *= Ag[gk]; Hc = Hn; if (before) hin = Hn; }
        }
        if (PASS == 1) {
            cp_prev = (g == 0) ? (W.carr + cidx) : nullptr; c_prev = (f32x2){Pc, Hc};
            LDS_BARRIER();
        } else {
            LAS float* hx = HX + dir * (64 * 68) + (16 * g) * 68 + eb * 16 + li; float H = hin;
            if (dir == 0) {
#pragma unroll
                for (int q = 0; q < 16; ++q) { H = av[q] * H + bv[q]; hx[q * 68] = H; }
            } else {
#pragma unroll
                for (int q = 15; q >= 0; --q) { H = av[q] * H + bv[q]; hx[q * 68] = H; }
            }
            LDS_BARRIER();
            const f32x4 f0 = *(const LAS f32x4*)(HX + tok * 68 + e0), f1 = *(const LAS f32x4*)(HX + tok * 68 + e0 + 4);
            const f32x4 g0 = *(const LAS f32x4*)(HX + 64 * 68 + tok * 68 + e0), g1 = *(const LAS f32x4*)(HX + 64 * 68 + tok * 68 + e0 + 4);
            u32x4 o; o.x = pk2((f0[0] + g0[0]) * bflo(gl.x), (f0[1] + g0[1]) * bfhi(gl.x)); o.y = pk2((f0[2] + g0[2]) * bflo(gl.y), (f0[3] + g0[3]) * bfhi(gl.y));
            o.z = pk2((f1[0] + g1[0]) * bflo(gl.z), (f1[1] + g1[1]) * bfhi(gl.z)); o.w = pk2((f1[2] + g1[2]) * bflo(gl.w), (f1[3] + g1[3]) * bfhi(gl.w));
            o_prev = o; p_prev = W.yrg + (size_t)(rowbase + t0 + tok) * 1024 + h * 64 + e0;
        }
    }
    if (PASS == 2) { if (p_prev) *(u32x4*)p_prev = o_prev; } else { if (cp_prev) *cp_prev = c_prev; }
}

#define XB_TMO      128
#define XB_XCNT(j)  (256  + 64 * (j))
#define XB_XSUB(j)  (1280 + 64 * (j))
#define XB_XGEN(j)  (2304 + 64 * (j))
#define XB_TOP      3328
#define XB_TOPGEN   3392
#define XCD_BAR_WORDS 3456
#define XB_SPIN_CAP (1u << 18)
__device__ __forceinline__ unsigned xb_ld(unsigned* p)              { return __hip_atomic_load(p, __ATOMIC_RELAXED, __HIP_MEMORY_SCOPE_AGENT); }
__device__ __forceinline__ unsigned xb_add(unsigned* p, unsigned v) { return __hip_atomic_fetch_add(p, v, __ATOMIC_RELAXED, __HIP_MEMORY_SCOPE_AGENT); }
__device__ __forceinline__ unsigned xb_xcc_id() { return (unsigned)__builtin_amdgcn_s_getreg((3 << 11) | 20) & 0xFu; }
#define XB_SPIN(cond, bar) do { unsigned _sp = 0; while (cond) { __builtin_amdgcn_s_sleep(1); \
    if ((++_sp & 255u) == 0u) { if (xb_ld(&(bar)[XB_TMO])) break; if (_sp > XB_SPIN_CAP) { atomicAdd(&(bar)[XB_TMO], 1u); break; } } } } while (0)
struct XcdBarrier { unsigned* bar; unsigned x; volatile LAS unsigned* st; };
__device__ __forceinline__ void xcd_barrier_complete(unsigned* bar, unsigned x, unsigned& nloc, unsigned& nx) {
    const unsigned Gn = gridDim.x * gridDim.y * gridDim.z;
    unsigned sum, cntx, mine, sp = 0u;
    for (;;) {
        sum = 0u; cntx = 0u; mine = 0u;
#pragma unroll
        for (unsigned j = 0; j < 16; ++j) { const unsigned c = xb_ld(&bar[XB_XCNT(j)]); sum += c; cntx += (c > 0u) ? 1u : 0u; mine = (j == x) ? c : mine; }
        if (sum == Gn) break;
        __builtin_amdgcn_s_sleep(1);
        if ((++sp & 255u) == 0u) { if (xb_ld(&bar[XB_TMO])) break; if (sp > XB_SPIN_CAP) { atomicAdd(&bar[XB_TMO], 1u); break; } }
    }
    nloc = mine > 0u ? mine : 1u; nx = cntx > 0u ? cntx : 1u;
}
__device__ __forceinline__ void xcd_barrier(const XcdBarrier& b) {
    asm volatile("s_waitcnt vmcnt(0)" ::: "memory");
    __syncthreads();
    if (threadIdx.x == 0) {
        unsigned* bar = b.bar;
        __builtin_amdgcn_s_waitcnt(0);
        unsigned nloc = b.st[0], nx = b.st[1];
        if (nloc == 0u) { xcd_barrier_complete(bar, b.x, nloc, nx); b.st[0] = nloc; b.st[1] = nx; }
        const unsigned old = xb_add(&bar[XB_XSUB(b.x)], 1u);
        const unsigned gen = old / nloc;
        if (old + 1u == (gen + 1u) * nloc) {
            __builtin_amdgcn_fence(__ATOMIC_RELEASE, "agent");
            asm volatile("s_waitcnt vmcnt(0)" ::: "memory");
            const unsigned og = xb_add(&bar[XB_TOP], 1u);
            const unsigned tg = og / nx;
            if (og + 1u == (tg + 1u) * nx) xb_add(&bar[XB_TOPGEN], 1u);
            else XB_SPIN(xb_ld(&bar[XB_TOPGEN]) == tg, bar);
            __builtin_amdgcn_fence(__ATOMIC_ACQUIRE, "agent");
            xb_add(&bar[XB_XGEN(b.x)], 1u);
            asm volatile("s_waitcnt vmcnt(0)" ::: "memory");
        } else {
            XB_SPIN(xb_ld(&bar[XB_XGEN(b.x)]) == gen, bar);
            __builtin_amdgcn_fence(__ATOMIC_ACQUIRE, "agent");
            asm volatile("s_waitcnt vmcnt(0)" ::: "memory");
        }
    }
    __syncthreads();
}

__device__ __forceinline__ void transpose_item(const float* W, int K, int N, bf16* WT, int mode, LAS float* scr, int item, int lane) {
    const int nblk = N / 64, kb = item / nblk, nb = item % nblk, k0 = 64 * kb, n0 = 64 * nb;
    const int lr = lane >> 4, lc = (lane & 15) * 4;
    f32x4 v[16];
#pragma unroll
    for (int i = 0; i < 16; ++i) v[i] = __builtin_nontemporal_load((const f32x4*)(W + (size_t)(k0 + 4 * i + lr) * N + n0 + lc));
#pragma unroll
    for (int i = 0; i < 16; ++i) { LAS float* d = scr + (4 * i + lr) * 65 + lc; d[0] = v[i][0]; d[1] = v[i][1]; d[2] = v[i][2]; d[3] = v[i][3]; }
    LDS_WAIT(); asm volatile("" ::: "memory");
    const int c = lane & 7;
#pragma unroll
    for (int j = 0; j < 8; ++j) { const int n = (lane >> 3) + 8 * j; const LAS float* sp = scr + (8 * c) * 65 + n;
        u32x4 o; o.x = pk2(sp[0 * 65], sp[1 * 65]); o.y = pk2(sp[2 * 65], sp[3 * 65]); o.z = pk2(sp[4 * 65], sp[5 * 65]); o.w = pk2(sp[6 * 65], sp[7 * 65]);
        const int nn = n0 + n; int row;
        if (mode == 0) row = nn;
        else if (mode == 1) row = (nn >> 7) * 256 + (nn & 127);
        else row = (nn >> 7) * 256 + 128 + (nn & 127);
        *(u32x4*)(WT + (size_t)row * K + k0 + 8 * c) = o; }
    LDS_WAIT(); asm volatile("" ::: "memory");
}

struct Args { const float* in[41]; float* out; unsigned char* ws; int ph_lo, ph_hi; };

enum { I_X = 0, I_C, I_CTX, I_CCTX, I_ADAW, I_ADAB, I_N1G, I_N2G, I_FG, I_WIN, I_RGCW, I_RGCB, I_WAF, I_BAF, I_WXF, I_BXF, I_LAMF, I_WAB, I_BAB, I_WXB, I_BXB, I_LAMB,
       I_RGPROJ, I_HYCW, I_HYCB, I_PW1, I_PB1, I_PW2, I_PB2, I_FREQ, I_PW3, I_SKIP, I_HYPROJ, I_WOUT, I_WG, I_BG, I_WE, I_BE, I_MW1, I_MW3, I_MW2 };

constexpr int NPHASE = 13;

__global__ void __launch_bounds__(NTHREADS, 2) fwd_kernel(Args args) {
    extern __shared__ __attribute__((aligned(16))) unsigned char lds_raw[];
    LAS unsigned char* lds = (LAS unsigned char*)lds_raw;
    const int tid = threadIdx.x, lane = tid & 63, wave = __builtin_amdgcn_readfirstlane(tid >> 6);
    const int G = gridDim.x, bid = blockIdx.x;
    const int gw = bid * NWAVES + wave, NGW = G * NWAVES;
    unsigned char* ws = args.ws;
    const int lo = args.ph_lo, hi = args.ph_hi;
#define IN(k) (lo <= (k) && (k) < hi)
#if ONE_LAUNCH
    cg::grid_group grid = cg::this_grid();
#define GRID_SYNC(k) do { if (IN(k) && IN((k) + 1)) { xcd_barrier(xbar); if (REPN(99) == 2) xcd_barrier(xbar); \
        if (PROBE_TS >= 0 && bid == 0 && tid == 0) tsbuf[(k) + 1] = __builtin_amdgcn_s_memrealtime(); } } while (0)
#else
#define GRID_SYNC(k) do { } while (0)
#endif
    int* cnt = (int*)(ws + WS_CTL);
    unsigned long long* tsbuf = (unsigned long long*)(ws + WS_CTL + 65536);
    if (PROBE_TS >= 0 && bid == 0 && tid == 0) tsbuf[0] = __builtin_amdgcn_s_memrealtime();
    XcdBarrier xbar; xbar.bar = (unsigned*)(ws + WS_CTL) + 4096; xbar.x = xb_xcc_id(); xbar.st = (volatile LAS unsigned*)(lds + LDS_BYTES - 64);
    if (tid < 2) xbar.st[tid] = 0u;
    __syncthreads();
    if (tid == 0) (void)xb_add(&xbar.bar[XB_XCNT(xbar.x)], 1u);
    if (args.ph_lo < 0) grid.sync();
    float* mod = (float*)(ws + WS_MOD);
    float* z2 = (float*)(ws + WS_Z2);
    float* ssq = (float*)(ws + WS_SSQ);
    int* tok_e = (int*)(ws + WS_ROUTE); int* tok_rank = tok_e + 2 * NTOK; float* tok_w = (float*)(tok_rank + 2 * NTOK); int* tok_slot = (int*)(tok_w + 2 * NTOK);
    bf16* rgproj_t = (bf16*)(ws + WS_WSMALL); bf16* hyproj_t = rgproj_t + 1024 * 1024; bf16* wout_t = hyproj_t + 1024 * 1024;
    bf16* win_t = (bf16*)(ws + WS_WIN);
    bf16* hx = (bf16*)(ws + WS_HX); bf16* yhy = (bf16*)(ws + WS_HX); bf16* Hbuf = (bf16*)(ws + WS_HX);
    bf16* prx = (bf16*)(ws + WS_PRX); bf16* merged = (bf16*)(ws + WS_PRX);
    bf16* grg = (bf16*)(ws + WS_GRG); bf16* hx2 = (bf16*)(ws + WS_GRG);
    bf16* phyT = (bf16*)(ws + WS_PHY);
    bf16* w13t = (bf16*)(ws + WS_W13); bf16* w2t = (bf16*)(ws + WS_W2);
    bf16* Xg = (bf16*)(ws + WS_XG); bf16* Ybuf = (bf16*)(ws + WS_XG);
    float* kf = (float*)(ws + WS_KF); bf16* yrg = (bf16*)(ws + WS_KF);
    f32x2* carr = (f32x2*)(ws + WS_CARR); float* cin = (float*)(ws + WS_CIN);
    bf16* gates = (bf16*)args.out;
    float* x1 = args.out;

    if (IN(0)) for (int rp = 0; rp < REPN(0); ++rp) {
        if (bid == 0) for (int i = tid; i < 1024; i += NTHREADS) cnt[i] = 0;
        const int nA = (G >= 192) ? 96 : 0; const bool doA = (nA == 0) || (bid < nA), doB = (nA == 0) || (bid >= nA);
        const int ob = bid - nA, OG = G - nA, ogw = ob * NWAVES + wave, ONGW = OG * NWAVES;
        if (doA) {
            LAS float* red = (LAS float*)lds;
            const float* c = args.in[I_C]; const float* cctx = args.in[I_CCTX]; const float* ada_w = args.in[I_ADAW]; const float* ada_b = args.in[I_ADAB];
            LAS float* sil = red + 8 * 5 * 64;
            for (int i = tid; i < 5 * 1024; i += NTHREADS) { const float cv = (i < 4096) ? c[i] : cctx[i - 4096]; sil[i] = cv * sigmoidf_(cv); }
            __syncthreads();
            for (int g = bid; g < 96; g += (nA ? nA : G)) {
                const int n = g * 64 + lane; float acc[5] = {0.f, 0.f, 0.f, 0.f, 0.f};
                for (int kk = 0; kk < 128; kk += 16) { float a[16];
#pragma unroll
                    for (int u = 0; u < 16; ++u) a[u] = __builtin_nontemporal_load(ada_w + (size_t)(wave * 128 + kk + u) * 6144 + n);
#pragma unroll
                    for (int u = 0; u < 16; ++u) { const int k = wave * 128 + kk + u;
#pragma unroll
                        for (int r = 0; r < 5; ++r) acc[r] += sil[r * 1024 + k] * a[u]; } }
#pragma unroll
                for (int r = 0; r < 5; ++r) red[(wave * 5 + r) * 64 + lane] = acc[r];
                __syncthreads();
                if (wave == 0) {
#pragma unroll
                    for (int r = 0; r < 5; ++r) { float s = ada_b[n]; for (int w = 0; w < 8; ++w) s += red[(w * 5 + r) * 64 + lane]; mod[r * 6144 + n] = s; } }
                __syncthreads();
            }
        }
        if (doB) {
            LAS float* fe = (LAS float*)lds + wave * 128; LAS float* z1 = fe + 64;
            const float* w1 = args.in[I_PW1]; const float* b1 = args.in[I_PB1]; const float* w2 = args.in[I_PW2]; const float* b2 = args.in[I_PB2]; const float* fr = args.in[I_FREQ];
            const float TWO_PI = 6.283185307179586f;
            float w1c[50], w2c[64];
#pragma unroll
            for (int i = 0; i < 50; ++i) w1c[i] = w1[i * 64 + lane];
#pragma unroll
            for (int i = 0; i < 64; ++i) w2c[i] = w2[i * 64 + lane];
            const float b1l = b1[lane], b2l = b2[lane], frl = fr[lane];
            for (int s = ogw; s < SEQ; s += ONGW) {
                float f = 0.f; const float sf = (float)s;
                if (lane == 0) f = sf / 8191.f;
                else if (lane <= 32) { const int j = (lane - 1) & 15; const float band = 1e-4f + (float)j * ((15.f - 1e-4f) / 15.f); float rev = sf * band * (1.f / 8192.f); rev -= floorf(rev + 0.5f);
                    f = (lane <= 16) ? cosf(TWO_PI * rev) : sinf(TWO_PI * rev); }
                else if (lane == 33) f = (float)(s >> 6) / 128.f;
                else if (lane <= 49) { const int mm = (lane <= 41) ? (lane - 33) : (lane - 41); float rev = (float)((s & 63) * mm) * (1.f / 64.f); rev -= floorf(rev + 0.5f);
                    f = (lane <= 41) ? cosf(TWO_PI * rev) : sinf(TWO_PI * rev); }
                fe[lane] = f; LDS_WAIT(); asm volatile("" ::: "memory");
                float a = b1l;
#pragma unroll
                for (int i = 0; i < 50; ++i) a += fe[i] * w1c[i];
                z1[lane] = sinf(frl * a); LDS_WAIT(); asm volatile("" ::: "memory");
                float a2 = b2l;
#pragma unroll
                for (int i = 0; i < 64; ++i) a2 += z1[i] * w2c[i];
                z2[(size_t)s * 64 + lane] = sinf(frl * a2);
                LDS_WAIT(); asm volatile("" ::: "memory");
            }
        }
        __syncthreads();
        if (doB) {
            LAS float* scr = (LAS float*)lds + wave * 4160;
            constexpr int I_IN = 16 * 112, I_SQ = 16 * 16;
            constexpr int NITEMS = I_IN + 3 * I_SQ;
            for (int it = ogw; it < NITEMS; it += ONGW) {
                int r = it;
                if (r < I_IN) { transpose_item(args.in[I_WIN], 1024, INC, win_t, 0, scr, r, lane); continue; } r -= I_IN;
                if (r < I_SQ) { transpose_item(args.in[I_RGPROJ], 1024, 1024, rgproj_t, 0, scr, r, lane); continue; } r -= I_SQ;
                if (r < I_SQ) { transpose_item(args.in[I_HYPROJ], 1024, 1024, hyproj_t, 0, scr, r, lane); continue; } r -= I_SQ;
                transpose_item(args.in[I_WOUT], 1024, 1024, wout_t, 0, scr, r, lane);
            }
        }
        if (doB) {
            bf16* wrh = (bf16*)(ws + 28 * MiB); bf16* wrl = wrh + 48 * 1024;
            for (int i = ob * NTHREADS + tid; i < 48 * 1024; i += OG * NTHREADS) { const int n = i >> 10, k = i & 1023;
                const float w = (n < 4) ? args.in[I_WG][k * 4 + n] : (n < 36) ? args.in[I_WE][k * 32 + (n - 4)] : 0.f;
                const unsigned h = pk2(w, 0.f) & 0xffffu; wrh[i] = (bf16)h; wrl[i] = (bf16)(pk2(w - bf2f(h), 0.f) & 0xffffu); }
        }
        if (doB) {
            bf16* wgt = (bf16*)(ws + WS_GATEW);
            for (int i = ob * NTHREADS + tid; i < 4 * 65536; i += OG * NTHREADS) { const int gi = i >> 16, r = i & 65535, hh = r >> 12, e = (r >> 6) & 63, d = r & 63;
                const float* src = gi == 0 ? args.in[I_WAF] : gi == 1 ? args.in[I_WXF] : gi == 2 ? args.in[I_WAB] : args.in[I_WXB];
                wgt[i] = (bf16)f2bf(src[hh * 4096 + d * 64 + e]); }
        }
    }
    GRID_SYNC(0);

    if (IN(1)) for (int rp = 0; rp < REPN(1); ++rp) {
        const float* x = args.in[I_X]; const float* ctx = args.in[I_CTX]; const float* n1g = args.in[I_N1G];
        f32x4 n1v[4];
#pragma unroll
        for (int j = 0; j < 4; ++j) n1v[j] = *(const f32x4*)(n1g + 4 * (64 * j + lane));
        for (int m0 = 2 * gw; m0 < MROWS; m0 += 2 * NGW) {
            f32x4 v[2][4]; float ss[2] = {0.f, 0.f};
#pragma unroll
            for (int u = 0; u < 2; ++u) { const int m = m0 + u; const float* xr = (m < NTOK) ? x + (size_t)m * 1024 : ctx + (size_t)(m - NTOK) * 1024;
#pragma unroll
                for (int j = 0; j < 4; ++j) v[u][j] = __builtin_nontemporal_load((const f32x4*)xr + 64 * j + lane); }
#pragma unroll
            for (int u = 0; u < 2; ++u)
#pragma unroll
                for (int j = 0; j < 4; ++j) ss[u] += (v[u][j][0] * v[u][j][0] + v[u][j][1] * v[u][j][1]) + (v[u][j][2] * v[u][j][2] + v[u][j][3] * v[u][j][3]);
#pragma unroll
            for (int u = 0; u < 2; ++u) { const int m = m0 + u; const int r = (m < NTOK) ? (m >> 13) : 4; const float* sh = mod + r * 6144; const float* sc = sh + 1024;
                const float rstd = rsqrtf(wave_sum(ss[u]) * (1.f / 1024.f) + 1e-6f);
#pragma unroll
                for (int j = 0; j < 4; ++j) { const int k = 4 * (64 * j + lane); const f32x4 g = n1v[j], s_ = *(const f32x4*)(sc + k), h = *(const f32x4*)(sh + k);
                    const f32x4 o = v[u][j] * rstd * g * (1.f + s_) + h; *(u32x2*)(hx + (size_t)m * 1024 + k) = pack4(o); } }
        }
        {
            LAS float* w3s = (LAS float*)lds;
            LAS float* z2t = w3s + 64 * 256;
            const float* w3 = args.in[I_PW3];
            const int sg = tid & 7, cgp = tid >> 3;
            int c0cur = -1;
            for (int it = bid; it < 8 * 128; it += G) {
                const int s0 = (it >> 3) * 64, c0 = (it & 7) * 256;
                __syncthreads();
                for (int e = tid; e < 64 * 64; e += NTHREADS) { const int r = e >> 6, jj = e & 63; z2t[jj * 68 + r] = z2[(size_t)(s0 + r) * 64 + jj]; }
                if (c0 != c0cur) { c0cur = c0;
                    for (int e = tid; e < 64 * 64; e += NTHREADS) { const int jj = e >> 6, c4 = e & 63; *(LAS f32x4*)(w3s + jj * 256 + 4 * c4) = *(const f32x4*)(w3 + (size_t)jj * 2048 + c0 + 4 * c4); } }
                __syncthreads();
                float acc[4][8];
#pragma unroll
                for (int a = 0; a < 4; ++a)
#pragma unroll
                    for (int q = 0; q < 8; ++q) acc[a][q] = 0.f;
#pragma unroll 4
                for (int jj = 0; jj < 64; ++jj) { const f32x4 w = *(const LAS f32x4*)(w3s + jj * 256 + 4 * cgp); const f32x4 za = *(const LAS f32x4*)(z2t + jj * 68 + 8 * sg), zb = *(const LAS f32x4*)(z2t + jj * 68 + 8 * sg + 4);
#pragma unroll
                    for (int a = 0; a < 4; ++a) { acc[a][0] += w[a] * za[0]; acc[a][1] += w[a] * za[1]; acc[a][2] += w[a] * za[2]; acc[a][3] += w[a] * za[3];
                        acc[a][4] += w[a] * zb[0]; acc[a][5] += w[a] * zb[1]; acc[a][6] += w[a] * zb[2]; acc[a][7] += w[a] * zb[3]; } }
                const float mind = -3.0701134573253944f, maxd = -15.350567286626972f;
#pragma unroll
                for (int a = 0; a < 4; ++a) { const int cp = c0 + 4 * cgp + a, ch = cp & 1023; const float delta = fabsf(mind + (float)ch * ((maxd - mind) / 1023.f));
                    f32x4 o0, o1;
#pragma unroll
                    for (int q = 0; q < 4; ++q) { o0[q] = acc[a][q] * __expf(-((float)(s0 + 8 * sg + q) / 8191.f) * delta); o1[q] = acc[a][4 + q] * __expf(-((float)(s0 + 8 * sg + 4 + q) / 8191.f) * delta); }
                    *(f32x4*)(kf + (size_t)cp * SEQ + s0 + 8 * sg) = o0; *(f32x4*)(kf + (size_t)cp * SEQ + s0 + 8 * sg + 4) = o1; }
            }
        }
    }
    GRID_SYNC(1);

    if (IN(2)) {
        { SchedInA S{(const char*)hx, (const char*)win_t, G, bid}; EpiInA E{prx, grg, gates}; pg8::gemm_phase(lds, 1024, S, E); }
        { SchedInB S{(const char*)hx, (const char*)win_t, G, bid}; EpiInB E{phyT}; pg8::gemm_phase(lds, 1024, S, E); }
    }
    GRID_SYNC(2);

    const ScanW SW{prx, grg, yrg, args.in[I_RGCW], args.in[I_RGCB], (const bf16*)(ws + WS_GATEW), args.in[I_BAF], args.in[I_BXF], args.in[I_LAMF], args.in[I_BAB], args.in[I_BXB], args.in[I_LAMB], carr, cin};
    if (IN(3)) {
        for (int rp = 0; rp < REPN(3); ++rp) scan_phase<1>(lds, SW, bid, G, NBATCH * NCHUNK * 16, tid, lane, wave);
        __syncthreads();
        {
            LAS cpx* X = (LAS cpx*)lds;
            LAS cpx* TWA = (LAS cpx*)(lds + 139264); LAS cpx* TWB = TWA + 512;
            for (int i = tid; i < 512 + 16; i += NTHREADS) { const float fr_ = (i < 512) ? (float)i * (1.f / 8192.f) : (float)(i - 512) * (1.f / 256.f);
                float sn, cs; sincospif(-fr_, &sn, &cs); TWA[i] = (cpx){cs, sn}; }
            __syncthreads();
            cpx* Kb = (cpx*)(ws + WS_HX) + (size_t)bid * 16384;
            unsigned* SX = (unsigned*)(ws + WS_HX + 32 * MiB) + (size_t)bid * 16384;
            const float* hcw = args.in[I_HYCW]; const float* hcb = args.in[I_HYCB]; const float* skip = args.in[I_SKIP];
            for (int rp = 0; rp < REPN(30); ++rp)
            for (int c = bid; c < 1024; c += G) {
                LDS_BARRIER();
                fft_fwd32A_filter(X, TWA, kf + (size_t)c * SEQ, kf + (size_t)(1024 + c) * SEQ, tid); LDS_BARRIER();
                fft_fwd32B(X, TWB, tid); LDS_BARRIER();
                fft_fwdD_toK(X, Kb, tid);
                const float w00 = hcw[c], w01 = hcw[3072 + c], w02 = hcw[6144 + c], b0 = hcb[c];
                const float w10 = hcw[1024 + c], w11 = hcw[3072 + 1024 + c], w12 = hcw[6144 + 1024 + c], b1 = hcb[1024 + c];
                const float w20 = hcw[2048 + c], w21 = hcw[3072 + 2048 + c], w22 = hcw[6144 + 2048 + c], b2 = hcb[2048 + c];
                const float sk = skip[c];
                for (int pair = 0; pair < 2; ++pair) {
                    const bf16* rA = phyT + ((size_t)(2 * pair) * 3072 + c) * SEQ; const bf16* rB = rA + (size_t)3072 * SEQ;
                    if (pair == 0) __syncthreads(); else LDS_BARRIER();
                    { int tb = tid; asm volatile("" : "+v"(tb));
                        Raw10 ra[2][6];
#pragma unroll
                        for (int it = 0; it < 2; ++it) { const int t0 = 8 * (tb + 512 * it);
                            load10_issue(ra[it][0], rA, t0); load10_issue(ra[it][1], rA + (size_t)1024 * SEQ, t0); load10_issue(ra[it][2], rA + (size_t)2048 * SEQ, t0);
                            load10_issue(ra[it][3], rB, t0); load10_issue(ra[it][4], rB + (size_t)1024 * SEQ, t0); load10_issue(ra[it][5], rB + (size_t)2048 * SEQ, t0); }
#pragma unroll
                        for (int it = 0; it < 2; ++it) { const int t0 = 8 * (tb + 512 * it); float p0[10], p1[10], p2[10], ua[8], ub[8]; unsigned qa[8], qb[8];
                            load10_finish(ra[it][0], p0); load10_finish(ra[it][1], p1); load10_finish(ra[it][2], p2);
#pragma unroll
                            for (int k = 0; k < 8; ++k) { ua[k] = (b2 + w20 * p2[k] + w21 * p2[k + 1] + w22 * p2[k + 2]) * (b1 + w10 * p1[k] + w11 * p1[k + 1] + w12 * p1[k + 2]);
                                const float x0 = b0 + w00 * p0[k] + w01 * p0[k + 1] + w02 * p0[k + 2]; qa[k] = pk2(x0, sk * ua[k] * x0); }
                            load10_finish(ra[it][3], p0); load10_finish(ra[it][4], p1); load10_finish(ra[it][5], p2);
#pragma unroll
                            for (int k = 0; k < 8; ++k) { ub[k] = (b2 + w20 * p2[k] + w21 * p2[k + 1] + w22 * p2[k + 2]) * (b1 + w10 * p1[k] + w11 * p1[k + 1] + w12 * p1[k + 2]);
                                const float x0 = b0 + w00 * p0[k] + w01 * p0[k + 1] + w02 * p0[k + 2]; qb[k] = pk2(x0, sk * ub[k] * x0); }
                            *(u32x4*)(SX + t0) = (u32x4){qa[0], qa[1], qa[2], qa[3]}; *(u32x4*)(SX + t0 + 4) = (u32x4){qa[4], qa[5], qa[6], qa[7]};
                            *(u32x4*)(SX + SEQ + t0) = (u32x4){qb[0], qb[1], qb[2], qb[3]}; *(u32x4*)(SX + SEQ + t0 + 4) = (u32x4){qb[4], qb[5], qb[6], qb[7]};
                            const int pb = pidx(t0);
#pragma unroll
                            for (int k = 0; k < 8; ++k) X[pb + k] = (cpx){ua[k], ub[k]}; } }
                    LDS_BARRIER();
                    fft_fwd32A<16>(X, TWA, tid); LDS_BARRIER();
                    fft_fwd32B(X, TWB, tid); LDS_BARRIER();
                    fft_fusedD(X, Kb, tid); LDS_BARRIER();
                    fft_inv32B(X, TWB, tid); __syncthreads();
                    fft_inv32A_final(X, TWA, tid, SX, (bf16*)rA, (bf16*)rB, rp == REPN(30) - 1);
                }
            }
        }
    }
    GRID_SYNC(3);

    if (IN(4)) for (int rp = 0; rp < REPN(4); ++rp) {
        const int gt = bid * NTHREADS + tid;
        if (gt < NBATCH * 2 * 1024) {
            const int c = gt & 1023, dir = (gt >> 10) & 1, b = gt >> 11; float s_ = 0.f;
            const size_t cbase = (size_t)(b * NCHUNK) * 2048 + dir * 1024 + c;
#pragma unroll 1
            for (int q0 = 0; q0 < NCHUNK; q0 += 33) { f32x2 ab[33];
#pragma unroll
                for (int u = 0; u < 33; ++u) { const int q = q0 + u; const int j = dir == 0 ? q : (q < 4 ? 3 - q : NCHUNK + 3 - q); ab[u] = __builtin_nontemporal_load(carr + cbase + (size_t)j * 2048); }
#pragma unroll
                for (int u = 0; u < 33; ++u) { const int q = q0 + u; const int j = dir == 0 ? q : (q < 4 ? 3 - q : NCHUNK + 3 - q); cin[cbase + (size_t)j * 2048] = s_; s_ = ab[u].x * s_ + ab[u].y; } }
        }
    }
    GRID_SYNC(4);

    if (IN(5)) {
        for (int rp = 0; rp < REPN(5); ++rp) scan_phase<2>(lds, SW, bid, G, NBATCH * 128 * 16, tid, lane, wave);
        __syncthreads();
        {
            LAS bf16* T = (LAS bf16*)lds;
            for (int rp = 0; rp < REPN(50); ++rp)
            for (int it = bid; it < NBATCH * 16 * 32; it += G) {
                const int tb4 = it & 31, cb = (it >> 5) & 15, b = it >> 9;
                const int cl = tid >> 3, ch = tid & 7;
                u32x4 v[4];
#pragma unroll
                for (int q = 0; q < 4; ++q) v[q] = *(const u32x4*)(phyT + ((size_t)b * 3072 + cb * 64 + cl) * SEQ + (tb4 * 4 + q) * 64 + ch * 8);
                __syncthreads();
#pragma unroll
                for (int q = 0; q < 4; ++q) *(LAS u32x4*)(T + q * 4608 + cl * 72 + ch * 8) = v[q];
                __syncthreads();
#pragma unroll
                for (int q = 0; q < 4; ++q) { const int tl = tid >> 3; unsigned w[8];
#pragma unroll
                    for (int e = 0; e < 8; ++e) w[e] = T[q * 4608 + (ch * 8 + e) * 72 + tl];
                    u32x4 o; o.x = w[0] | (w[1] << 16); o.y = w[2] | (w[3] << 16); o.z = w[4] | (w[5] << 16); o.w = w[6] | (w[7] << 16);
                    *(u32x4*)(yhy + (size_t)(b * SEQ + (tb4 * 4 + q) * 64 + tl) * 1024 + cb * 64 + ch * 8) = o; }
            }
        }
    }
    GRID_SYNC(5);

    if (IN(6)) for (int rp = 0; rp < REPN(6); ++rp) {
        SchedMerge S{(const char*)yrg, (const char*)yhy, (const char*)rgproj_t, (const char*)hyproj_t, G, bid}; EpiMerge E{gates, merged};
        pg8::gemm_phase(lds, 1024, S, E);
    }
    GRID_SYNC(6);

    if (IN(7)) {
        SchedOut S{(const char*)merged, (const char*)wout_t, G, bid}; EpiOut E{args.in[I_X], mod, x1, ssq};
        pg8::gemm_phase(lds, 1024, S, E);
    }
    GRID_SYNC(7);

    if (IN(8)) {
        {
            LAS bf16* XH = (LAS bf16*)lds;
            LAS bf16* XL = XH + 128 * 72;
            LAS bf16* WH = XL + 128 * 72;
            LAS bf16* WLo = WH + 48 * 72;
            LAS float* LG = (LAS float*)(WLo + 48 * 72);
            LAS float* RS = LG + 128 * 49;
            LAS int* LCNT = (LAS int*)(RS + 128); LAS int* LBASE = LCNT + 32;
            const float* n2g = args.in[I_N2G]; const float* bg = args.in[I_BG]; const float* be = args.in[I_BE];
            const bf16* wrh = (const bf16*)(ws + 28 * MiB); const bf16* wrl = wrh + 48 * 1024;
            int nrep8 = REPN(8); asm volatile("" : "+s"(nrep8));
_Pragma("unroll 1")
            for (int rp = 0; rp < nrep8; ++rp)
            for (int tile = bid; tile < NTOK / 128; tile += G) {
                const int R0 = tile * 128; const int b = R0 >> 13; const float* sh = mod + b * 6144 + 3072; const float* sc = sh + 1024;
                __syncthreads();
                if (tid < 128) { const float* sp = ssq + (size_t)(R0 + tid) * 16; float ss = 0.f; for (int q = 0; q < 16; ++q) ss += sp[q]; RS[tid] = rsqrtf(ss * (1.f / 1024.f) + 1e-6f); }
                if (tid < 32) LCNT[tid] = 0;
                int ea_ = 0, eb_ = 0, la_ = 0, lb_ = 0; float wa_ = 0.f, wb_ = 0.f;
                __syncthreads();
                f32x4 lacc[3];
#pragma unroll
                for (int c = 0; c < 3; ++c) lacc[c] = (f32x4){0.f, 0.f, 0.f, 0.f};
                const int lrow = tid >> 2, lq = tid & 3; const float rstd = RS[lrow];
                const int mg = lane >> 4, mli = lane & 15;
#pragma unroll 1
                for (int kc = 0; kc < 16; ++kc) {
                    const int k0 = kc * 64 + lq * 16;
                    f32x4 o[4];
#pragma unroll
                    for (int i = 0; i < 4; ++i) { const int k = k0 + 4 * i; const f32x4 v = *(const f32x4*)(x1 + (size_t)(R0 + lrow) * 1024 + k);
                        const f32x4 g = *(const f32x4*)(n2g + k), s_ = *(const f32x4*)(sc + k), hh = *(const f32x4*)(sh + k); o[i] = v * rstd * g * (1.f + s_) + hh; }
                    unsigned hi[8], lo[8];
#pragma unroll
                    for (int i = 0; i < 4; ++i)
#pragma unroll
                        for (int q = 0; q < 2; ++q) { const float a0 = o[i][2 * q], a1 = o[i][2 * q + 1]; const unsigned h = pk2(a0, a1); hi[2 * i + q] = h; lo[2 * i + q] = pk2(a0 - bflo(h), a1 - bfhi(h)); }
                    *(u32x4*)(hx2 + (size_t)(R0 + lrow) * 1024 + k0) = (u32x4){hi[0], hi[1], hi[2], hi[3]};
                    *(u32x4*)(hx2 + (size_t)(R0 + lrow) * 1024 + k0 + 8) = (u32x4){hi[4], hi[5], hi[6], hi[7]};
                    u32x4 wph = {0u, 0u, 0u, 0u}, wpl = {0u, 0u, 0u, 0u};
                    if (tid < 384) { wph = *(const u32x4*)(wrh + (size_t)(tid >> 3) * 1024 + kc * 64 + (tid & 7) * 8); wpl = *(const u32x4*)(wrl + (size_t)(tid >> 3) * 1024 + kc * 64 + (tid & 7) * 8); }
                    __syncthreads();
                    *(LAS u32x4*)(XH + lrow * 72 + lq * 16) = (u32x4){hi[0], hi[1], hi[2], hi[3]}; *(LAS u32x4*)(XH + lrow * 72 + lq * 16 + 8) = (u32x4){hi[4], hi[5], hi[6], hi[7]};
                    *(LAS u32x4*)(XL + lrow * 72 + lq * 16) = (u32x4){lo[0], lo[1], lo[2], lo[3]}; *(LAS u32x4*)(XL + lrow * 72 + lq * 16 + 8) = (u32x4){lo[4], lo[5], lo[6], lo[7]};
                    if (tid < 384) { *(LAS u32x4*)(WH + (tid >> 3) * 72 + (tid & 7) * 8) = wph; *(LAS u32x4*)(WLo + (tid >> 3) * 72 + (tid & 7) * 8) = wpl; }
                    __syncthreads();
#pragma unroll
                    for (int ks = 0; ks < 2; ++ks) { const bf16x8 aH = *(const LAS bf16x8*)(XH + (wave * 16 + mli) * 72 + ks * 32 + mg * 8), aL = *(const LAS bf16x8*)(XL + (wave * 16 + mli) * 72 + ks * 32 + mg * 8);
#pragma unroll
                        for (int nt = 0; nt < 3; ++nt) { const bf16x8 bH = *(const LAS bf16x8*)(WH + (nt * 16 + mli) * 72 + ks * 32 + mg * 8), bL = *(const LAS bf16x8*)(WLo + (nt * 16 + mli) * 72 + ks * 32 + mg * 8);
                            lacc[nt] = __builtin_amdgcn_mfma_f32_16x16x32_bf16(aH, bH, lacc[nt], 0, 0, 0); lacc[nt] = __builtin_amdgcn_mfma_f32_16x16x32_bf16(aL, bH, lacc[nt], 0, 0, 0);
                            lacc[nt] = __builtin_amdgcn_mfma_f32_16x16x32_bf16(aH, bL, lacc[nt], 0, 0, 0); } }
                }
#pragma unroll
                for (int nt = 0; nt < 3; ++nt)
#pragma unroll
                    for (int r = 0; r < 4; ++r) LG[(wave * 16 + 4 * mg + r) * 49 + nt * 16 + mli] = lacc[nt][r];
                __syncthreads();
                if (tid < 128) {
                    float lg[36];
#pragma unroll
                    for (int c = 0; c < 36; ++c) lg[c] = LG[tid * 49 + c] + (c < 4 ? bg[c] : be[c - 4]);
                    int grp = 0; float gm = lg[0];
#pragma unroll
                    for (int q = 1; q < 4; ++q) if (lg[q] > gm) { gm = lg[q]; grp = q; }
                    float den = 0.f;
#pragma unroll
                    for (int q = 0; q < 4; ++q) den += __expf(lg[q] - gm);
                    const float pg = 1.f / den;
                    float ep[8];
#pragma unroll
                    for (int q = 0; q < 8; ++q) ep[q] = grp == 0 ? lg[4 + q] : grp == 1 ? lg[12 + q] : grp == 2 ? lg[20 + q] : lg[28 + q];
                    int i1 = 0; float v1 = ep[0];
#pragma unroll
                    for (int q = 1; q < 8; ++q) if (ep[q] > v1) { v1 = ep[q]; i1 = q; }
                    int i2 = -1; float v2 = -3.0e38f;
#pragma unroll
                    for (int q = 0; q < 8; ++q) if (q != i1 && ep[q] > v2) { v2 = ep[q]; i2 = q; }
                    const float e2 = __expf(v2 - v1); const float p1 = 1.f / (1.f + e2), p2 = e2 / (1.f + e2);
                    ea_ = grp * 8 + i1; eb_ = grp * 8 + i2; wa_ = pg * p1; wb_ = pg * p2;
                    la_ = __hip_atomic_fetch_add(LCNT + ea_, 1, __ATOMIC_RELAXED, __HIP_MEMORY_SCOPE_WORKGROUP); lb_ = __hip_atomic_fetch_add(LCNT + eb_, 1, __ATOMIC_RELAXED, __HIP_MEMORY_SCOPE_WORKGROUP);
                }
                __syncthreads();
                if (tid < 32 && rp == nrep8 - 1) LBASE[tid] = atomicAdd(cnt + 32 * tid, LCNT[tid]);
                __syncthreads();
                if (tid < 128 && rp == nrep8 - 1) { const int m = R0 + tid;
                    tok_e[2 * m] = ea_; tok_e[2 * m + 1] = eb_; tok_rank[2 * m] = LBASE[ea_] + la_; tok_rank[2 * m + 1] = LBASE[eb_] + lb_; tok_w[2 * m] = wa_; tok_w[2 * m + 1] = wb_; }
            }
        }
        __syncthreads();
        {
            LAS float* scr = (LAS float*)lds + wave * 4160;
            constexpr int I_E13 = 16 * 8, I_E2 = 8 * 16;
            constexpr int NITEMS = NEXP * (2 * I_E13);
            (void)I_E2;
            for (int rp = 0; rp < REPN(80); ++rp)
            for (int it = gw; it < NITEMS; it += NGW) {
                const int e = it / (2 * I_E13); int r = it % (2 * I_E13);
                if (r < I_E13) { transpose_item(args.in[I_MW1] + (size_t)e * 1024 * 512, 1024, 512, w13t + (size_t)e * 1024 * 1024, 1, scr, r, lane); continue; } r -= I_E13;
                transpose_item(args.in[I_MW3] + (size_t)e * 1024 * 512, 1024, 512, w13t + (size_t)e * 1024 * 1024, 2, scr, r, lane);
            }
        }
    }
    GRID_SYNC(8);

    LAS int* blk_exp = (LAS int*)(lds + MISC_OFF); LAS int* pstart = blk_exp + 320; LAS int* ecnt = pstart + 40;
    int* row_tok = (int*)(ws + WS_GATEW + 512 * 1024);
    int nblk = 0;
    if (hi > 9 && lo <= 11) {
        __syncthreads();
        if (tid == 0) { int p = 0; for (int e = 0; e < NEXP; ++e) { const int c_ = __hip_atomic_load(cnt + 32 * e, __ATOMIC_RELAXED, __HIP_MEMORY_SCOPE_AGENT); const int nb = (c_ + 255) >> 8; pstart[e] = p * 256; ecnt[e] = c_; for (int q = 0; q < nb; ++q) blk_exp[p + q] = e; p += nb; } pstart[32] = p; }
        __syncthreads();
        nblk = pstart[32];
    }

    if (IN(9)) for (int rp = 0; rp < REPN(9); ++rp) {
        const int gt = bid * NTHREADS + tid, GT = G * NTHREADS;
        for (int a = gt; a < 2 * NTOK; a += GT) { const int e = tok_e[a], rk = tok_rank[a]; const int slot = pstart[e] + rk; tok_slot[a] = slot; row_tok[slot] = a >> 1; }
        for (int r = gt; r < nblk * 256; r += GT) { const int e = blk_exp[r >> 8]; if (r - pstart[e] >= ecnt[e]) row_tok[r] = 0; }
    }
    GRID_SYNC(9);

    if (IN(10)) for (int rp = 0; rp < REPN(10); ++rp) {
        const int units = nblk * 4, rounds = (units + G - 1) / G; int need = rounds > 0 ? (units + rounds - 1) / rounds : G; if (G - need < 8) need = G;
        const int nsp = G - need;
        if (bid >= need || nsp == 0) {
            LAS float* scr = (LAS float*)lds + wave * 4160; constexpr int I_W2 = 8 * 16;
            const int w0 = (nsp ? (bid - need) : bid) * NWAVES + wave, nw = (nsp ? nsp : G) * NWAVES;
            for (int it = w0; it < NEXP * I_W2; it += nw) { const int e = it / I_W2, r = it % I_W2;
                transpose_item(args.in[I_MW2] + (size_t)e * 512 * 1024, 512, 1024, w2t + (size_t)e * 1024 * 512, 0, scr, r, lane); }
            __syncthreads();
        }
        if (bid < need) {
            SchedMoeUp S{(const char*)hx2, (const char*)w13t, blk_exp, row_tok, nblk, need, bid}; EpiMoeUp E{Hbuf};
            pg8::gemm_phase<EpiMoeUp, SchedMoeUp, true>(lds, 1024, S, E);
        }
    }
    GRID_SYNC(10);

    if (IN(11)) for (int rp = 0; rp < REPN(11); ++rp) {
        SchedMoeDown S{(const char*)Hbuf, (const char*)w2t, blk_exp, nblk, G, bid}; EpiMoeDown E{Ybuf};
        pg8::gemm_phase(lds, 512, S, E);
    }
    GRID_SYNC(11);

    if (IN(12)) {
        const float* fg = args.in[I_FG];
        f32x4 fgv[4];
#pragma unroll
        for (int j = 0; j < 4; ++j) fgv[j] = *(const f32x4*)(fg + 4 * (64 * j + lane));
        int nrep12 = REPN(12); asm volatile("" : "+s"(nrep12));
_Pragma("unroll 1")
        for (int rp = 0; rp < nrep12; ++rp)
        for (int m0 = 2 * gw; m0 < NTOK; m0 += 2 * NGW) {
            f32x4 v[2][4]; float ss[2] = {0.f, 0.f};
#pragma unroll
            for (int u = 0; u < 2; ++u) { const int m = m0 + u; const int b = m >> 13; const float* g2 = mod + b * 6144 + 5120;
                const int sa = tok_slot[2 * m], sb = tok_slot[2 * m + 1]; const float wa = tok_w[2 * m], wb = tok_w[2 * m + 1];
#pragma unroll
                for (int j = 0; j < 4; ++j) { const int k = 4 * (64 * j + lane);
                    const u32x2 ya = *(const u32x2*)(Ybuf + (size_t)sa * 1024 + k), yb = *(const u32x2*)(Ybuf + (size_t)sb * 1024 + k);
                    const f32x4 fa = {bflo(ya.x), bfhi(ya.x), bflo(ya.y), bfhi(ya.y)}, fb = {bflo(yb.x), bfhi(yb.x), bflo(yb.y), bfhi(yb.y)};
                    const f32x4 xv = *(const f32x4*)(x1 + (size_t)m * 1024 + k), gv = *(const f32x4*)(g2 + k);
                    v[u][j] = xv + gv * (fa * wa + fb * wb); ss[u] += (v[u][j][0] * v[u][j][0] + v[u][j][1] * v[u][j][1]) + (v[u][j][2] * v[u][j][2] + v[u][j][3] * v[u][j][3]); } }
#pragma unroll
            for (int u = 0; u < 2; ++u) { const int m = m0 + u; const float rstd = rsqrtf(wave_sum(ss[u]) * (1.f / 1024.f) + 1e-6f);
#pragma unroll
                for (int j = 0; j < 4; ++j) { const int k = 4 * (64 * j + lane); if (rp == nrep12 - 1) st_nt((f32x4*)(args.out + (size_t)m * 1024 + k), v[u][j] * rstd * fgv[j]); } }
        }
    }
    if (PROBE_TS >= 0) {
        xcd_barrier(xbar);
        if (bid == 0 && tid == 0) tsbuf[13] = __builtin_amdgcn_s_memrealtime();
        xcd_barrier(xbar);
        const int pk_ = PROBE_TS < 0 ? 0 : (PROBE_TS % 100); const int sub_ = PROBE_TS < 0 ? 0 : (PROBE_TS / 100);
        const unsigned long long t0_ = __hip_atomic_load(tsbuf + pk_, __ATOMIC_RELAXED, __HIP_MEMORY_SCOPE_AGENT), t1_ = __hip_atomic_load(tsbuf + pk_ + 1, __ATOMIC_RELAXED, __HIP_MEMORY_SCOPE_AGENT);
        const float binw = sub_ == 1 ? 10.f : 40.f;
        const float us = floorf((float)(t1_ - t0_) * 0.01f / binw + 0.5f); const float vv = sqrtf(1.0025f * us);
        for (size_t i = (size_t)bid * NTHREADS + tid; i < (size_t)NTOK * 1024; i += (size_t)G * NTHREADS) args.out[i] = vv;
    }
}

extern "C" void kernel_launch(void* const* d_in, const int* in_sizes, int n_in, void* d_out, int out_size, void* d_ws, size_t ws_size, hipStream_t stream) {
    static int grid = 0;
    if (grid == 0) {
        if (n_in != 41 || out_size != NTOK * DM || ws_size < WS_END) { fprintf(stderr, "kernel_launch: unexpected shapes (n_in %d, out %d, ws %zu)\n", n_in, out_size, ws_size); grid = -1; return; }
        int dev = 0, cus = 0, per_cu = 0;
        hipGetDevice(&dev); hipDeviceGetAttribute(&cus, hipDeviceAttributeMultiprocessorCount, dev);
        if (hipFuncSetAttribute((const void*)fwd_kernel, hipFuncAttributeMaxDynamicSharedMemorySize, LDS_BYTES) != hipSuccess) { fprintf(stderr, "kernel_launch: hipFuncSetAttribute failed\n"); grid = -1; return; }
        hipOccupancyMaxActiveBlocksPerMultiprocessor(&per_cu, (const void*)fwd_kernel, NTHREADS, LDS_BYTES);
        (void)hipGetLastError();
        if (per_cu < 1) { fprintf(stderr, "kernel_launch: occupancy query says %d blocks per CU\n", per_cu); per_cu = 1; }
        grid = cus;
        fprintf(stderr, "kernel_launch: grid %d (cus %d, per_cu %d)\n", grid, cus, per_cu);
    }
    if (grid < 0) return;
    if (hipMemsetAsync((char*)d_ws + WS_CTL + 4096 * 4, 0, XCD_BAR_WORDS * 4, stream) != hipSuccess) { fprintf(stderr, "kernel_launch: memset failed\n"); return; }
    Args a{};
    for (int i = 0; i < 41; ++i) a.in[i] = (const float*)d_in[i];
    a.out = (float*)d_out; a.ws = (unsigned char*)d_ws;
#if ONE_LAUNCH
    a.ph_lo = 0; a.ph_hi = NPHASE;
    void* kargs[] = {&a};
    hipError_t e = hipLaunchCooperativeKernel((const void*)fwd_kernel, dim3(grid), dim3(NTHREADS), kargs, LDS_BYTES, stream);
    if (e != hipSuccess) fprintf(stderr, "cooperative launch failed: %s (grid %d)\n", hipGetErrorString(e), grid);
#else
    for (int p = 0; p < NPHASE; ++p) { a.ph_lo = p; a.ph_hi = p + 1; hipLaunchKernelGGL(fwd_kernel, dim3(grid), dim3(NTHREADS), LDS_BYTES, stream, a); }
#endif
}
```

```cpp
#include <hip/hip_runtime.h>
#include <hip/hip_cooperative_groups.h>
#include <cstdio>
#include <cstdint>
namespace cg = cooperative_groups;

#ifndef ONE_LAUNCH
#define ONE_LAUNCH 1
#endif

#ifndef PROBE_REP
#define PROBE_REP -1
#endif
#ifndef PROBE_TS
#define PROBE_TS -1
#endif
#define REPN(k) ((PROBE_REP == (k)) ? 2 : 1)
#define LAS __attribute__((address_space(3)))
typedef unsigned short bf16;
typedef float f32x4 __attribute__((ext_vector_type(4)));
typedef float f32x2 __attribute__((ext_vector_type(2)));
typedef short bf16x8 __attribute__((ext_vector_type(8)));
typedef unsigned u32x4 __attribute__((ext_vector_type(4)));
typedef unsigned u32x2 __attribute__((ext_vector_type(2)));

constexpr int DM = 1024, NBATCH = 4, SEQ = 8192, NTOK = NBATCH * SEQ, CTXL = 256, NCTX = NBATCH * CTXL, MROWS = NTOK + NCTX;
constexpr int INC = 7168, NEXP = 32, DEXP = 512, PMAXBLK = 288;
constexpr int NCHUNK = 132;
constexpr int NTHREADS = 512, NWAVES = 8;
constexpr int LDS_BYTES = 148480;
constexpr int MISC_OFF = 145408;

constexpr size_t MiB = 1u << 20;
constexpr size_t WS_CTL = 0, WS_MOD = 1 * MiB, WS_Z2 = 2 * MiB, WS_SSQ = 4 * MiB, WS_ROUTE = 6 * MiB, WS_GATEW = 7 * MiB;
constexpr size_t WS_WSMALL = 8 * MiB, WS_WIN = 14 * MiB;
constexpr size_t WS_HX = 32 * MiB;
constexpr size_t WS_PRX = 98 * MiB;
constexpr size_t WS_GRG = 164 * MiB;
constexpr size_t WS_PHY = 228 * MiB;
constexpr size_t WS_W13 = 228 * MiB, WS_W2 = 292 * MiB;
constexpr size_t WS_XG = 324 * MiB;
constexpr size_t WS_KF = 420 * MiB;
constexpr size_t WS_CARR = 484 * MiB, WS_CIN = 494 * MiB, WS_END = 512 * MiB;

__device__ __forceinline__ unsigned f2bf(float f) { unsigned u = __builtin_bit_cast(unsigned, f); return (u + 0x7fffu + ((u >> 16) & 1u)) >> 16; }
typedef float pkf2_t __attribute__((ext_vector_type(2)));
typedef __bf16 pkb2_t __attribute__((ext_vector_type(2)));
__device__ __forceinline__ unsigned pk2(float lo, float hi) { const pkf2_t v = {lo, hi}; return __builtin_bit_cast(unsigned, __builtin_convertvector(v, pkb2_t)); }
__device__ __forceinline__ float bf2f(unsigned b) { return __builtin_bit_cast(float, b << 16); }
__device__ __forceinline__ float bflo(unsigned w) { return __builtin_bit_cast(float, w << 16); }
__device__ __forceinline__ float bfhi(unsigned w) { return __builtin_bit_cast(float, w & 0xffff0000u); }
__device__ __forceinline__ float wave_sum(float v) {
#pragma unroll
    for (int o = 1; o < 64; o <<= 1) v += __shfl_xor(v, o);
    return v;
}
__device__ __forceinline__ float sigmoidf_(float v) { return __builtin_amdgcn_rcpf(1.f + __expf(-v)); }
__device__ __forceinline__ float gelu_tanh(float v) { const float z = 0.7978845608028654f * (v + 0.044715f * v * v * v); const float t = 1.f - 2.f * __builtin_amdgcn_rcpf(1.f + __expf(2.f * z)); return 0.5f * v * (1.f + t); }
#define LDS_WAIT() asm volatile("s_waitcnt lgkmcnt(0)" ::: "memory")
#define LDS_BARRIER() do { asm volatile("s_waitcnt lgkmcnt(0)" ::: "memory"); __builtin_amdgcn_s_barrier(); asm volatile("" ::: "memory"); } while (0)

namespace pg8 {
#define PG8_LAS __attribute__((address_space(3)))
constexpr int BM = 256, BK = 64, HALF = 128, HTB = HALF * BK * 2, STAGE_BYTES = 8 * HTB, NXCD = 8, WGM = 4;
__host__ __device__ __forceinline__ int lds_byte(int r, int c) { const int st = (r >> 4) * 2 + (c >> 5), rr = r & 15, cc = c & 31, ob = rr * 64 + cc * 2; return st * 1024 + (ob ^ (((ob >> 9) & 1) << 5)); }
__host__ __device__ __forceinline__ void stage_rc(int b, int& R, int& C) { const int st = b / 1024, sb = b % 1024, swz = sb ^ (((sb >> 9) & 1) << 5); R = (st >> 1) * 16 + swz / 64; C = (st & 1) * 32 + (swz % 64) / 2; }

__host__ __device__ __forceinline__ int perm32(int rho) { const int n = rho >> 4, i = rho & 15; return 8 * (i >> 2) + 4 * n + (i & 3); }
struct Unit { int pm, pn, last; const char* A; const char* B; };

__device__ __forceinline__ void rect_map(int wg, int nM, int nN, int& pm, int& pn) {
    const int nwg = nM * nN; int wgid = wg; { const int q = nwg / NXCD, r = nwg % NXCD, xcd = wgid % NXCD, off = wgid / NXCD; wgid = (xcd < r ? xcd * (q + 1) : r * (q + 1) + (xcd - r) * q) + off; }
    const int nig = WGM * nN, gid = wgid / nig, fm = gid * WGM, gsz = (nM - fm) < WGM ? (nM - fm) : WGM;
    pm = fm + ((wgid % nig) % gsz); pn = (wgid % nig) / gsz;
}

template <class Epi, class Sched, bool GATHER = false>
__device__ __forceinline__ void gemm_phase(PG8_LAS unsigned char* lds, const int K, const Sched& S, const Epi& E) {
    const int tid = threadIdx.x, wid = __builtin_amdgcn_readfirstlane(tid >> 6), lane = tid & 63, wr = wid >> 2, wc = wid & 3, fr = lane & 15, fq = lane >> 4;
    const int nt = K / BK;
    unsigned voffA[2]; int stR[2], stC[2]; unsigned voffB[2];
#pragma unroll
    for (int i = 0; i < 2; ++i) { int R, C; stage_rc(tid * 16 + i * 8192, R, C); voffA[i] = (unsigned)(R * K + C) * 2u; stR[i] = R; stC[i] = C;
        const int Rb = Epi::PERM ? ((R & ~31) + perm32(R & 31)) : R; voffB[i] = (unsigned)(Rb * K + C) * 2u; }
    unsigned voffGc[2][2], voffGn[2][2];
#define PG8_GOFF(dst, u) do { _Pragma("unroll") for (int _h = 0; _h < 2; ++_h) _Pragma("unroll") for (int _i = 0; _i < 2; ++_i) \
        dst[_h][_i] = (unsigned)(S.row_tok[(u).pm * 256 + _h * 128 + stR[_i]] * K + stC[_i]) * 2u; } while (0)
    const size_t kstep = (size_t)(BK * 2);
    const size_t hstep = (size_t)HALF * K * 2;
    const unsigned ldsw = (unsigned)wid * 1024u;
    const int aoff = lds_byte(wr * 64 + fr, fq * 8), boff = lds_byte(wc * 32 + fr, fq * 8);
#define PG8_SA(b, h) (((b) * 2 + (h)) * HTB)
#define PG8_SB(b, h) ((4 + (b) * 2 + (h)) * HTB)
#define PG8_STAGE(bufoff, gbase, voff) do { _Pragma("unroll") for (int _i = 0; _i < 2; ++_i) \
        __builtin_amdgcn_global_load_lds((const unsigned*)((const char*)(gbase) + (voff)[_i]), (PG8_LAS unsigned*)(lds + (bufoff) + ldsw + _i * 8192), 16, 0, 0); } while (0)
#define PG8_STAGE_A(bufoff, kptr, half, isnext) do { if constexpr (GATHER) { if (isnext) PG8_STAGE(bufoff, kptr, voffGn[half]); else PG8_STAGE(bufoff, kptr, voffGc[half]); } \
        else PG8_STAGE(bufoff, (kptr) + (half) * hstep, voffA); } while (0)
#define PG8_LDA(dst, b, h) do { _Pragma("unroll") for (int m = 0; m < 4; ++m) _Pragma("unroll") for (int k = 0; k < 2; ++k) dst[m][k] = *(const PG8_LAS bf16x8*)(lds + PG8_SA(b, h) + aoff + m * 2048 + k * 1024); } while (0)
#define PG8_LDB(dst, b, h) do { _Pragma("unroll") for (int n = 0; n < 2; ++n) _Pragma("unroll") for (int k = 0; k < 2; ++k) dst[n][k] = *(const PG8_LAS bf16x8*)(lds + PG8_SB(b, h) + boff + n * 2048 + k * 1024); } while (0)
#define PG8_MMA(ai, bj, At, Bt) do { __builtin_amdgcn_s_setprio(1); _Pragma("unroll") for (int m = 0; m < 4; ++m) _Pragma("unroll") for (int n = 0; n < 2; ++n) _Pragma("unroll") for (int k = 0; k < 2; ++k) \
        acc[ai][bj][m][n] = __builtin_amdgcn_mfma_f32_16x16x32_bf16(Bt[n][k], At[m][k], acc[ai][bj][m][n], 0, 0, 0); __builtin_amdgcn_s_setprio(0); } while (0)
#define PG8_WAIT_V(n) asm volatile("s_waitcnt vmcnt(" #n ")" ::: "memory")
#define PG8_WAIT_L(n) asm volatile("s_waitcnt lgkmcnt(" #n ")" ::: "memory")
#define PG8_BAR __builtin_amdgcn_s_barrier()
#define PG8_SCHED __builtin_amdgcn_sched_barrier(0)
    Unit cur, nxt; int ui = 0;
    if (!S.next(0, cur)) return;
    f32x4 acc[2][2][4][2];
#pragma unroll
    for (int a = 0; a < 2; ++a)
#pragma unroll
        for (int b = 0; b < 2; ++b)
#pragma unroll
            for (int m = 0; m < 4; ++m)
#pragma unroll
                for (int n = 0; n < 2; ++n) acc[a][b][m][n] = (f32x4){0.f, 0.f, 0.f, 0.f};
    bf16x8 At[4][2], B0[2][2], B1[2][2];
    const char* cA = cur.A; const char* cB = cur.B;
    if constexpr (GATHER) { PG8_GOFF(voffGc, cur); }
    PG8_STAGE(PG8_SB(0, 0), cB, voffB); PG8_STAGE(PG8_SB(0, 1), cB + hstep, voffB); PG8_STAGE_A(PG8_SA(0, 0), cA, 0, false); PG8_STAGE_A(PG8_SA(0, 1), cA, 1, false);
    if (wr == 1) PG8_BAR;
    PG8_WAIT_V(2); PG8_BAR;
    PG8_STAGE(PG8_SB(1, 0), cB + kstep, voffB); PG8_STAGE_A(PG8_SA(1, 0), cA + kstep, 0, false); PG8_STAGE(PG8_SB(1, 1), cB + hstep + kstep, voffB);
    PG8_WAIT_V(6); PG8_BAR;
    for (;;) {
        const bool has_next = S.next(ui + 1, nxt);
        const char* nA = has_next ? nxt.A : cA; const char* nB = has_next ? nxt.B : cB;
        if constexpr (GATHER) { if (has_next) { PG8_GOFF(voffGn, nxt); } else { _Pragma("unroll") for (int _h = 0; _h < 2; ++_h) _Pragma("unroll") for (int _i = 0; _i < 2; ++_i) voffGn[_h][_i] = voffGc[_h][_i]; } }
        for (int t = 0; t < nt; t += 2) {
            const bool last = (t == nt - 2);
            const char* a1 = cA + (size_t)(t + 1) * kstep;
            const char* a2 = last ? nA : cA + (size_t)(t + 2) * kstep; const char* b2 = last ? nB : cB + (size_t)(t + 2) * kstep;
            const char* a3 = a2 + kstep; const char* b3 = b2 + kstep;
            PG8_LDB(B0, 0, 0); PG8_LDB(B1, 0, 1); PG8_SCHED; PG8_LDA(At, 0, 0); PG8_STAGE_A(PG8_SA(1, 1), a1, 1, false);
            PG8_WAIT_V(8); PG8_WAIT_L(0); PG8_BAR; PG8_MMA(0, 0, At, B0); PG8_MMA(0, 1, At, B1); PG8_BAR; PG8_SCHED;
            PG8_LDA(At, 0, 1); PG8_STAGE(PG8_SB(0, 0), b2, voffB); PG8_STAGE(PG8_SB(0, 1), b2 + hstep, voffB); PG8_STAGE_A(PG8_SA(0, 0), a2, 0, last);
            PG8_WAIT_V(8); PG8_WAIT_L(0); PG8_BAR; PG8_MMA(1, 0, At, B0); PG8_MMA(1, 1, At, B1); PG8_BAR; PG8_SCHED;
            PG8_LDB(B0, 1, 0); PG8_LDB(B1, 1, 1); PG8_SCHED; PG8_LDA(At, 1, 0); PG8_STAGE_A(PG8_SA(0, 1), a2, 1, last);
            PG8_WAIT_V(8); PG8_WAIT_L(0); PG8_BAR; PG8_MMA(0, 0, At, B0); PG8_MMA(0, 1, At, B1); PG8_BAR; PG8_SCHED;
            PG8_LDA(At, 1, 1); PG8_STAGE(PG8_SB(1, 0), b3, voffB); PG8_STAGE(PG8_SB(1, 1), b3 + hstep, voffB); PG8_STAGE_A(PG8_SA(1, 0), a3, 0, last);
            PG8_WAIT_V(8); PG8_WAIT_L(0); PG8_BAR; PG8_MMA(1, 0, At, B0); PG8_MMA(1, 1, At, B1); PG8_BAR; PG8_SCHED;
        }
        if (wr == 0) PG8_BAR;
        if (cur.last) E.fin(acc, cur, wr, wc, fr, fq); else E.mid(acc, cur, wr, wc, fr, fq);
        if (!has_next) break;
        if (cur.last) {
#pragma unroll
            for (int a = 0; a < 2; ++a)
#pragma unroll
                for (int b = 0; b < 2; ++b)
#pragma unroll
                    for (int m = 0; m < 4; ++m)
#pragma unroll
                        for (int n = 0; n < 2; ++n) acc[a][b][m][n] = (f32x4){0.f, 0.f, 0.f, 0.f};
        }
        cur = nxt; cA = nA; cB = nB; ++ui;
        if constexpr (GATHER) { _Pragma("unroll") for (int _h = 0; _h < 2; ++_h) _Pragma("unroll") for (int _i = 0; _i < 2; ++_i) voffGc[_h][_i] = voffGn[_h][_i]; }
        if (wr == 1) PG8_BAR;
    }
    PG8_WAIT_V(0);
    PG8_BAR;
#undef PG8_SA
#undef PG8_SB
#undef PG8_STAGE
#undef PG8_STAGE_A
#undef PG8_GOFF
#undef PG8_LDA
#undef PG8_LDB
#undef PG8_MMA
#undef PG8_WAIT_V
#undef PG8_WAIT_L
#undef PG8_BAR
#undef PG8_SCHED
}
}
using pg8::Unit;
typedef f32x4 AccT[2][2][4][2];

__device__ __forceinline__ void st_nt(u32x4* p, u32x4 v) { __builtin_nontemporal_store(v, p); }
__device__ __forceinline__ void st_nt(f32x4* p, f32x4 v) { __builtin_nontemporal_store(v, p); }
__device__ __forceinline__ u32x2 pack4(f32x4 v) { u32x2 w; w.x = pk2(v[0], v[1]); w.y = pk2(v[2], v[3]); return w; }

#define EPI_LOOP_ROWS _Pragma("unroll") for (int ai = 0; ai < 2; ++ai) _Pragma("unroll") for (int m = 0; m < 4; ++m)
#define EPI_LOOP_COLS _Pragma("unroll") for (int bj = 0; bj < 2; ++bj) _Pragma("unroll") for (int n = 0; n < 2; ++n)

__device__ __forceinline__ u32x4 pack8(f32x4 a, f32x4 b) { return (u32x4){pk2(a[0], a[1]), pk2(a[2], a[3]), pk2(b[0], b[1]), pk2(b[2], b[3])}; }
__device__ __forceinline__ void unpack8(u32x4 w, f32x4& a, f32x4& b) { a = (f32x4){bflo(w.x), bfhi(w.x), bflo(w.y), bfhi(w.y)}; b = (f32x4){bflo(w.z), bfhi(w.z), bflo(w.w), bfhi(w.w)}; }
#define EPI_LOOP_BJ _Pragma("unroll") for (int bj = 0; bj < 2; ++bj)
struct EpiInA {
    static constexpr bool PERM = true;
    bf16* prx; bf16* grg; bf16* gates;
    __device__ __forceinline__ void mid(AccT& acc, const Unit& u, int wr, int wc, int fr, int fq) const {}
    __device__ __forceinline__ void fin(AccT& acc, const Unit& u, int wr, int wc, int fr, int fq) const {
        const int row0 = u.pm * 256 + wr * 64 + fr, col0 = u.pn * 256 + wc * 32 + 8 * fq;
        EPI_LOOP_ROWS { const size_t r = (size_t)(row0 + ai * 128 + m * 16);
            EPI_LOOP_BJ { const int c = col0 + bj * 128; f32x4 v0 = acc[ai][bj][m][0], v1 = acc[ai][bj][m][1];
                if (u.pn < 4) { st_nt((u32x4*)(prx + r * 1024 + c), pack8(v0, v1)); }
                else if (u.pn < 8) { for (int i = 0; i < 4; ++i) { v0[i] = gelu_tanh(v0[i]); v1[i] = gelu_tanh(v1[i]); } st_nt((u32x4*)(grg + r * 1024 + (c - 1024)), pack8(v0, v1)); }
                else { for (int i = 0; i < 4; ++i) { v0[i] = sigmoidf_(v0[i]); v1[i] = sigmoidf_(v1[i]); } st_nt((u32x4*)(gates + r * 2048 + (c - 2048)), pack8(v0, v1)); } } }
    }
};
struct EpiInB {
    static constexpr bool PERM = true;
    bf16* phyT;
    __device__ __forceinline__ void mid(AccT& acc, const Unit& u, int wr, int wc, int fr, int fq) const {}
    __device__ __forceinline__ void fin(AccT& acc, const Unit& u, int wr, int wc, int fr, int fq) const {
        const int row0 = u.pm * 256 + wr * 64 + fr, col0 = u.pn * 256 + wc * 32 + 8 * fq;
        const int b = u.pn >> 5;
        EPI_LOOP_ROWS { const size_t j = (size_t)(row0 + ai * 128 + m * 16);
            EPI_LOOP_BJ { const int t = col0 + bj * 128 - b * SEQ;
                st_nt((u32x4*)(phyT + ((size_t)b * 3072 + j) * SEQ + t), pack8(acc[ai][bj][m][0], acc[ai][bj][m][1])); } }
    }
};
struct EpiMerge {
    static constexpr bool PERM = true;
    const bf16* gates; bf16* merged;
    __device__ __forceinline__ void mid(AccT& acc, const Unit& u, int wr, int wc, int fr, int fq) const {
        const int row0 = u.pm * 256 + wr * 64 + fr, col0 = u.pn * 256 + wc * 32 + 8 * fq;
        EPI_LOOP_ROWS { const size_t r = (size_t)(row0 + ai * 128 + m * 16);
            EPI_LOOP_BJ { const int c = col0 + bj * 128;
                f32x4 sa0, sa1, sb0, sb1; unpack8(*(const u32x4*)(gates + r * 2048 + c), sa0, sa1); unpack8(*(const u32x4*)(gates + r * 2048 + 1024 + c), sb0, sb1);
                for (int i = 0; i < 4; ++i) { acc[ai][bj][m][0][i] *= sa0[i] * __builtin_amdgcn_rcpf(fmaxf(sb0[i], 1e-30f)); acc[ai][bj][m][1][i] *= sa1[i] * __builtin_amdgcn_rcpf(fmaxf(sb1[i], 1e-30f)); } } }
    }
    __device__ __forceinline__ void fin(AccT& acc, const Unit& u, int wr, int wc, int fr, int fq) const {
        const int row0 = u.pm * 256 + wr * 64 + fr, col0 = u.pn * 256 + wc * 32 + 8 * fq;
        EPI_LOOP_ROWS { const size_t r = (size_t)(row0 + ai * 128 + m * 16);
            EPI_LOOP_BJ { const int c = col0 + bj * 128;
                f32x4 sb0, sb1; unpack8(*(const u32x4*)(gates + r * 2048 + 1024 + c), sb0, sb1);
                f32x4 v0 = acc[ai][bj][m][0], v1 = acc[ai][bj][m][1];
                for (int i = 0; i < 4; ++i) { v0[i] *= fmaxf(sb0[i], 1e-30f); v1[i] *= fmaxf(sb1[i], 1e-30f); }
                *(u32x4*)(merged + r * 1024 + c) = pack8(v0, v1); } }
    }
};
struct EpiOut {
    static constexpr bool PERM = true;
    const float* x; const float* mod; bf16* x1; float* ssq;
    __device__ __forceinline__ void mid(AccT& acc, const Unit& u, int wr, int wc, int fr, int fq) const {}
    __device__ __forceinline__ void fin(AccT& acc, const Unit& u, int wr, int wc, int fr, int fq) const {
        const int row0 = u.pm * 256 + wr * 64 + fr, col0 = u.pn * 256 + wc * 32 + 8 * fq;
        const float* g1 = mod + (u.pm >> 5) * 6144 + 2048;
        EPI_LOOP_ROWS { const size_t r = (size_t)(row0 + ai * 128 + m * 16); float s = 0.f;
            EPI_LOOP_BJ { const int c = col0 + bj * 128;
                const f32x4 xv0 = __builtin_nontemporal_load((const f32x4*)(x + r * 1024 + c)), xv1 = __builtin_nontemporal_load((const f32x4*)(x + r * 1024 + c + 4));
                const f32x4 gv0 = *(const f32x4*)(g1 + c), gv1 = *(const f32x4*)(g1 + c + 4);
                const f32x4 o0 = xv0 + gv0 * acc[ai][bj][m][0], o1 = xv1 + gv1 * acc[ai][bj][m][1];
                *(u32x4*)(x1 + r * 1024 + c) = pack8(o0, o1);
                s += ((o0[0] * o0[0] + o0[1] * o0[1]) + (o0[2] * o0[2] + o0[3] * o0[3])) + ((o1[0] * o1[0] + o1[1] * o1[1]) + (o1[2] * o1[2] + o1[3] * o1[3])); }
            s += __shfl_xor(s, 16); s += __shfl_xor(s, 32);
            if (fq == 0) ssq[r * 16 + u.pn * 4 + wc] = s; }
    }
};
struct EpiMoeUp {
    static constexpr bool PERM = true;
    bf16* H;
    __device__ __forceinline__ void mid(AccT& acc, const Unit& u, int wr, int wc, int fr, int fq) const {}
    __device__ __forceinline__ void fin(AccT& acc, const Unit& u, int wr, int wc, int fr, int fq) const {
        const int row0 = u.pm * 256 + wr * 64 + fr, col0 = u.pn * 128 + wc * 32 + 8 * fq;
        EPI_LOOP_ROWS { const size_t r = (size_t)(row0 + ai * 128 + m * 16); f32x4 h0, h1;
            for (int i = 0; i < 4; ++i) { const float a0 = acc[ai][0][m][0][i], a1 = acc[ai][0][m][1][i]; h0[i] = a0 * sigmoidf_(a0) * acc[ai][1][m][0][i]; h1[i] = a1 * sigmoidf_(a1) * acc[ai][1][m][1][i]; }
            *(u32x4*)(H + r * 512 + col0) = pack8(h0, h1); }
    }
};
struct EpiMoeDown {
    static constexpr bool PERM = true;
    bf16* Y;
    __device__ __forceinline__ void mid(AccT& acc, const Unit& u, int wr, int wc, int fr, int fq) const {}
    __device__ __forceinline__ void fin(AccT& acc, const Unit& u, int wr, int wc, int fr, int fq) const {
        const int row0 = u.pm * 256 + wr * 64 + fr, col0 = u.pn * 256 + wc * 32 + 8 * fq;
        EPI_LOOP_ROWS { const size_t r = (size_t)(row0 + ai * 128 + m * 16);
            EPI_LOOP_BJ { const int c = col0 + bj * 128; *(u32x4*)(Y + r * 1024 + c) = pack8(acc[ai][bj][m][0], acc[ai][bj][m][1]); } }
    }
};

constexpr size_t TSTEP1K = (size_t)256 * 1024 * 2;
struct SchedInA { const char* hx; const char* wt; int G, c;
    __device__ __forceinline__ bool next(int i, Unit& u) const {
        int Lx = (i >> (REPN(2) - 1)) * G + c, pm, pn;
        if (Lx < 2048) pg8::rect_map(Lx, 128, 16, pm, pn);
        else { Lx -= 2048; if (Lx >= 16) return false; pm = 128 + (Lx >> 2); pn = Lx & 3; }
        const int wrow = pn < 8 ? pn * 256 : 5120 + (pn - 8) * 256;
        u.pm = pm; u.pn = pn; u.last = 1; u.A = hx + (size_t)pm * TSTEP1K; u.B = wt + (size_t)wrow * 2048; return true; } };
struct SchedInB { const char* hx; const char* wt; int G, c;
    __device__ __forceinline__ bool next(int i, Unit& u) const {
        const int Lx = (i >> (REPN(21) - 1)) * G + c; if (Lx >= 12 * 128) return false; int pm, pn; pg8::rect_map(Lx, 12, 128, pm, pn);
        u.pm = pm; u.pn = pn; u.last = 1; u.A = wt + (size_t)(2048 + pm * 256) * 2048; u.B = hx + (size_t)pn * TSTEP1K; return true; } };
struct SchedMerge { const char* yrg; const char* yhy; const char* wrg; const char* why; int G, c;
    __device__ __forceinline__ bool next(int i, Unit& u) const {
        const int T = (i >> 1) * G + c, part = i & 1; if (T >= 512) return false; int pm, pn; pg8::rect_map(T, 128, 4, pm, pn);
        u.pm = pm; u.pn = pn; u.last = part; u.A = (part ? yhy : yrg) + (size_t)pm * TSTEP1K; u.B = (part ? why : wrg) + (size_t)pn * TSTEP1K; return true; } };
struct SchedOut { const char* a; const char* w; int G, c;
    __device__ __forceinline__ bool next(int i, Unit& u) const {
        const int T = (i >> (REPN(7) - 1)) * G + c; if (T >= 512) return false; int pm, pn; pg8::rect_map(T, 128, 4, pm, pn);
        u.pm = pm; u.pn = pn; u.last = 1; u.A = a + (size_t)pm * TSTEP1K; u.B = w + (size_t)pn * TSTEP1K; return true; } };
struct SchedMoeUp { const char* xg; const char* w13; const LAS int* blk_exp; const int* row_tok; int nblk, G, c;
    __device__ __forceinline__ bool next(int i, Unit& u) const {
        const int T = i * G + c; if (T >= nblk * 4) return false; const int pm = T >> 2, pn = T & 3, e = blk_exp[pm];
        u.pm = pm; u.pn = pn; u.last = 1; u.A = xg; u.B = w13 + (size_t)e * (1024 * 1024 * 2) + (size_t)pn * TSTEP1K; return true; } };
struct SchedMoeDown { const char* h; const char* w2; const LAS int* blk_exp; int nblk, G, c;
    __device__ __forceinline__ bool next(int i, Unit& u) const {
        const int T = i * G + c; if (T >= nblk * 4) return false; const int pm = T >> 2, pn = T & 3, e = blk_exp[pm];
        u.pm = pm; u.pn = pn; u.last = 1; u.A = h + (size_t)pm * (256 * 512 * 2); u.B = w2 + (size_t)e * (1024 * 512 * 2) + (size_t)pn * (256 * 512 * 2); return true; } };


typedef f32x2 cpx;
__device__ __forceinline__ int pidx(int i) { return i + (i >> 4); }
__device__ __forceinline__ cpx cmul(cpx a, cpx b) { return (cpx){a.x * b.x - a.y * b.y, a.x * b.y + a.y * b.x}; }
template <bool INV> __device__ __forceinline__ cpx mul_w4(cpx a) { return INV ? (cpx){-a.y, a.x} : (cpx){a.y, -a.x}; }
template <bool INV> __device__ __forceinline__ void dft4(cpx& a, cpx& b, cpx& c, cpx& d) {
    const cpx t0 = a + c, t1 = a - c, t2 = b + d, t3 = b - d; const cpx t3r = mul_w4<INV>(t3);
    a = t0 + t2; b = t1 + t3r; c = t0 - t2; d = t1 - t3r; }
template <bool INV> __device__ __forceinline__ cpx twc(cpx x, float cr, float ci) { return cmul(x, (cpx){cr, INV ? -ci : ci}); }
#define SLOT16(q) (4 * ((q) & 3) + ((q) >> 2))
template <bool INV> __device__ __forceinline__ void dft16(cpx (&x)[16]) {
    const float C1 = 0.9238795325112867f, S1 = 0.3826834323650898f, R = 0.7071067811865476f;
#pragma unroll
    for (int m2 = 0; m2 < 4; ++m2) dft4<INV>(x[m2], x[4 + m2], x[8 + m2], x[12 + m2]);
    x[5] = twc<INV>(x[5], C1, -S1); x[9] = twc<INV>(x[9], R, -R); x[6] = twc<INV>(x[6], R, -R);
    x[13] = twc<INV>(x[13], S1, -C1); x[7] = twc<INV>(x[7], S1, -C1); x[10] = mul_w4<INV>(x[10]);
    x[14] = twc<INV>(x[14], -R, -R); x[11] = twc<INV>(x[11], -R, -R); x[15] = twc<INV>(x[15], -C1, S1);
#pragma unroll
    for (int q1 = 0; q1 < 4; ++q1) dft4<INV>(x[4 * q1], x[4 * q1 + 1], x[4 * q1 + 2], x[4 * q1 + 3]);
}
template <int S_, int NIN> __device__ __forceinline__ void fft_fwd16(LAS cpx* X, const LAS cpx* TW, int tid) {
    constexpr int PS = S_ + S_ / 16;
#pragma unroll 1
    for (int it = 0; it < 2; ++it) {
        int bf = tid + 512 * it; asm volatile("" : "+v"(bf)); const int blk = bf / S_, j = bf % S_; const int base = pidx(blk * (16 * S_) + j);
        cpx x[16];
#pragma unroll
        for (int m = 0; m < 16; ++m) x[m] = (m < NIN) ? X[base + PS * m] : (cpx){0.f, 0.f};
        dft16<false>(x);
        const cpx w1 = TW[j]; cpx w = w1;
        X[base] = x[0];
#pragma unroll
        for (int q = 1; q < 16; ++q) { X[base + PS * q] = cmul(x[SLOT16(q)], w); w = cmul(w, w1); }
    }
}
template <int S_, int NOUT> __device__ __forceinline__ void fft_inv16(LAS cpx* X, const LAS cpx* TW, int tid) {
    constexpr int PS = S_ + S_ / 16;
#pragma unroll 1
    for (int it = 0; it < 2; ++it) {
        int bf = tid + 512 * it; asm volatile("" : "+v"(bf)); const int blk = bf / S_, j = bf % S_; const int base = pidx(blk * (16 * S_) + j);
        cpx w1 = TW[j]; w1.y = -w1.y; cpx w = w1;
        cpx x[16]; x[0] = X[base];
#pragma unroll
        for (int q = 1; q < 16; ++q) { x[q] = cmul(X[base + PS * q], w); w = cmul(w, w1); }
        dft16<true>(x);
#pragma unroll
        for (int m = 0; m < NOUT; ++m) X[base + PS * m] = x[SLOT16(m)];
    }
}
template <bool INV> __device__ __forceinline__ void fft_r4(LAS cpx* X, const LAS cpx* TW, int tid) {
#pragma unroll 2
    for (int it = 0; it < 8; ++it) {
        int bf = tid + 512 * it; asm volatile("" : "+v"(bf)); const int blk = bf >> 4, j = bf & 15; const int base = 68 * blk + j;
        cpx w1 = TW[j]; if (INV) w1.y = -w1.y; const cpx w2 = cmul(w1, w1), w3 = cmul(w2, w1);
        cpx a = X[base], b = X[base + 17], c = X[base + 34], d = X[base + 51];
        if (INV) { b = cmul(b, w1); c = cmul(c, w2); d = cmul(d, w3); }
        dft4<INV>(a, b, c, d);
        if (!INV) { b = cmul(b, w1); c = cmul(c, w2); d = cmul(d, w3); }
        X[base] = a; X[base + 17] = b; X[base + 34] = c; X[base + 51] = d;
    }
}

template <bool INV, bool OZERO> __device__ __forceinline__ void dft32(cpx (&e)[16], cpx (&o)[16]) {
    const float C[16] = {1.f, 0.9807852804032304f, 0.9238795325112867f, 0.8314696123025452f, 0.7071067811865476f, 0.5555702330196022f, 0.3826834323650898f, 0.1950903220161283f,
                         0.f, -0.1950903220161283f, -0.3826834323650898f, -0.5555702330196022f, -0.7071067811865476f, -0.8314696123025452f, -0.9238795325112867f, -0.9807852804032304f};
    const float S[16] = {0.f, 0.1950903220161283f, 0.3826834323650898f, 0.5555702330196022f, 0.7071067811865476f, 0.8314696123025452f, 0.9238795325112867f, 0.9807852804032304f,
                         1.f, 0.9807852804032304f, 0.9238795325112867f, 0.8314696123025452f, 0.7071067811865476f, 0.5555702330196022f, 0.3826834323650898f, 0.1950903220161283f};
#pragma unroll
    for (int m = 0; m < 16; ++m) { const cpx a = e[m]; cpx d;
        if (OZERO) d = a; else { const cpx b = o[m]; e[m] = a + b; d = a - b; }
        o[m] = (m == 0) ? d : (m == 8) ? mul_w4<INV>(d) : twc<INV>(d, C[m], -S[m]); }
    dft16<INV>(e); dft16<INV>(o);
}
template <int NIN> __device__ __forceinline__ void fft_fwd32A(LAS cpx* X, const LAS cpx* TW, int tid) {
    int j = tid; asm volatile("" : "+v"(j)); const int base = pidx(j); constexpr int PS = 544;
    cpx e[16], o[16];
#pragma unroll
    for (int m = 0; m < 16; ++m) { e[m] = X[base + PS * m]; o[m] = (NIN == 32) ? X[base + PS * (m + 16)] : (cpx){0.f, 0.f}; }
    dft32<false, NIN == 16>(e, o);
    const cpx w1 = TW[j], w2 = cmul(w1, w1); cpx te = w2, to = w1;
    X[base] = e[0]; X[base + PS] = cmul(o[0], to); to = cmul(to, w2);
#pragma unroll
    for (int q = 1; q < 16; ++q) { X[base + PS * (2 * q)] = cmul(e[SLOT16(q)], te); X[base + PS * (2 * q + 1)] = cmul(o[SLOT16(q)], to); te = cmul(te, w2); to = cmul(to, w2); }
}
__device__ __forceinline__ void fft_fwd32A_filter(LAS cpx* X, const LAS cpx* TW, const float* kfw, const float* kbw, int tid) {
    int j = tid; asm volatile("" : "+v"(j)); const int base = pidx(j); constexpr int PS = 544;
    cpx e[16], o[16];
#pragma unroll
    for (int m = 0; m < 16; ++m) e[m] = (cpx){kfw[j + 512 * m], 0.f};
#pragma unroll
    for (int m = 0; m < 16; ++m) { const int i = j + 512 * m; o[m] = (cpx){(i == 0) ? 0.f : kbw[SEQ - i], 0.f}; }
    dft32<false, false>(e, o);
    const cpx w1 = TW[j], w2 = cmul(w1, w1); cpx te = w2, to = w1;
    X[base] = e[0]; X[base + PS] = cmul(o[0], to); to = cmul(to, w2);
#pragma unroll
    for (int q = 1; q < 16; ++q) { X[base + PS * (2 * q)] = cmul(e[SLOT16(q)], te); X[base + PS * (2 * q + 1)] = cmul(o[SLOT16(q)], to); te = cmul(te, w2); to = cmul(to, w2); }
}
__device__ __forceinline__ void fft_fwd32B(LAS cpx* X, const LAS cpx* TW, int tid) {
    int t = tid; asm volatile("" : "+v"(t)); const int blk = t >> 4, j = t & 15; const int base = 544 * blk + j; constexpr int PS = 17;
    cpx e[16], o[16];
#pragma unroll
    for (int m = 0; m < 16; ++m) { e[m] = X[base + PS * m]; o[m] = X[base + PS * (m + 16)]; }
    dft32<false, false>(e, o);
    const cpx w1 = TW[j], w2 = cmul(w1, w1); cpx te = w2, to = w1;
    X[base] = e[0]; X[base + PS] = cmul(o[0], to); to = cmul(to, w2);
#pragma unroll
    for (int q = 1; q < 16; ++q) { X[base + PS * (2 * q)] = cmul(e[SLOT16(q)], te); X[base + PS * (2 * q + 1)] = cmul(o[SLOT16(q)], to); te = cmul(te, w2); to = cmul(to, w2); }
}
template <int PS, int NOUT> __device__ __forceinline__ void fft_inv32_core(LAS cpx* X, int base, cpx w1c) {
    const cpx w2 = cmul(w1c, w1c); cpx te = w2, to = w1c;
    cpx e[16], o[16];
    cpx zin[32];
    zin[0] = X[base]; zin[1] = cmul(X[base + PS], to); to = cmul(to, w2);
#pragma unroll
    for (int q = 1; q < 16; ++q) { zin[2 * q] = cmul(X[base + PS * (2 * q)], te); zin[2 * q + 1] = cmul(X[base + PS * (2 * q + 1)], to); te = cmul(te, w2); to = cmul(to, w2); }
#pragma unroll
    for (int m = 0; m < 16; ++m) { e[m] = zin[m]; o[m] = zin[m + 16]; }
    dft32<true, false>(e, o);
#pragma unroll
    for (int m = 0; m < NOUT; ++m) X[base + PS * m] = (m & 1) ? o[SLOT16(m >> 1)] : e[SLOT16(m >> 1)];
}
__device__ __forceinline__ void fft_inv32A_final(const LAS cpx* X, const LAS cpx* TW, int tid, const unsigned* sx, bf16* rowA, bf16* rowB, bool dostore) {
    int j = tid; asm volatile("" : "+v"(j)); cpx w1 = TW[j]; w1.y = -w1.y; const int base = pidx(j); constexpr int PS = 544;
    unsigned sa[16], sb[16];
#pragma unroll
    for (int m = 0; m < 16; ++m) { sa[m] = __hip_atomic_load(sx + j + 512 * m, __ATOMIC_RELAXED, __HIP_MEMORY_SCOPE_AGENT); sb[m] = __hip_atomic_load(sx + SEQ + j + 512 * m, __ATOMIC_RELAXED, __HIP_MEMORY_SCOPE_AGENT); }
    const cpx w2 = cmul(w1, w1); cpx te = w2, to = w1;
    cpx e[16], o[16]; cpx zin[32];
    zin[0] = X[base]; zin[1] = cmul(X[base + PS], to); to = cmul(to, w2);
#pragma unroll
    for (int q = 1; q < 16; ++q) { zin[2 * q] = cmul(X[base + PS * (2 * q)], te); zin[2 * q + 1] = cmul(X[base + PS * (2 * q + 1)], to); te = cmul(te, w2); to = cmul(to, w2); }
#pragma unroll
    for (int m = 0; m < 16; ++m) { e[m] = zin[m]; o[m] = zin[m + 16]; }
    dft32<true, false>(e, o);
    if (dostore) {
#pragma unroll
        for (int m = 0; m < 16; ++m) { const cpx y = (m & 1) ? o[SLOT16(m >> 1)] : e[SLOT16(m >> 1)]; const int t = j + 512 * m;
            const float oa = y.x * bflo(sa[m]) + bfhi(sa[m]), ob = y.y * bflo(sb[m]) + bfhi(sb[m]);
            rowA[t] = (bf16)(pk2(oa, 0.f) & 0xffffu); rowB[t] = (bf16)(pk2(ob, 0.f) & 0xffffu); }
    }
}
__device__ __forceinline__ void fft_inv32B(LAS cpx* X, const LAS cpx* TW, int tid) {
    int t = tid; asm volatile("" : "+v"(t)); const int blk = t >> 4, j = t & 15; cpx w1 = TW[j]; w1.y = -w1.y;
    fft_inv32_core<17, 32>(X, 544 * blk + j, w1);
}
template <int NOUT> __device__ __forceinline__ void fft_inv32A(LAS cpx* X, const LAS cpx* TW, int tid) {
    int j = tid; asm volatile("" : "+v"(j)); cpx w1 = TW[j]; w1.y = -w1.y;
    fft_inv32_core<544, NOUT>(X, pidx(j), w1);
}
__device__ __forceinline__ void fft_fwdD_toK(const LAS cpx* X, cpx* Kb, int tid) {
#pragma unroll 1
    for (int it = 0; it < 2; ++it) {
        int bf = tid + 512 * it; asm volatile("" : "+v"(bf)); const int base = 17 * bf;
        cpx x[16];
#pragma unroll
        for (int m = 0; m < 16; ++m) x[m] = X[base + m];
        dft16<false>(x);
#pragma unroll
        for (int q = 0; q < 16; ++q) Kb[q * 1024 + bf] = x[SLOT16(q)] * (1.f / 16384.f);
    }
}
__device__ __forceinline__ void fft_kload1(cpx (&kq)[16], const cpx* Kb, int bf) {
#pragma unroll
    for (int q = 0; q < 16; ++q) { const unsigned long long kb = __hip_atomic_load((const unsigned long long*)(Kb + q * 1024 + bf), __ATOMIC_RELAXED, __HIP_MEMORY_SCOPE_AGENT);
        kq[q] = (cpx){__builtin_bit_cast(float, (unsigned)kb), __builtin_bit_cast(float, (unsigned)(kb >> 32))}; }
}
__device__ __forceinline__ void fft_fusedD_one(LAS cpx* X, const cpx (&kq)[16], int bf) {
    const int base = 17 * bf; cpx x[16], z[16];
#pragma unroll
    for (int m = 0; m < 16; ++m) x[m] = X[base + m];
    dft16<false>(x);
#pragma unroll
    for (int q = 0; q < 16; ++q) z[q] = cmul(x[SLOT16(q)], kq[q]);
    dft16<true>(z);
#pragma unroll
    for (int m = 0; m < 16; ++m) X[base + m] = z[SLOT16(m)];
}
__device__ __forceinline__ void fft_fusedD(LAS cpx* X, const cpx* Kb, int tid) {
    int bf = tid; asm volatile("" : "+v"(bf));
    cpx k0[16], k1[16];
    fft_kload1(k0, Kb, bf); fft_kload1(k1, Kb, bf + 512);
    fft_fusedD_one(X, k0, bf);
    fft_fusedD_one(X, k1, bf + 512);
}
struct Raw10 { u32x4 q; unsigned short l, r; };
__device__ __forceinline__ void load10_issue(Raw10& R, const bf16* row, int t0) {
    const int lane = threadIdx.x & 63; R.q = *(const u32x4*)(row + t0); R.l = 0; R.r = 0;
    if (lane == 0 && t0 > 0) R.l = row[t0 - 1];
    if (lane == 63 && t0 + 8 < SEQ) R.r = row[t0 + 8];
}
__device__ __forceinline__ void load10_finish(const Raw10& R, float (&pv)[10]) {
    const int lane = threadIdx.x & 63; const u32x4 q = R.q;
    pv[1] = bflo(q.x); pv[2] = bfhi(q.x); pv[3] = bflo(q.y); pv[4] = bfhi(q.y); pv[5] = bflo(q.z); pv[6] = bfhi(q.z); pv[7] = bflo(q.w); pv[8] = bfhi(q.w);
    float l = __shfl_up(pv[8], 1), r = __shfl_down(pv[1], 1);
    if (lane == 0) l = bf2f(R.l);
    if (lane == 63) r = bf2f(R.r);
    pv[0] = l; pv[9] = r;
}

struct ScanW { const bf16* prx; const bf16* grg; bf16* yrg; const float* rgcw; const float* rgcb; const bf16* wgt;
               const float* ba_f; const float* bx_f; const float* lam_f; const float* ba_b; const float* bx_b; const float* lam_b; f32x2* carr; const float* cin; };
__device__ __forceinline__ float neg_expm1_neg(float x) {
    return (x > -0.1f) ? -x * (1.f + x * 0.5f * (1.f + x * (1.f / 3.f) * (1.f + x * 0.25f * (1.f + x * 0.2f)))) : 1.f - __expf(x);
}
struct ScanPre { u32x4 p[4]; u32x4 gl; float cinv; };
template <int PASS>
__device__ __forceinline__ void scan_decode(int it, int& b, int& j, int& h) {
    h = it & 15; const int rest = it >> 4;
    if (PASS == 1) { j = rest % NCHUNK; b = rest / NCHUNK; } else { j = (rest & 127) + 4; b = rest >> 7; }
}
template <int PASS>
__device__ __forceinline__ void scan_prefetch(ScanPre& R, const ScanW& W, int it, int tid, int cidx_lane) {
    int b, j, h; scan_decode<PASS>(it, b, j, h);
    const int isctx = j < 4; const int seglen = isctx ? CTXL : SEQ; const int t0 = isctx ? j * 64 : (j - 4) * 64; const int rowbase = isctx ? NTOK + b * CTXL : b * SEQ;
    const int tok = tid >> 3, cg0 = h * 64 + (tid & 7) * 8;
#pragma unroll
    for (int jj = 0; jj < 4; ++jj) { const int tt = t0 + tok + jj - 2; R.p[jj] = (u32x4){0u, 0u, 0u, 0u};
        if (tt >= 0 && tt < seglen) R.p[jj] = *(const u32x4*)(W.prx + (size_t)(rowbase + tt) * 1024 + cg0); }
    R.cinv = 0.f;
    if (PASS == 2) { R.gl = *(const u32x4*)(W.grg + (size_t)(rowbase + t0 + tok) * 1024 + cg0); R.cinv = W.cin[(size_t)(b * NCHUNK + j) * 2048 + h * 64 + cidx_lane]; }
}
template <int PASS>
__device__ __forceinline__ void scan_phase(LAS unsigned char* lds, const ScanW& W, int first, int stride, int nitems, int tid, int lane, int wave) {
    LAS float* XCF = (LAS float*)lds;
    LAS bf16* XCB = (LAS bf16*)(lds + 16896);
    LAS float* HX = (LAS float*)(lds + 16896 + 9216);
    if (first >= nitems) return;
    const int dir = wave >> 2, eb = wave & 3, g = lane >> 4, li = lane & 15;
    const int tok = tid >> 3, e0 = (tid & 7) * 8;
    int hcur = -1;
    float cw[4][8], cb[8]; bf16x8 bR[2], bI[2]; float ba = 0.f, bx = 0.f, sp8 = 0.f, sp8l = 0.f, nba = 0.f, nbx = 0.f;
    const int cidx_lane = dir * 1024 + eb * 16 + li;
    ScanPre R; scan_prefetch<PASS>(R, W, first, tid, cidx_lane);
    u32x4 o_prev = {0u, 0u, 0u, 0u}; bf16* p_prev = nullptr; f32x2 c_prev = {0.f, 0.f}; f32x2* cp_prev = nullptr;
#pragma unroll 1
    for (int it = first; it < nitems; it += stride) {
        int b, j, h; scan_decode<PASS>(it, b, j, h);
        const int isctx = j < 4; const int t0 = isctx ? j * 64 : (j - 4) * 64; const int rowbase = isctx ? NTOK + b * CTXL : b * SEQ;
        const int ch = h * 64 + eb * 16 + li;
        const size_t cidx = ((size_t)(b * NCHUNK + j) * 2 + dir) * 1024 + ch;
        const float cinv = R.cinv;
        if (h != hcur) {
            hcur = h; const int cg0 = h * 64 + e0;
#pragma unroll
            for (int jj = 0; jj < 4; ++jj) { const f32x4 w0 = *(const f32x4*)(W.rgcw + jj * 1024 + cg0), w1 = *(const f32x4*)(W.rgcw + jj * 1024 + cg0 + 4);
                cw[jj][0] = w0[0]; cw[jj][1] = w0[1]; cw[jj][2] = w0[2]; cw[jj][3] = w0[3]; cw[jj][4] = w1[0]; cw[jj][5] = w1[1]; cw[jj][6] = w1[2]; cw[jj][7] = w1[3]; }
            { const f32x4 c0 = *(const f32x4*)(W.rgcb + cg0), c1 = *(const f32x4*)(W.rgcb + cg0 + 4); cb[0] = c0[0]; cb[1] = c0[1]; cb[2] = c0[2]; cb[3] = c0[3]; cb[4] = c1[0]; cb[5] = c1[1]; cb[6] = c1[2]; cb[7] = c1[3]; }
            const bf16* wp = W.wgt + ((size_t)((dir * 2) * 16 + h) * 64 + eb * 16 + li) * 64 + g * 8;
            bR[0] = *(const bf16x8*)(wp); bR[1] = *(const bf16x8*)(wp + 32); bI[0] = *(const bf16x8*)(wp + 16 * 4096); bI[1] = *(const bf16x8*)(wp + 16 * 4096 + 32);
            ba = (dir ? W.ba_b : W.ba_f)[ch]; bx = (dir ? W.bx_b : W.bx_f)[ch]; const float lam = (dir ? W.lam_b : W.lam_f)[ch];
            sp8 = -8.f * log1pf(__expf(-lam)); sp8l = sp8 * 1.4426950408889634f; nba = -ba * 1.4426950408889634f; nbx = -bx * 1.4426950408889634f;
        }
        {
            float xv[8];
#pragma unroll
            for (int q = 0; q < 8; ++q) xv[q] = cb[q];
#pragma unroll
            for (int jj = 0; jj < 4; ++jj) { const u32x4 p = R.p[jj];
                xv[0] += cw[jj][0] * bflo(p.x); xv[1] += cw[jj][1] * bfhi(p.x); xv[2] += cw[jj][2] * bflo(p.y); xv[3] += cw[jj][3] * bfhi(p.y);
                xv[4] += cw[jj][4] * bflo(p.z); xv[5] += cw[jj][5] * bfhi(p.z); xv[6] += cw[jj][6] * bflo(p.w); xv[7] += cw[jj][7] * bfhi(p.w); }
#pragma unroll
            for (int q = 0; q < 8; ++q) XCF[tok * 65 + e0 + q] = xv[q];
            *(LAS u32x4*)(XCB + tok * 72 + e0) = (u32x4){pk2(xv[0], xv[1]), pk2(xv[2], xv[3]), pk2(xv[4], xv[5]), pk2(xv[6], xv[7])};
        }
        const u32x4 gl = R.gl;
        if (it + stride < nitems) scan_prefetch<PASS>(R, W, it + stride, tid, cidx_lane);
        if (PASS == 2) { if (p_prev) *(u32x4*)p_prev = o_prev; } else { if (cp_prev) *cp_prev = c_prev; }
        LDS_BARRIER();
        f32x4 aR[4], aI[4];
#pragma unroll
        for (int mb = 0; mb < 4; ++mb) { aR[mb] = (f32x4){0.f, 0.f, 0.f, 0.f}; aI[mb] = (f32x4){0.f, 0.f, 0.f, 0.f};
            const int trow = 16 * (li >> 2) + 4 * mb + (li & 3);
#pragma unroll
            for (int ks = 0; ks < 2; ++ks) { const bf16x8 af = *(const LAS bf16x8*)(XCB + trow * 72 + ks * 32 + g * 8);
                aR[mb] = __builtin_amdgcn_mfma_f32_16x16x32_bf16(af, bR[ks], aR[mb], 0, 0, 0); aI[mb] = __builtin_amdgcn_mfma_f32_16x16x32_bf16(af, bI[ks], aI[mb], 0, 0, 0); } }
        float av[16], bv[16];
#pragma unroll
        for (int mb = 0; mb < 4; ++mb)
#pragma unroll
            for (int r = 0; r < 4; ++r) { const int tk = 16 * g + 4 * mb + r; const float xcv = XCF[tk * 65 + eb * 16 + li];
                const float rr = __builtin_amdgcn_rcpf(1.f + __builtin_amdgcn_exp2f(__builtin_fmaf(aR[mb][r], -1.4426950408889634f, nba)));
                const float ii = __builtin_amdgcn_rcpf(1.f + __builtin_amdgcn_exp2f(__builtin_fmaf(aI[mb][r], -1.4426950408889634f, nbx)));
                const float a = __builtin_amdgcn_exp2f(sp8l * rr); const float om = (1.f - a) * (1.f + a);
                av[4 * mb + r] = a; bv[4 * mb + r] = __builtin_amdgcn_sqrtf(om) * ii * xcv; }
        float A16 = 1.f, B16 = 0.f;
        if (dir == 0) {
#pragma unroll
            for (int q = 0; q < 16; ++q) { B16 = av[q] * B16 + bv[q]; A16 *= av[q]; }
        } else {
#pragma unroll
            for (int q = 15; q >= 0; --q) { B16 = av[q] * B16 + bv[q]; A16 *= av[q]; }
        }
        float Pc = 1.f, Hc = cinv, hin;
        {
            LAS float* chn = (LAS float*)(lds + 60928) + wave * 128 + li * 8;
            *(LAS f32x2*)(chn + g * 2) = (f32x2){A16, B16};
            LDS_WAIT(); asm volatile("" ::: "memory");
            const f32x4 c01 = *(const LAS f32x4*)(chn), c23 = *(const LAS f32x4*)(chn + 4);
            LDS_WAIT(); asm volatile("" ::: "memory");
            const float Ag[4] = {c01[0], c01[2], c23[0], c23[2]}, Bg[4] = {c01[1], c01[3], c23[1], c23[3]};
            hin = Hc;
#pragma unroll
            for (int k = 0; k < 4; ++k) { const int gk = (dir == 0) ? k : 3 - k;
                const bool before = (dir == 0) ? (gk < g) : (gk > g);
                const float Hn = Ag[gk] * Hc + Bg[gk]; Pc *= Ag[gk]; Hc = Hn; if (before) hin = Hn; }
        }
        if (PASS == 1) {
            cp_prev = (g == 0) ? (W.carr + cidx) : nullptr; c_prev = (f32x2){Pc, Hc};
            LDS_BARRIER();
        } else {
            LAS float* hx = HX + dir * (64 * 68) + (16 * g) * 68 + eb * 16 + li; float H = hin;
            if (dir == 0) {
#pragma unroll
                for (int q = 0; q < 16; ++q) { H = av[q] * H + bv[q]; hx[q * 68] = H; }
            } else {
#pragma unroll
                for (int q = 15; q >= 0; --q) { H = av[q] * H + bv[q]; hx[q * 68] = H; }
            }
            LDS_BARRIER();
            const f32x4 f0 = *(const LAS f32x4*)(HX + tok * 68 + e0), f1 = *(const LAS f32x4*)(HX + tok * 68 + e0 + 4);
            const f32x4 g0 = *(const LAS f32x4*)(HX + 64 * 68 + tok * 68 + e0), g1 = *(const LAS f32x4*)(HX + 64 * 68 + tok * 68 + e0 + 4);
            u32x4 o; o.x = pk2((f0[0] + g0[0]) * bflo(gl.x), (f0[1] + g0[1]) * bfhi(gl.x)); o.y = pk2((f0[2] + g0[2]) * bflo(gl.y), (f0[3] + g0[3]) * bfhi(gl.y));
            o.z = pk2((f1[0] + g1[0]) * bflo(gl.z), (f1[1] + g1[1]) * bfhi(gl.z)); o.w = pk2((f1[2] + g1[2]) * bflo(gl.w), (f1[3] + g1[3]) * bfhi(gl.w));
            o_prev = o; p_prev = W.yrg + (size_t)(rowbase + t0 + tok) * 1024 + h * 64 + e0;
        }
    }
    if (PASS == 2) { if (p_prev) *(u32x4*)p_prev = o_prev; } else { if (cp_prev) *cp_prev = c_prev; }
}

#define XB_TMO      128
#define XB_XCNT(j)  (256  + 64 * (j))
#define XB_XSUB(j)  (1280 + 64 * (j))
#define XB_XGEN(j)  (2304 + 64 * (j))
#define XB_TOP      3328
#define XB_TOPGEN   3392
#define XCD_BAR_WORDS 3456
#define XB_SPIN_CAP (1u << 18)
__device__ __forceinline__ unsigned xb_ld(unsigned* p)              { return __hip_atomic_load(p, __ATOMIC_RELAXED, __HIP_MEMORY_SCOPE_AGENT); }
__device__ __forceinline__ unsigned xb_add(unsigned* p, unsigned v) { return __hip_atomic_fetch_add(p, v, __ATOMIC_RELAXED, __HIP_MEMORY_SCOPE_AGENT); }
__device__ __forceinline__ unsigned xb_xcc_id() { return (unsigned)__builtin_amdgcn_s_getreg((3 << 11) | 20) & 0xFu; }
#define XB_SPIN(cond, bar) do { unsigned _sp = 0; while (cond) { __builtin_amdgcn_s_sleep(1); \
    if ((++_sp & 255u) == 0u) { if (xb_ld(&(bar)[XB_TMO])) break; if (_sp > XB_SPIN_CAP) { atomicAdd(&(bar)[XB_TMO], 1u); break; } } } } while (0)
struct XcdBarrier { unsigned* bar; unsigned x; volatile LAS unsigned* st; };
__device__ __forceinline__ void xcd_barrier_complete(unsigned* bar, unsigned x, unsigned& nloc, unsigned& nx) {
    const unsigned Gn = gridDim.x * gridDim.y * gridDim.z;
    unsigned sum, cntx, mine, sp = 0u;
    for (;;) {
        sum = 0u; cntx = 0u; mine = 0u;
#pragma unroll
        for (unsigned j = 0; j < 16; ++j) { const unsigned c = xb_ld(&bar[XB_XCNT(j)]); sum += c; cntx += (c > 0u) ? 1u : 0u; mine = (j == x) ? c : mine; }
        if (sum == Gn) break;
        __builtin_amdgcn_s_sleep(1);
        if ((++sp & 255u) == 0u) { if (xb_ld(&bar[XB_TMO])) break; if (sp > XB_SPIN_CAP) { atomicAdd(&bar[XB_TMO], 1u); break; } }
    }
    nloc = mine > 0u ? mine : 1u; nx = cntx > 0u ? cntx : 1u;
}
__device__ __forceinline__ void xcd_barrier(const XcdBarrier& b) {
    asm volatile("s_waitcnt vmcnt(0)" ::: "memory");
    __syncthreads();
    if (threadIdx.x == 0) {
        unsigned* bar = b.bar;
        __builtin_amdgcn_s_waitcnt(0);
        unsigned nloc = b.st[0], nx = b.st[1];
        if (nloc == 0u) { xcd_barrier_complete(bar, b.x, nloc, nx); b.st[0] = nloc; b.st[1] = nx; }
        const unsigned old = xb_add(&bar[XB_XSUB(b.x)], 1u);
        const unsigned gen = old / nloc;
        if (old + 1u == (gen + 1u) * nloc) {
            __builtin_amdgcn_fence(__ATOMIC_RELEASE, "agent");
            asm volatile("s_waitcnt vmcnt(0)" ::: "memory");
            const unsigned og = xb_add(&bar[XB_TOP], 1u);
            const unsigned tg = og / nx;
            if (og + 1u == (tg + 1u) * nx) xb_add(&bar[XB_TOPGEN], 1u);
            else XB_SPIN(xb_ld(&bar[XB_TOPGEN]) == tg, bar);
            __builtin_amdgcn_fence(__ATOMIC_ACQUIRE, "agent");
            xb_add(&bar[XB_XGEN(b.x)], 1u);
            asm volatile("s_waitcnt vmcnt(0)" ::: "memory");
        } else {
            XB_SPIN(xb_ld(&bar[XB_XGEN(b.x)]) == gen, bar);
            __builtin_amdgcn_fence(__ATOMIC_ACQUIRE, "agent");
            asm volatile("s_waitcnt vmcnt(0)" ::: "memory");
        }
    }
    __syncthreads();
}

__device__ __forceinline__ void transpose_item(const float* W, int K, int N, bf16* WT, int mode, LAS float* scr, int item, int lane) {
    const int nblk = N / 64, kb = item / nblk, nb = item % nblk, k0 = 64 * kb, n0 = 64 * nb;
    const int lr = lane >> 4, lc = (lane & 15) * 4;
    f32x4 v[16];
#pragma unroll
    for (int i = 0; i < 16; ++i) v[i] = __builtin_nontemporal_load((const f32x4*)(W + (size_t)(k0 + 4 * i + lr) * N + n0 + lc));
#pragma unroll
    for (int i = 0; i < 16; ++i) { LAS float* d = scr + (4 * i + lr) * 65 + lc; d[0] = v[i][0]; d[1] = v[i][1]; d[2] = v[i][2]; d[3] = v[i][3]; }
    LDS_WAIT(); asm volatile("" ::: "memory");
    const int c = lane & 7;
#pragma unroll
    for (int j = 0; j < 8; ++j) { const int n = (lane >> 3) + 8 * j; const LAS float* sp = scr + (8 * c) * 65 + n;
        u32x4 o; o.x = pk2(sp[0 * 65], sp[1 * 65]); o.y = pk2(sp[2 * 65], sp[3 * 65]); o.z = pk2(sp[4 * 65], sp[5 * 65]); o.w = pk2(sp[6 * 65], sp[7 * 65]);
        const int nn = n0 + n; int row;
        if (mode == 0) row = nn;
        else if (mode == 1) row = (nn >> 7) * 256 + (nn & 127);
        else row = (nn >> 7) * 256 + 128 + (nn & 127);
        *(u32x4*)(WT + (size_t)row * K + k0 + 8 * c) = o; }
    LDS_WAIT(); asm volatile("" ::: "memory");
}

struct Args { const float* in[41]; float* out; unsigned char* ws; int ph_lo, ph_hi; };

enum { I_X = 0, I_C, I_CTX, I_CCTX, I_ADAW, I_ADAB, I_N1G, I_N2G, I_FG, I_WIN, I_RGCW, I_RGCB, I_WAF, I_BAF, I_WXF, I_BXF, I_LAMF, I_WAB, I_BAB, I_WXB, I_BXB, I_LAMB,
       I_RGPROJ, I_HYCW, I_HYCB, I_PW1, I_PB1, I_PW2, I_PB2, I_FREQ, I_PW3, I_SKIP, I_HYPROJ, I_WOUT, I_WG, I_BG, I_WE, I_BE, I_MW1, I_MW3, I_MW2 };

constexpr int NPHASE = 13;

__global__ void __launch_bounds__(NTHREADS, 2) fwd_kernel(Args args) {
    extern __shared__ __attribute__((aligned(16))) unsigned char lds_raw[];
    LAS unsigned char* lds = (LAS unsigned char*)lds_raw;
    const int tid = threadIdx.x, lane = tid & 63, wave = __builtin_amdgcn_readfirstlane(tid >> 6);
    const int G = gridDim.x, bid = blockIdx.x;
    const int gw = bid * NWAVES + wave, NGW = G * NWAVES;
    unsigned char* ws = args.ws;
    const int lo = args.ph_lo, hi = args.ph_hi;
#define IN(k) (lo <= (k) && (k) < hi)
#if ONE_LAUNCH
    cg::grid_group grid = cg::this_grid();
#define GRID_SYNC(k) do { if (IN(k) && IN((k) + 1)) { xcd_barrier(xbar); if (REPN(99) == 2) xcd_barrier(xbar); \
        if (PROBE_TS >= 0 && bid == 0 && tid == 0) tsbuf[(k) + 1] = __builtin_amdgcn_s_memrealtime(); } } while (0)
#else
#define GRID_SYNC(k) do { } while (0)
#endif
    int* cnt = (int*)(ws + WS_CTL);
    unsigned long long* tsbuf = (unsigned long long*)(ws + WS_CTL + 65536);
    if (PROBE_TS >= 0 && bid == 0 && tid == 0) tsbuf[0] = __builtin_amdgcn_s_memrealtime();
    XcdBarrier xbar; xbar.bar = (unsigned*)(ws + WS_CTL) + 4096; xbar.x = xb_xcc_id(); xbar.st = (volatile LAS unsigned*)(lds + LDS_BYTES - 64);
    if (tid < 2) xbar.st[tid] = 0u;
    __syncthreads();
    if (tid == 0) (void)xb_add(&xbar.bar[XB_XCNT(xbar.x)], 1u);
    if (args.ph_lo < 0) grid.sync();
    float* mod = (float*)(ws + WS_MOD);
    float* z2 = (float*)(ws + WS_Z2);
    float* ssq = (float*)(ws + WS_SSQ);
    int* tok_e = (int*)(ws + WS_ROUTE); int* tok_rank = tok_e + 2 * NTOK; float* tok_w = (float*)(tok_rank + 2 * NTOK); int* tok_slot = (int*)(tok_w + 2 * NTOK);
    bf16* rgproj_t = (bf16*)(ws + WS_WSMALL); bf16* hyproj_t = rgproj_t + 1024 * 1024; bf16* wout_t = hyproj_t + 1024 * 1024;
    bf16* win_t = (bf16*)(ws + WS_WIN);
    bf16* hx = (bf16*)(ws + WS_HX); bf16* yhy = (bf16*)(ws + WS_HX); bf16* Hbuf = (bf16*)(ws + WS_HX);
    bf16* prx = (bf16*)(ws + WS_PRX); bf16* merged = (bf16*)(ws + WS_PRX);
    bf16* grg = (bf16*)(ws + WS_GRG); bf16* x1 = (bf16*)(ws + WS_GRG);
    bf16* phyT = (bf16*)(ws + WS_PHY);
    bf16* w13t = (bf16*)(ws + WS_W13); bf16* w2t = (bf16*)(ws + WS_W2);
    bf16* Xg = (bf16*)(ws + WS_XG); bf16* Ybuf = (bf16*)(ws + WS_XG);
    float* kf = (float*)(ws + WS_KF); bf16* yrg = (bf16*)(ws + WS_KF);
    f32x2* carr = (f32x2*)(ws + WS_CARR); float* cin = (float*)(ws + WS_CIN);
    bf16* gates = (bf16*)args.out;
    bf16* hx2 = (bf16*)args.out;

    if (IN(0)) for (int rp = 0; rp < REPN(0); ++rp) {
        if (bid == 0) for (int i = tid; i < 1024; i += NTHREADS) cnt[i] = 0;
        const int nA = (G >= 192) ? 96 : 0; const bool doA = (nA == 0) || (bid < nA), doB = (nA == 0) || (bid >= nA);
        const int ob = bid - nA, OG = G - nA, ogw = ob * NWAVES + wave, ONGW = OG * NWAVES;
        if (doA) {
            LAS float* red = (LAS float*)lds;
            const float* c = args.in[I_C]; const float* cctx = args.in[I_CCTX]; const float* ada_w = args.in[I_ADAW]; const float* ada_b = args.in[I_ADAB];
            LAS float* sil = red + 8 * 5 * 64;
            for (int i = tid; i < 5 * 1024; i += NTHREADS) { const float cv = (i < 4096) ? c[i] : cctx[i - 4096]; sil[i] = cv * sigmoidf_(cv); }
            __syncthreads();
            for (int g = bid; g < 96; g += (nA ? nA : G)) {
                const int n = g * 64 + lane; float acc[5] = {0.f, 0.f, 0.f, 0.f, 0.f};
                for (int kk = 0; kk < 128; kk += 16) { float a[16];
#pragma unroll
                    for (int u = 0; u < 16; ++u) a[u] = __builtin_nontemporal_load(ada_w + (size_t)(wave * 128 + kk + u) * 6144 + n);
#pragma unroll
                    for (int u = 0; u < 16; ++u) { const int k = wave * 128 + kk + u;
#pragma unroll
                        for (int r = 0; r < 5; ++r) acc[r] += sil[r * 1024 + k] * a[u]; } }
#pragma unroll
                for (int r = 0; r < 5; ++r) red[(wave * 5 + r) * 64 + lane] = acc[r];
                __syncthreads();
                if (wave == 0) {
#pragma unroll
                    for (int r = 0; r < 5; ++r) { float s = ada_b[n]; for (int w = 0; w < 8; ++w) s += red[(w * 5 + r) * 64 + lane]; mod[r * 6144 + n] = s; } }
                __syncthreads();
            }
        }
        if (doB) {
            LAS float* fe = (LAS float*)lds + wave * 128; LAS float* z1 = fe + 64;
            const float* w1 = args.in[I_PW1]; const float* b1 = args.in[I_PB1]; const float* w2 = args.in[I_PW2]; const float* b2 = args.in[I_PB2]; const float* fr = args.in[I_FREQ];
            const float TWO_PI = 6.283185307179586f;
            float w1c[50], w2c[64];
#pragma unroll
            for (int i = 0; i < 50; ++i) w1c[i] = w1[i * 64 + lane];
#pragma unroll
            for (int i = 0; i < 64; ++i) w2c[i] = w2[i * 64 + lane];
            const float b1l = b1[lane], b2l = b2[lane], frl = fr[lane];
            for (int s = ogw; s < SEQ; s += ONGW) {
                float f = 0.f; const float sf = (float)s;
                if (lane == 0) f = sf / 8191.f;
                else if (lane <= 32) { const int j = (lane - 1) & 15; const float band = 1e-4f + (float)j * ((15.f - 1e-4f) / 15.f); float rev = sf * band * (1.f / 8192.f); rev -= floorf(rev + 0.5f);
                    f = (lane <= 16) ? cosf(TWO_PI * rev) : sinf(TWO_PI * rev); }
                else if (lane == 33) f = (float)(s >> 6) / 128.f;
                else if (lane <= 49) { const int mm = (lane <= 41) ? (lane - 33) : (lane - 41); float rev = (float)((s & 63) * mm) * (1.f / 64.f); rev -= floorf(rev + 0.5f);
                    f = (lane <= 41) ? cosf(TWO_PI * rev) : sinf(TWO_PI * rev); }
                fe[lane] = f; LDS_WAIT(); asm volatile("" ::: "memory");
                float a = b1l;
#pragma unroll
                for (int i = 0; i < 50; ++i) a += fe[i] * w1c[i];
                z1[lane] = sinf(frl * a); LDS_WAIT(); asm volatile("" ::: "memory");
                float a2 = b2l;
#pragma unroll
                for (int i = 0; i < 64; ++i) a2 += z1[i] * w2c[i];
                z2[(size_t)s * 64 + lane] = sinf(frl * a2);
                LDS_WAIT(); asm volatile("" ::: "memory");
            }
        }
        __syncthreads();
        if (doB) {
            LAS float* scr = (LAS float*)lds + wave * 4160;
            constexpr int I_IN = 16 * 112, I_SQ = 16 * 16;
            constexpr int NITEMS = I_IN + 3 * I_SQ;
            for (int it = ogw; it < NITEMS; it += ONGW) {
                int r = it;
                if (r < I_IN) { transpose_item(args.in[I_WIN], 1024, INC, win_t, 0, scr, r, lane); continue; } r -= I_IN;
                if (r < I_SQ) { transpose_item(args.in[I_RGPROJ], 1024, 1024, rgproj_t, 0, scr, r, lane); continue; } r -= I_SQ;
                if (r < I_SQ) { transpose_item(args.in[I_HYPROJ], 1024, 1024, hyproj_t, 0, scr, r, lane); continue; } r -= I_SQ;
                transpose_item(args.in[I_WOUT], 1024, 1024, wout_t, 0, scr, r, lane);
            }
        }
        if (doB) {
            bf16* wrh = (bf16*)(ws + 28 * MiB); bf16* wrl = wrh + 48 * 1024;
            for (int i = ob * NTHREADS + tid; i < 48 * 1024; i += OG * NTHREADS) { const int n = i >> 10, k = i & 1023;
                const float w = (n < 4) ? args.in[I_WG][k * 4 + n] : (n < 36) ? args.in[I_WE][k * 32 + (n - 4)] : 0.f;
                const unsigned h = pk2(w, 0.f) & 0xffffu; wrh[i] = (bf16)h; wrl[i] = (bf16)(pk2(w - bf2f(h), 0.f) & 0xffffu); }
        }
        if (doB) {
            bf16* wgt = (bf16*)(ws + WS_GATEW);
            for (int i = ob * NTHREADS + tid; i < 4 * 65536; i += OG * NTHREADS) { const int gi = i >> 16, r = i & 65535, hh = r >> 12, e = (r >> 6) & 63, d = r & 63;
                const float* src = gi == 0 ? args.in[I_WAF] : gi == 1 ? args.in[I_WXF] : gi == 2 ? args.in[I_WAB] : args.in[I_WXB];
                wgt[i] = (bf16)f2bf(src[hh * 4096 + d * 64 + e]); }
        }
    }
    GRID_SYNC(0);

    if (IN(1)) for (int rp = 0; rp < REPN(1); ++rp) {
        const float* x = args.in[I_X]; const float* ctx = args.in[I_CTX]; const float* n1g = args.in[I_N1G];
        f32x4 n1v[4];
#pragma unroll
        for (int j = 0; j < 4; ++j) n1v[j] = *(const f32x4*)(n1g + 4 * (64 * j + lane));
        for (int m0 = 2 * gw; m0 < MROWS; m0 += 2 * NGW) {
            f32x4 v[2][4]; float ss[2] = {0.f, 0.f};
#pragma unroll
            for (int u = 0; u < 2; ++u) { const int m = m0 + u; const float* xr = (m < NTOK) ? x + (size_t)m * 1024 : ctx + (size_t)(m - NTOK) * 1024;
#pragma unroll
                for (int j = 0; j < 4; ++j) v[u][j] = __builtin_nontemporal_load((const f32x4*)xr + 64 * j + lane); }
#pragma unroll
            for (int u = 0; u < 2; ++u)
#pragma unroll
                for (int j = 0; j < 4; ++j) ss[u] += (v[u][j][0] * v[u][j][0] + v[u][j][1] * v[u][j][1]) + (v[u][j][2] * v[u][j][2] + v[u][j][3] * v[u][j][3]);
#pragma unroll
            for (int u = 0; u < 2; ++u) { const int m = m0 + u; const int r = (m < NTOK) ? (m >> 13) : 4; const float* sh = mod + r * 6144; const float* sc = sh + 1024;
                const float rstd = rsqrtf(wave_sum(ss[u]) * (1.f / 1024.f) + 1e-6f);
#pragma unroll
                for (int j = 0; j < 4; ++j) { const int k = 4 * (64 * j + lane); const f32x4 g = n1v[j], s_ = *(const f32x4*)(sc + k), h = *(const f32x4*)(sh + k);
                    const f32x4 o = v[u][j] * rstd * g * (1.f + s_) + h; *(u32x2*)(hx + (size_t)m * 1024 + k) = pack4(o); } }
        }
        {
            LAS float* w3s = (LAS float*)lds;
            LAS float* z2t = w3s + 64 * 256;
            const float* w3 = args.in[I_PW3];
            const int sg = tid & 7, cgp = tid >> 3;
            int c0cur = -1;
            for (int it = bid; it < 8 * 128; it += G) {
                const int s0 = (it >> 3) * 64, c0 = (it & 7) * 256;
                __syncthreads();
                for (int e = tid; e < 64 * 64; e += NTHREADS) { const int r = e >> 6, jj = e & 63; z2t[jj * 68 + r] = z2[(size_t)(s0 + r) * 64 + jj]; }
                if (c0 != c0cur) { c0cur = c0;
                    for (int e = tid; e < 64 * 64; e += NTHREADS) { const int jj = e >> 6, c4 = e & 63; *(LAS f32x4*)(w3s + jj * 256 + 4 * c4) = *(const f32x4*)(w3 + (size_t)jj * 2048 + c0 + 4 * c4); } }
                __syncthreads();
                float acc[4][8];
#pragma unroll
                for (int a = 0; a < 4; ++a)
#pragma unroll
                    for (int q = 0; q < 8; ++q) acc[a][q] = 0.f;
#pragma unroll 4
                for (int jj = 0; jj < 64; ++jj) { const f32x4 w = *(const LAS f32x4*)(w3s + jj * 256 + 4 * cgp); const f32x4 za = *(const LAS f32x4*)(z2t + jj * 68 + 8 * sg), zb = *(const LAS f32x4*)(z2t + jj * 68 + 8 * sg + 4);
#pragma unroll
                    for (int a = 0; a < 4; ++a) { acc[a][0] += w[a] * za[0]; acc[a][1] += w[a] * za[1]; acc[a][2] += w[a] * za[2]; acc[a][3] += w[a] * za[3];
                        acc[a][4] += w[a] * zb[0]; acc[a][5] += w[a] * zb[1]; acc[a][6] += w[a] * zb[2]; acc[a][7] += w[a] * zb[3]; } }
                const float mind = -3.0701134573253944f, maxd = -15.350567286626972f;
#pragma unroll
                for (int a = 0; a < 4; ++a) { const int cp = c0 + 4 * cgp + a, ch = cp & 1023; const float delta = fabsf(mind + (float)ch * ((maxd - mind) / 1023.f));
                    f32x4 o0, o1;
#pragma unroll
                    for (int q = 0; q < 4; ++q) { o0[q] = acc[a][q] * __expf(-((float)(s0 + 8 * sg + q) / 8191.f) * delta); o1[q] = acc[a][4 + q] * __expf(-((float)(s0 + 8 * sg + 4 + q) / 8191.f) * delta); }
                    *(f32x4*)(kf + (size_t)cp * SEQ + s0 + 8 * sg) = o0; *(f32x4*)(kf + (size_t)cp * SEQ + s0 + 8 * sg + 4) = o1; }
            }
        }
    }
    GRID_SYNC(1);

    if (IN(2)) {
        { SchedInA S{(const char*)hx, (const char*)win_t, G, bid}; EpiInA E{prx, grg, gates}; pg8::gemm_phase(lds, 1024, S, E); }
        { SchedInB S{(const char*)hx, (const char*)win_t, G, bid}; EpiInB E{phyT}; pg8::gemm_phase(lds, 1024, S, E); }
    }
    GRID_SYNC(2);

    const ScanW SW{prx, grg, yrg, args.in[I_RGCW], args.in[I_RGCB], (const bf16*)(ws + WS_GATEW), args.in[I_BAF], args.in[I_BXF], args.in[I_LAMF], args.in[I_BAB], args.in[I_BXB], args.in[I_LAMB], carr, cin};
    if (IN(3)) {
        for (int rp = 0; rp < REPN(3); ++rp) scan_phase<1>(lds, SW, bid, G, NBATCH * NCHUNK * 16, tid, lane, wave);
        __syncthreads();
        {
            LAS cpx* X = (LAS cpx*)lds;
            LAS cpx* TWA = (LAS cpx*)(lds + 139264); LAS cpx* TWB = TWA + 512;
            for (int i = tid; i < 512 + 16; i += NTHREADS) { const float fr_ = (i < 512) ? (float)i * (1.f / 8192.f) : (float)(i - 512) * (1.f / 256.f);
                float sn, cs; sincospif(-fr_, &sn, &cs); TWA[i] = (cpx){cs, sn}; }
            __syncthreads();
            cpx* Kb = (cpx*)(ws + WS_HX) + (size_t)bid * 16384;
            unsigned* SX = (unsigned*)(ws + WS_HX + 32 * MiB) + (size_t)bid * 16384;
            const float* hcw = args.in[I_HYCW]; const float* hcb = args.in[I_HYCB]; const float* skip = args.in[I_SKIP];
            for (int rp = 0; rp < REPN(30); ++rp)
            for (int c = bid; c < 1024; c += G) {
                LDS_BARRIER();
                fft_fwd32A_filter(X, TWA, kf + (size_t)c * SEQ, kf + (size_t)(1024 + c) * SEQ, tid); LDS_BARRIER();
                fft_fwd32B(X, TWB, tid); LDS_BARRIER();
                fft_fwdD_toK(X, Kb, tid);
                const float w00 = hcw[c], w01 = hcw[3072 + c], w02 = hcw[6144 + c], b0 = hcb[c];
                const float w10 = hcw[1024 + c], w11 = hcw[3072 + 1024 + c], w12 = hcw[6144 + 1024 + c], b1 = hcb[1024 + c];
                const float w20 = hcw[2048 + c], w21 = hcw[3072 + 2048 + c], w22 = hcw[6144 + 2048 + c], b2 = hcb[2048 + c];
                const float sk = skip[c];
                for (int pair = 0; pair < 2; ++pair) {
                    const bf16* rA = phyT + ((size_t)(2 * pair) * 3072 + c) * SEQ; const bf16* rB = rA + (size_t)3072 * SEQ;
                    if (pair == 0) __syncthreads(); else LDS_BARRIER();
                    { int tb = tid; asm volatile("" : "+v"(tb));
                        Raw10 ra[2][6];
#pragma unroll
                        for (int it = 0; it < 2; ++it) { const int t0 = 8 * (tb + 512 * it);
                            load10_issue(ra[it][0], rA, t0); load10_issue(ra[it][1], rA + (size_t)1024 * SEQ, t0); load10_issue(ra[it][2], rA + (size_t)2048 * SEQ, t0);
                            load10_issue(ra[it][3], rB, t0); load10_issue(ra[it][4], rB + (size_t)1024 * SEQ, t0); load10_issue(ra[it][5], rB + (size_t)2048 * SEQ, t0); }
#pragma unroll
                        for (int it = 0; it < 2; ++it) { const int t0 = 8 * (tb + 512 * it); float p0[10], p1[10], p2[10], ua[8], ub[8]; unsigned qa[8], qb[8];
                            load10_finish(ra[it][0], p0); load10_finish(ra[it][1], p1); load10_finish(ra[it][2], p2);
#pragma unroll
                            for (int k = 0; k < 8; ++k) { ua[k] = (b2 + w20 * p2[k] + w21 * p2[k + 1] + w22 * p2[k + 2]) * (b1 + w10 * p1[k] + w11 * p1[k + 1] + w12 * p1[k + 2]);
                                const float x0 = b0 + w00 * p0[k] + w01 * p0[k + 1] + w02 * p0[k + 2]; qa[k] = pk2(x0, sk * ua[k] * x0); }
                            load10_finish(ra[it][3], p0); load10_finish(ra[it][4], p1); load10_finish(ra[it][5], p2);
#pragma unroll
                            for (int k = 0; k < 8; ++k) { ub[k] = (b2 + w20 * p2[k] + w21 * p2[k + 1] + w22 * p2[k + 2]) * (b1 + w10 * p1[k] + w11 * p1[k + 1] + w12 * p1[k + 2]);
                                const float x0 = b0 + w00 * p0[k] + w01 * p0[k + 1] + w02 * p0[k + 2]; qb[k] = pk2(x0, sk * ub[k] * x0); }
                            *(u32x4*)(SX + t0) = (u32x4){qa[0], qa[1], qa[2], qa[3]}; *(u32x4*)(SX + t0 + 4) = (u32x4){qa[4], qa[5], qa[6], qa[7]};
                            *(u32x4*)(SX + SEQ + t0) = (u32x4){qb[0], qb[1], qb[2], qb[3]}; *(u32x4*)(SX + SEQ + t0 + 4) = (u32x4){qb[4], qb[5], qb[6], qb[7]};
                            const int pb = pidx(t0);
#pragma unroll
                            for (int k = 0; k < 8; ++k) X[pb + k] = (cpx){ua[k], ub[k]}; } }
                    LDS_BARRIER();
                    fft_fwd32A<16>(X, TWA, tid); LDS_BARRIER();
                    fft_fwd32B(X, TWB, tid); LDS_BARRIER();
                    fft_fusedD(X, Kb, tid); LDS_BARRIER();
                    fft_inv32B(X, TWB, tid); __syncthreads();
                    fft_inv32A_final(X, TWA, tid, SX, (bf16*)rA, (bf16*)rB, rp == REPN(30) - 1);
                }
            }
        }
    }
    GRID_SYNC(3);

    if (IN(4)) for (int rp = 0; rp < REPN(4); ++rp) {
        const int gt = bid * NTHREADS + tid;
        if (gt < NBATCH * 2 * 1024) {
            const int c = gt & 1023, dir = (gt >> 10) & 1, b = gt >> 11; float s_ = 0.f;
            const size_t cbase = (size_t)(b * NCHUNK) * 2048 + dir * 1024 + c;
#pragma unroll 1
            for (int q0 = 0; q0 < NCHUNK; q0 += 33) { f32x2 ab[33];
#pragma unroll
                for (int u = 0; u < 33; ++u) { const int q = q0 + u; const int j = dir == 0 ? q : (q < 4 ? 3 - q : NCHUNK + 3 - q); ab[u] = __builtin_nontemporal_load(carr + cbase + (size_t)j * 2048); }
#pragma unroll
                for (int u = 0; u < 33; ++u) { const int q = q0 + u; const int j = dir == 0 ? q : (q < 4 ? 3 - q : NCHUNK + 3 - q); cin[cbase + (size_t)j * 2048] = s_; s_ = ab[u].x * s_ + ab[u].y; } }
        }
    }
    GRID_SYNC(4);

    if (IN(5)) {
        for (int rp = 0; rp < REPN(5); ++rp) scan_phase<2>(lds, SW, bid, G, NBATCH * 128 * 16, tid, lane, wave);
        __syncthreads();
        {
            LAS bf16* T = (LAS bf16*)lds;
            for (int rp = 0; rp < REPN(50); ++rp)
            for (int it = bid; it < NBATCH * 16 * 32; it += G) {
                const int tb4 = it & 31, cb = (it >> 5) & 15, b = it >> 9;
                const int cl = tid >> 3, ch = tid & 7;
                u32x4 v[4];
#pragma unroll
                for (int q = 0; q < 4; ++q) v[q] = *(const u32x4*)(phyT + ((size_t)b * 3072 + cb * 64 + cl) * SEQ + (tb4 * 4 + q) * 64 + ch * 8);
                __syncthreads();
#pragma unroll
                for (int q = 0; q < 4; ++q) *(LAS u32x4*)(T + q * 4608 + cl * 72 + ch * 8) = v[q];
                __syncthreads();
#pragma unroll
                for (int q = 0; q < 4; ++q) { const int tl = tid >> 3; unsigned w[8];
#pragma unroll
                    for (int e = 0; e < 8; ++e) w[e] = T[q * 4608 + (ch * 8 + e) * 72 + tl];
                    u32x4 o; o.x = w[0] | (w[1] << 16); o.y = w[2] | (w[3] << 16); o.z = w[4] | (w[5] << 16); o.w = w[6] | (w[7] << 16);
                    *(u32x4*)(yhy + (size_t)(b * SEQ + (tb4 * 4 + q) * 64 + tl) * 1024 + cb * 64 + ch * 8) = o; }
            }
        }
    }
    GRID_SYNC(5);

    if (IN(6)) for (int rp = 0; rp < REPN(6); ++rp) {
        SchedMerge S{(const char*)yrg, (const char*)yhy, (const char*)rgproj_t, (const char*)hyproj_t, G, bid}; EpiMerge E{gates, merged};
        pg8::gemm_phase(lds, 1024, S, E);
    }
    GRID_SYNC(6);

    if (IN(7)) {
        SchedOut S{(const char*)merged, (const char*)wout_t, G, bid}; EpiOut E{args.in[I_X], mod, x1, ssq};
        pg8::gemm_phase(lds, 1024, S, E);
    }
    GRID_SYNC(7);

    if (IN(8)) {
        {
            LAS bf16* XH = (LAS bf16*)lds;
            LAS bf16* XL = XH + 128 * 72;
            LAS bf16* WH = XL + 128 * 72;
            LAS bf16* WLo = WH + 48 * 72;
            LAS float* LG = (LAS float*)(WLo + 48 * 72);
            LAS float* RS = LG + 128 * 49;
            LAS int* LCNT = (LAS int*)(RS + 128); LAS int* LBASE = LCNT + 32;
            const float* n2g = args.in[I_N2G]; const float* bg = args.in[I_BG]; const float* be = args.in[I_BE];
            const bf16* wrh = (const bf16*)(ws + 28 * MiB); const bf16* wrl = wrh + 48 * 1024;
            int nrep8 = REPN(8); asm volatile("" : "+s"(nrep8));
_Pragma("unroll 1")
            for (int rp = 0; rp < nrep8; ++rp)
            for (int tile = bid; tile < NTOK / 128; tile += G) {
                const int R0 = tile * 128; const int b = R0 >> 13; const float* sh = mod + b * 6144 + 3072; const float* sc = sh + 1024;
                __syncthreads();
                if (tid < 128) { const float* sp = ssq + (size_t)(R0 + tid) * 16; float ss = 0.f; for (int q = 0; q < 16; ++q) ss += sp[q]; RS[tid] = rsqrtf(ss * (1.f / 1024.f) + 1e-6f); }
                if (tid < 32) LCNT[tid] = 0;
                int ea_ = 0, eb_ = 0, la_ = 0, lb_ = 0; float wa_ = 0.f, wb_ = 0.f;
                __syncthreads();
                f32x4 lacc[3];
#pragma unroll
                for (int c = 0; c < 3; ++c) lacc[c] = (f32x4){0.f, 0.f, 0.f, 0.f};
                const int lrow = tid >> 2, lq = tid & 3; const float rstd = RS[lrow];
                const int mg = lane >> 4, mli = lane & 15;
#pragma unroll 1
                for (int kc = 0; kc < 16; ++kc) {
                    const int k0 = kc * 64 + lq * 16;
                    f32x4 o[4], xin[4];
                    unpack8(*(const u32x4*)(x1 + (size_t)(R0 + lrow) * 1024 + k0), xin[0], xin[1]); unpack8(*(const u32x4*)(x1 + (size_t)(R0 + lrow) * 1024 + k0 + 8), xin[2], xin[3]);
#pragma unroll
                    for (int i = 0; i < 4; ++i) { const int k = k0 + 4 * i; const f32x4 v = xin[i];
                        const f32x4 g = *(const f32x4*)(n2g + k), s_ = *(const f32x4*)(sc + k), hh = *(const f32x4*)(sh + k); o[i] = v * rstd * g * (1.f + s_) + hh; }
                    unsigned hi[8], lo[8];
#pragma unroll
                    for (int i = 0; i < 4; ++i)
#pragma unroll
                        for (int q = 0; q < 2; ++q) { const float a0 = o[i][2 * q], a1 = o[i][2 * q + 1]; const unsigned h = pk2(a0, a1); hi[2 * i + q] = h; lo[2 * i + q] = pk2(a0 - bflo(h), a1 - bfhi(h)); }
                    *(u32x4*)(hx2 + (size_t)(R0 + lrow) * 1024 + k0) = (u32x4){hi[0], hi[1], hi[2], hi[3]};
                    *(u32x4*)(hx2 + (size_t)(R0 + lrow) * 1024 + k0 + 8) = (u32x4){hi[4], hi[5], hi[6], hi[7]};
                    u32x4 wph = {0u, 0u, 0u, 0u}, wpl = {0u, 0u, 0u, 0u};
                    if (tid < 384) { wph = *(const u32x4*)(wrh + (size_t)(tid >> 3) * 1024 + kc * 64 + (tid & 7) * 8); wpl = *(const u32x4*)(wrl + (size_t)(tid >> 3) * 1024 + kc * 64 + (tid & 7) * 8); }
                    __syncthreads();
                    *(LAS u32x4*)(XH + lrow * 72 + lq * 16) = (u32x4){hi[0], hi[1], hi[2], hi[3]}; *(LAS u32x4*)(XH + lrow * 72 + lq * 16 + 8) = (u32x4){hi[4], hi[5], hi[6], hi[7]};
                    *(LAS u32x4*)(XL + lrow * 72 + lq * 16) = (u32x4){lo[0], lo[1], lo[2], lo[3]}; *(LAS u32x4*)(XL + lrow * 72 + lq * 16 + 8) = (u32x4){lo[4], lo[5], lo[6], lo[7]};
                    if (tid < 384) { *(LAS u32x4*)(WH + (tid >> 3) * 72 + (tid & 7) * 8) = wph; *(LAS u32x4*)(WLo + (tid >> 3) * 72 + (tid & 7) * 8) = wpl; }
                    __syncthreads();
#pragma unroll
                    for (int ks = 0; ks < 2; ++ks) { const bf16x8 aH = *(const LAS bf16x8*)(XH + (wave * 16 + mli) * 72 + ks * 32 + mg * 8), aL = *(const LAS bf16x8*)(XL + (wave * 16 + mli) * 72 + ks * 32 + mg * 8);
#pragma unroll
                        for (int nt = 0; nt < 3; ++nt) { const bf16x8 bH = *(const LAS bf16x8*)(WH + (nt * 16 + mli) * 72 + ks * 32 + mg * 8), bL = *(const LAS bf16x8*)(WLo + (nt * 16 + mli) * 72 + ks * 32 + mg * 8);
                            lacc[nt] = __builtin_amdgcn_mfma_f32_16x16x32_bf16(aH, bH, lacc[nt], 0, 0, 0); lacc[nt] = __builtin_amdgcn_mfma_f32_16x16x32_bf16(aL, bH, lacc[nt], 0, 0, 0);
                            lacc[nt] = __builtin_amdgcn_mfma_f32_16x16x32_bf16(aH, bL, lacc[nt], 0, 0, 0); } }
                }
#pragma unroll
                for (int nt = 0; nt < 3; ++nt)
#pragma unroll
                    for (int r = 0; r < 4; ++r) LG[(wave * 16 + 4 * mg + r) * 49 + nt * 16 + mli] = lacc[nt][r];
                __syncthreads();
                if (tid < 128) {
                    float lg[36];
#pragma unroll
                    for (int c = 0; c < 36; ++c) lg[c] = LG[tid * 49 + c] + (c < 4 ? bg[c] : be[c - 4]);
                    int grp = 0; float gm = lg[0];
#pragma unroll
                    for (int q = 1; q < 4; ++q) if (lg[q] > gm) { gm = lg[q]; grp = q; }
                    float den = 0.f;
#pragma unroll
                    for (int q = 0; q < 4; ++q) den += __expf(lg[q] - gm);
                    const float pg = 1.f / den;
                    float ep[8];
#pragma unroll
                    for (int q = 0; q < 8; ++q) ep[q] = grp == 0 ? lg[4 + q] : grp == 1 ? lg[12 + q] : grp == 2 ? lg[20 + q] : lg[28 + q];
                    int i1 = 0; float v1 = ep[0];
#pragma unroll
                    for (int q = 1; q < 8; ++q) if (ep[q] > v1) { v1 = ep[q]; i1 = q; }
                    int i2 = -1; float v2 = -3.0e38f;
#pragma unroll
                    for (int q = 0; q < 8; ++q) if (q != i1 && ep[q] > v2) { v2 = ep[q]; i2 = q; }
                    const float e2 = __expf(v2 - v1); const float p1 = 1.f / (1.f + e2), p2 = e2 / (1.f + e2);
                    ea_ = grp * 8 + i1; eb_ = grp * 8 + i2; wa_ = pg * p1; wb_ = pg * p2;
                    la_ = __hip_atomic_fetch_add(LCNT + ea_, 1, __ATOMIC_RELAXED, __HIP_MEMORY_SCOPE_WORKGROUP); lb_ = __hip_atomic_fetch_add(LCNT + eb_, 1, __ATOMIC_RELAXED, __HIP_MEMORY_SCOPE_WORKGROUP);
                }
                __syncthreads();
                if (tid < 32 && rp == nrep8 - 1) LBASE[tid] = atomicAdd(cnt + 32 * tid, LCNT[tid]);
                __syncthreads();
                if (tid < 128 && rp == nrep8 - 1) { const int m = R0 + tid;
                    tok_e[2 * m] = ea_; tok_e[2 * m + 1] = eb_; tok_rank[2 * m] = LBASE[ea_] + la_; tok_rank[2 * m + 1] = LBASE[eb_] + lb_; tok_w[2 * m] = wa_; tok_w[2 * m + 1] = wb_; }
            }
        }
        __syncthreads();
        {
            LAS float* scr = (LAS float*)lds + wave * 4160;
            constexpr int I_E13 = 16 * 8, I_E2 = 8 * 16;
            constexpr int NITEMS = NEXP * (2 * I_E13);
            (void)I_E2;
            for (int rp = 0; rp < REPN(80); ++rp)
            for (int it = gw; it < NITEMS; it += NGW) {
                const int e = it / (2 * I_E13); int r = it % (2 * I_E13);
                if (r < I_E13) { transpose_item(args.in[I_MW1] + (size_t)e * 1024 * 512, 1024, 512, w13t + (size_t)e * 1024 * 1024, 1, scr, r, lane); continue; } r -= I_E13;
                transpose_item(args.in[I_MW3] + (size_t)e * 1024 * 512, 1024, 512, w13t + (size_t)e * 1024 * 1024, 2, scr, r, lane);
            }
        }
    }
    GRID_SYNC(8);

    LAS int* blk_exp = (LAS int*)(lds + MISC_OFF); LAS int* pstart = blk_exp + 320; LAS int* ecnt = pstart + 40;
    int* row_tok = (int*)(ws + WS_GATEW + 512 * 1024);
    int nblk = 0;
    if (hi > 9 && lo <= 11) {
        __syncthreads();
        if (tid == 0) { int p = 0; for (int e = 0; e < NEXP; ++e) { const int c_ = __hip_atomic_load(cnt + 32 * e, __ATOMIC_RELAXED, __HIP_MEMORY_SCOPE_AGENT); const int nb = (c_ + 255) >> 8; pstart[e] = p * 256; ecnt[e] = c_; for (int q = 0; q < nb; ++q) blk_exp[p + q] = e; p += nb; } pstart[32] = p; }
        __syncthreads();
        nblk = pstart[32];
    }

    if (IN(9)) for (int rp = 0; rp < REPN(9); ++rp) {
        const int gt = bid * NTHREADS + tid, GT = G * NTHREADS;
        for (int a = gt; a < 2 * NTOK; a += GT) { const int e = tok_e[a], rk = tok_rank[a]; const int slot = pstart[e] + rk; tok_slot[a] = slot; row_tok[slot] = a >> 1; }
        for (int r = gt; r < nblk * 256; r += GT) { const int e = blk_exp[r >> 8]; if (r - pstart[e] >= ecnt[e]) row_tok[r] = 0; }
    }
    GRID_SYNC(9);

    if (IN(10)) for (int rp = 0; rp < REPN(10); ++rp) {
        const int units = nblk * 4, rounds = (units + G - 1) / G; int need = rounds > 0 ? (units + rounds - 1) / rounds : G; if (G - need < 8) need = G;
        const int nsp = G - need;
        if (bid >= need || nsp == 0) {
            LAS float* scr = (LAS float*)lds + wave * 4160; constexpr int I_W2 = 8 * 16;
            const int w0 = (nsp ? (bid - need) : bid) * NWAVES + wave, nw = (nsp ? nsp : G) * NWAVES;
            for (int it = w0; it < NEXP * I_W2; it += nw) { const int e = it / I_W2, r = it % I_W2;
                transpose_item(args.in[I_MW2] + (size_t)e * 512 * 1024, 512, 1024, w2t + (size_t)e * 1024 * 512, 0, scr, r, lane); }
            __syncthreads();
        }
        if (bid < need) {
            SchedMoeUp S{(const char*)hx2, (const char*)w13t, blk_exp, row_tok, nblk, need, bid}; EpiMoeUp E{Hbuf};
            pg8::gemm_phase<EpiMoeUp, SchedMoeUp, true>(lds, 1024, S, E);
        }
    }
    GRID_SYNC(10);

    if (IN(11)) for (int rp = 0; rp < REPN(11); ++rp) {
        SchedMoeDown S{(const char*)Hbuf, (const char*)w2t, blk_exp, nblk, G, bid}; EpiMoeDown E{Ybuf};
        pg8::gemm_phase(lds, 512, S, E);
    }
    GRID_SYNC(11);

    if (IN(12)) {
        const float* fg = args.in[I_FG];
        f32x4 fgv[4];
#pragma unroll
        for (int j = 0; j < 4; ++j) fgv[j] = *(const f32x4*)(fg + 4 * (64 * j + lane));
        int nrep12 = REPN(12); asm volatile("" : "+s"(nrep12));
_Pragma("unroll 1")
        for (int rp = 0; rp < nrep12; ++rp)
        for (int m0 = 2 * gw; m0 < NTOK; m0 += 2 * NGW) {
            f32x4 v[2][4]; float ss[2] = {0.f, 0.f};
#pragma unroll
            for (int u = 0; u < 2; ++u) { const int m = m0 + u; const int b = m >> 13; const float* g2 = mod + b * 6144 + 5120;
                const int sa = tok_slot[2 * m], sb = tok_slot[2 * m + 1]; const float wa = tok_w[2 * m], wb = tok_w[2 * m + 1];
#pragma unroll
                for (int j = 0; j < 4; ++j) { const int k = 4 * (64 * j + lane);
                    const u32x2 ya = *(const u32x2*)(Ybuf + (size_t)sa * 1024 + k), yb = *(const u32x2*)(Ybuf + (size_t)sb * 1024 + k);
                    const f32x4 fa = {bflo(ya.x), bfhi(ya.x), bflo(ya.y), bfhi(ya.y)}, fb = {bflo(yb.x), bfhi(yb.x), bflo(yb.y), bfhi(yb.y)};
                    const u32x2 xw = *(const u32x2*)(x1 + (size_t)m * 1024 + k); const f32x4 xv = {bflo(xw.x), bfhi(xw.x), bflo(xw.y), bfhi(xw.y)}, gv = *(const f32x4*)(g2 + k);
                    v[u][j] = xv + gv * (fa * wa + fb * wb); ss[u] += (v[u][j][0] * v[u][j][0] + v[u][j][1] * v[u][j][1]) + (v[u][j][2] * v[u][j][2] + v[u][j][3] * v[u][j][3]); } }
#pragma unroll
            for (int u = 0; u < 2; ++u) { const int m = m0 + u; const float rstd = rsqrtf(wave_sum(ss[u]) * (1.f / 1024.f) + 1e-6f);
#pragma unroll
                for (int j = 0; j < 4; ++j) { const int k = 4 * (64 * j + lane); if (rp == nrep12 - 1) st_nt((f32x4*)(args.out + (size_t)m * 1024 + k), v[u][j] * rstd * fgv[j]); } }
        }
    }
    if (PROBE_TS >= 0) {
        xcd_barrier(xbar);
        if (bid == 0 && tid == 0) tsbuf[13] = __builtin_amdgcn_s_memrealtime();
        xcd_barrier(xbar);
        const int pk_ = PROBE_TS < 0 ? 0 : (PROBE_TS % 100); const int sub_ = PROBE_TS < 0 ? 0 : (PROBE_TS / 100);
        const unsigned long long t0_ = __hip_atomic_load(tsbuf + pk_, __ATOMIC_RELAXED, __HIP_MEMORY_SCOPE_AGENT), t1_ = __hip_atomic_load(tsbuf + pk_ + 1, __ATOMIC_RELAXED, __HIP_MEMORY_SCOPE_AGENT);
        const float binw = sub_ == 1 ? 10.f : 40.f;
        const float us = floorf((float)(t1_ - t0_) * 0.01f / binw + 0.5f); const float vv = sqrtf(1.0025f * us);
        for (size_t i = (size_t)bid * NTHREADS + tid; i < (size_t)NTOK * 1024; i += (size_t)G * NTHREADS) args.out[i] = vv;
    }
}

extern "C" void kernel_launch(void* const* d_in, const int* in_sizes, int n_in, void* d_out, int out_size, void* d_ws, size_t ws_size, hipStream_t stream) {
    static int grid = 0;
    if (grid == 0) {
        if (n_in != 41 || out_size != NTOK * DM || ws_size < WS_END) { fprintf(stderr, "kernel_launch: unexpected shapes (n_in %d, out %d, ws %zu)\n", n_in, out_size, ws_size); grid = -1; return; }
        int dev = 0, cus = 0, per_cu = 0;
        hipGetDevice(&dev); hipDeviceGetAttribute(&cus, hipDeviceAttributeMultiprocessorCount, dev);
        if (hipFuncSetAttribute((const void*)fwd_kernel, hipFuncAttributeMaxDynamicSharedMemorySize, LDS_BYTES) != hipSuccess) { fprintf(stderr, "kernel_launch: hipFuncSetAttribute failed\n"); grid = -1; return; }
        hipOccupancyMaxActiveBlocksPerMultiprocessor(&per_cu, (const void*)fwd_kernel, NTHREADS, LDS_BYTES);
        (void)hipGetLastError();
        if (per_cu < 1) { fprintf(stderr, "kernel_launch: occupancy query says %d blocks per CU\n", per_cu); per_cu = 1; }
        grid = cus;
        fprintf(stderr, "kernel_launch: grid %d (cus %d, per_cu %d)\n", grid, cus, per_cu);
    }
    if (grid < 0) return;
    if (hipMemsetAsync((char*)d_ws + WS_CTL + 4096 * 4, 0, XCD_BAR_WORDS * 4, stream) != hipSuccess) { fprintf(stderr, "kernel_launch: memset failed\n"); return; }
    Args a{};
    for (int i = 0; i < 41; ++i) a.in[i] = (const float*)d_in[i];
    a.out = (float*)d_out; a.ws = (unsigned char*)d_ws;
#if ONE_LAUNCH
    a.ph_lo = 0; a.ph_hi = NPHASE;
    void* kargs[] = {&a};
    hipError_t e = hipLaunchCooperativeKernel((const void*)fwd_kernel, dim3(grid), dim3(NTHREADS), kargs, LDS_BYTES, stream);
    if (e != hipSuccess) fprintf(stderr, "cooperative launch failed: %s (grid %d)\n", hipGetErrorString(e), grid);
#else
    for (int p = 0; p < NPHASE; ++p) { a.ph_lo = p; a.ph_hi = p + 1; hipLaunchKernelGGL(fwd_kernel, dim3(grid), dim3(NTHREADS), LDS_BYTES, stream, a); }
#endif
}
```
